# Optimizing an MI355X kernel written in HIP

```python
import math
import jax
import jax.numpy as jnp
from jax import lax
import numpy as np

D_MODEL = 1024
BATCH = 16
SEQ = 2048
DEPTH = 2

BRANCH_WIDTH = D_MODEL // 2
N_BRANCHES = 5
EPS = 1e-6

SSD_HEAD_DIM = 64
SSD_HEADS = BRANCH_WIDTH // SSD_HEAD_DIM
SSD_GROUPS = 2
SSD_HPG = SSD_HEADS // SSD_GROUPS
SSD_STATE = 128
SSD_CONV = 5
SSD_CHUNK = 128
SSD_CONV_CH = BRANCH_WIDTH + 2 * SSD_GROUPS * SSD_STATE

DIFF_HEADS = 4
DIFF_V_DIM = BRANCH_WIDTH // DIFF_HEADS
DIFF_QK_DIM = DIFF_V_DIM // 2
Q_BLOCK = 128

WIN_HEAD_DIM = 64
WIN_Q_HEADS = BRANCH_WIDTH // WIN_HEAD_DIM
WIN_KV_HEADS = 2
WIN_GROUP = WIN_Q_HEADS // WIN_KV_HEADS
WINDOW = 128
WIN_BLOCK = 128

S5_GROUP_CH = 16
S5_GROUPS = BRANCH_WIDTH // S5_GROUP_CH
S5_STATE = 64
S5_DT_MIN = 1e-3
S5_DT_MAX = 1e-1

MEM_LEN = 256
MEM_HEADS = 4
MEM_HEAD_DIM = BRANCH_WIDTH // MEM_HEADS

REL_BUCKETS = 32
REL_MAX_DIST = 128
REL_HEADS = DIFF_HEADS + WIN_Q_HEADS

IN_SIZES = (SSD_CONV_CH, BRANCH_WIDTH, 2 * SSD_HEADS,
            2 * DIFF_HEADS * DIFF_QK_DIM, 2 * DIFF_HEADS * DIFF_QK_DIM, DIFF_HEADS * DIFF_V_DIM, BRANCH_WIDTH,
            WIN_Q_HEADS * WIN_HEAD_DIM, WIN_KV_HEADS * WIN_HEAD_DIM, WIN_KV_HEADS * WIN_HEAD_DIM, BRANCH_WIDTH,
            BRANCH_WIDTH, BRANCH_WIDTH,
            MEM_HEADS * MEM_HEAD_DIM, BRANCH_WIDTH)
IN_WIDTH = sum(IN_SIZES)

kernel_name = 'hybrid_gated_parallel_encoder'


def _split_points():
    pts, acc = [], 0
    for size in IN_SIZES[:-1]:
        acc += size
        pts.append(acc)
    return pts


def _rmsnorm(x, g):
    xf = x.astype(jnp.float32)
    y = xf * lax.rsqrt(jnp.mean(xf * xf, axis=-1, keepdims=True) + EPS)
    return (y * g.astype(jnp.float32)).astype(x.dtype)


def _t5_bucket(rel):
    half = REL_BUCKETS // 2
    max_exact = half // 2
    n = jnp.abs(rel)
    nf = jnp.maximum(n, 1).astype(jnp.float32)
    large = max_exact + (jnp.log(nf / max_exact) / math.log(REL_MAX_DIST / max_exact)
                         * (half - max_exact)).astype(jnp.int32)
    large = jnp.minimum(large, half - 1)
    return jnp.where(rel > 0, half, 0) + jnp.where(n < max_exact, n, large)


def _segsum(a):
    t = a.shape[-1]
    cs = jnp.cumsum(a, axis=-1)
    seg = cs[..., :, None] - cs[..., None, :]
    return jnp.where(jnp.tril(jnp.ones((t, t), dtype=bool)), seg, -jnp.inf)


def _depthwise_conv(x, w, b):
    k, c = w.shape
    y = lax.conv_general_dilated(x, w[:, None, :].astype(x.dtype), window_strides=(1,),
                                 padding=[(k // 2, k // 2)], dimension_numbers=('NWC', 'WIO', 'NWC'),
                                 feature_group_count=c)
    return y + b.astype(x.dtype)


def _ssd_scan(xs, a, bm, cm):
    b, s, g, r, p = xs.shape
    n = bm.shape[-1]
    l = SSD_CHUNK
    c = s // l
    xs = xs.reshape(b, c, l, g, r, p)
    bm = bm.reshape(b, c, l, g, n)
    cm = cm.reshape(b, c, l, g, n)
    a = a.reshape(b, c, l, g, r).transpose(0, 1, 3, 4, 2)
    a_cs = jnp.cumsum(a, axis=-1)
    decay_in = jnp.exp(_segsum(a))
    cb = jnp.einsum('bclgn,bcsgn->bcgls', cm, bm)
    y_diag = jnp.einsum('bcgls,bcgrls,bcsgrp->bclgrp', cb, decay_in, xs)
    decay_states = jnp.exp(a_cs[..., -1:] - a_cs)
    states = jnp.einsum('bclgn,bcgrl,bclgrp->bcgrpn', bm, decay_states, xs)
    states = jnp.concatenate([jnp.zeros_like(states[:, :1]), states], axis=1)
    a_last = jnp.pad(a_cs[..., -1], ((0, 0), (1, 0), (0, 0), (0, 0)))
    decay_chunk = jnp.exp(_segsum(a_last.transpose(0, 2, 3, 1)))
    states = jnp.einsum('bgrzc,bcgrpn->bzgrpn', decay_chunk, states)[:, :-1]
    y_off = jnp.einsum('bclgn,bcgrpn,bcgrl->bclgrp', cm, states, jnp.exp(a_cs))
    return (y_diag + y_off).reshape(b, s, g, r, p)


def _ssd_branch(xbc, z, dt_raw, conv_w, conv_b, dt_bias, a_log, d_skip, norm_g):
    bsz, s, _ = xbc.shape
    f32 = jnp.float32
    nbc = SSD_GROUPS * SSD_STATE
    xbc = jax.nn.silu(_depthwise_conv(xbc, conv_w, conv_b)).astype(f32)
    xs = xbc[..., :BRANCH_WIDTH].reshape(bsz, s, SSD_GROUPS, SSD_HPG, SSD_HEAD_DIM)
    bm = xbc[..., BRANCH_WIDTH:BRANCH_WIDTH + nbc].reshape(bsz, s, SSD_GROUPS, SSD_STATE)
    cm = xbc[..., BRANCH_WIDTH + nbc:].reshape(bsz, s, SSD_GROUPS, SSD_STATE)
    dt = jax.nn.softplus(dt_raw.astype(f32).reshape(bsz, s, 2, SSD_HEADS) + dt_bias.astype(f32))
    a = -jnp.exp(a_log.astype(f32))
    dt_f = dt[:, :, 0].reshape(bsz, s, SSD_GROUPS, SSD_HPG)
    dt_b = dt[:, :, 1].reshape(bsz, s, SSD_GROUPS, SSD_HPG)
    flip = lambda t: jnp.flip(t, axis=1)
    y_f = _ssd_scan(xs * dt_f[..., None], dt_f * a[0].reshape(SSD_GROUPS, SSD_HPG), bm, cm)
    y_b = flip(_ssd_scan(flip(xs * dt_b[..., None]), flip(dt_b * a[1].reshape(SSD_GROUPS, SSD_HPG)),
                         flip(bm), flip(cm)))
    y = y_f + y_b + d_skip.astype(f32).reshape(SSD_GROUPS, SSD_HPG, 1) * xs
    y = y.reshape(bsz, s, BRANCH_WIDTH)
    return _rmsnorm(y * jax.nn.silu(z.astype(f32)), norm_g).astype(z.dtype)


def _diff_branch(q, k, v, z, lam_params, subln_g, rel_bias, lam_init):
    bsz, s, _ = q.shape
    f32 = jnp.float32
    q = q.reshape(bsz, s, DIFF_HEADS, 2, DIFF_QK_DIM) * (DIFF_QK_DIM ** -0.5)
    k = k.reshape(bsz, s, DIFF_HEADS, 2, DIFF_QK_DIM)
    v = v.reshape(bsz, s, DIFF_HEADS, DIFF_V_DIM)
    lp = lam_params.astype(f32)
    lam = jnp.exp(jnp.sum(lp[0] * lp[1])) - jnp.exp(jnp.sum(lp[2] * lp[3])) + lam_init
    nb = s // Q_BLOCK
    qb = jnp.moveaxis(q.reshape(bsz, nb, Q_BLOCK, DIFF_HEADS, 2, DIFF_QK_DIM), 1, 0)
    k_pos = jnp.arange(s)
    table = rel_bias[:, :DIFF_HEADS].astype(f32)

    def block(args):
        q_blk, i = args
        scores = jnp.einsum('bqhtd,bkhtd->bhtqk', q_blk, k).astype(f32)
        q_pos = i * Q_BLOCK + jnp.arange(Q_BLOCK)
        bias = table[_t5_bucket(k_pos[None, :] - q_pos[:, None])]
        scores = scores + jnp.transpose(bias, (2, 0, 1))[None, :, None]
        p = jax.nn.softmax(scores, axis=-1)
        attn = p[:, :, 0] - lam * p[:, :, 1]
        return jnp.einsum('bhqk,bkhe->bqhe', attn.astype(v.dtype), v)

    o = lax.map(block, (qb, jnp.arange(nb)))
    o = jnp.moveaxis(o, 0, 1).reshape(bsz, s, DIFF_HEADS, DIFF_V_DIM)
    o = _rmsnorm(o, subln_g) * (1.0 - lam_init)
    return o.reshape(bsz, s, BRANCH_WIDTH) * jax.nn.silu(z)


def _window_branch(q, k, v, z, sink, rel_bias):
    bsz, s, _ = q.shape
    f32 = jnp.float32
    nb = s // WIN_BLOCK
    q = q.reshape(bsz, nb, WIN_BLOCK, WIN_KV_HEADS, WIN_GROUP, WIN_HEAD_DIM) * (WIN_HEAD_DIM ** -0.5)

    def band(t):
        t = t.reshape(bsz, s, WIN_KV_HEADS, WIN_HEAD_DIM)
        tp = jnp.pad(t, ((0, 0), (WIN_BLOCK, WIN_BLOCK), (0, 0), (0, 0)))
        tp = tp.reshape(bsz, nb + 2, WIN_BLOCK, WIN_KV_HEADS, WIN_HEAD_DIM)
        return jnp.concatenate([tp[:, :-2], tp[:, 1:-1], tp[:, 2:]], axis=2)

    kb, vb = band(k), band(v)
    scores = jnp.einsum('bnqgrd,bnkgd->bngrqk', q, kb).astype(f32)
    qi = jnp.arange(WIN_BLOCK)[:, None]
    kj = jnp.arange(3 * WIN_BLOCK)[None, :]
    rel = kj - WIN_BLOCK - qi
    bias = rel_bias[:, DIFF_HEADS:].astype(f32)[_t5_bucket(rel)]
    bias = jnp.transpose(bias, (2, 0, 1)).reshape(WIN_KV_HEADS, WIN_GROUP, WIN_BLOCK, 3 * WIN_BLOCK)
    k_glob = jnp.arange(nb)[:, None] * WIN_BLOCK + kj - WIN_BLOCK
    valid = ((jnp.abs(rel) <= WINDOW)[None] & (k_glob >= 0)[:, None, :] & (k_glob < s)[:, None, :])
    scores = jnp.where(valid[None, :, None, None], scores + bias, -jnp.inf)
    sink_l = sink.astype(f32).reshape(WIN_KV_HEADS, WIN_GROUP)[None, None, :, :, None, None]
    m = jnp.maximum(jnp.max(scores, axis=-1, keepdims=True), sink_l)
    p = jnp.exp(scores - m)
    p = p / (jnp.sum(p, axis=-1, keepdims=True) + jnp.exp(sink_l - m))
    o = jnp.einsum('bngrqk,bnkgd->bnqgrd', p.astype(vb.dtype), vb)
    return o.reshape(bsz, s, BRANCH_WIDTH) * jax.nn.silu(z)


def _s5_direction(uf, lr, li, log_dt, b_re, b_im, c_re, c_im, reverse):
    s = uf.shape[1]
    dt = jnp.exp(log_dt)[:, None]
    mag = jnp.exp(lr * dt)
    a_re = mag * jnp.cos(li * dt)
    a_im = mag * jnp.sin(li * dt)
    den = lr * lr + li * li
    f_re = ((a_re - 1.0) * lr + a_im * li) / den
    f_im = (a_im * lr - (a_re - 1.0) * li) / den
    bb_re = f_re[..., None] * b_re - f_im[..., None] * b_im
    bb_im = f_re[..., None] * b_im + f_im[..., None] * b_re
    bu_re = jnp.einsum('bsgc,gpc->bsgp', uf, bb_re)
    bu_im = jnp.einsum('bsgc,gpc->bsgp', uf, bb_im)
    g, p = lr.shape
    a_re_s = jnp.broadcast_to(a_re[None, None], (1, s, g, p))
    a_im_s = jnp.broadcast_to(a_im[None, None], (1, s, g, p))

    def combine(e1, e2):
        a1r, a1i, b1r, b1i = e1
        a2r, a2i, b2r, b2i = e2
        return (a2r * a1r - a2i * a1i, a2r * a1i + a2i * a1r,
                a2r * b1r - a2i * b1i + b2r, a2r * b1i + a2i * b1r + b2i)

    _, _, xr, xi = lax.associative_scan(combine, (a_re_s, a_im_s, bu_re, bu_im), reverse=reverse, axis=1)
    return jnp.einsum('bsgp,gcp->bsgc', xr, c_re) - jnp.einsum('bsgp,gcp->bsgc', xi, c_im)


def _s5_branch(u, z, lam_re, lam_im, log_dt, b_re, b_im, c_re, c_im, d_skip, glu_w, glu_b):
    bsz, s, _ = u.shape
    f32 = jnp.float32
    uf = u.astype(f32).reshape(bsz, s, S5_GROUPS, S5_GROUP_CH)
    lam_re, lam_im, log_dt = lam_re.astype(f32), lam_im.astype(f32), log_dt.astype(f32)
    b_re, b_im, c_re, c_im = b_re.astype(f32), b_im.astype(f32), c_re.astype(f32), c_im.astype(f32)
    y_f = _s5_direction(uf, lam_re[0], lam_im[0], log_dt[0], b_re, b_im, c_re[0], c_im[0], False)
    y_b = _s5_direction(uf, lam_re[1], lam_im[1], log_dt[1], b_re, b_im, c_re[1], c_im[1], True)
    y = y_f + y_b + d_skip.astype(f32).reshape(S5_GROUPS, S5_GROUP_CH) * uf
    g = jax.nn.gelu(y.reshape(bsz, s, BRANCH_WIDTH))
    y = g * jax.nn.sigmoid(g @ glu_w.astype(f32) + glu_b.astype(f32))
    return y.astype(z.dtype) * jax.nn.silu(z)


def _mem_branch(q, z, mk, mv):
    bsz, s, _ = q.shape
    m = mk.shape[1]
    q = q.reshape(bsz, s, MEM_HEADS, MEM_HEAD_DIM) * (MEM_HEAD_DIM ** -0.5)
    mk = mk.reshape(bsz, m, MEM_HEADS, MEM_HEAD_DIM)
    mv = mv.reshape(bsz, m, MEM_HEADS, MEM_HEAD_DIM)
    p = jax.nn.softmax(jnp.einsum('bqhd,bmhd->bhqm', q, mk).astype(jnp.float32), axis=-1)
    o = jnp.einsum('bhqm,bmhd->bqhd', p.astype(mv.dtype), mv)
    return o.reshape(bsz, s, BRANCH_WIDTH) * jax.nn.silu(z)


def setup_inputs(seed: int = 0) -> dict:
    key = jax.random.key(seed)
    ks = iter(jax.random.split(key, 48))
    f32 = jnp.float32
    L = DEPTH
    BW = BRANCH_WIDTH

    def nrm(shape, scale):
        return jax.random.normal(next(ks), shape, f32) * scale

    x = nrm((BATCH, SEQ, D_MODEL), 1.0)
    mem = nrm((BATCH, MEM_LEN, D_MODEL), 1.0)
    rel_bias = nrm((REL_BUCKETS, REL_HEADS), 0.2)
    final_g = 1.0 + nrm((D_MODEL,), 0.02)
    norm_g = 1.0 + nrm((L, D_MODEL), 0.02)
    w_in = nrm((L, D_MODEL, IN_WIDTH), D_MODEL ** -0.5)
    ssd_conv_w = nrm((L, SSD_CONV, SSD_CONV_CH), SSD_CONV ** -0.5)
    ssd_conv_b = nrm((L, SSD_CONV_CH), 0.02)
    dt0 = jnp.exp(jax.random.uniform(next(ks), (L, 2, SSD_HEADS), f32, math.log(1e-3), math.log(1e-1)))
    ssd_dt_bias = dt0 + jnp.log(-jnp.expm1(-dt0))
    ssd_a_log = jnp.log(jax.random.uniform(next(ks), (L, 2, SSD_HEADS), f32, 1.0, 16.0))
    ssd_d = 1.0 + nrm((L, SSD_HEADS), 0.02)
    ssd_norm_g = 1.0 + nrm((L, BW), 0.02)
    diff_lambda = nrm((L, 4, DIFF_QK_DIM), 0.1)
    diff_subln_g = 1.0 + nrm((L, DIFF_V_DIM), 0.02)
    win_sink = nrm((L, WIN_Q_HEADS), 0.5)
    s5_lam_re = -0.5 + nrm((L, 2, S5_GROUPS, S5_STATE), 0.02)
    s5_lam_im = math.pi * jnp.arange(S5_STATE, dtype=f32) + nrm((L, 2, S5_GROUPS, S5_STATE), 0.01)
    s5_log_dt = jax.random.uniform(next(ks), (L, 2, S5_GROUPS), f32, math.log(S5_DT_MIN), math.log(S5_DT_MAX))
    s5_b_re = nrm((L, S5_GROUPS, S5_STATE, S5_GROUP_CH), (2 * S5_GROUP_CH) ** -0.5)
    s5_b_im = nrm((L, S5_GROUPS, S5_STATE, S5_GROUP_CH), (2 * S5_GROUP_CH) ** -0.5)
    s5_c_re = nrm((L, 2, S5_GROUPS, S5_GROUP_CH, S5_STATE), S5_STATE ** -0.5)
    s5_c_im = nrm((L, 2, S5_GROUPS, S5_GROUP_CH, S5_STATE), S5_STATE ** -0.5)
    s5_d = nrm((L, BW), 1.0)
    s5_glu_w = nrm((L, BW, BW), BW ** -0.5)
    s5_glu_b = nrm((L, BW), 0.02)
    mem_norm_g = 1.0 + nrm((L, D_MODEL), 0.02)
    mem_w_kv = nrm((L, D_MODEL, 2 * MEM_HEADS * MEM_HEAD_DIM), D_MODEL ** -0.5)
    merge_w = nrm((L, N_BRANCHES, D_MODEL, D_MODEL), D_MODEL ** -0.5)
    merge_b = nrm((L, N_BRANCHES, D_MODEL), 0.02)
    branch_w = nrm((L, N_BRANCHES, BW, D_MODEL), BW ** -0.5)
    w_out = nrm((L, D_MODEL, D_MODEL), D_MODEL ** -0.5)
    return {'x': x, 'mem': mem, 'rel_bias': rel_bias, 'final_g': final_g, 'norm_g': norm_g, 'w_in': w_in,
            'ssd_conv_w': ssd_conv_w, 'ssd_conv_b': ssd_conv_b, 'ssd_dt_bias': ssd_dt_bias,
            'ssd_a_log': ssd_a_log, 'ssd_d': ssd_d, 'ssd_norm_g': ssd_norm_g,
            'diff_lambda': diff_lambda, 'diff_subln_g': diff_subln_g, 'win_sink': win_sink,
            's5_lam_re': s5_lam_re, 's5_lam_im': s5_lam_im, 's5_log_dt': s5_log_dt,
            's5_b_re': s5_b_re, 's5_b_im': s5_b_im, 's5_c_re': s5_c_re, 's5_c_im': s5_c_im,
            's5_d': s5_d, 's5_glu_w': s5_glu_w, 's5_glu_b': s5_glu_b,
            'mem_norm_g': mem_norm_g, 'mem_w_kv': mem_w_kv, 'merge_w': merge_w, 'merge_b': merge_b,
            'branch_w': branch_w, 'w_out': w_out}


def reference(x, mem, rel_bias, final_g, norm_g, w_in, ssd_conv_w, ssd_conv_b, ssd_dt_bias, ssd_a_log,
              ssd_d, ssd_norm_g, diff_lambda, diff_subln_g, win_sink, s5_lam_re, s5_lam_im, s5_log_dt,
              s5_b_re, s5_b_im, s5_c_re, s5_c_im, s5_d, s5_glu_w, s5_glu_b, mem_norm_g, mem_w_kv,
              merge_w, merge_b, branch_w, w_out):
    splits = _split_points()
    half_kv = MEM_HEADS * MEM_HEAD_DIM
    for l in range(DEPTH):
        lam_init = 0.8 - 0.6 * math.exp(-0.3 * l)
        h = _rmsnorm(x, norm_g[l])
        (s_xbc, s_z, s_dt, d_q, d_k, d_v, d_z, c_q, c_k, c_v, c_z,
         u_in, u_z, m_q, m_z) = jnp.split(h @ w_in[l], splits, axis=-1)
        kv = _rmsnorm(mem, mem_norm_g[l]) @ mem_w_kv[l]
        outs = (
            _ssd_branch(s_xbc, s_z, s_dt, ssd_conv_w[l], ssd_conv_b[l], ssd_dt_bias[l], ssd_a_log[l],
                        ssd_d[l], ssd_norm_g[l]),
            _diff_branch(d_q, d_k, d_v, d_z, diff_lambda[l], diff_subln_g[l], rel_bias, lam_init),
            _window_branch(c_q, c_k, c_v, c_z, win_sink[l], rel_bias),
            _s5_branch(u_in, u_z, s5_lam_re[l], s5_lam_im[l], s5_log_dt[l], s5_b_re[l], s5_b_im[l],
                       s5_c_re[l], s5_c_im[l], s5_d[l], s5_glu_w[l], s5_glu_b[l]),
            _mem_branch(m_q, m_z, kv[..., :half_kv], kv[..., half_kv:]),
        )
        y = jnp.zeros_like(x)
        for i in range(N_BRANCHES):
            gate = jax.nn.sigmoid(h @ merge_w[l, i] + merge_b[l, i])
            y = y + gate * (outs[i] @ branch_w[l, i])
        x = x + y @ w_out[l]
    return _rmsnorm(x, final_g)
```

```cpp
#include <hip/hip_runtime.h>
#include <hip/hip_cooperative_groups.h>
#include <cstdio>
namespace cg = cooperative_groups;

#define DI __device__ __forceinline__
typedef unsigned short u16;
typedef __attribute__((ext_vector_type(8))) short bf16x8;
typedef __attribute__((ext_vector_type(4))) short s16x4;
typedef __attribute__((ext_vector_type(16))) float f32x16;
typedef __attribute__((ext_vector_type(4))) float f32x4;
typedef __attribute__((ext_vector_type(2))) float f32x2;
typedef __attribute__((ext_vector_type(4))) unsigned u32x4;
typedef __attribute__((ext_vector_type(2))) unsigned u32x2;
typedef __attribute__((ext_vector_type(2))) __bf16 bf2_t;

constexpr int S_ = 2048, D_ = 1024, NBATCH = 16, BWID = 512, MEML = 256;
constexpr int PW = 7040;
constexpr int P_XBC = 0, P_SZ = 1024, P_DQ = 1536, P_DK = 2048, P_DV = 2560, P_DZ = 3072, P_CQ = 3584, P_CK = 4096,
              P_CV = 4224, P_CZ = 4352, P_UIN = 4864, P_UZ = 5376, P_MQ = 5888, P_MZ = 6400, P_DT = 6912;
constexpr size_t WIN_OFF = 0, WMG_OFF = 7208960, WBR_OFF = 12451840, WOUT_OFF = 15073280, WGLU_OFF = 16121856,
                 WKV_OFF = 16384000, LAYER_W = 17432576;
constexpr int LUTS = 4096;
constexpr int SMEM_BYTES = 75 * 1024;
constexpr float EPS_ = 1e-6f;
#ifndef PH
#define PH 0xffff
#endif
#ifndef MX
#define MX 0xff
#endif

struct Params {
  const float* in[31];
  float* out;
  u16* W; u16* KV; u16* memb; float* memrs; float* lut; int* ctr;
  u16* h; u16* P; u16* xa; u16* o0; u16* o1; u16* o2; u16* o3; u16* o4; u16* syb; u16* s5f;
  int BG; int pad;
};

DI unsigned pk2(float a, float b) { bf2_t r = __builtin_convertvector((f32x2){a, b}, bf2_t); return __builtin_bit_cast(unsigned, r); }
DI u16 f2bf(float a) { return (u16)(pk2(a, 0.f) & 0xffffu); }
DI float bf2f(u16 v) { return __uint_as_float(((unsigned)v) << 16); }
DI float bflo(unsigned v) { return __uint_as_float(v << 16); }
DI float bfhi(unsigned v) { return __uint_as_float(v & 0xffff0000u); }
DI float sigmoidf_(float x) { return 1.f / (1.f + __expf(-x)); }
DI float siluf_(float x) { return x / (1.f + __expf(-x)); }
DI int crow(int reg, int h) { return (reg & 3) + 8 * (reg >> 2) + 4 * h; }
DI int otid() { int t = threadIdx.x; asm volatile("" : "+v"(t)); return t; }
DI float wave_sum(float v) { for (int o = 32; o > 0; o >>= 1) v += __shfl_xor(v, o, 64); return v; }
#define MFMA32(a, b, c) __builtin_amdgcn_mfma_f32_32x32x16_bf16((a), (b), (c), 0, 0, 0)
#define MFMA16(a, b, c) __builtin_amdgcn_mfma_f32_16x16x32_bf16((a), (b), (c), 0, 0, 0)

DI bf16x8 ldfrag(const u16* base, int stride, int row, int col) { return *reinterpret_cast<const bf16x8*>(base + row * stride + col); }
DI s16x4 tr4(const u16* base, int stride, int krow0, int col0, int lane) {
  const int i16 = lane & 15, q = i16 >> 2, pp = i16 & 3, blk = (lane >> 4) & 1;
  const u16* a = base + (krow0 + q) * stride + col0 + 16 * blk + 4 * pp;
  return __builtin_amdgcn_ds_read_tr16_b64_v4i16((__attribute__((address_space(3))) s16x4*)(a));
}
DI bf16x8 ldfrag_tr_nat(const u16* base, int stride, int k0, int col0, int lane) {
  const int h = lane >> 5;
  s16x4 lo = tr4(base, stride, k0 + 8 * h, col0, lane), hi = tr4(base, stride, k0 + 8 * h + 4, col0, lane);
  return __builtin_shufflevector(lo, hi, 0, 1, 2, 3, 4, 5, 6, 7);
}
DI bf16x8 ldfrag_tr_perm(const u16* base, int stride, int k0, int col0, int lane) {
  const int h = lane >> 5;
  s16x4 lo = tr4(base, stride, k0 + 4 * h, col0, lane), hi = tr4(base, stride, k0 + 8 + 4 * h, col0, lane);
  return __builtin_shufflevector(lo, hi, 0, 1, 2, 3, 4, 5, 6, 7);
}
DI bf16x8 pack8(const f32x16& x, int s) {
  u32x4 u;
  u.x = pk2(x[8 * s + 0], x[8 * s + 1]); u.y = pk2(x[8 * s + 2], x[8 * s + 3]);
  u.z = pk2(x[8 * s + 4], x[8 * s + 5]); u.w = pk2(x[8 * s + 6], x[8 * s + 7]);
  return __builtin_bit_cast(bf16x8, u);
}
DI u32x4 scale8(u32x4 v, float f) {
  u32x4 o;
  o.x = pk2(bflo(v.x) * f, bfhi(v.x) * f); o.y = pk2(bflo(v.y) * f, bfhi(v.y) * f);
  o.z = pk2(bflo(v.z) * f, bfhi(v.z) * f); o.w = pk2(bflo(v.w) * f, bfhi(v.w) * f);
  return o;
}
DI void unpack8(u32x4 v, float* f) {
  f[0] = bflo(v.x); f[1] = bfhi(v.x); f[2] = bflo(v.y); f[3] = bfhi(v.y);
  f[4] = bflo(v.z); f[5] = bfhi(v.z); f[6] = bflo(v.w); f[7] = bfhi(v.w);
}
DI void wave_lds_sync() {
  __builtin_amdgcn_fence(__ATOMIC_RELEASE, "wavefront");
  __builtin_amdgcn_wave_barrier();
  __builtin_amdgcn_fence(__ATOMIC_ACQUIRE, "wavefront");
}

template <int BN>
DI void gemm_acc(const u16* __restrict__ A, int lda, const u16* __restrict__ Bt, int ldb, int K,
                 f32x16 (&acc)[2][BN / 64], char* smem) {
  constexpr int NJ = BN / 64, NBC = BN / 32;
  u16* sA = (u16*)smem;
  u16* sB = sA + 128 * 72;
  const int tid = otid(), lane = tid & 63, w = tid >> 6, wm = w >> 1, wn = w & 1, r = lane & 31, h = lane >> 5;
  u32x4 ra[4], rb[NBC];
  const int crow_ = tid >> 3, ccol = (tid & 7) * 8;
  const u16* Ap = A + (size_t)crow_ * lda + ccol;
  const u16* Bp = Bt + (size_t)crow_ * ldb + ccol;
#pragma unroll
  for (int i = 0; i < 4; ++i) ra[i] = *(const u32x4*)(Ap + (size_t)(32 * i) * lda);
#pragma unroll
  for (int i = 0; i < NBC; ++i) rb[i] = *(const u32x4*)(Bp + (size_t)(32 * i) * ldb);
  const int nk = K >> 6;
  for (int kt = 0; kt < nk; ++kt) {
    __syncthreads();
#pragma unroll
    for (int i = 0; i < 4; ++i) *(u32x4*)(sA + (crow_ + 32 * i) * 72 + ccol) = ra[i];
#pragma unroll
    for (int i = 0; i < NBC; ++i) *(u32x4*)(sB + (crow_ + 32 * i) * 72 + ccol) = rb[i];
    __syncthreads();
    if (kt + 1 < nk) {
      const int ko = (kt + 1) * 64;
#pragma unroll
      for (int i = 0; i < 4; ++i) ra[i] = *(const u32x4*)(Ap + (size_t)(32 * i) * lda + ko);
#pragma unroll
      for (int i = 0; i < NBC; ++i) rb[i] = *(const u32x4*)(Bp + (size_t)(32 * i) * ldb + ko);
    }
#pragma unroll
    for (int ks = 0; ks < 4; ++ks) {
      bf16x8 a[2], b[NJ];
#pragma unroll
      for (int i = 0; i < 2; ++i) a[i] = ldfrag(sA, 72, wm * 64 + 32 * i + r, ks * 16 + 8 * h);
#pragma unroll
      for (int j = 0; j < NJ; ++j) b[j] = ldfrag(sB, 72, wn * (BN / 2) + 32 * j + r, ks * 16 + 8 * h);
#pragma unroll
      for (int i = 0; i < 2; ++i)
#pragma unroll
        for (int j = 0; j < NJ; ++j) acc[i][j] = MFMA32(a[i], b[j], acc[i][j]);
    }
  }
}

template <int NJ>
DI void zero_acc(f32x16 (&acc)[2][NJ]) {
#pragma unroll
  for (int i = 0; i < 2; ++i)
#pragma unroll
    for (int j = 0; j < NJ; ++j)
#pragma unroll
      for (int e = 0; e < 16; ++e) acc[i][j][e] = 0.f;
}

DI int t5_bucket(int rel) {
  int n = rel < 0 ? -rel : rel;
  float nf = (float)(n > 1 ? n : 1);
  int large = 8 + (int)(logf(nf / 8.f) / logf(16.f) * 8.f);
  large = large < 15 ? large : 15;
  return (rel > 0 ? 16 : 0) + (n < 8 ? n : large);
}

DI void prep_job(const float* __restrict__ src, int K, int Nsrc, u16* __restrict__ dst, int Ndst, int mode,
                 const float* __restrict__ scale, char* smem, int bid, int nblk) {
  u16* sT = (u16*)smem;
  const int tid = otid();
  const int ntn = Ndst >> 6, ntk = K >> 6;
  for (int t = bid; t < ntn * ntk; t += nblk) {
    const int n0 = (t / ntk) << 6, k0 = (t % ntk) << 6;
    const int n = n0 + (tid & 63);
    int sc = n;
    if (mode == 1) sc = (n < 1536) ? n : (n < 6912 ? n + 16 : (n < 6928 ? n - 6912 + 1536 : -1));
    __syncthreads();
#pragma unroll 4
    for (int i = 0; i < 16; ++i) {
      const int k = i * 4 + (tid >> 6);
      float v = 0.f;
      if (sc >= 0) v = src[(size_t)(k0 + k) * Nsrc + sc];
      if (scale) v *= scale[k0 + k];
      sT[(tid & 63) * 72 + k] = f2bf(v);
    }
    __syncthreads();
    const int nn = tid >> 2, ks = (tid & 3) * 16;
    u32x4 v0 = *(const u32x4*)(sT + nn * 72 + ks), v1 = *(const u32x4*)(sT + nn * 72 + ks + 8);
    u16* d = dst + (size_t)(n0 + nn) * K + k0 + ks;
    *(u32x4*)d = v0;
    *(u32x4*)(d + 8) = v1;
  }
}

DI void phase_prologue(const Params& p, char* smem, int bid, int nblk) {
  const int tid = otid(), lane = tid & 63, w = tid >> 6;
  if (bid == 0) p.ctr[tid] = 0;
  for (int i = bid * 256 + tid; i < 12 * 4095; i += nblk * 256) {
    const int hd = i / 4095, idx = i % 4095;
    p.lut[hd * LUTS + idx] = p.in[2][t5_bucket(idx - 2047) * 12 + hd];
  }
  for (int row = bid * 4 + w; row < NBATCH * MEML; row += nblk * 4) {
    const float* src = p.in[1] + (size_t)row * D_;
    float ss = 0.f;
#pragma unroll
    for (int i = 0; i < 4; ++i) {
      f32x4 v = *(const f32x4*)(src + i * 256 + lane * 4);
      ss += v[0] * v[0] + v[1] * v[1] + v[2] * v[2] + v[3] * v[3];
      u32x2 o; o.x = pk2(v[0], v[1]); o.y = pk2(v[2], v[3]);
      *(u32x2*)(p.memb + (size_t)row * D_ + i * 256 + lane * 4) = o;
    }
    ss = wave_sum(ss);
    if (lane == 0) p.memrs[row] = rsqrtf(ss / (float)D_ + EPS_);
  }
  for (int l = 0; l < 2; ++l) {
    u16* W = p.W + (size_t)l * LAYER_W;
    prep_job(p.in[5] + (size_t)l * D_ * 6928, D_, 6928, W + WIN_OFF, PW, 1, nullptr, smem, bid, nblk);
    for (int i = 0; i < 5; ++i)
      prep_job(p.in[27] + ((size_t)l * 5 + i) * D_ * D_, D_, D_, W + WMG_OFF + (size_t)i * D_ * D_, D_, 0, nullptr, smem, bid, nblk);
    for (int i = 0; i < 5; ++i)
      prep_job(p.in[29] + ((size_t)l * 5 + i) * BWID * D_, BWID, D_, W + WBR_OFF + (size_t)i * D_ * BWID, D_, 0, nullptr, smem, bid, nblk);
    prep_job(p.in[30] + (size_t)l * D_ * D_, D_, D_, W + WOUT_OFF, D_, 0, nullptr, smem, bid, nblk);
    prep_job(p.in[23] + (size_t)l * BWID * BWID, BWID, BWID, W + WGLU_OFF, BWID, 0, nullptr, smem, bid, nblk);
    prep_job(p.in[26] + (size_t)l * D_ * D_, D_, D_, W + WKV_OFF, D_, 0, p.in[25] + (size_t)l * D_, smem, bid, nblk);
  }
}

DI void phase_norm(const float* __restrict__ x, const float* __restrict__ g, u16* __restrict__ hdst, int nrows, int bid, int nblk) {
  const int tid_ = otid(), lane = tid_ & 63, w = tid_ >> 6;
  for (int row = bid * 4 + w; row < nrows; row += nblk * 4) {
    const float* src = x + (size_t)row * D_;
    f32x4 v[4];
    float ss = 0.f;
#pragma unroll
    for (int i = 0; i < 4; ++i) {
      v[i] = *(const f32x4*)(src + i * 256 + lane * 4);
      ss += v[i][0] * v[i][0] + v[i][1] * v[i][1] + v[i][2] * v[i][2] + v[i][3] * v[i][3];
    }
    ss = wave_sum(ss);
    const float rs = rsqrtf(ss / (float)D_ + EPS_);
#pragma unroll
    for (int i = 0; i < 4; ++i) {
      f32x4 gg = *(const f32x4*)(g + i * 256 + lane * 4);
      u32x2 o; o.x = pk2(v[i][0] * rs * gg[0], v[i][1] * rs * gg[1]); o.y = pk2(v[i][2] * rs * gg[2], v[i][3] * rs * gg[3]);
      *(u32x2*)(hdst + (size_t)row * D_ + i * 256 + lane * 4) = o;
    }
  }
}

DI void phase_final(float* __restrict__ x, const float* __restrict__ g, int nrows, int bid, int nblk) {
  const int tid_ = otid(), lane = tid_ & 63, w = tid_ >> 6;
  for (int row = bid * 4 + w; row < nrows; row += nblk * 4) {
    float* src = x + (size_t)row * D_;
    f32x4 v[4];
    float ss = 0.f;
#pragma unroll
    for (int i = 0; i < 4; ++i) {
      v[i] = *(const f32x4*)(src + i * 256 + lane * 4);
      ss += v[i][0] * v[i][0] + v[i][1] * v[i][1] + v[i][2] * v[i][2] + v[i][3] * v[i][3];
    }
    ss = wave_sum(ss);
    const float rs = rsqrtf(ss / (float)D_ + EPS_);
#pragma unroll
    for (int i = 0; i < 4; ++i) {
      f32x4 gg = *(const f32x4*)(g + i * 256 + lane * 4);
      f32x4 o; o[0] = v[i][0] * rs * gg[0]; o[1] = v[i][1] * rs * gg[1]; o[2] = v[i][2] * rs * gg[2]; o[3] = v[i][3] * rs * gg[3];
      *(f32x4*)(src + i * 256 + lane * 4) = o;
    }
  }
}

DI void phase_kv(const Params& p, char* smem, int bid, int nblk) {
  const int tid_ = otid(), lane = tid_ & 63, w = tid_ >> 6, wm = w >> 1, wn = w & 1, r = lane & 31, h = lane >> 5;
  for (int t = bid; t < 2 * 32 * 8; t += nblk) {
    const int l = t >> 8, tt = t & 255, m0 = (tt >> 3) * 128, n0 = (tt & 7) * 128;
    f32x16 acc[2][2];
    zero_acc<2>(acc);
    gemm_acc<128>(p.memb + (size_t)m0 * D_, D_, p.W + (size_t)l * LAYER_W + WKV_OFF + (size_t)n0 * D_, D_, D_, acc, smem);
    u16* dst = p.KV + (size_t)l * NBATCH * MEML * D_;
#pragma unroll
    for (int i = 0; i < 2; ++i)
#pragma unroll
      for (int e = 0; e < 16; ++e) {
        const int row = m0 + wm * 64 + 32 * i + crow(e, h);
        const float rs = p.memrs[row];
#pragma unroll
        for (int j = 0; j < 2; ++j) dst[(size_t)row * D_ + n0 + wn * 64 + 32 * j + r] = f2bf(acc[i][j][e] * rs);
      }
  }
}

DI void phase_inproj(const Params& p, int l, int Tg, char* smem, int bid, int nblk) {
  const int tid_ = otid(), lane = tid_ & 63, w = tid_ >> 6, wm = w >> 1, wn = w & 1, r = lane & 31, h = lane >> 5;
  const int ntn = PW / 128;
  const int ntiles = (Tg / 128) * ntn;
  for (int t = bid; t < ntiles; t += nblk) {
    const int m0 = (t / ntn) * 128, n0 = (t % ntn) * 128;
    f32x16 acc[2][2];
    zero_acc<2>(acc);
    gemm_acc<128>(p.h + (size_t)m0 * D_, D_, p.W + (size_t)l * LAYER_W + WIN_OFF + (size_t)n0 * D_, D_, D_, acc, smem);
#pragma unroll
    for (int i = 0; i < 2; ++i)
#pragma unroll
      for (int e = 0; e < 16; ++e) {
        const int row = m0 + wm * 64 + 32 * i + crow(e, h);
#pragma unroll
        for (int j = 0; j < 2; ++j) p.P[(size_t)row * PW + n0 + wn * 64 + 32 * j + r] = f2bf(acc[i][j][e]);
      }
  }
}

DI void phase_glu(const Params& p, int l, int Tg, char* smem, int bid, int nblk) {
  const int tid_ = otid(), lane = tid_ & 63, w = tid_ >> 6, wm = w >> 1, wn = w & 1, r = lane & 31, h = lane >> 5;
  const float* gb = p.in[24] + (size_t)l * BWID;
  const int ntiles = (Tg / 128) * 4;
  for (int t = bid; t < ntiles; t += nblk) {
    const int m0 = (t >> 2) * 128, n0 = (t & 3) * 128;
    f32x16 acc[2][2];
    zero_acc<2>(acc);
    gemm_acc<128>(p.s5f + (size_t)m0 * BWID, BWID, p.W + (size_t)l * LAYER_W + WGLU_OFF + (size_t)n0 * BWID, BWID, BWID, acc, smem);
#pragma unroll
    for (int i = 0; i < 2; ++i)
#pragma unroll
      for (int e = 0; e < 16; ++e) {
        const int row = m0 + wm * 64 + 32 * i + crow(e, h);
#pragma unroll
        for (int j = 0; j < 2; ++j) {
          const int col = n0 + wn * 64 + 32 * j + r;
          const float g = bf2f(p.s5f[(size_t)row * BWID + col]);
          const float z = bf2f(p.P[(size_t)row * PW + P_UZ + col]);
          p.o3[(size_t)row * BWID + col] = f2bf(g * sigmoidf_(acc[i][j][e] + gb[col]) * siluf_(z));
        }
      }
  }
}

DI void phase_merge(const Params& p, int l, int Tg, u16* __restrict__ ydst, char* smem, int bid, int nblk) {
  const int tid_ = otid(), lane = tid_ & 63, w = tid_ >> 6, wm = w >> 1, wn = w & 1, r = lane & 31, h = lane >> 5;
  const int ntiles = (Tg / 128) * 16;
  const u16* W = p.W + (size_t)l * LAYER_W;
  for (int t = bid; t < ntiles; t += nblk) {
    const int m0 = (t >> 4) * 128, n0 = (t & 15) * 64;
    const int col = n0 + wn * 32 + r;
    f32x16 yacc[2];
#pragma unroll
    for (int i = 0; i < 2; ++i)
#pragma unroll
      for (int e = 0; e < 16; ++e) yacc[i][e] = 0.f;
    for (int br = 0; br < 5; ++br) {
      const u16* ob = (br == 0) ? p.o0 : (br == 1) ? p.o1 : (br == 2) ? p.o2 : (br == 3) ? p.o3 : p.o4;
      f32x16 ag[2][1], ap[2][1];
      zero_acc<1>(ag);
      zero_acc<1>(ap);
      gemm_acc<64>(p.h + (size_t)m0 * D_, D_, W + WMG_OFF + (size_t)br * D_ * D_ + (size_t)n0 * D_, D_, D_, ag, smem);
      gemm_acc<64>(ob + (size_t)m0 * BWID, BWID, W + WBR_OFF + (size_t)br * D_ * BWID + (size_t)n0 * BWID, BWID, BWID, ap, smem);
      const float b = p.in[28][((size_t)l * 5 + br) * D_ + col];
#pragma unroll
      for (int i = 0; i < 2; ++i)
#pragma unroll
        for (int e = 0; e < 16; ++e) yacc[i][e] += sigmoidf_(ag[i][0][e] + b) * ap[i][0][e];
    }
#pragma unroll
    for (int i = 0; i < 2; ++i)
#pragma unroll
      for (int e = 0; e < 16; ++e) {
        const int row = m0 + wm * 64 + 32 * i + crow(e, h);
        ydst[(size_t)row * D_ + col] = f2bf(yacc[i][e]);
      }
  }
}

DI void phase_out(const Params& p, int l, int Tg, const u16* ysrc, const float* xin,
                  float* xout, char* smem, int bid, int nblk) {
  const int tid_ = otid(), lane = tid_ & 63, w = tid_ >> 6, wm = w >> 1, wn = w & 1, r = lane & 31, h = lane >> 5;
  const int ntiles = (Tg / 128) * 8;
  for (int t = bid; t < ntiles; t += nblk) {
    const int m0 = (t >> 3) * 128, n0 = (t & 7) * 128;
    f32x16 acc[2][2];
    zero_acc<2>(acc);
    gemm_acc<128>(ysrc + (size_t)m0 * D_, D_, p.W + (size_t)l * LAYER_W + WOUT_OFF + (size_t)n0 * D_, D_, D_, acc, smem);
#pragma unroll
    for (int i = 0; i < 2; ++i)
#pragma unroll
      for (int e = 0; e < 16; ++e) {
        const size_t row = m0 + wm * 64 + 32 * i + crow(e, h);
#pragma unroll
        for (int j = 0; j < 2; ++j) {
          const size_t idx = row * D_ + n0 + wn * 64 + 32 * j + r;
          xout[idx] = xin[idx] + acc[i][j][e];
        }
      }
  }
}

DI void phase_conv(const Params& p, int l, int Tg, int bid, int nblk) {
  const float* cw = p.in[6] + (size_t)l * 5 * 1024;
  const float* cb = p.in[7] + (size_t)l * 1024;
  const int total = Tg * 128;
  for (int idx = bid * 256 + threadIdx.x; idx < total; idx += nblk * 256) {
    const int tok = idx >> 7, c0 = (idx & 127) * 8;
    const int spos = tok & (S_ - 1);
    float acc[8];
#pragma unroll
    for (int j = 0; j < 8; ++j) acc[j] = cb[c0 + j];
#pragma unroll
    for (int k = 0; k < 5; ++k) {
      const int sp = spos + k - 2;
      if (sp >= 0 && sp < S_) {
        u32x4 v = *(const u32x4*)(p.P + (size_t)(tok + k - 2) * PW + c0);
        float f[8];
        unpack8(v, f);
#pragma unroll
        for (int j = 0; j < 8; ++j) acc[j] += f[j] * cw[k * 1024 + c0 + j];
      }
    }
    u32x4 o;
    o.x = pk2(siluf_(acc[0]), siluf_(acc[1])); o.y = pk2(siluf_(acc[2]), siluf_(acc[3]));
    o.z = pk2(siluf_(acc[4]), siluf_(acc[5])); o.w = pk2(siluf_(acc[6]), siluf_(acc[7]));
    *(u32x4*)(p.xa + (size_t)tok * 1024 + c0) = o;
  }
}

template <int DQK, int DV>
DI void attn_pass(const bf16x8 (&qf)[DQK / 16], const u16* __restrict__ Kg, int ldk, const u16* __restrict__ Vg, int ldv,
                  int kt0, int kt1, int q_pos, int q_lo, const float* lut, int window, float m_init, float l_init,
                  f32x16 (&o)[DV / 32], float& l_out, u16* sK, u16* sV) {
  constexpr int LDK = DQK + 8, LDV = DV + 16, NKC = DQK / 32, NVC = DV / 32;
  const int tid = otid(), lane = tid & 63, r = lane & 31, h = lane >> 5;
  u32x4 rk[NKC], rv[NVC];
#pragma unroll
  for (int d = 0; d < DV / 32; ++d)
#pragma unroll
    for (int e = 0; e < 16; ++e) o[d][e] = 0.f;
  float m = m_init, lsum = (h == 0) ? l_init : 0.f;
  {
#pragma unroll
    for (int i = 0; i < NKC; ++i) { const int c = tid + 256 * i, row = c / (DQK / 8), col = (c % (DQK / 8)) * 8; rk[i] = *(const u32x4*)(Kg + (size_t)(kt0 * 64 + row) * ldk + col); }
#pragma unroll
    for (int i = 0; i < NVC; ++i) { const int c = tid + 256 * i, row = c / (DV / 8), col = (c % (DV / 8)) * 8; rv[i] = *(const u32x4*)(Vg + (size_t)(kt0 * 64 + row) * ldv + col); }
  }
  for (int kt = kt0; kt < kt1; ++kt) {
    __syncthreads();
#pragma unroll
    for (int i = 0; i < NKC; ++i) { const int c = tid + 256 * i, row = c / (DQK / 8), col = (c % (DQK / 8)) * 8; *(u32x4*)(sK + row * LDK + col) = rk[i]; }
#pragma unroll
    for (int i = 0; i < NVC; ++i) { const int c = tid + 256 * i, row = c / (DV / 8), col = (c % (DV / 8)) * 8; *(u32x4*)(sV + row * LDV + col) = rv[i]; }
    __syncthreads();
    if (kt + 1 < kt1) {
#pragma unroll
      for (int i = 0; i < NKC; ++i) { const int c = tid + 256 * i, row = c / (DQK / 8), col = (c % (DQK / 8)) * 8; rk[i] = *(const u32x4*)(Kg + (size_t)((kt + 1) * 64 + row) * ldk + col); }
#pragma unroll
      for (int i = 0; i < NVC; ++i) { const int c = tid + 256 * i, row = c / (DV / 8), col = (c % (DV / 8)) * 8; rv[i] = *(const u32x4*)(Vg + (size_t)((kt + 1) * 64 + row) * ldv + col); }
    }
    f32x16 s[2];
#pragma unroll
    for (int t = 0; t < 2; ++t) {
#pragma unroll
      for (int e = 0; e < 16; ++e) s[t][e] = 0.f;
#pragma unroll
      for (int ks = 0; ks < DQK / 16; ++ks) {
        bf16x8 a = ldfrag(sK, LDK, 32 * t + r, 16 * ks + 8 * h);
        s[t] = MFMA32(a, qf[ks], s[t]);
      }
    }
    const int kbase = kt * 64;
    if (lut) {
      const bool far_ = (window == 0) && ((kbase - (q_lo + 31) >= 91) || (q_lo - (kbase + 63) >= 91));
      if (far_) {
        const float bconst = lut[kbase - q_lo + 2047];
#pragma unroll
        for (int t = 0; t < 2; ++t)
#pragma unroll
          for (int e = 0; e < 16; ++e) s[t][e] += bconst;
      } else {
#pragma unroll
        for (int t = 0; t < 2; ++t)
#pragma unroll
          for (int e = 0; e < 16; ++e) {
            const int rel = kbase + 32 * t + crow(e, h) - q_pos;
            float v = s[t][e] + lut[rel + 2047];
            if (window > 0 && (rel > window || rel < -window)) v = -INFINITY;
            s[t][e] = v;
          }
      }
    }
    float mx = s[0][0];
#pragma unroll
    for (int t = 0; t < 2; ++t)
#pragma unroll
      for (int e = 0; e < 16; ++e) mx = fmaxf(mx, s[t][e]);
    mx = fmaxf(mx, __shfl_xor(mx, 32, 64));
    const float mn = fmaxf(m, mx);
    const float alpha = __expf(m - mn);
    m = mn;
    float ps = 0.f;
#pragma unroll
    for (int t = 0; t < 2; ++t)
#pragma unroll
      for (int e = 0; e < 16; ++e) { const float pv = __expf(s[t][e] - mn); s[t][e] = pv; ps += pv; }
    lsum = lsum * alpha + ps;
#pragma unroll
    for (int d = 0; d < DV / 32; ++d)
#pragma unroll
      for (int e = 0; e < 16; ++e) o[d][e] *= alpha;
    bf16x8 pf[2][2];
#pragma unroll
    for (int t = 0; t < 2; ++t)
#pragma unroll
      for (int s2 = 0; s2 < 2; ++s2) pf[t][s2] = pack8(s[t], s2);
#pragma unroll
    for (int d = 0; d < DV / 32; ++d)
#pragma unroll
      for (int t = 0; t < 2; ++t)
#pragma unroll
        for (int s2 = 0; s2 < 2; ++s2) {
          bf16x8 a = ldfrag_tr_perm(sV, LDV, 32 * t + 16 * s2, 32 * d, lane);
          o[d] = MFMA32(a, pf[t][s2], o[d]);
        }
  }
  lsum += __shfl_xor(lsum, 32, 64);
  l_out = lsum;
}

template <int DQK>
DI void load_qfrag(bf16x8 (&qf)[DQK / 16], const u16* qrow, float scale, int h) {
#pragma unroll
  for (int ks = 0; ks < DQK / 16; ++ks) {
    u32x4 v = *(const u32x4*)(qrow + 16 * ks + 8 * h);
    qf[ks] = __builtin_bit_cast(bf16x8, scale8(v, scale));
  }
}

DI void attn_lds(char* smem, u16*& sK, u16*& sV, float*& slut) {
  sK = (u16*)smem; sV = sK + 64 * 136; slut = (float*)(sV + 64 * 144);
}

DI void diff_item(const Params& p, int l, int item, char* smem) {
  const int tid = otid(), lane = tid & 63, w = tid >> 6, r = lane & 31, h = lane >> 5;
  const int bl = item >> 6, hd = (item >> 4) & 3, qb = item & 15;
  u16 *sK, *sV; float* slut;
  attn_lds(smem, sK, sV, slut);
  __syncthreads();
  for (int i = tid; i < 4095; i += 256) slut[i] = p.lut[hd * LUTS + i];
  const float lam_init = 0.8f - 0.6f * expf(-0.3f * (float)l);
  const float* lp = p.in[12] + (size_t)l * 4 * 64;
  const float d1 = wave_sum(lp[lane] * lp[64 + lane]), d2 = wave_sum(lp[128 + lane] * lp[192 + lane]);
  const float lam = expf(d1) - expf(d2) + lam_init;
  const int q_lo = qb * 128 + 32 * w, q_pos = q_lo + r;
  const size_t tokq = (size_t)bl * S_ + q_pos;
  const u16* Pb = p.P + (size_t)bl * S_ * PW;
  f32x16 o[4];
  float lt;
  u16* odst = p.o1 + tokq * BWID + hd * 128;
  {
    bf16x8 qf[4];
    load_qfrag<64>(qf, p.P + tokq * PW + P_DQ + (hd * 2 + 0) * 64, 0.125f, h);
    attn_pass<64, 128>(qf, Pb + P_DK + (hd * 2 + 0) * 64, PW, Pb + P_DV + hd * 128, PW, 0, 32, q_pos, q_lo, slut, 0, -INFINITY, 0.f, o, lt, sK, sV);
    const float inv = 1.f / lt;
#pragma unroll
    for (int d = 0; d < 4; ++d)
#pragma unroll
      for (int g4 = 0; g4 < 4; ++g4) {
        u32x2 ov;
        ov.x = pk2(o[d][4 * g4 + 0] * inv, o[d][4 * g4 + 1] * inv);
        ov.y = pk2(o[d][4 * g4 + 2] * inv, o[d][4 * g4 + 3] * inv);
        *(u32x2*)(odst + 32 * d + 8 * g4 + 4 * h) = ov;
      }
  }
  {
    bf16x8 qf[4];
    load_qfrag<64>(qf, p.P + tokq * PW + P_DQ + (hd * 2 + 1) * 64, 0.125f, h);
    attn_pass<64, 128>(qf, Pb + P_DK + (hd * 2 + 1) * 64, PW, Pb + P_DV + hd * 128, PW, 0, 32, q_pos, q_lo, slut, 0, -INFINITY, 0.f, o, lt, sK, sV);
    const float inv = lam / lt;
#pragma unroll
    for (int d = 0; d < 4; ++d)
#pragma unroll
      for (int g4 = 0; g4 < 4; ++g4) {
        const u32x2 pv = *(const u32x2*)(odst + 32 * d + 8 * g4 + 4 * h);
        o[d][4 * g4 + 0] = bflo(pv.x) - o[d][4 * g4 + 0] * inv;
        o[d][4 * g4 + 1] = bfhi(pv.x) - o[d][4 * g4 + 1] * inv;
        o[d][4 * g4 + 2] = bflo(pv.y) - o[d][4 * g4 + 2] * inv;
        o[d][4 * g4 + 3] = bfhi(pv.y) - o[d][4 * g4 + 3] * inv;
      }
  }
  float ss = 0.f;
#pragma unroll
  for (int d = 0; d < 4; ++d)
#pragma unroll
    for (int e = 0; e < 16; ++e) ss += o[d][e] * o[d][e];
  ss += __shfl_xor(ss, 32, 64);
  const float rs = rsqrtf(ss / 128.f + EPS_) * (1.f - lam_init);
  const float* sg = p.in[13] + (size_t)l * 128;
#pragma unroll
  for (int d = 0; d < 4; ++d)
#pragma unroll
    for (int g4 = 0; g4 < 4; ++g4) {
      const int dv = 32 * d + 8 * g4 + 4 * h;
      const u32x2 zz = *(const u32x2*)(p.P + tokq * PW + P_DZ + hd * 128 + dv);
      const float z0 = bflo(zz.x), z1 = bfhi(zz.x), z2 = bflo(zz.y), z3 = bfhi(zz.y);
      u32x2 ov;
      ov.x = pk2(o[d][4 * g4 + 0] * rs * sg[dv + 0] * siluf_(z0), o[d][4 * g4 + 1] * rs * sg[dv + 1] * siluf_(z1));
      ov.y = pk2(o[d][4 * g4 + 2] * rs * sg[dv + 2] * siluf_(z2), o[d][4 * g4 + 3] * rs * sg[dv + 3] * siluf_(z3));
      *(u32x2*)(odst + dv) = ov;
    }
}

DI void win_item(const Params& p, int l, int item, char* smem) {
  const int tid = otid(), lane = tid & 63, w = tid >> 6, r = lane & 31, h = lane >> 5;
  const int bl = item >> 7, qh = (item >> 4) & 7, qb = item & 15;
  const int kvh = qh >> 2;
  u16 *sK, *sV; float* slut;
  attn_lds(smem, sK, sV, slut);
  __syncthreads();
  for (int i = tid; i < 4095; i += 256) slut[i] = p.lut[(4 + qh) * LUTS + i];
  const float sink = p.in[14][l * 8 + qh];
  const int q_lo = qb * 128 + 32 * w, q_pos = q_lo + r;
  const size_t tokq = (size_t)bl * S_ + q_pos;
  const u16* Pb = p.P + (size_t)bl * S_ * PW;
  int kt0 = qb * 2 - 2; if (kt0 < 0) kt0 = 0;
  int kt1 = qb * 2 + 4; if (kt1 > 32) kt1 = 32;
  f32x16 o[2];
  float lt;
  bf16x8 qf[4];
  load_qfrag<64>(qf, p.P + tokq * PW + P_CQ + qh * 64, 0.125f, h);
  attn_pass<64, 64>(qf, Pb + P_CK + kvh * 64, PW, Pb + P_CV + kvh * 64, PW, kt0, kt1, q_pos, q_lo, slut, 128, sink, 1.f, o, lt, sK, sV);
  const float inv = 1.f / lt;
#pragma unroll
  for (int d = 0; d < 2; ++d)
#pragma unroll
    for (int g4 = 0; g4 < 4; ++g4) {
      const int dv = 32 * d + 8 * g4 + 4 * h;
      const u32x2 zz = *(const u32x2*)(p.P + tokq * PW + P_CZ + qh * 64 + dv);
      const float z0 = bflo(zz.x), z1 = bfhi(zz.x), z2 = bflo(zz.y), z3 = bfhi(zz.y);
      u32x2 ov;
      ov.x = pk2(o[d][4 * g4 + 0] * inv * siluf_(z0), o[d][4 * g4 + 1] * inv * siluf_(z1));
      ov.y = pk2(o[d][4 * g4 + 2] * inv * siluf_(z2), o[d][4 * g4 + 3] * inv * siluf_(z3));
      *(u32x2*)(p.o2 + tokq * BWID + qh * 64 + dv) = ov;
    }
}

DI void mem_item(const Params& p, int l, int grp, int item, char* smem) {
  const int tid = otid(), lane = tid & 63, w = tid >> 6, r = lane & 31, h = lane >> 5;
  const int bl = item >> 6, hd = (item >> 4) & 3, qb = item & 15;
  u16 *sK, *sV; float* slut;
  attn_lds(smem, sK, sV, slut);
  const int q_lo = qb * 128 + 32 * w, q_pos = q_lo + r;
  const size_t tokq = (size_t)bl * S_ + q_pos;
  const int bg = grp * p.BG + bl;
  const u16* kv = p.KV + ((size_t)l * NBATCH + bg) * MEML * D_;
  f32x16 o[4];
  float lt;
  bf16x8 qf[8];
  load_qfrag<128>(qf, p.P + tokq * PW + P_MQ + hd * 128, 0.08838834764831845f, h);
  attn_pass<128, 128>(qf, kv + hd * 128, D_, kv + 512 + hd * 128, D_, 0, 4, q_pos, q_lo, nullptr, 0, -INFINITY, 0.f, o, lt, sK, sV);
  const float inv = 1.f / lt;
#pragma unroll
  for (int d = 0; d < 4; ++d)
#pragma unroll
    for (int g4 = 0; g4 < 4; ++g4) {
      const int dv = 32 * d + 8 * g4 + 4 * h;
      const u32x2 zz = *(const u32x2*)(p.P + tokq * PW + P_MZ + hd * 128 + dv);
      const float z0 = bflo(zz.x), z1 = bfhi(zz.x), z2 = bflo(zz.y), z3 = bfhi(zz.y);
      u32x2 ov;
      ov.x = pk2(o[d][4 * g4 + 0] * inv * siluf_(z0), o[d][4 * g4 + 1] * inv * siluf_(z1));
      ov.y = pk2(o[d][4 * g4 + 2] * inv * siluf_(z2), o[d][4 * g4 + 3] * inv * siluf_(z3));
      *(u32x2*)(p.o4 + tokq * BWID + hd * 128 + dv) = ov;
    }
}

DI void ssd_item(const Params& p, int l, int item, char* smem) {
  const int tid = otid(), lane = tid & 63, w = tid >> 6, r = lane & 31, h = lane >> 5;
  const int bl = item >> 4, hd = (item >> 1) & 7, dir = item & 1;
  const int gq = hd >> 2, lt = w & 1, ph = w >> 1;
  u16* sB = (u16*)smem;
  u16* sC = sB + 64 * 136;
  u16* sX1 = sC + 64 * 136;
  u16* sX2 = sX1 + 64 * 80;
  u16* sS = sX2 + 64 * 80;
  float* sW = (float*)(sS + 64 * 136);
  float* sDt = sW + 64;
  const float Aneg = -expf(p.in[9][(l * 2 + dir) * 8 + hd]);
  const float dtb = p.in[8][(l * 2 + dir) * 8 + hd];
  u16* ydst = dir ? p.syb : p.o0;
  const u16* Pb = p.P + (size_t)bl * S_ * PW;
  const u16* xab = p.xa + (size_t)bl * S_ * 1024;
  __syncthreads();
  for (int i = tid; i < 64 * 136 / 2; i += 256) ((unsigned*)sS)[i] = 0u;
  f32x16 accS[2];
#pragma unroll
  for (int i = 0; i < 2; ++i)
#pragma unroll
    for (int e = 0; e < 16; ++e) accS[i][e] = 0.f;
  for (int cc = 0; cc < 32; ++cc) {
    __syncthreads();
    if (tid < 64) {
      const int pp = 64 * cc + tid, tok = dir ? (S_ - 1 - pp) : pp;
      const float x = bf2f(Pb[(size_t)tok * PW + P_DT + dir * 8 + hd]) + dtb;
      const float dt = x > 20.f ? x : log1pf(expf(x));
      float a = dt * Aneg;
#pragma unroll
      for (int o = 1; o < 64; o <<= 1) { const float t = __shfl_up(a, o, 64); if (lane >= o) a += t; }
      sW[tid] = a;
      sDt[tid] = dt;
    }
#pragma unroll
    for (int i = 0; i < 4; ++i) {
      const int c = tid + 256 * i, row = c >> 4, col = (c & 15) * 8;
      const int pp = 64 * cc + row, tok = dir ? (S_ - 1 - pp) : pp;
      *(u32x4*)(sB + row * 136 + col) = *(const u32x4*)(xab + (size_t)tok * 1024 + 512 + gq * 128 + col);
      *(u32x4*)(sC + row * 136 + col) = *(const u32x4*)(xab + (size_t)tok * 1024 + 768 + gq * 128 + col);
    }
    __syncthreads();
    const float wlast = sW[63];
#pragma unroll
    for (int i = 0; i < 2; ++i) {
      const int c = tid + 256 * i, row = c >> 3, col = (c & 7) * 8;
      const int pp = 64 * cc + row, tok = dir ? (S_ - 1 - pp) : pp;
      const u32x4 v = *(const u32x4*)(xab + (size_t)tok * 1024 + hd * 64 + col);
      const float f1 = sDt[row], f2 = f1 * __expf(wlast - sW[row]);
      *(u32x4*)(sX1 + row * 80 + col) = scale8(v, f1);
      *(u32x4*)(sX2 + row * 80 + col) = scale8(v, f2);
    }
    __syncthreads();
    f32x16 ay;
#pragma unroll
    for (int e = 0; e < 16; ++e) ay[e] = 0.f;
#pragma unroll
    for (int ks = 0; ks < 8; ++ks) {
      bf16x8 a = ldfrag(sS, 136, 32 * ph + r, 16 * ks + 8 * h);
      bf16x8 b = ldfrag(sC, 136, 32 * lt + r, 16 * ks + 8 * h);
      ay = MFMA32(a, b, ay);
    }
    const float wl = sW[32 * lt + r];
    {
      const float ewl = __expf(wl);
#pragma unroll
      for (int e = 0; e < 16; ++e) ay[e] *= ewl;
    }
    for (int st = 0; st <= lt; ++st) {
      f32x16 g;
#pragma unroll
      for (int e = 0; e < 16; ++e) g[e] = 0.f;
#pragma unroll
      for (int ks = 0; ks < 8; ++ks) {
        bf16x8 a = ldfrag(sB, 136, 32 * st + r, 16 * ks + 8 * h);
        bf16x8 b = ldfrag(sC, 136, 32 * lt + r, 16 * ks + 8 * h);
        g = MFMA32(a, b, g);
      }
#pragma unroll
      for (int e = 0; e < 16; ++e) {
        const int sidx = 32 * st + crow(e, h);
        const float f = (sidx <= 32 * lt + r) ? __expf(wl - sW[sidx]) : 0.f;
        g[e] *= f;
      }
#pragma unroll
      for (int s2 = 0; s2 < 2; ++s2) {
        bf16x8 pfr = pack8(g, s2);
        bf16x8 a = ldfrag_tr_perm(sX1, 80, 32 * st + 16 * s2, 32 * ph, lane);
        ay = MFMA32(a, pfr, ay);
      }
    }
    {
      const int pp = 64 * cc + 32 * lt + r, tok = dir ? (S_ - 1 - pp) : pp;
      u16* yd = ydst + ((size_t)bl * S_ + tok) * BWID + hd * 64 + 32 * ph + 4 * h;
#pragma unroll
      for (int g4 = 0; g4 < 4; ++g4) {
        u32x2 ov; ov.x = pk2(ay[4 * g4 + 0], ay[4 * g4 + 1]); ov.y = pk2(ay[4 * g4 + 2], ay[4 * g4 + 3]);
        *(u32x2*)(yd + 8 * g4) = ov;
      }
    }
    {
      const float ew = __expf(wlast);
#pragma unroll
      for (int pt = 0; pt < 2; ++pt)
#pragma unroll
        for (int e = 0; e < 16; ++e) accS[pt][e] *= ew;
#pragma unroll
      for (int ks = 0; ks < 4; ++ks) {
        bf16x8 b = ldfrag_tr_nat(sB, 136, 16 * ks, 32 * w, lane);
#pragma unroll
        for (int pt = 0; pt < 2; ++pt) {
          bf16x8 a = ldfrag_tr_nat(sX2, 80, 16 * ks, 32 * pt, lane);
          accS[pt] = MFMA32(a, b, accS[pt]);
        }
      }
    }
    __syncthreads();
#pragma unroll
    for (int pt = 0; pt < 2; ++pt)
#pragma unroll
      for (int e = 0; e < 16; ++e) sS[(32 * pt + crow(e, h)) * 136 + 32 * w + r] = f2bf(accS[pt][e]);
  }
}

DI void s5_item(const Params& p, int l, int item, char* smem) {
  const int tid = otid(), lane = tid & 63, w = tid >> 6;
  const int wi = item * 4 + w;
  const int bl = wi >> 6, g = (wi >> 1) & 31, dir = wi & 1;
  float* sBu = (float*)(smem + w * 12800);
  u16* sX = (u16*)(smem + w * 12800 + 8448);
  const int c16 = lane & 15, kg = lane >> 4;
  const float* lre = p.in[15] + ((size_t)(l * 2 + dir) * 32 + g) * 64;
  const float* lim = p.in[16] + ((size_t)(l * 2 + dir) * 32 + g) * 64;
  const float dt = expf(p.in[17][(l * 2 + dir) * 32 + g]);
  const float* bre = p.in[18] + ((size_t)l * 32 + g) * 64 * 16;
  const float* bim = p.in[19] + ((size_t)l * 32 + g) * 64 * 16;
  const float* cre = p.in[20] + (((size_t)(l * 2 + dir) * 32 + g) * 16) * 64;
  const float* cim = p.in[21] + (((size_t)(l * 2 + dir) * 32 + g) * 16) * 64;
  float ar, ai;
  {
    const float lr = lre[lane], li = lim[lane];
    const float mag = expf(lr * dt);
    ar = mag * cosf(li * dt); ai = mag * sinf(li * dt);
  }
  bf16x8 bfr[8];
#pragma unroll
  for (int ct = 0; ct < 4; ++ct) {
    const int st = 16 * ct + c16;
    const float lr = lre[st], li = lim[st];
    const float mag = expf(lr * dt);
    const float a_r = mag * cosf(li * dt), a_i = mag * sinf(li * dt);
    const float den = lr * lr + li * li;
    const float fr = ((a_r - 1.f) * lr + a_i * li) / den, fi = (a_i * lr - (a_r - 1.f) * li) / den;
    float vr[8], vi[8];
#pragma unroll
    for (int j = 0; j < 8; ++j) {
      float br_ = 0.f, bi_ = 0.f;
      if (kg < 2) { br_ = bre[st * 16 + 8 * kg + j]; bi_ = bim[st * 16 + 8 * kg + j]; }
      vr[j] = fr * br_ - fi * bi_;
      vi[j] = fr * bi_ + fi * br_;
    }
    u32x4 ur, ui;
    ur.x = pk2(vr[0], vr[1]); ur.y = pk2(vr[2], vr[3]); ur.z = pk2(vr[4], vr[5]); ur.w = pk2(vr[6], vr[7]);
    ui.x = pk2(vi[0], vi[1]); ui.y = pk2(vi[2], vi[3]); ui.z = pk2(vi[4], vi[5]); ui.w = pk2(vi[6], vi[7]);
    bfr[ct] = __builtin_bit_cast(bf16x8, ur);
    bfr[4 + ct] = __builtin_bit_cast(bf16x8, ui);
  }
  bf16x8 cfr[4];
#pragma unroll
  for (int ks = 0; ks < 4; ++ks) {
    const float* src = (ks < 2) ? (cre + c16 * 64 + 32 * ks + 8 * kg) : (cim + c16 * 64 + 32 * (ks - 2) + 8 * kg);
    const float sg = (ks < 2) ? 1.f : -1.f;
    u32x4 u;
    u.x = pk2(sg * src[0], sg * src[1]); u.y = pk2(sg * src[2], sg * src[3]);
    u.z = pk2(sg * src[4], sg * src[5]); u.w = pk2(sg * src[6], sg * src[7]);
    cfr[ks] = __builtin_bit_cast(bf16x8, u);
  }
  u16* ydst = dir ? p.o3 : p.s5f;
  const u16* Pb = p.P + (size_t)bl * S_ * PW + P_UIN + g * 16;
  float xr = 0.f, xi = 0.f;
  u32x4 unext = (u32x4){0u, 0u, 0u, 0u};
  {
    const int tok = dir ? (S_ - 1 - c16) : c16;
    if (kg < 2) unext = *(const u32x4*)(Pb + (size_t)tok * PW + 8 * kg);
  }
  for (int cc = 0; cc < S_ / 16; ++cc) {
    const bf16x8 ua = __builtin_bit_cast(bf16x8, unext);
    if (cc + 1 < S_ / 16) {
      const int pp = 16 * (cc + 1) + c16, tok = dir ? (S_ - 1 - pp) : pp;
      if (kg < 2) unext = *(const u32x4*)(Pb + (size_t)tok * PW + 8 * kg);
    }
    wave_lds_sync();
#pragma unroll
    for (int ct = 0; ct < 8; ++ct) {
      f32x4 d = {0.f, 0.f, 0.f, 0.f};
      d = MFMA16(ua, bfr[ct], d);
#pragma unroll
      for (int e = 0; e < 4; ++e) sBu[(4 * kg + e) * 132 + 16 * ct + c16] = d[e];
    }
    wave_lds_sync();
#pragma unroll
    for (int t = 0; t < 16; ++t) {
      const float bur = sBu[t * 132 + lane], bui = sBu[t * 132 + 64 + lane];
      const float nr = ar * xr - ai * xi + bur;
      const float ni = ar * xi + ai * xr + bui;
      xr = nr; xi = ni;
      sX[t * 136 + lane] = f2bf(xr);
      sX[t * 136 + 64 + lane] = f2bf(xi);
    }
    wave_lds_sync();
    f32x4 y = {0.f, 0.f, 0.f, 0.f};
#pragma unroll
    for (int ks = 0; ks < 4; ++ks) {
      bf16x8 a = ldfrag(sX, 136, c16, 32 * ks + 8 * kg);
      y = MFMA16(a, cfr[ks], y);
    }
#pragma unroll
    for (int e = 0; e < 4; ++e) {
      const int pp = 16 * cc + 4 * kg + e, tok = dir ? (S_ - 1 - pp) : pp;
      ydst[((size_t)bl * S_ + tok) * BWID + g * 16 + c16] = f2bf(y[e]);
    }
  }
}

DI void phase_finalize(const Params& p, int l, int Tg, int bid, int nblk) {
  const int tid_ = otid(), lane = tid_ & 63, w = tid_ >> 6;
  const float* dsk = p.in[10] + l * 8;
  const float* ng = p.in[11] + (size_t)l * BWID;
  const float* s5d = p.in[22] + (size_t)l * BWID;
  const int c0 = lane * 8;
  for (int tok = bid * 4 + w; tok < Tg; tok += nblk * 4) {
    float yf[8], yb[8], xs[8], z[8];
    unpack8(*(const u32x4*)(p.o0 + (size_t)tok * BWID + c0), yf);
    unpack8(*(const u32x4*)(p.syb + (size_t)tok * BWID + c0), yb);
    unpack8(*(const u32x4*)(p.xa + (size_t)tok * 1024 + c0), xs);
    unpack8(*(const u32x4*)(p.P + (size_t)tok * PW + P_SZ + c0), z);
    const float dk = dsk[c0 >> 6];
    float v[8], ss = 0.f;
#pragma unroll
    for (int j = 0; j < 8; ++j) { v[j] = (yf[j] + yb[j] + dk * xs[j]) * siluf_(z[j]); ss += v[j] * v[j]; }
    ss = wave_sum(ss);
    const float rs = rsqrtf(ss / (float)BWID + EPS_);
    u32x4 o;
    o.x = pk2(v[0] * rs * ng[c0 + 0], v[1] * rs * ng[c0 + 1]); o.y = pk2(v[2] * rs * ng[c0 + 2], v[3] * rs * ng[c0 + 3]);
    o.z = pk2(v[4] * rs * ng[c0 + 4], v[5] * rs * ng[c0 + 5]); o.w = pk2(v[6] * rs * ng[c0 + 6], v[7] * rs * ng[c0 + 7]);
    *(u32x4*)(p.o0 + (size_t)tok * BWID + c0) = o;
    float sf[8], sb[8], u[8], gq[8];
    unpack8(*(const u32x4*)(p.s5f + (size_t)tok * BWID + c0), sf);
    unpack8(*(const u32x4*)(p.o3 + (size_t)tok * BWID + c0), sb);
    unpack8(*(const u32x4*)(p.P + (size_t)tok * PW + P_UIN + c0), u);
#pragma unroll
    for (int j = 0; j < 8; ++j) {
      const float y = sf[j] + sb[j] + s5d[c0 + j] * u[j];
      const float t = tanhf(0.7978845608028654f * (y + 0.044715f * y * y * y));
      gq[j] = 0.5f * y * (1.f + t);
    }
    u32x4 o2;
    o2.x = pk2(gq[0], gq[1]); o2.y = pk2(gq[2], gq[3]); o2.z = pk2(gq[4], gq[5]); o2.w = pk2(gq[6], gq[7]);
    *(u32x4*)(p.s5f + (size_t)tok * BWID + c0) = o2;
  }
}

DI void phase_mixers(const Params& p, int l, int grp, int* ctr, char* smem) {
  __shared__ int s_item;
  const int BG = p.BG;
  const int n_ssd = BG * 16, n_s5 = BG * 16, n_diff = BG * 64, n_mem = BG * 64, n_win = BG * 128;
  const int total = n_ssd + n_s5 + n_diff + n_mem + n_win;
  for (;;) {
    __syncthreads();
    if (threadIdx.x == 0) s_item = atomicAdd(ctr, 1);
    __syncthreads();
    int it = s_item;
    if (it >= total) break;
    if (it < n_ssd) { if (MX & 1) ssd_item(p, l, it, smem); continue; }
    it -= n_ssd;
    if (it < n_s5) { if (MX & 2) s5_item(p, l, it, smem); continue; }
    it -= n_s5;
    if (it < n_diff) { if (MX & 4) diff_item(p, l, it, smem); continue; }
    it -= n_diff;
    if (it < n_mem) { if (MX & 8) mem_item(p, l, grp, it, smem); continue; }
    it -= n_mem;
    if (MX & 16) win_item(p, l, it, smem);
  }
}

__global__ void __launch_bounds__(256, 2) fwd_megakernel(Params p) {
  extern __shared__ __attribute__((aligned(16))) char smem[];
  cg::grid_group grid = cg::this_grid();
  const int bid = blockIdx.x, nblk = gridDim.x;
  const int BG = p.BG, Tg = BG * S_, ngrp = NBATCH / BG;
  if (PH & 1) phase_prologue(p, smem, bid, nblk);
  grid.sync();
  if (PH & 2) phase_kv(p, smem, bid, nblk);
  for (int grp = 0; grp < ngrp; ++grp) {
    const size_t rowoff = (size_t)grp * Tg * D_;
    for (int l = 0; l < 2; ++l) {
      const float* xin = (l == 0 ? p.in[0] : (const float*)p.out) + rowoff;
      if (PH & 4) phase_norm(xin, p.in[4] + (size_t)l * D_, p.h, Tg, bid, nblk);
      grid.sync();
      if (PH & 8) phase_inproj(p, l, Tg, smem, bid, nblk);
      grid.sync();
      if (PH & 16) phase_conv(p, l, Tg, bid, nblk);
      grid.sync();
      if (PH & 32) phase_mixers(p, l, grp, p.ctr + grp * 2 + l, smem);
      grid.sync();
      if (PH & 64) phase_finalize(p, l, Tg, bid, nblk);
      grid.sync();
      if (PH & 128) phase_glu(p, l, Tg, smem, bid, nblk);
      grid.sync();
      if (PH & 256) phase_merge(p, l, Tg, p.P, smem, bid, nblk);
      grid.sync();
      if (PH & 512) phase_out(p, l, Tg, p.P, xin, p.out + rowoff, smem, bid, nblk);
      grid.sync();
    }
  }
  if (PH & 1024) phase_final(p.out, p.in[3], NBATCH * S_, bid, nblk);
}

extern "C" void kernel_launch(void* const* d_in, const int* in_sizes, int n_in, void* d_out, int out_size, void* d_ws,
                              size_t ws_size, hipStream_t stream) {
  static int grid_blocks = 0;
  if (!grid_blocks) {
    int dev = 0, cus = 0, per_cu = 0;
    hipGetDevice(&dev);
    hipDeviceGetAttribute(&cus, hipDeviceAttributeMultiprocessorCount, dev);
    hipFuncSetAttribute((const void*)fwd_megakernel, hipFuncAttributeMaxDynamicSharedMemorySize, SMEM_BYTES);
    hipOccupancyMaxActiveBlocksPerMultiprocessor(&per_cu, fwd_megakernel, 256, SMEM_BYTES);
    if (per_cu > 2) per_cu = 2;
    if (per_cu < 1) per_cu = 1;
    grid_blocks = cus * per_cu;
  }
  Params p{};
  for (int i = 0; i < 31; ++i) p.in[i] = (const float*)d_in[i];
  p.out = (float*)d_out;
  char* ws = (char*)d_ws;
  size_t off = 0;
  auto take = [&](size_t bytes) { char* r = ws + off; off += (bytes + 255) & ~(size_t)255; return r; };
  p.W = (u16*)take(2 * LAYER_W * 2);
  p.KV = (u16*)take((size_t)2 * NBATCH * MEML * D_ * 2);
  p.memb = (u16*)take((size_t)NBATCH * MEML * D_ * 2);
  p.memrs = (float*)take(NBATCH * MEML * 4);
  p.lut = (float*)take(12 * LUTS * 4);
  p.ctr = (int*)take(4096);
  const size_t fixed = off;
  int BG = 8;
  auto need = [&](int bg) { size_t tg = (size_t)bg * S_; return fixed + tg * (D_ * 2 + (size_t)PW * 2 + 1024 * 2 + 7 * BWID * 2) + 16 * 256; };
  while (BG > 1 && need(BG) > ws_size) BG >>= 1;
  const size_t Tg = (size_t)BG * S_;
  p.h = (u16*)take(Tg * D_ * 2);
  p.P = (u16*)take(Tg * PW * 2);
  p.xa = (u16*)take(Tg * 1024 * 2);
  p.o0 = (u16*)take(Tg * BWID * 2);
  p.o1 = (u16*)take(Tg * BWID * 2);
  p.o2 = (u16*)take(Tg * BWID * 2);
  p.o3 = (u16*)take(Tg * BWID * 2);
  p.o4 = (u16*)take(Tg * BWID * 2);
  p.syb = (u16*)take(Tg * BWID * 2);
  p.s5f = (u16*)take(Tg * BWID * 2);
  p.BG = BG;
  p.pad = 0;
  void* args[] = {&p};
  hipError_t e = hipLaunchCooperativeKernel((const void*)fwd_megakernel, dim3(grid_blocks), dim3(256), args, SMEM_BYTES, stream);
  if (e != hipSuccess) fprintf(stderr, "cooperative launch failed: %s (grid %d)\n", hipGetErrorString(e), grid_blocks);
}
```

```cpp
#include <hip/hip_runtime.h>
#include <hip/hip_cooperative_groups.h>
#include <cstdio>
namespace cg = cooperative_groups;

#define DI __device__ __forceinline__
typedef unsigned short u16;
typedef __attribute__((ext_vector_type(8))) short bf16x8;
typedef __attribute__((ext_vector_type(4))) short s16x4;
typedef __attribute__((ext_vector_type(16))) float f32x16;
typedef __attribute__((ext_vector_type(4))) float f32x4;
typedef __attribute__((ext_vector_type(2))) float f32x2;
typedef __attribute__((ext_vector_type(4))) unsigned u32x4;
typedef __attribute__((ext_vector_type(2))) unsigned u32x2;
typedef __attribute__((ext_vector_type(2))) __bf16 bf2_t;

constexpr int S_ = 2048, D_ = 1024, NBATCH = 16, BWID = 512, MEML = 256;
constexpr int PW = 7040;
constexpr int P_XBC = 0, P_SZ = 1024, P_DQ = 1536, P_DK = 2048, P_DV = 2560, P_DZ = 3072, P_CQ = 3584, P_CK = 4096,
              P_CV = 4224, P_CZ = 4352, P_UIN = 4864, P_UZ = 5376, P_MQ = 5888, P_MZ = 6400, P_DT = 6912;
constexpr size_t WIN_OFF = 0, WMG_OFF = 7208960, WBR_OFF = 12451840, WOUT_OFF = 15073280, WGLU_OFF = 16121856,
                 WKV_OFF = 16384000, LAYER_W = 17432576;
constexpr int LUTS = 4096;
constexpr int SMEM_BYTES = 75 * 1024;
constexpr float EPS_ = 1e-6f;
#ifndef PH
#define PH 0xffff
#endif
#ifndef MX
#define MX 0xff
#endif
#ifndef DUP
#define DUP 0
#endif

struct Params {
  const float* in[31];
  float* out;
  u16* W; u16* KV; u16* memb; float* memrs; float* lut; int* ctr; unsigned* bar;
  u16* h; u16* P; u16* xa; u16* o0; u16* o1; u16* o2; u16* o3; u16* o4; u16* syb; u16* s5f;
  int BG; int pad;
};

DI unsigned pk2(float a, float b) { bf2_t r = __builtin_convertvector((f32x2){a, b}, bf2_t); return __builtin_bit_cast(unsigned, r); }
DI u16 f2bf(float a) { return (u16)(pk2(a, 0.f) & 0xffffu); }
DI float bf2f(u16 v) { return __uint_as_float(((unsigned)v) << 16); }
DI float bflo(unsigned v) { return __uint_as_float(v << 16); }
DI float bfhi(unsigned v) { return __uint_as_float(v & 0xffff0000u); }
DI float sigmoidf_(float x) { return 1.f / (1.f + __expf(-x)); }
DI float siluf_(float x) { return x / (1.f + __expf(-x)); }
DI int crow(int reg, int h) { return (reg & 3) + 8 * (reg >> 2) + 4 * h; }
DI int otid() { int t = threadIdx.x; asm volatile("" : "+v"(t)); return t; }
DI float wave_sum(float v) { for (int o = 32; o > 0; o >>= 1) v += __shfl_xor(v, o, 64); return v; }
#define MFMA32(a, b, c) __builtin_amdgcn_mfma_f32_32x32x16_bf16((a), (b), (c), 0, 0, 0)
#define MFMA16(a, b, c) __builtin_amdgcn_mfma_f32_16x16x32_bf16((a), (b), (c), 0, 0, 0)

DI bf16x8 ldfrag(const u16* base, int stride, int row, int col) { return *reinterpret_cast<const bf16x8*>(base + row * stride + col); }
DI s16x4 tr4(const u16* base, int stride, int krow0, int col0, int lane) {
  const int i16 = lane & 15, q = i16 >> 2, pp = i16 & 3, blk = (lane >> 4) & 1;
  const u16* a = base + (krow0 + q) * stride + col0 + 16 * blk + 4 * pp;
  return __builtin_amdgcn_ds_read_tr16_b64_v4i16((__attribute__((address_space(3))) s16x4*)(a));
}
DI bf16x8 ldfrag_tr_nat(const u16* base, int stride, int k0, int col0, int lane) {
  const int h = lane >> 5;
  s16x4 lo = tr4(base, stride, k0 + 8 * h, col0, lane), hi = tr4(base, stride, k0 + 8 * h + 4, col0, lane);
  return __builtin_shufflevector(lo, hi, 0, 1, 2, 3, 4, 5, 6, 7);
}
DI bf16x8 ldfrag_tr_perm(const u16* base, int stride, int k0, int col0, int lane) {
  const int h = lane >> 5;
  s16x4 lo = tr4(base, stride, k0 + 4 * h, col0, lane), hi = tr4(base, stride, k0 + 8 + 4 * h, col0, lane);
  return __builtin_shufflevector(lo, hi, 0, 1, 2, 3, 4, 5, 6, 7);
}
DI bf16x8 pack8(const f32x16& x, int s) {
  u32x4 u;
  u.x = pk2(x[8 * s + 0], x[8 * s + 1]); u.y = pk2(x[8 * s + 2], x[8 * s + 3]);
  u.z = pk2(x[8 * s + 4], x[8 * s + 5]); u.w = pk2(x[8 * s + 6], x[8 * s + 7]);
  return __builtin_bit_cast(bf16x8, u);
}
DI u32x4 scale8(u32x4 v, float f) {
  u32x4 o;
  o.x = pk2(bflo(v.x) * f, bfhi(v.x) * f); o.y = pk2(bflo(v.y) * f, bfhi(v.y) * f);
  o.z = pk2(bflo(v.z) * f, bfhi(v.z) * f); o.w = pk2(bflo(v.w) * f, bfhi(v.w) * f);
  return o;
}
DI void unpack8(u32x4 v, float* f) {
  f[0] = bflo(v.x); f[1] = bfhi(v.x); f[2] = bflo(v.y); f[3] = bfhi(v.y);
  f[4] = bflo(v.z); f[5] = bfhi(v.z); f[6] = bflo(v.w); f[7] = bfhi(v.w);
}
DI void wave_lds_sync() {
  __builtin_amdgcn_fence(__ATOMIC_RELEASE, "wavefront");
  __builtin_amdgcn_wave_barrier();
  __builtin_amdgcn_fence(__ATOMIC_ACQUIRE, "wavefront");
}


#define XB_TMO      128
#define XB_XCNT(j)  (256  + 64 * (j))
#define XB_XSUB(j)  (1280 + 64 * (j))
#define XB_XGEN(j)  (2304 + 64 * (j))
#define XB_TOP      3328
#define XB_TOPGEN   3392
#define XCD_BAR_WORDS 3456
#define XB_SPIN_CAP (1u << 24)
#define LAS __attribute__((address_space(3)))
DI unsigned xb_ld(unsigned* p) { return __hip_atomic_load(p, __ATOMIC_RELAXED, __HIP_MEMORY_SCOPE_AGENT); }
DI unsigned xb_add(unsigned* p, unsigned v) { return __hip_atomic_fetch_add(p, v, __ATOMIC_RELAXED, __HIP_MEMORY_SCOPE_AGENT); }
DI unsigned xb_xcc_id() { return (unsigned)__builtin_amdgcn_s_getreg((3 << 11) | 20) & 0xFu; }
#define XB_SPIN(cond, bar) do { unsigned _sp = 0; while (cond) { __builtin_amdgcn_s_sleep(1); \
    if ((++_sp & 255u) == 0u) { if (xb_ld(&(bar)[XB_TMO])) break; if (_sp > XB_SPIN_CAP) { atomicAdd(&(bar)[XB_TMO], 1u); break; } } } } while (0)
struct XcdBarrier { unsigned* bar; unsigned x; volatile LAS unsigned* st; };
DI XcdBarrier xcd_barrier_post(unsigned* bar, volatile LAS unsigned* st) {
  XcdBarrier b; b.bar = bar; b.x = xb_xcc_id(); b.st = st;
  if (threadIdx.x == 0) (void)xb_add(&bar[XB_XCNT(b.x)], 1u);
  return b;
}
DI void xcd_barrier_complete(unsigned* bar, unsigned x, unsigned& nloc, unsigned& nx) {
  const unsigned G = gridDim.x * gridDim.y * gridDim.z;
  unsigned sum, cnt, mine, sp = 0u;
  for (;;) {
    sum = 0u; cnt = 0u; mine = 0u;
#pragma unroll
    for (unsigned j = 0; j < 16; ++j) { const unsigned c = xb_ld(&bar[XB_XCNT(j)]); sum += c; cnt += (c > 0u) ? 1u : 0u; mine = (j == x) ? c : mine; }
    if (sum == G) break;
    __builtin_amdgcn_s_sleep(1);
    if ((++sp & 255u) == 0u) { if (xb_ld(&bar[XB_TMO])) break; if (sp > XB_SPIN_CAP) { atomicAdd(&bar[XB_TMO], 1u); break; } }
  }
  nloc = mine > 0u ? mine : 1u; nx = cnt > 0u ? cnt : 1u;
}
DI void xcd_barrier(const XcdBarrier& b) {
  asm volatile("s_waitcnt vmcnt(0)" ::: "memory");
  __syncthreads();
  if (threadIdx.x == 0) {
    unsigned* bar = b.bar;
    __builtin_amdgcn_s_waitcnt(0);
    unsigned nloc = b.st[0], nx = b.st[1];
    if (nloc == 0u) { xcd_barrier_complete(bar, b.x, nloc, nx); b.st[0] = nloc; b.st[1] = nx; }
    const unsigned old = xb_add(&bar[XB_XSUB(b.x)], 1u);
    const unsigned gen = old / nloc;
    if (old + 1u == (gen + 1u) * nloc) {
      __builtin_amdgcn_fence(__ATOMIC_RELEASE, "agent");
      asm volatile("s_waitcnt vmcnt(0)" ::: "memory");
      const unsigned og = xb_add(&bar[XB_TOP], 1u);
      const unsigned tg = og / nx;
      if (og + 1u == (tg + 1u) * nx) xb_add(&bar[XB_TOPGEN], 1u);
      else XB_SPIN(xb_ld(&bar[XB_TOPGEN]) == tg, bar);
      __builtin_amdgcn_fence(__ATOMIC_ACQUIRE, "agent");
      xb_add(&bar[XB_XGEN(b.x)], 1u);
      asm volatile("s_waitcnt vmcnt(0)" ::: "memory");
    } else {
      XB_SPIN(xb_ld(&bar[XB_XGEN(b.x)]) == gen, bar);
      __builtin_amdgcn_fence(__ATOMIC_ACQUIRE, "agent");
      asm volatile("s_waitcnt vmcnt(0)" ::: "memory");
    }
  }
  __syncthreads();
}

template <int BM, int BN>
DI void gemm_acc(const u16* __restrict__ A, int lda, const u16* __restrict__ Bt, int ldb, int K,
                 f32x16 (&acc)[BM / 64][BN / 64], char* smem) {
  constexpr int MI = BM / 64, NJ = BN / 64, NAC = BM / 32, NBC = BN / 32;
  u16* sA = (u16*)smem;
  u16* sB = sA + BM * 72;
  const int tid = otid(), lane = tid & 63, w = tid >> 6, wm = w >> 1, wn = w & 1, r = lane & 31, h = lane >> 5;
  u32x4 ra[NAC], rb[NBC];
  const int crow_ = tid >> 3, ccol = (tid & 7) * 8;
  const u16* Ap = A + (size_t)crow_ * lda + ccol;
  const u16* Bp = Bt + (size_t)crow_ * ldb + ccol;
#pragma unroll
  for (int i = 0; i < NAC; ++i) ra[i] = *(const u32x4*)(Ap + (size_t)(32 * i) * lda);
#pragma unroll
  for (int i = 0; i < NBC; ++i) rb[i] = *(const u32x4*)(Bp + (size_t)(32 * i) * ldb);
  const int nk = K >> 6;
  for (int kt = 0; kt < nk; ++kt) {
    __syncthreads();
#pragma unroll
    for (int i = 0; i < NAC; ++i) *(u32x4*)(sA + (crow_ + 32 * i) * 72 + ccol) = ra[i];
#pragma unroll
    for (int i = 0; i < NBC; ++i) *(u32x4*)(sB + (crow_ + 32 * i) * 72 + ccol) = rb[i];
    __syncthreads();
    if (kt + 1 < nk) {
      const int ko = (kt + 1) * 64;
#pragma unroll
      for (int i = 0; i < NAC; ++i) ra[i] = *(const u32x4*)(Ap + (size_t)(32 * i) * lda + ko);
#pragma unroll
      for (int i = 0; i < NBC; ++i) rb[i] = *(const u32x4*)(Bp + (size_t)(32 * i) * ldb + ko);
    }
#pragma unroll
    for (int ks = 0; ks < 4; ++ks) {
      bf16x8 b[NJ];
#pragma unroll
      for (int j = 0; j < NJ; ++j) b[j] = ldfrag(sB, 72, wn * (BN / 2) + 32 * j + r, ks * 16 + 8 * h);
#pragma unroll
      for (int i = 0; i < MI; ++i) {
        const bf16x8 a = ldfrag(sA, 72, wm * (BM / 2) + 32 * i + r, ks * 16 + 8 * h);
#pragma unroll
        for (int j = 0; j < NJ; ++j) acc[i][j] = MFMA32(a, b[j], acc[i][j]);
      }
    }
  }
}

template <int MI, int NJ>
DI void zero_acc(f32x16 (&acc)[MI][NJ]) {
#pragma unroll
  for (int i = 0; i < MI; ++i)
#pragma unroll
    for (int j = 0; j < NJ; ++j)
#pragma unroll
      for (int e = 0; e < 16; ++e) acc[i][j][e] = 0.f;
}

#define TILE_WALK_BEGIN(MT, NT, SM, SN)                                                   \
  {                                                                                       \
    const int xg_ = bid & 7, loc_ = bid >> 3, nloc_ = nblk >> 3;                          \
    const int nsn_ = ((NT) + (SN) - 1) / (SN), nst_ = (((MT) + (SM) - 1) / (SM)) * nsn_;  \
    for (int st_ = xg_; st_ < nst_; st_ += 8)                                             \
      for (int j_ = loc_; j_ < (SM) * (SN); j_ += nloc_) {                                \
        const int mi = (st_ / nsn_) * (SM) + j_ / (SN), ni = (st_ % nsn_) * (SN) + j_ % (SN); \
        if (mi >= (MT) || ni >= (NT)) continue;
#define TILE_WALK_END }}

DI int t5_bucket(int rel) {
  int n = rel < 0 ? -rel : rel;
  float nf = (float)(n > 1 ? n : 1);
  int large = 8 + (int)(logf(nf / 8.f) / logf(16.f) * 8.f);
  large = large < 15 ? large : 15;
  return (rel > 0 ? 16 : 0) + (n < 8 ? n : large);
}

DI void prep_job(const float* __restrict__ src, int K, int Nsrc, u16* __restrict__ dst, int Ndst, int mode,
                 const float* __restrict__ scale, char* smem, int bid, int nblk) {
  u16* sT = (u16*)smem;
  const int tid = otid();
  const int ntn = Ndst >> 6, ntk = K >> 6;
  for (int t = bid; t < ntn * ntk; t += nblk) {
    const int n0 = (t / ntk) << 6, k0 = (t % ntk) << 6;
    const int n = n0 + (tid & 63);
    int sc = n;
    if (mode == 1) sc = (n < 1536) ? n : (n < 6912 ? n + 16 : (n < 6928 ? n - 6912 + 1536 : -1));
    __syncthreads();
#pragma unroll 4
    for (int i = 0; i < 16; ++i) {
      const int k = i * 4 + (tid >> 6);
      float v = 0.f;
      if (sc >= 0) v = src[(size_t)(k0 + k) * Nsrc + sc];
      if (scale) v *= scale[k0 + k];
      sT[(tid & 63) * 72 + k] = f2bf(v);
    }
    __syncthreads();
    const int nn = tid >> 2, ks = (tid & 3) * 16;
    u32x4 v0 = *(const u32x4*)(sT + nn * 72 + ks), v1 = *(const u32x4*)(sT + nn * 72 + ks + 8);
    u16* d = dst + (size_t)(n0 + nn) * K + k0 + ks;
    *(u32x4*)d = v0;
    *(u32x4*)(d + 8) = v1;
  }
}

DI void phase_prologue(const Params& p, char* smem, int bid, int nblk) {
  const int tid = otid(), lane = tid & 63, w = tid >> 6;
  for (int i = bid * 256 + tid; i < 12 * 4095; i += nblk * 256) {
    const int hd = i / 4095, idx = i % 4095;
    p.lut[hd * LUTS + idx] = p.in[2][t5_bucket(idx - 2047) * 12 + hd];
  }
  for (int row = bid * 4 + w; row < NBATCH * MEML; row += nblk * 4) {
    const float* src = p.in[1] + (size_t)row * D_;
    float ss = 0.f;
#pragma unroll
    for (int i = 0; i < 4; ++i) {
      f32x4 v = *(const f32x4*)(src + i * 256 + lane * 4);
      ss += v[0] * v[0] + v[1] * v[1] + v[2] * v[2] + v[3] * v[3];
      u32x2 o; o.x = pk2(v[0], v[1]); o.y = pk2(v[2], v[3]);
      *(u32x2*)(p.memb + (size_t)row * D_ + i * 256 + lane * 4) = o;
    }
    ss = wave_sum(ss);
    if (lane == 0) p.memrs[row] = rsqrtf(ss / (float)D_ + EPS_);
  }
  for (int l = 0; l < 2; ++l) {
    u16* W = p.W + (size_t)l * LAYER_W;
    prep_job(p.in[5] + (size_t)l * D_ * 6928, D_, 6928, W + WIN_OFF, PW, 1, nullptr, smem, bid, nblk);
    for (int i = 0; i < 5; ++i)
      prep_job(p.in[27] + ((size_t)l * 5 + i) * D_ * D_, D_, D_, W + WMG_OFF + (size_t)i * D_ * D_, D_, 0, nullptr, smem, bid, nblk);
    for (int i = 0; i < 5; ++i)
      prep_job(p.in[29] + ((size_t)l * 5 + i) * BWID * D_, BWID, D_, W + WBR_OFF + (size_t)i * D_ * BWID, D_, 0, nullptr, smem, bid, nblk);
    prep_job(p.in[30] + (size_t)l * D_ * D_, D_, D_, W + WOUT_OFF, D_, 0, nullptr, smem, bid, nblk);
    prep_job(p.in[23] + (size_t)l * BWID * BWID, BWID, BWID, W + WGLU_OFF, BWID, 0, nullptr, smem, bid, nblk);
    prep_job(p.in[26] + (size_t)l * D_ * D_, D_, D_, W + WKV_OFF, D_, 0, p.in[25] + (size_t)l * D_, smem, bid, nblk);
  }
}

DI void phase_norm(const float* __restrict__ x, const float* __restrict__ g, u16* __restrict__ hdst, int nrows, int bid, int nblk) {
  const int tid_ = otid(), lane = tid_ & 63, w = tid_ >> 6;
  for (int row = bid * 4 + w; row < nrows; row += nblk * 4) {
    const float* src = x + (size_t)row * D_;
    f32x4 v[4];
    float ss = 0.f;
#pragma unroll
    for (int i = 0; i < 4; ++i) {
      v[i] = *(const f32x4*)(src + i * 256 + lane * 4);
      ss += v[i][0] * v[i][0] + v[i][1] * v[i][1] + v[i][2] * v[i][2] + v[i][3] * v[i][3];
    }
    ss = wave_sum(ss);
    const float rs = rsqrtf(ss / (float)D_ + EPS_);
#pragma unroll
    for (int i = 0; i < 4; ++i) {
      f32x4 gg = *(const f32x4*)(g + i * 256 + lane * 4);
      u32x2 o; o.x = pk2(v[i][0] * rs * gg[0], v[i][1] * rs * gg[1]); o.y = pk2(v[i][2] * rs * gg[2], v[i][3] * rs * gg[3]);
      *(u32x2*)(hdst + (size_t)row * D_ + i * 256 + lane * 4) = o;
    }
  }
}

DI void phase_final(float* __restrict__ x, const float* __restrict__ g, int nrows, int bid, int nblk) {
  const int tid_ = otid(), lane = tid_ & 63, w = tid_ >> 6;
  for (int row = bid * 4 + w; row < nrows; row += nblk * 4) {
    float* src = x + (size_t)row * D_;
    f32x4 v[4];
    float ss = 0.f;
#pragma unroll
    for (int i = 0; i < 4; ++i) {
      v[i] = *(const f32x4*)(src + i * 256 + lane * 4);
      ss += v[i][0] * v[i][0] + v[i][1] * v[i][1] + v[i][2] * v[i][2] + v[i][3] * v[i][3];
    }
    ss = wave_sum(ss);
    const float rs = rsqrtf(ss / (float)D_ + EPS_);
#pragma unroll
    for (int i = 0; i < 4; ++i) {
      f32x4 gg = *(const f32x4*)(g + i * 256 + lane * 4);
      f32x4 o; o[0] = v[i][0] * rs * gg[0]; o[1] = v[i][1] * rs * gg[1]; o[2] = v[i][2] * rs * gg[2]; o[3] = v[i][3] * rs * gg[3];
      *(f32x4*)(src + i * 256 + lane * 4) = o;
    }
  }
}

DI void phase_kv(const Params& p, char* smem, int bid, int nblk) {
  const int tid_ = otid(), lane = tid_ & 63, w = tid_ >> 6, wm = w >> 1, wn = w & 1, r = lane & 31, h = lane >> 5;
  for (int t = bid; t < 2 * 32 * 8; t += nblk) {
    const int l = t >> 8, tt = t & 255, m0 = (tt >> 3) * 128, n0 = (tt & 7) * 128;
    f32x16 acc[2][2];
    zero_acc<2, 2>(acc);
    gemm_acc<128, 128>(p.memb + (size_t)m0 * D_, D_, p.W + (size_t)l * LAYER_W + WKV_OFF + (size_t)n0 * D_, D_, D_, acc, smem);
    u16* dst = p.KV + (size_t)l * NBATCH * MEML * D_;
#pragma unroll
    for (int i = 0; i < 2; ++i)
#pragma unroll
      for (int e = 0; e < 16; ++e) {
        const int row = m0 + wm * 64 + 32 * i + crow(e, h);
        const float rs = p.memrs[row];
#pragma unroll
        for (int j = 0; j < 2; ++j) dst[(size_t)row * D_ + n0 + wn * 64 + 32 * j + r] = f2bf(acc[i][j][e] * rs);
      }
  }
}

DI void phase_inproj(const Params& p, int l, int Tg, char* smem, int bid, int nblk) {
  const int tid_ = otid(), lane = tid_ & 63, w = tid_ >> 6, wm = w >> 1, wn = w & 1, r = lane & 31, h = lane >> 5;
  const int MT = Tg / 256, NT = PW / 128;
  TILE_WALK_BEGIN(MT, NT, 8, 8)
    const int m0 = mi * 256, n0 = ni * 128;
    f32x16 acc[4][2];
    zero_acc<4, 2>(acc);
    gemm_acc<256, 128>(p.h + (size_t)m0 * D_, D_, p.W + (size_t)l * LAYER_W + WIN_OFF + (size_t)n0 * D_, D_, D_, acc, smem);
#pragma unroll
    for (int i = 0; i < 4; ++i)
#pragma unroll
      for (int e = 0; e < 16; ++e) {
        const int row = m0 + wm * 128 + 32 * i + crow(e, h);
#pragma unroll
        for (int j = 0; j < 2; ++j) p.P[(size_t)row * PW + n0 + wn * 64 + 32 * j + r] = f2bf(acc[i][j][e]);
      }
  TILE_WALK_END
}

DI void phase_glu(const Params& p, int l, int Tg, char* smem, int bid, int nblk) {
  const int tid_ = otid(), lane = tid_ & 63, w = tid_ >> 6, wm = w >> 1, wn = w & 1, r = lane & 31, h = lane >> 5;
  const float* gb = p.in[24] + (size_t)l * BWID;
  const int ntiles = (Tg / 128) * 4;
  for (int t = bid; t < ntiles; t += nblk) {
    const int m0 = (t >> 2) * 128, n0 = (t & 3) * 128;
    f32x16 acc[2][2];
    zero_acc<2, 2>(acc);
    gemm_acc<128, 128>(p.s5f + (size_t)m0 * BWID, BWID, p.W + (size_t)l * LAYER_W + WGLU_OFF + (size_t)n0 * BWID, BWID, BWID, acc, smem);
#pragma unroll
    for (int i = 0; i < 2; ++i)
#pragma unroll
      for (int e = 0; e < 16; ++e) {
        const int row = m0 + wm * 64 + 32 * i + crow(e, h);
#pragma unroll
        for (int j = 0; j < 2; ++j) {
          const int col = n0 + wn * 64 + 32 * j + r;
          const float g = bf2f(p.s5f[(size_t)row * BWID + col]);
          const float z = bf2f(p.P[(size_t)row * PW + P_UZ + col]);
          p.o3[(size_t)row * BWID + col] = f2bf(g * sigmoidf_(acc[i][j][e] + gb[col]) * siluf_(z));
        }
      }
  }
}

DI void phase_merge(const Params& p, int l, int Tg, u16* __restrict__ ydst, char* smem, int bid, int nblk) {
  const int tid_ = otid(), lane = tid_ & 63, w = tid_ >> 6, wm = w >> 1, wn = w & 1, r = lane & 31, h = lane >> 5;
  const int MT = Tg / 128, NT = 8;
  const u16* W = p.W + (size_t)l * LAYER_W;
  TILE_WALK_BEGIN(MT, NT, 16, 4)
    const int m0 = mi * 128, n0 = ni * 128;
    f32x16 yacc[2][2];
    zero_acc<2, 2>(yacc);
    for (int br = 0; br < 5; ++br) {
      const u16* ob = (br == 0) ? p.o0 : (br == 1) ? p.o1 : (br == 2) ? p.o2 : (br == 3) ? p.o3 : p.o4;
      unsigned* sG = (unsigned*)(smem + 40 * 1024) + tid_;
      {
        f32x16 ag[2][2];
        zero_acc<2, 2>(ag);
        gemm_acc<128, 128>(p.h + (size_t)m0 * D_, D_, W + WMG_OFF + (size_t)br * D_ * D_ + (size_t)n0 * D_, D_, D_, ag, smem);
#pragma unroll
        for (int j = 0; j < 2; ++j) {
          const float b = p.in[28][((size_t)l * 5 + br) * D_ + n0 + wn * 64 + 32 * j + r];
#pragma unroll
          for (int i = 0; i < 2; ++i)
#pragma unroll
            for (int e = 0; e < 8; ++e)
              sG[((i * 2 + j) * 8 + e) * 256] = pk2(sigmoidf_(ag[i][j][2 * e] + b), sigmoidf_(ag[i][j][2 * e + 1] + b));
        }
      }
      f32x16 ap[2][2];
      zero_acc<2, 2>(ap);
      gemm_acc<128, 128>(ob + (size_t)m0 * BWID, BWID, W + WBR_OFF + (size_t)br * D_ * BWID + (size_t)n0 * BWID, BWID, BWID, ap, smem);
#pragma unroll
      for (int i = 0; i < 2; ++i)
#pragma unroll
        for (int j = 0; j < 2; ++j)
#pragma unroll
          for (int e = 0; e < 8; ++e) {
            const unsigned gv = sG[((i * 2 + j) * 8 + e) * 256];
            yacc[i][j][2 * e] += bflo(gv) * ap[i][j][2 * e];
            yacc[i][j][2 * e + 1] += bfhi(gv) * ap[i][j][2 * e + 1];
          }
    }
#pragma unroll
    for (int i = 0; i < 2; ++i)
#pragma unroll
      for (int e = 0; e < 16; ++e) {
        const int row = m0 + wm * 64 + 32 * i + crow(e, h);
#pragma unroll
        for (int j = 0; j < 2; ++j) ydst[(size_t)row * D_ + n0 + wn * 64 + 32 * j + r] = f2bf(yacc[i][j][e]);
      }
  TILE_WALK_END
}

DI void phase_out(const Params& p, int l, int Tg, const u16* ysrc, const float* xin,
                  float* xout, char* smem, int bid, int nblk) {
  const int tid_ = otid(), lane = tid_ & 63, w = tid_ >> 6, wm = w >> 1, wn = w & 1, r = lane & 31, h = lane >> 5;
  const int MT = Tg / 256, NT = 8;
  TILE_WALK_BEGIN(MT, NT, 8, 8)
    const int m0 = mi * 256, n0 = ni * 128;
    f32x16 acc[4][2];
    zero_acc<4, 2>(acc);
    gemm_acc<256, 128>(ysrc + (size_t)m0 * D_, D_, p.W + (size_t)l * LAYER_W + WOUT_OFF + (size_t)n0 * D_, D_, D_, acc, smem);
#pragma unroll
    for (int i = 0; i < 4; ++i)
#pragma unroll
      for (int e = 0; e < 16; ++e) {
        const size_t row = m0 + wm * 128 + 32 * i + crow(e, h);
#pragma unroll
        for (int j = 0; j < 2; ++j) {
          const size_t idx = row * D_ + n0 + wn * 64 + 32 * j + r;
          xout[idx] = xin[idx] + acc[i][j][e];
        }
      }
  TILE_WALK_END
}

DI void phase_conv(const Params& p, int l, int Tg, int bid, int nblk) {
  const float* cw = p.in[6] + (size_t)l * 5 * 1024;
  const float* cb = p.in[7] + (size_t)l * 1024;
  const int total = Tg * 128;
  for (int idx = bid * 256 + threadIdx.x; idx < total; idx += nblk * 256) {
    const int tok = idx >> 7, c0 = (idx & 127) * 8;
    const int spos = tok & (S_ - 1);
    float acc[8];
#pragma unroll
    for (int j = 0; j < 8; ++j) acc[j] = cb[c0 + j];
#pragma unroll
    for (int k = 0; k < 5; ++k) {
      const int sp = spos + k - 2;
      if (sp >= 0 && sp < S_) {
        u32x4 v = *(const u32x4*)(p.P + (size_t)(tok + k - 2) * PW + c0);
        float f[8];
        unpack8(v, f);
#pragma unroll
        for (int j = 0; j < 8; ++j) acc[j] += f[j] * cw[k * 1024 + c0 + j];
      }
    }
    u32x4 o;
    o.x = pk2(siluf_(acc[0]), siluf_(acc[1])); o.y = pk2(siluf_(acc[2]), siluf_(acc[3]));
    o.z = pk2(siluf_(acc[4]), siluf_(acc[5])); o.w = pk2(siluf_(acc[6]), siluf_(acc[7]));
    *(u32x4*)(p.xa + (size_t)tok * 1024 + c0) = o;
  }
}

template <int DQK, int DV>
DI void attn_pass(const bf16x8 (&qf)[DQK / 16], const u16* __restrict__ Kg, int ldk, const u16* __restrict__ Vg, int ldv,
                  int kt0, int kt1, int q_pos, int q_lo, const float* lut, int window, float m_init, float l_init,
                  f32x16 (&o)[DV / 32], float& l_out, u16* sK, u16* sV) {
  constexpr int LDK = DQK + 8, LDV = DV + 16, NKC = DQK / 32, NVC = DV / 32;
  const int tid = otid(), lane = tid & 63, r = lane & 31, h = lane >> 5;
  u32x4 rk[NKC], rv[NVC];
#pragma unroll
  for (int d = 0; d < DV / 32; ++d)
#pragma unroll
    for (int e = 0; e < 16; ++e) o[d][e] = 0.f;
  float m = m_init, lsum = (h == 0) ? l_init : 0.f;
  {
#pragma unroll
    for (int i = 0; i < NKC; ++i) { const int c = tid + 256 * i, row = c / (DQK / 8), col = (c % (DQK / 8)) * 8; rk[i] = *(const u32x4*)(Kg + (size_t)(kt0 * 64 + row) * ldk + col); }
#pragma unroll
    for (int i = 0; i < NVC; ++i) { const int c = tid + 256 * i, row = c / (DV / 8), col = (c % (DV / 8)) * 8; rv[i] = *(const u32x4*)(Vg + (size_t)(kt0 * 64 + row) * ldv + col); }
  }
  for (int kt = kt0; kt < kt1; ++kt) {
    __syncthreads();
#pragma unroll
    for (int i = 0; i < NKC; ++i) { const int c = tid + 256 * i, row = c / (DQK / 8), col = (c % (DQK / 8)) * 8; *(u32x4*)(sK + row * LDK + col) = rk[i]; }
#pragma unroll
    for (int i = 0; i < NVC; ++i) { const int c = tid + 256 * i, row = c / (DV / 8), col = (c % (DV / 8)) * 8; *(u32x4*)(sV + row * LDV + col) = rv[i]; }
    __syncthreads();
    if (kt + 1 < kt1) {
#pragma unroll
      for (int i = 0; i < NKC; ++i) { const int c = tid + 256 * i, row = c / (DQK / 8), col = (c % (DQK / 8)) * 8; rk[i] = *(const u32x4*)(Kg + (size_t)((kt + 1) * 64 + row) * ldk + col); }
#pragma unroll
      for (int i = 0; i < NVC; ++i) { const int c = tid + 256 * i, row = c / (DV / 8), col = (c % (DV / 8)) * 8; rv[i] = *(const u32x4*)(Vg + (size_t)((kt + 1) * 64 + row) * ldv + col); }
    }
    f32x16 s[2];
#pragma unroll
    for (int t = 0; t < 2; ++t) {
#pragma unroll
      for (int e = 0; e < 16; ++e) s[t][e] = 0.f;
#pragma unroll
      for (int ks = 0; ks < DQK / 16; ++ks) {
        bf16x8 a = ldfrag(sK, LDK, 32 * t + r, 16 * ks + 8 * h);
        s[t] = MFMA32(a, qf[ks], s[t]);
      }
    }
    const int kbase = kt * 64;
    if (lut) {
      const bool far_ = (window == 0) && ((kbase - (q_lo + 31) >= 91) || (q_lo - (kbase + 63) >= 91));
      if (far_) {
        const float bconst = lut[kbase - q_lo + 2047];
#pragma unroll
        for (int t = 0; t < 2; ++t)
#pragma unroll
          for (int e = 0; e < 16; ++e) s[t][e] += bconst;
      } else {
#pragma unroll
        for (int t = 0; t < 2; ++t)
#pragma unroll
          for (int e = 0; e < 16; ++e) {
            const int rel = kbase + 32 * t + crow(e, h) - q_pos;
            float v = s[t][e] + lut[rel + 2047];
            if (window > 0 && (rel > window || rel < -window)) v = -INFINITY;
            s[t][e] = v;
          }
      }
    }
    float mx = s[0][0];
#pragma unroll
    for (int t = 0; t < 2; ++t)
#pragma unroll
      for (int e = 0; e < 16; ++e) mx = fmaxf(mx, s[t][e]);
    mx = fmaxf(mx, __shfl_xor(mx, 32, 64));
    const float mn = fmaxf(m, mx);
    const float alpha = __expf(m - mn);
    m = mn;
    float ps = 0.f;
#pragma unroll
    for (int t = 0; t < 2; ++t)
#pragma unroll
      for (int e = 0; e < 16; ++e) { const float pv = __expf(s[t][e] - mn); s[t][e] = pv; ps += pv; }
    lsum = lsum * alpha + ps;
#pragma unroll
    for (int d = 0; d < DV / 32; ++d)
#pragma unroll
      for (int e = 0; e < 16; ++e) o[d][e] *= alpha;
    bf16x8 pf[2][2];
#pragma unroll
    for (int t = 0; t < 2; ++t)
#pragma unroll
      for (int s2 = 0; s2 < 2; ++s2) pf[t][s2] = pack8(s[t], s2);
#pragma unroll
    for (int d = 0; d < DV / 32; ++d)
#pragma unroll
      for (int t = 0; t < 2; ++t)
#pragma unroll
        for (int s2 = 0; s2 < 2; ++s2) {
          bf16x8 a = ldfrag_tr_perm(sV, LDV, 32 * t + 16 * s2, 32 * d, lane);
          o[d] = MFMA32(a, pf[t][s2], o[d]);
        }
  }
  lsum += __shfl_xor(lsum, 32, 64);
  l_out = lsum;
}

template <int DQK>
DI void load_qfrag(bf16x8 (&qf)[DQK / 16], const u16* qrow, float scale, int h) {
#pragma unroll
  for (int ks = 0; ks < DQK / 16; ++ks) {
    u32x4 v = *(const u32x4*)(qrow + 16 * ks + 8 * h);
    qf[ks] = __builtin_bit_cast(bf16x8, scale8(v, scale));
  }
}

DI void attn_lds(char* smem, u16*& sK, u16*& sV, float*& slut) {
  sK = (u16*)smem; sV = sK + 64 * 136; slut = (float*)(sV + 64 * 144);
}

DI void diff_item(const Params& p, int l, int item, char* smem) {
  const int tid = otid(), lane = tid & 63, w = tid >> 6, r = lane & 31, h = lane >> 5;
  const int bl = item >> 6, hd = (item >> 4) & 3, qb = item & 15;
  u16 *sK, *sV; float* slut;
  attn_lds(smem, sK, sV, slut);
  __syncthreads();
  for (int i = tid; i < 4095; i += 256) slut[i] = p.lut[hd * LUTS + i];
  const float lam_init = 0.8f - 0.6f * expf(-0.3f * (float)l);
  const float* lp = p.in[12] + (size_t)l * 4 * 64;
  const float d1 = wave_sum(lp[lane] * lp[64 + lane]), d2 = wave_sum(lp[128 + lane] * lp[192 + lane]);
  const float lam = expf(d1) - expf(d2) + lam_init;
  const int q_lo = qb * 128 + 32 * w, q_pos = q_lo + r;
  const size_t tokq = (size_t)bl * S_ + q_pos;
  const u16* Pb = p.P + (size_t)bl * S_ * PW;
  f32x16 o[4];
  float lt;
  u16* odst = p.o1 + tokq * BWID + hd * 128;
  {
    bf16x8 qf[4];
    load_qfrag<64>(qf, p.P + tokq * PW + P_DQ + (hd * 2 + 0) * 64, 0.125f, h);
    attn_pass<64, 128>(qf, Pb + P_DK + (hd * 2 + 0) * 64, PW, Pb + P_DV + hd * 128, PW, 0, 32, q_pos, q_lo, slut, 0, -INFINITY, 0.f, o, lt, sK, sV);
    const float inv = 1.f / lt;
#pragma unroll
    for (int d = 0; d < 4; ++d)
#pragma unroll
      for (int g4 = 0; g4 < 4; ++g4) {
        u32x2 ov;
        ov.x = pk2(o[d][4 * g4 + 0] * inv, o[d][4 * g4 + 1] * inv);
        ov.y = pk2(o[d][4 * g4 + 2] * inv, o[d][4 * g4 + 3] * inv);
        *(u32x2*)(odst + 32 * d + 8 * g4 + 4 * h) = ov;
      }
  }
  {
    bf16x8 qf[4];
    load_qfrag<64>(qf, p.P + tokq * PW + P_DQ + (hd * 2 + 1) * 64, 0.125f, h);
    attn_pass<64, 128>(qf, Pb + P_DK + (hd * 2 + 1) * 64, PW, Pb + P_DV + hd * 128, PW, 0, 32, q_pos, q_lo, slut, 0, -INFINITY, 0.f, o, lt, sK, sV);
    const float inv = lam / lt;
#pragma unroll
    for (int d = 0; d < 4; ++d)
#pragma unroll
      for (int g4 = 0; g4 < 4; ++g4) {
        const u32x2 pv = *(const u32x2*)(odst + 32 * d + 8 * g4 + 4 * h);
        o[d][4 * g4 + 0] = bflo(pv.x) - o[d][4 * g4 + 0] * inv;
        o[d][4 * g4 + 1] = bfhi(pv.x) - o[d][4 * g4 + 1] * inv;
        o[d][4 * g4 + 2] = bflo(pv.y) - o[d][4 * g4 + 2] * inv;
        o[d][4 * g4 + 3] = bfhi(pv.y) - o[d][4 * g4 + 3] * inv;
      }
  }
  float ss = 0.f;
#pragma unroll
  for (int d = 0; d < 4; ++d)
#pragma unroll
    for (int e = 0; e < 16; ++e) ss += o[d][e] * o[d][e];
  ss += __shfl_xor(ss, 32, 64);
  const float rs = rsqrtf(ss / 128.f + EPS_) * (1.f - lam_init);
  const float* sg = p.in[13] + (size_t)l * 128;
#pragma unroll
  for (int d = 0; d < 4; ++d)
#pragma unroll
    for (int g4 = 0; g4 < 4; ++g4) {
      const int dv = 32 * d + 8 * g4 + 4 * h;
      const u32x2 zz = *(const u32x2*)(p.P + tokq * PW + P_DZ + hd * 128 + dv);
      const float z0 = bflo(zz.x), z1 = bfhi(zz.x), z2 = bflo(zz.y), z3 = bfhi(zz.y);
      u32x2 ov;
      ov.x = pk2(o[d][4 * g4 + 0] * rs * sg[dv + 0] * siluf_(z0), o[d][4 * g4 + 1] * rs * sg[dv + 1] * siluf_(z1));
      ov.y = pk2(o[d][4 * g4 + 2] * rs * sg[dv + 2] * siluf_(z2), o[d][4 * g4 + 3] * rs * sg[dv + 3] * siluf_(z3));
      *(u32x2*)(odst + dv) = ov;
    }
}

DI void win_item(const Params& p, int l, int item, char* smem) {
  const int tid = otid(), lane = tid & 63, w = tid >> 6, r = lane & 31, h = lane >> 5;
  const int bl = item >> 7, qh = (item >> 4) & 7, qb = item & 15;
  const int kvh = qh >> 2;
  u16 *sK, *sV; float* slut;
  attn_lds(smem, sK, sV, slut);
  __syncthreads();
  for (int i = tid; i < 4095; i += 256) slut[i] = p.lut[(4 + qh) * LUTS + i];
  const float sink = p.in[14][l * 8 + qh];
  const int q_lo = qb * 128 + 32 * w, q_pos = q_lo + r;
  const size_t tokq = (size_t)bl * S_ + q_pos;
  const u16* Pb = p.P + (size_t)bl * S_ * PW;
  int kt0 = qb * 2 - 2; if (kt0 < 0) kt0 = 0;
  int kt1 = qb * 2 + 4; if (kt1 > 32) kt1 = 32;
  f32x16 o[2];
  float lt;
  bf16x8 qf[4];
  load_qfrag<64>(qf, p.P + tokq * PW + P_CQ + qh * 64, 0.125f, h);
  attn_pass<64, 64>(qf, Pb + P_CK + kvh * 64, PW, Pb + P_CV + kvh * 64, PW, kt0, kt1, q_pos, q_lo, slut, 128, sink, 1.f, o, lt, sK, sV);
  const float inv = 1.f / lt;
#pragma unroll
  for (int d = 0; d < 2; ++d)
#pragma unroll
    for (int g4 = 0; g4 < 4; ++g4) {
      const int dv = 32 * d + 8 * g4 + 4 * h;
      const u32x2 zz = *(const u32x2*)(p.P + tokq * PW + P_CZ + qh * 64 + dv);
      const float z0 = bflo(zz.x), z1 = bfhi(zz.x), z2 = bflo(zz.y), z3 = bfhi(zz.y);
      u32x2 ov;
      ov.x = pk2(o[d][4 * g4 + 0] * inv * siluf_(z0), o[d][4 * g4 + 1] * inv * siluf_(z1));
      ov.y = pk2(o[d][4 * g4 + 2] * inv * siluf_(z2), o[d][4 * g4 + 3] * inv * siluf_(z3));
      *(u32x2*)(p.o2 + tokq * BWID + qh * 64 + dv) = ov;
    }
}

DI void mem_item(const Params& p, int l, int grp, int item, char* smem) {
  const int tid = otid(), lane = tid & 63, w = tid >> 6, r = lane & 31, h = lane >> 5;
  const int bl = item >> 6, hd = (item >> 4) & 3, qb = item & 15;
  u16 *sK, *sV; float* slut;
  attn_lds(smem, sK, sV, slut);
  const int q_lo = qb * 128 + 32 * w, q_pos = q_lo + r;
  const size_t tokq = (size_t)bl * S_ + q_pos;
  const int bg = grp * p.BG + bl;
  const u16* kv = p.KV + ((size_t)l * NBATCH + bg) * MEML * D_;
  f32x16 o[4];
  float lt;
  bf16x8 qf[8];
  load_qfrag<128>(qf, p.P + tokq * PW + P_MQ + hd * 128, 0.08838834764831845f, h);
  attn_pass<128, 128>(qf, kv + hd * 128, D_, kv + 512 + hd * 128, D_, 0, 4, q_pos, q_lo, nullptr, 0, -INFINITY, 0.f, o, lt, sK, sV);
  const float inv = 1.f / lt;
#pragma unroll
  for (int d = 0; d < 4; ++d)
#pragma unroll
    for (int g4 = 0; g4 < 4; ++g4) {
      const int dv = 32 * d + 8 * g4 + 4 * h;
      const u32x2 zz = *(const u32x2*)(p.P + tokq * PW + P_MZ + hd * 128 + dv);
      const float z0 = bflo(zz.x), z1 = bfhi(zz.x), z2 = bflo(zz.y), z3 = bfhi(zz.y);
      u32x2 ov;
      ov.x = pk2(o[d][4 * g4 + 0] * inv * siluf_(z0), o[d][4 * g4 + 1] * inv * siluf_(z1));
      ov.y = pk2(o[d][4 * g4 + 2] * inv * siluf_(z2), o[d][4 * g4 + 3] * inv * siluf_(z3));
      *(u32x2*)(p.o4 + tokq * BWID + hd * 128 + dv) = ov;
    }
}

DI void ssd_item(const Params& p, int l, int item, char* smem) {
  const int tid = otid(), lane = tid & 63, w = tid >> 6, r = lane & 31, h = lane >> 5;
  const int bl = item >> 4, hd = (item >> 1) & 7, dir = item & 1;
  const int gq = hd >> 2, lt = w & 1, ph = w >> 1;
  u16* sB = (u16*)smem;
  u16* sC = sB + 64 * 136;
  u16* sX1 = sC + 64 * 136;
  u16* sX2 = sX1 + 64 * 80;
  u16* sS = sX2 + 64 * 80;
  float* sW = (float*)(sS + 64 * 136);
  float* sDt = sW + 64;
  const float Aneg = -expf(p.in[9][(l * 2 + dir) * 8 + hd]);
  const float dtb = p.in[8][(l * 2 + dir) * 8 + hd];
  u16* ydst = dir ? p.syb : p.o0;
  const u16* Pb = p.P + (size_t)bl * S_ * PW;
  const u16* xab = p.xa + (size_t)bl * S_ * 1024;
  __syncthreads();
  for (int i = tid; i < 64 * 136 / 2; i += 256) ((unsigned*)sS)[i] = 0u;
  f32x16 accS[2];
#pragma unroll
  for (int i = 0; i < 2; ++i)
#pragma unroll
    for (int e = 0; e < 16; ++e) accS[i][e] = 0.f;
  for (int cc = 0; cc < 32; ++cc) {
    __syncthreads();
    if (tid < 64) {
      const int pp = 64 * cc + tid, tok = dir ? (S_ - 1 - pp) : pp;
      const float x = bf2f(Pb[(size_t)tok * PW + P_DT + dir * 8 + hd]) + dtb;
      const float dt = x > 20.f ? x : log1pf(expf(x));
      float a = dt * Aneg;
#pragma unroll
      for (int o = 1; o < 64; o <<= 1) { const float t = __shfl_up(a, o, 64); if (lane >= o) a += t; }
      sW[tid] = a;
      sDt[tid] = dt;
    }
#pragma unroll
    for (int i = 0; i < 4; ++i) {
      const int c = tid + 256 * i, row = c >> 4, col = (c & 15) * 8;
      const int pp = 64 * cc + row, tok = dir ? (S_ - 1 - pp) : pp;
      *(u32x4*)(sB + row * 136 + col) = *(const u32x4*)(xab + (size_t)tok * 1024 + 512 + gq * 128 + col);
      *(u32x4*)(sC + row * 136 + col) = *(const u32x4*)(xab + (size_t)tok * 1024 + 768 + gq * 128 + col);
    }
    __syncthreads();
    const float wlast = sW[63];
#pragma unroll
    for (int i = 0; i < 2; ++i) {
      const int c = tid + 256 * i, row = c >> 3, col = (c & 7) * 8;
      const int pp = 64 * cc + row, tok = dir ? (S_ - 1 - pp) : pp;
      const u32x4 v = *(const u32x4*)(xab + (size_t)tok * 1024 + hd * 64 + col);
      const float f1 = sDt[row], f2 = f1 * __expf(wlast - sW[row]);
      *(u32x4*)(sX1 + row * 80 + col) = scale8(v, f1);
      *(u32x4*)(sX2 + row * 80 + col) = scale8(v, f2);
    }
    __syncthreads();
    f32x16 ay;
#pragma unroll
    for (int e = 0; e < 16; ++e) ay[e] = 0.f;
#pragma unroll
    for (int ks = 0; ks < 8; ++ks) {
      bf16x8 a = ldfrag(sS, 136, 32 * ph + r, 16 * ks + 8 * h);
      bf16x8 b = ldfrag(sC, 136, 32 * lt + r, 16 * ks + 8 * h);
      ay = MFMA32(a, b, ay);
    }
    const float wl = sW[32 * lt + r];
    {
      const float ewl = __expf(wl);
#pragma unroll
      for (int e = 0; e < 16; ++e) ay[e] *= ewl;
    }
    for (int st = 0; st <= lt; ++st) {
      f32x16 g;
#pragma unroll
      for (int e = 0; e < 16; ++e) g[e] = 0.f;
#pragma unroll
      for (int ks = 0; ks < 8; ++ks) {
        bf16x8 a = ldfrag(sB, 136, 32 * st + r, 16 * ks + 8 * h);
        bf16x8 b = ldfrag(sC, 136, 32 * lt + r, 16 * ks + 8 * h);
        g = MFMA32(a, b, g);
      }
#pragma unroll
      for (int e = 0; e < 16; ++e) {
        const int sidx = 32 * st + crow(e, h);
        const float f = (sidx <= 32 * lt + r) ? __expf(wl - sW[sidx]) : 0.f;
        g[e] *= f;
      }
#pragma unroll
      for (int s2 = 0; s2 < 2; ++s2) {
        bf16x8 pfr = pack8(g, s2);
        bf16x8 a = ldfrag_tr_perm(sX1, 80, 32 * st + 16 * s2, 32 * ph, lane);
        ay = MFMA32(a, pfr, ay);
      }
    }
    {
      const int pp = 64 * cc + 32 * lt + r, tok = dir ? (S_ - 1 - pp) : pp;
      u16* yd = ydst + ((size_t)bl * S_ + tok) * BWID + hd * 64 + 32 * ph + 4 * h;
#pragma unroll
      for (int g4 = 0; g4 < 4; ++g4) {
        u32x2 ov; ov.x = pk2(ay[4 * g4 + 0], ay[4 * g4 + 1]); ov.y = pk2(ay[4 * g4 + 2], ay[4 * g4 + 3]);
        *(u32x2*)(yd + 8 * g4) = ov;
      }
    }
    {
      const float ew = __expf(wlast);
#pragma unroll
      for (int pt = 0; pt < 2; ++pt)
#pragma unroll
        for (int e = 0; e < 16; ++e) accS[pt][e] *= ew;
#pragma unroll
      for (int ks = 0; ks < 4; ++ks) {
        bf16x8 b = ldfrag_tr_nat(sB, 136, 16 * ks, 32 * w, lane);
#pragma unroll
        for (int pt = 0; pt < 2; ++pt) {
          bf16x8 a = ldfrag_tr_nat(sX2, 80, 16 * ks, 32 * pt, lane);
          accS[pt] = MFMA32(a, b, accS[pt]);
        }
      }
    }
    __syncthreads();
#pragma unroll
    for (int pt = 0; pt < 2; ++pt)
#pragma unroll
      for (int e = 0; e < 16; ++e) sS[(32 * pt + crow(e, h)) * 136 + 32 * w + r] = f2bf(accS[pt][e]);
  }
}

DI void s5_item(const Params& p, int l, int item, char* smem) {
  const int tid = otid(), lane = tid & 63, w = tid >> 6;
  const int wi = item * 4 + w;
  const int bl = wi >> 6, g = (wi >> 1) & 31, dir = wi & 1;
  float* sBu = (float*)(smem + w * 12800);
  u16* sX = (u16*)(smem + w * 12800 + 8448);
  const int c16 = lane & 15, kg = lane >> 4;
  const float* lre = p.in[15] + ((size_t)(l * 2 + dir) * 32 + g) * 64;
  const float* lim = p.in[16] + ((size_t)(l * 2 + dir) * 32 + g) * 64;
  const float dt = expf(p.in[17][(l * 2 + dir) * 32 + g]);
  const float* bre = p.in[18] + ((size_t)l * 32 + g) * 64 * 16;
  const float* bim = p.in[19] + ((size_t)l * 32 + g) * 64 * 16;
  const float* cre = p.in[20] + (((size_t)(l * 2 + dir) * 32 + g) * 16) * 64;
  const float* cim = p.in[21] + (((size_t)(l * 2 + dir) * 32 + g) * 16) * 64;
  float ar, ai;
  {
    const float lr = lre[lane], li = lim[lane];
    const float mag = expf(lr * dt);
    ar = mag * cosf(li * dt); ai = mag * sinf(li * dt);
  }
  bf16x8 bfr[8];
#pragma unroll
  for (int ct = 0; ct < 4; ++ct) {
    const int st = 16 * ct + c16;
    const float lr = lre[st], li = lim[st];
    const float mag = expf(lr * dt);
    const float a_r = mag * cosf(li * dt), a_i = mag * sinf(li * dt);
    const float den = lr * lr + li * li;
    const float fr = ((a_r - 1.f) * lr + a_i * li) / den, fi = (a_i * lr - (a_r - 1.f) * li) / den;
    float vr[8], vi[8];
#pragma unroll
    for (int j = 0; j < 8; ++j) {
      float br_ = 0.f, bi_ = 0.f;
      if (kg < 2) { br_ = bre[st * 16 + 8 * kg + j]; bi_ = bim[st * 16 + 8 * kg + j]; }
      vr[j] = fr * br_ - fi * bi_;
      vi[j] = fr * bi_ + fi * br_;
    }
    u32x4 ur, ui;
    ur.x = pk2(vr[0], vr[1]); ur.y = pk2(vr[2], vr[3]); ur.z = pk2(vr[4], vr[5]); ur.w = pk2(vr[6], vr[7]);
    ui.x = pk2(vi[0], vi[1]); ui.y = pk2(vi[2], vi[3]); ui.z = pk2(vi[4], vi[5]); ui.w = pk2(vi[6], vi[7]);
    bfr[ct] = __builtin_bit_cast(bf16x8, ur);
    bfr[4 + ct] = __builtin_bit_cast(bf16x8, ui);
  }
  bf16x8 cfr[4];
#pragma unroll
  for (int ks = 0; ks < 4; ++ks) {
    const float* src = (ks < 2) ? (cre + c16 * 64 + 32 * ks + 8 * kg) : (cim + c16 * 64 + 32 * (ks - 2) + 8 * kg);
    const float sg = (ks < 2) ? 1.f : -1.f;
    u32x4 u;
    u.x = pk2(sg * src[0], sg * src[1]); u.y = pk2(sg * src[2], sg * src[3]);
    u.z = pk2(sg * src[4], sg * src[5]); u.w = pk2(sg * src[6], sg * src[7]);
    cfr[ks] = __builtin_bit_cast(bf16x8, u);
  }
  u16* ydst = dir ? p.o3 : p.s5f;
  const u16* Pb = p.P + (size_t)bl * S_ * PW + P_UIN + g * 16;
  float xr = 0.f, xi = 0.f;
  u32x4 unext = (u32x4){0u, 0u, 0u, 0u};
  {
    const int tok = dir ? (S_ - 1 - c16) : c16;
    if (kg < 2) unext = *(const u32x4*)(Pb + (size_t)tok * PW + 8 * kg);
  }
  for (int cc = 0; cc < S_ / 16; ++cc) {
    const bf16x8 ua = __builtin_bit_cast(bf16x8, unext);
    if (cc + 1 < S_ / 16) {
      const int pp = 16 * (cc + 1) + c16, tok = dir ? (S_ - 1 - pp) : pp;
      if (kg < 2) unext = *(const u32x4*)(Pb + (size_t)tok * PW + 8 * kg);
    }
    wave_lds_sync();
#pragma unroll
    for (int ct = 0; ct < 8; ++ct) {
      f32x4 d = {0.f, 0.f, 0.f, 0.f};
      d = MFMA16(ua, bfr[ct], d);
#pragma unroll
      for (int e = 0; e < 4; ++e) sBu[(4 * kg + e) * 132 + 16 * ct + c16] = d[e];
    }
    wave_lds_sync();
#pragma unroll
    for (int t = 0; t < 16; ++t) {
      const float bur = sBu[t * 132 + lane], bui = sBu[t * 132 + 64 + lane];
      const float nr = ar * xr - ai * xi + bur;
      const float ni = ar * xi + ai * xr + bui;
      xr = nr; xi = ni;
      sX[t * 136 + lane] = f2bf(xr);
      sX[t * 136 + 64 + lane] = f2bf(xi);
    }
    wave_lds_sync();
    f32x4 y = {0.f, 0.f, 0.f, 0.f};
#pragma unroll
    for (int ks = 0; ks < 4; ++ks) {
      bf16x8 a = ldfrag(sX, 136, c16, 32 * ks + 8 * kg);
      y = MFMA16(a, cfr[ks], y);
    }
#pragma unroll
    for (int e = 0; e < 4; ++e) {
      const int pp = 16 * cc + 4 * kg + e, tok = dir ? (S_ - 1 - pp) : pp;
      ydst[((size_t)bl * S_ + tok) * BWID + g * 16 + c16] = f2bf(y[e]);
    }
  }
}

DI void phase_finalize(const Params& p, int l, int Tg, int bid, int nblk) {
  const int tid_ = otid(), lane = tid_ & 63, w = tid_ >> 6;
  const float* dsk = p.in[10] + l * 8;
  const float* ng = p.in[11] + (size_t)l * BWID;
  const float* s5d = p.in[22] + (size_t)l * BWID;
  const int c0 = lane * 8;
  for (int tok = bid * 4 + w; tok < Tg; tok += nblk * 4) {
    float yf[8], yb[8], xs[8], z[8];
    unpack8(*(const u32x4*)(p.o0 + (size_t)tok * BWID + c0), yf);
    unpack8(*(const u32x4*)(p.syb + (size_t)tok * BWID + c0), yb);
    unpack8(*(const u32x4*)(p.xa + (size_t)tok * 1024 + c0), xs);
    unpack8(*(const u32x4*)(p.P + (size_t)tok * PW + P_SZ + c0), z);
    const float dk = dsk[c0 >> 6];
    float v[8], ss = 0.f;
#pragma unroll
    for (int j = 0; j < 8; ++j) { v[j] = (yf[j] + yb[j] + dk * xs[j]) * siluf_(z[j]); ss += v[j] * v[j]; }
    ss = wave_sum(ss);
    const float rs = rsqrtf(ss / (float)BWID + EPS_);
    u32x4 o;
    o.x = pk2(v[0] * rs * ng[c0 + 0], v[1] * rs * ng[c0 + 1]); o.y = pk2(v[2] * rs * ng[c0 + 2], v[3] * rs * ng[c0 + 3]);
    o.z = pk2(v[4] * rs * ng[c0 + 4], v[5] * rs * ng[c0 + 5]); o.w = pk2(v[6] * rs * ng[c0 + 6], v[7] * rs * ng[c0 + 7]);
    *(u32x4*)(p.o0 + (size_t)tok * BWID + c0) = o;
    float sf[8], sb[8], u[8], gq[8];
    unpack8(*(const u32x4*)(p.s5f + (size_t)tok * BWID + c0), sf);
    unpack8(*(const u32x4*)(p.o3 + (size_t)tok * BWID + c0), sb);
    unpack8(*(const u32x4*)(p.P + (size_t)tok * PW + P_UIN + c0), u);
#pragma unroll
    for (int j = 0; j < 8; ++j) {
      const float y = sf[j] + sb[j] + s5d[c0 + j] * u[j];
      const float t = tanhf(0.7978845608028654f * (y + 0.044715f * y * y * y));
      gq[j] = 0.5f * y * (1.f + t);
    }
    u32x4 o2;
    o2.x = pk2(gq[0], gq[1]); o2.y = pk2(gq[2], gq[3]); o2.z = pk2(gq[4], gq[5]); o2.w = pk2(gq[6], gq[7]);
    *(u32x4*)(p.s5f + (size_t)tok * BWID + c0) = o2;
  }
}

DI void phase_mixers(const Params& p, int l, int grp, int* ctr, char* smem, volatile int* s_itemp) {
  const int BG = p.BG;
  const int n_ssd = BG * 16, n_s5 = BG * 16, n_diff = BG * 64, n_mem = BG * 64, n_win = BG * 128;
  const int total = n_ssd + n_s5 + n_diff + n_mem + n_win;
  for (;;) {
    __syncthreads();
    if (threadIdx.x == 0) *s_itemp = atomicAdd(ctr, 1);
    __syncthreads();
    int it = *s_itemp;
    if (it >= total) break;
    if (it < n_ssd) { if (MX & 1) ssd_item(p, l, it, smem); continue; }
    it -= n_ssd;
    if (it < n_s5) { if (MX & 2) s5_item(p, l, it, smem); continue; }
    it -= n_s5;
    if (it < n_diff) { if (MX & 4) diff_item(p, l, it, smem); continue; }
    it -= n_diff;
    if (it < n_mem) { if (MX & 8) mem_item(p, l, grp, it, smem); continue; }
    it -= n_mem;
    if (MX & 16) win_item(p, l, it, smem);
  }
}

__global__ void __launch_bounds__(256, 2) fwd_megakernel(Params p) {
  extern __shared__ __attribute__((aligned(16))) char smem[];
  __shared__ __attribute__((aligned(16))) unsigned s_misc[8];
  cg::grid_group grid = cg::this_grid();
  const int bid = blockIdx.x, nblk = gridDim.x;
  const int BG = p.BG, Tg = BG * S_, ngrp = NBATCH / BG;
  if (threadIdx.x < 8) s_misc[threadIdx.x] = 0u;
  __syncthreads();
  XcdBarrier xb = xcd_barrier_post(p.bar, (volatile LAS unsigned*)s_misc);
  if (PH & 1) phase_prologue(p, smem, bid, nblk);
  grid.sync();
  if (PH & 2) phase_kv(p, smem, bid, nblk);
  for (int grp = 0; grp < ngrp; ++grp) {
    const size_t rowoff = (size_t)grp * Tg * D_;
    for (int l = 0; l < 2; ++l) {
      const float* xin = (l == 0 ? p.in[0] : (const float*)p.out) + rowoff;
      if (PH & 4) phase_norm(xin, p.in[4] + (size_t)l * D_, p.h, Tg, bid, nblk);
      if (DUP & 4) phase_norm(xin, p.in[4] + (size_t)l * D_, p.h, Tg, bid, nblk);
      xcd_barrier(xb);
      if (PH & 8) phase_inproj(p, l, Tg, smem, bid, nblk);
      xcd_barrier(xb);
      if (PH & 16) phase_conv(p, l, Tg, bid, nblk);
      if (DUP & 16) phase_conv(p, l, Tg, bid, nblk);
      xcd_barrier(xb);
      if (PH & 32) phase_mixers(p, l, grp, p.ctr + grp * 2 + l, smem, (volatile int*)&s_misc[4]);
      xcd_barrier(xb);
      if (PH & 64) phase_finalize(p, l, Tg, bid, nblk);
      xcd_barrier(xb);
      if (PH & 128) phase_glu(p, l, Tg, smem, bid, nblk);
      if (DUP & 128) phase_glu(p, l, Tg, smem, bid, nblk);
      xcd_barrier(xb);
      if (PH & 256) phase_merge(p, l, Tg, p.P, smem, bid, nblk);
      xcd_barrier(xb);
      if (PH & 512) phase_out(p, l, Tg, p.P, xin, p.out + rowoff, smem, bid, nblk);
      xcd_barrier(xb);
    }
  }
  if (PH & 1024) phase_final(p.out, p.in[3], NBATCH * S_, bid, nblk);
}

extern "C" void kernel_launch(void* const* d_in, const int* in_sizes, int n_in, void* d_out, int out_size, void* d_ws,
                              size_t ws_size, hipStream_t stream) {
  static int grid_blocks = 0;
  if (!grid_blocks) {
    int dev = 0, cus = 0, per_cu = 0;
    hipGetDevice(&dev);
    hipDeviceGetAttribute(&cus, hipDeviceAttributeMultiprocessorCount, dev);
    hipFuncSetAttribute((const void*)fwd_megakernel, hipFuncAttributeMaxDynamicSharedMemorySize, SMEM_BYTES);
    hipOccupancyMaxActiveBlocksPerMultiprocessor(&per_cu, fwd_megakernel, 256, SMEM_BYTES);
    if (per_cu > 2) per_cu = 2;
    if (per_cu < 1) per_cu = 1;
    grid_blocks = cus * per_cu;
  }
  Params p{};
  for (int i = 0; i < 31; ++i) p.in[i] = (const float*)d_in[i];
  p.out = (float*)d_out;
  char* ws = (char*)d_ws;
  size_t off = 0;
  auto take = [&](size_t bytes) { char* r = ws + off; off += (bytes + 255) & ~(size_t)255; return r; };
  p.W = (u16*)take(2 * LAYER_W * 2);
  p.KV = (u16*)take((size_t)2 * NBATCH * MEML * D_ * 2);
  p.memb = (u16*)take((size_t)NBATCH * MEML * D_ * 2);
  p.memrs = (float*)take(NBATCH * MEML * 4);
  p.lut = (float*)take(12 * LUTS * 4);
  p.ctr = (int*)take(4096);
  p.bar = (unsigned*)take(XCD_BAR_WORDS * 4);
  const size_t fixed = off;
  int BG = 8;
  auto need = [&](int bg) { size_t tg = (size_t)bg * S_; return fixed + tg * (D_ * 2 + (size_t)PW * 2 + 1024 * 2 + 7 * BWID * 2) + 16 * 256; };
  while (BG > 1 && need(BG) > ws_size) BG >>= 1;
  const size_t Tg = (size_t)BG * S_;
  p.h = (u16*)take(Tg * D_ * 2);
  p.P = (u16*)take(Tg * PW * 2);
  p.xa = (u16*)take(Tg * 1024 * 2);
  p.o0 = (u16*)take(Tg * BWID * 2);
  p.o1 = (u16*)take(Tg * BWID * 2);
  p.o2 = (u16*)take(Tg * BWID * 2);
  p.o3 = (u16*)take(Tg * BWID * 2);
  p.o4 = (u16*)take(Tg * BWID * 2);
  p.syb = (u16*)take(Tg * BWID * 2);
  p.s5f = (u16*)take(Tg * BWID * 2);
  p.BG = BG;
  p.pad = 0;
  hipMemsetAsync(p.ctr, 0, 4096 + ((XCD_BAR_WORDS * 4 + 255) & ~255), stream);
  void* args[] = {&p};
  hipError_t e = hipLaunchCooperativeKernel((const void*)fwd_megakernel, dim3(grid_blocks), dim3(256), args, SMEM_BYTES, stream);
  if (e != hipSuccess) fprintf(stderr, "cooperative launch failed: %s (grid %d)\n", hipGetErrorString(e), grid_blocks);
}
```

```cpp
#include <hip/hip_runtime.h>
#include <hip/hip_cooperative_groups.h>
#include <cstdio>
namespace cg = cooperative_groups;

#define DI __device__ __forceinline__
typedef unsigned short u16;
typedef __attribute__((ext_vector_type(8))) short bf16x8;
typedef __attribute__((ext_vector_type(4))) short s16x4;
typedef __attribute__((ext_vector_type(16))) float f32x16;
typedef __attribute__((ext_vector_type(4))) float f32x4;
typedef __attribute__((ext_vector_type(2))) float f32x2;
typedef __attribute__((ext_vector_type(4))) unsigned u32x4;
typedef __attribute__((ext_vector_type(2))) unsigned u32x2;
typedef __attribute__((ext_vector_type(2))) __bf16 bf2_t;

constexpr int S_ = 2048, D_ = 1024, NBATCH = 16, BWID = 512, MEML = 256;
constexpr int PW = 7040;
constexpr int P_XBC = 0, P_SZ = 1024, P_DQ = 1536, P_DK = 2048, P_DV = 2560, P_DZ = 3072, P_CQ = 3584, P_CK = 4096,
              P_CV = 4224, P_CZ = 4352, P_UIN = 4864, P_UZ = 5376, P_MQ = 5888, P_MZ = 6400, P_DT = 6912;
constexpr size_t WIN_OFF = 0, WMG_OFF = 7208960, WBR_OFF = 12451840, WOUT_OFF = 15073280, WGLU_OFF = 16121856,
                 WKV_OFF = 16384000, LAYER_W = 17432576;
constexpr int LUTS = 4096;
constexpr int SMEM_BYTES = 75 * 1024;
constexpr float EPS_ = 1e-6f;
#ifndef PH
#define PH 0xffff
#endif
#ifndef MX
#define MX 0xff
#endif
#ifndef DUP
#define DUP 0
#endif

struct Params {
  const float* in[31];
  float* out;
  u16* W; u16* KV; u16* memb; float* memrs; float* lut; int* ctr; unsigned* bar;
  u16* h; u16* P; u16* xa; u16* o0; u16* o1; u16* o2; u16* o3; u16* o4; u16* syb; u16* s5f;
  int BG; int pad;
};

DI unsigned pk2(float a, float b) { bf2_t r = __builtin_convertvector((f32x2){a, b}, bf2_t); return __builtin_bit_cast(unsigned, r); }
DI u16 f2bf(float a) { return (u16)(pk2(a, 0.f) & 0xffffu); }
DI float bf2f(u16 v) { return __uint_as_float(((unsigned)v) << 16); }
DI float bflo(unsigned v) { return __uint_as_float(v << 16); }
DI float bfhi(unsigned v) { return __uint_as_float(v & 0xffff0000u); }
DI float sigmoidf_(float x) { return 1.f / (1.f + __expf(-x)); }
DI float siluf_(float x) { return x / (1.f + __expf(-x)); }
DI int crow(int reg, int h) { return (reg & 3) + 8 * (reg >> 2) + 4 * h; }
DI int otid() { int t = threadIdx.x; asm volatile("" : "+v"(t)); return t; }
DI float wave_sum(float v) { for (int o = 32; o > 0; o >>= 1) v += __shfl_xor(v, o, 64); return v; }
#define MFMA32(a, b, c) __builtin_amdgcn_mfma_f32_32x32x16_bf16((a), (b), (c), 0, 0, 0)
#define MFMA16(a, b, c) __builtin_amdgcn_mfma_f32_16x16x32_bf16((a), (b), (c), 0, 0, 0)

DI bf16x8 ldfrag(const u16* base, int stride, int row, int col) { return *reinterpret_cast<const bf16x8*>(base + row * stride + col); }
DI s16x4 tr4(const u16* base, int stride, int krow0, int col0, int lane) {
  const int i16 = lane & 15, q = i16 >> 2, pp = i16 & 3, blk = (lane >> 4) & 1;
  const u16* a = base + (krow0 + q) * stride + col0 + 16 * blk + 4 * pp;
  return __builtin_amdgcn_ds_read_tr16_b64_v4i16((__attribute__((address_space(3))) s16x4*)(a));
}
DI bf16x8 ldfrag_tr_nat(const u16* base, int stride, int k0, int col0, int lane) {
  const int h = lane >> 5;
  s16x4 lo = tr4(base, stride, k0 + 8 * h, col0, lane), hi = tr4(base, stride, k0 + 8 * h + 4, col0, lane);
  return __builtin_shufflevector(lo, hi, 0, 1, 2, 3, 4, 5, 6, 7);
}
DI bf16x8 ldfrag_tr_perm(const u16* base, int stride, int k0, int col0, int lane) {
  const int h = lane >> 5;
  s16x4 lo = tr4(base, stride, k0 + 4 * h, col0, lane), hi = tr4(base, stride, k0 + 8 + 4 * h, col0, lane);
  return __builtin_shufflevector(lo, hi, 0, 1, 2, 3, 4, 5, 6, 7);
}
DI bf16x8 pack8(const f32x16& x, int s) {
  u32x4 u;
  u.x = pk2(x[8 * s + 0], x[8 * s + 1]); u.y = pk2(x[8 * s + 2], x[8 * s + 3]);
  u.z = pk2(x[8 * s + 4], x[8 * s + 5]); u.w = pk2(x[8 * s + 6], x[8 * s + 7]);
  return __builtin_bit_cast(bf16x8, u);
}
DI u32x4 scale8(u32x4 v, float f) {
  u32x4 o;
  o.x = pk2(bflo(v.x) * f, bfhi(v.x) * f); o.y = pk2(bflo(v.y) * f, bfhi(v.y) * f);
  o.z = pk2(bflo(v.z) * f, bfhi(v.z) * f); o.w = pk2(bflo(v.w) * f, bfhi(v.w) * f);
  return o;
}
DI void unpack8(u32x4 v, float* f) {
  f[0] = bflo(v.x); f[1] = bfhi(v.x); f[2] = bflo(v.y); f[3] = bfhi(v.y);
  f[4] = bflo(v.z); f[5] = bfhi(v.z); f[6] = bflo(v.w); f[7] = bfhi(v.w);
}
DI void wave_lds_sync() {
  __builtin_amdgcn_fence(__ATOMIC_RELEASE, "wavefront");
  __builtin_amdgcn_wave_barrier();
  __builtin_amdgcn_fence(__ATOMIC_ACQUIRE, "wavefront");
}


#define XB_TMO      128
#define XB_XCNT(j)  (256  + 64 * (j))
#define XB_XSUB(j)  (1280 + 64 * (j))
#define XB_XGEN(j)  (2304 + 64 * (j))
#define XB_TOP      3328
#define XB_TOPGEN   3392
#define XCD_BAR_WORDS 3456
#define XB_SPIN_CAP (1u << 24)
#define LAS __attribute__((address_space(3)))
DI unsigned xb_ld(unsigned* p) { return __hip_atomic_load(p, __ATOMIC_RELAXED, __HIP_MEMORY_SCOPE_AGENT); }
DI unsigned xb_add(unsigned* p, unsigned v) { return __hip_atomic_fetch_add(p, v, __ATOMIC_RELAXED, __HIP_MEMORY_SCOPE_AGENT); }
DI unsigned xb_xcc_id() { return (unsigned)__builtin_amdgcn_s_getreg((3 << 11) | 20) & 0xFu; }
#define XB_SPIN(cond, bar) do { unsigned _sp = 0; while (cond) { __builtin_amdgcn_s_sleep(1); \
    if ((++_sp & 255u) == 0u) { if (xb_ld(&(bar)[XB_TMO])) break; if (_sp > XB_SPIN_CAP) { atomicAdd(&(bar)[XB_TMO], 1u); break; } } } } while (0)
struct XcdBarrier { unsigned* bar; unsigned x; volatile LAS unsigned* st; };
DI XcdBarrier xcd_barrier_post(unsigned* bar, volatile LAS unsigned* st) {
  XcdBarrier b; b.bar = bar; b.x = xb_xcc_id(); b.st = st;
  if (threadIdx.x == 0) (void)xb_add(&bar[XB_XCNT(b.x)], 1u);
  return b;
}
DI void xcd_barrier_complete(unsigned* bar, unsigned x, unsigned& nloc, unsigned& nx) {
  const unsigned G = gridDim.x * gridDim.y * gridDim.z;
  unsigned sum, cnt, mine, sp = 0u;
  for (;;) {
    sum = 0u; cnt = 0u; mine = 0u;
#pragma unroll
    for (unsigned j = 0; j < 16; ++j) { const unsigned c = xb_ld(&bar[XB_XCNT(j)]); sum += c; cnt += (c > 0u) ? 1u : 0u; mine = (j == x) ? c : mine; }
    if (sum == G) break;
    __builtin_amdgcn_s_sleep(1);
    if ((++sp & 255u) == 0u) { if (xb_ld(&bar[XB_TMO])) break; if (sp > XB_SPIN_CAP) { atomicAdd(&bar[XB_TMO], 1u); break; } }
  }
  nloc = mine > 0u ? mine : 1u; nx = cnt > 0u ? cnt : 1u;
}
DI void xcd_barrier(const XcdBarrier& b) {
  asm volatile("s_waitcnt vmcnt(0)" ::: "memory");
  __syncthreads();
  if (threadIdx.x == 0) {
    unsigned* bar = b.bar;
    __builtin_amdgcn_s_waitcnt(0);
    unsigned nloc = b.st[0], nx = b.st[1];
    if (nloc == 0u) { xcd_barrier_complete(bar, b.x, nloc, nx); b.st[0] = nloc; b.st[1] = nx; }
    const unsigned old = xb_add(&bar[XB_XSUB(b.x)], 1u);
    const unsigned gen = old / nloc;
    if (old + 1u == (gen + 1u) * nloc) {
      __builtin_amdgcn_fence(__ATOMIC_RELEASE, "agent");
      asm volatile("s_waitcnt vmcnt(0)" ::: "memory");
      const unsigned og = xb_add(&bar[XB_TOP], 1u);
      const unsigned tg = og / nx;
      if (og + 1u == (tg + 1u) * nx) xb_add(&bar[XB_TOPGEN], 1u);
      else XB_SPIN(xb_ld(&bar[XB_TOPGEN]) == tg, bar);
      __builtin_amdgcn_fence(__ATOMIC_ACQUIRE, "agent");
      xb_add(&bar[XB_XGEN(b.x)], 1u);
      asm volatile("s_waitcnt vmcnt(0)" ::: "memory");
    } else {
      XB_SPIN(xb_ld(&bar[XB_XGEN(b.x)]) == gen, bar);
      __builtin_amdgcn_fence(__ATOMIC_ACQUIRE, "agent");
      asm volatile("s_waitcnt vmcnt(0)" ::: "memory");
    }
  }
  __syncthreads();
}

template <int BM, int BN>
DI void gemm_acc(const u16* __restrict__ A, int lda, int kstrA, const u16* __restrict__ Bt, int ldb, int kstrB, int K,
                 f32x16 (&acc)[BM / 64][BN / 64], char* smem) {
  constexpr int MI = BM / 64, NJ = BN / 64, NAC = BM / 32, NBC = BN / 32;
  u16* sA = (u16*)smem;
  u16* sB = sA + BM * 72;
  const int tid = otid(), lane = tid & 63, w = tid >> 6, wm = w >> 1, wn = w & 1, r = lane & 31, h = lane >> 5;
  u32x4 ra[NAC], rb[NBC];
  const int crow_ = tid >> 3, ccol = (tid & 7) * 8;
  const u16* Ap = A + (size_t)crow_ * lda + ccol;
  const u16* Bp = Bt + (size_t)crow_ * ldb + ccol;
#pragma unroll
  for (int i = 0; i < NAC; ++i) ra[i] = *(const u32x4*)(Ap + (size_t)(32 * i) * lda);
#pragma unroll
  for (int i = 0; i < NBC; ++i) rb[i] = *(const u32x4*)(Bp + (size_t)(32 * i) * ldb);
  const int nk = K >> 6;
  for (int kt = 0; kt < nk; ++kt) {
    __syncthreads();
#pragma unroll
    for (int i = 0; i < NAC; ++i) *(u32x4*)(sA + (crow_ + 32 * i) * 72 + ccol) = ra[i];
#pragma unroll
    for (int i = 0; i < NBC; ++i) *(u32x4*)(sB + (crow_ + 32 * i) * 72 + ccol) = rb[i];
    __syncthreads();
    if (kt + 1 < nk) {
      const size_t koA = (size_t)(kt + 1) * kstrA, koB = (size_t)(kt + 1) * kstrB;
#pragma unroll
      for (int i = 0; i < NAC; ++i) ra[i] = *(const u32x4*)(Ap + (size_t)(32 * i) * lda + koA);
#pragma unroll
      for (int i = 0; i < NBC; ++i) rb[i] = *(const u32x4*)(Bp + (size_t)(32 * i) * ldb + koB);
    }
#pragma unroll
    for (int ks = 0; ks < 4; ++ks) {
      bf16x8 b[NJ];
#pragma unroll
      for (int j = 0; j < NJ; ++j) b[j] = ldfrag(sB, 72, wn * (BN / 2) + 32 * j + r, ks * 16 + 8 * h);
#pragma unroll
      for (int i = 0; i < MI; ++i) {
        const bf16x8 a = ldfrag(sA, 72, wm * (BM / 2) + 32 * i + r, ks * 16 + 8 * h);
#pragma unroll
        for (int j = 0; j < NJ; ++j) acc[i][j] = MFMA32(a, b[j], acc[i][j]);
      }
    }
  }
}

DI size_t wtile(int n0, int K) { return (size_t)(n0 >> 7) * (size_t)(K >> 6) * 8192; }
DI size_t htile(int m0) { return (size_t)(m0 >> 8) * 16 * 16384 + (size_t)(m0 & 255) * 64; }

template <int MI, int NJ>
DI void zero_acc(f32x16 (&acc)[MI][NJ]) {
#pragma unroll
  for (int i = 0; i < MI; ++i)
#pragma unroll
    for (int j = 0; j < NJ; ++j)
#pragma unroll
      for (int e = 0; e < 16; ++e) acc[i][j][e] = 0.f;
}

#define TILE_WALK_BEGIN(MT, NT, SM, SN)                                                   \
  {                                                                                       \
    const int xg_ = bid & 7, loc_ = bid >> 3, nloc_ = nblk >> 3;                          \
    const int nsn_ = ((NT) + (SN) - 1) / (SN), nst_ = (((MT) + (SM) - 1) / (SM)) * nsn_;  \
    for (int st_ = xg_; st_ < nst_; st_ += 8)                                             \
      for (int j_ = loc_; j_ < (SM) * (SN); j_ += nloc_) {                                \
        const int mi = (st_ / nsn_) * (SM) + j_ / (SN), ni = (st_ % nsn_) * (SN) + j_ % (SN); \
        if (mi >= (MT) || ni >= (NT)) continue;
#define TILE_WALK_END }}

DI int t5_bucket(int rel) {
  int n = rel < 0 ? -rel : rel;
  float nf = (float)(n > 1 ? n : 1);
  int large = 8 + (int)(logf(nf / 8.f) / logf(16.f) * 8.f);
  large = large < 15 ? large : 15;
  return (rel > 0 ? 16 : 0) + (n < 8 ? n : large);
}

DI void prep_job(const float* __restrict__ src, int K, int Nsrc, u16* __restrict__ dst, int Ndst, int mode,
                 const float* __restrict__ scale, char* smem, int bid, int nblk) {
  u16* sT = (u16*)smem;
  const int tid = otid();
  const int ntn = Ndst >> 6, ntk = K >> 6;
  float v[16];
  auto gl = [&](int t) {
    const int n0 = (t / ntk) << 6, k0 = (t % ntk) << 6;
    const int n = n0 + (tid & 63);
    int sc = n;
    if (mode == 1) sc = (n < 1536) ? n : (n < 6912 ? n + 16 : (n < 6928 ? n - 6912 + 1536 : -1));
#pragma unroll
    for (int i = 0; i < 16; ++i) {
      const int k = i * 4 + (tid >> 6);
      float x = 0.f;
      if (sc >= 0) x = src[(size_t)(k0 + k) * Nsrc + sc];
      if (scale) x *= scale[k0 + k];
      v[i] = x;
    }
  };
  if (bid < ntn * ntk) gl(bid);
  for (int t = bid; t < ntn * ntk; t += nblk) {
    const int n0 = (t / ntk) << 6, k0 = (t % ntk) << 6;
    __syncthreads();
#pragma unroll
    for (int i = 0; i < 16; ++i) sT[(tid & 63) * 72 + i * 4 + (tid >> 6)] = f2bf(v[i]);
    if (t + nblk < ntn * ntk) gl(t + nblk);
    __syncthreads();
    const int nn = tid >> 2, ks = (tid & 3) * 16;
    u32x4 v0 = *(const u32x4*)(sT + nn * 72 + ks), v1 = *(const u32x4*)(sT + nn * 72 + ks + 8);
    u16* d = dst + ((size_t)((n0 + nn) >> 7) * (size_t)(K >> 6) + (size_t)(k0 >> 6)) * 8192 + (size_t)((n0 + nn) & 127) * 64 + ks;
    *(u32x4*)d = v0;
    *(u32x4*)(d + 8) = v1;
  }
}

DI void phase_prologue(const Params& p, char* smem, int bid, int nblk) {
  const int tid = otid(), lane = tid & 63, w = tid >> 6;
  for (int i = bid * 256 + tid; i < 12 * 4095; i += nblk * 256) {
    const int hd = i / 4095, idx = i % 4095;
    p.lut[hd * LUTS + idx] = p.in[2][t5_bucket(idx - 2047) * 12 + hd];
  }
  for (int row = bid * 4 + w; row < NBATCH * MEML; row += nblk * 4) {
    const float* src = p.in[1] + (size_t)row * D_;
    float ss = 0.f;
#pragma unroll
    for (int i = 0; i < 4; ++i) {
      f32x4 v = *(const f32x4*)(src + i * 256 + lane * 4);
      ss += v[0] * v[0] + v[1] * v[1] + v[2] * v[2] + v[3] * v[3];
      u32x2 o; o.x = pk2(v[0], v[1]); o.y = pk2(v[2], v[3]);
      *(u32x2*)(p.memb + (size_t)row * D_ + i * 256 + lane * 4) = o;
    }
    ss = wave_sum(ss);
    if (lane == 0) p.memrs[row] = rsqrtf(ss / (float)D_ + EPS_);
  }
  for (int l = 0; l < 2; ++l) {
    u16* W = p.W + (size_t)l * LAYER_W;
    prep_job(p.in[5] + (size_t)l * D_ * 6928, D_, 6928, W + WIN_OFF, PW, 1, nullptr, smem, bid, nblk);
    for (int i = 0; i < 5; ++i)
      prep_job(p.in[27] + ((size_t)l * 5 + i) * D_ * D_, D_, D_, W + WMG_OFF + (size_t)i * D_ * D_, D_, 0, nullptr, smem, bid, nblk);
    for (int i = 0; i < 5; ++i)
      prep_job(p.in[29] + ((size_t)l * 5 + i) * BWID * D_, BWID, D_, W + WBR_OFF + (size_t)i * D_ * BWID, D_, 0, nullptr, smem, bid, nblk);
    prep_job(p.in[30] + (size_t)l * D_ * D_, D_, D_, W + WOUT_OFF, D_, 0, nullptr, smem, bid, nblk);
    prep_job(p.in[23] + (size_t)l * BWID * BWID, BWID, BWID, W + WGLU_OFF, BWID, 0, nullptr, smem, bid, nblk);
    prep_job(p.in[26] + (size_t)l * D_ * D_, D_, D_, W + WKV_OFF, D_, 0, p.in[25] + (size_t)l * D_, smem, bid, nblk);
  }
}

DI void phase_norm(const float* __restrict__ x, const float* __restrict__ g, u16* __restrict__ hdst, int nrows, int bid, int nblk) {
  const int tid_ = otid(), lane = tid_ & 63, w = tid_ >> 6;
  for (int row = bid * 4 + w; row < nrows; row += nblk * 4) {
    const float* src = x + (size_t)row * D_;
    f32x4 v[4];
    float ss = 0.f;
#pragma unroll
    for (int i = 0; i < 4; ++i) {
      v[i] = *(const f32x4*)(src + i * 256 + lane * 4);
      ss += v[i][0] * v[i][0] + v[i][1] * v[i][1] + v[i][2] * v[i][2] + v[i][3] * v[i][3];
    }
    ss = wave_sum(ss);
    const float rs = rsqrtf(ss / (float)D_ + EPS_);
#pragma unroll
    for (int i = 0; i < 4; ++i) {
      f32x4 gg = *(const f32x4*)(g + i * 256 + lane * 4);
      u32x2 o; o.x = pk2(v[i][0] * rs * gg[0], v[i][1] * rs * gg[1]); o.y = pk2(v[i][2] * rs * gg[2], v[i][3] * rs * gg[3]);
      const int c = i * 256 + lane * 4;
      *(u32x2*)(hdst + ((size_t)(row >> 8) * 16 + (c >> 6)) * 16384 + (size_t)(row & 255) * 64 + (c & 63)) = o;
    }
  }
}

DI void phase_final(float* __restrict__ x, const float* __restrict__ g, int nrows, int bid, int nblk) {
  const int tid_ = otid(), lane = tid_ & 63, w = tid_ >> 6;
  for (int row = bid * 4 + w; row < nrows; row += nblk * 4) {
    float* src = x + (size_t)row * D_;
    f32x4 v[4];
    float ss = 0.f;
#pragma unroll
    for (int i = 0; i < 4; ++i) {
      v[i] = *(const f32x4*)(src + i * 256 + lane * 4);
      ss += v[i][0] * v[i][0] + v[i][1] * v[i][1] + v[i][2] * v[i][2] + v[i][3] * v[i][3];
    }
    ss = wave_sum(ss);
    const float rs = rsqrtf(ss / (float)D_ + EPS_);
#pragma unroll
    for (int i = 0; i < 4; ++i) {
      f32x4 gg = *(const f32x4*)(g + i * 256 + lane * 4);
      f32x4 o; o[0] = v[i][0] * rs * gg[0]; o[1] = v[i][1] * rs * gg[1]; o[2] = v[i][2] * rs * gg[2]; o[3] = v[i][3] * rs * gg[3];
      *(f32x4*)(src + i * 256 + lane * 4) = o;
    }
  }
}

DI void phase_kv(const Params& p, char* smem, int bid, int nblk) {
  const int tid_ = otid(), lane = tid_ & 63, w = tid_ >> 6, wm = w >> 1, wn = w & 1, r = lane & 31, h = lane >> 5;
  for (int t = bid; t < 2 * 32 * 8; t += nblk) {
    const int l = t >> 8, tt = t & 255, m0 = (tt >> 3) * 128, n0 = (tt & 7) * 128;
    f32x16 acc[2][2];
    zero_acc<2, 2>(acc);
    gemm_acc<128, 128>(p.memb + (size_t)m0 * D_, D_, 64, p.W + (size_t)l * LAYER_W + WKV_OFF + wtile(n0, D_), 64, 8192, D_, acc, smem);
    u16* dst = p.KV + (size_t)l * NBATCH * MEML * D_;
#pragma unroll
    for (int i = 0; i < 2; ++i)
#pragma unroll
      for (int e = 0; e < 16; ++e) {
        const int row = m0 + wm * 64 + 32 * i + crow(e, h);
        const float rs = p.memrs[row];
#pragma unroll
        for (int j = 0; j < 2; ++j) dst[(size_t)row * D_ + n0 + wn * 64 + 32 * j + r] = f2bf(acc[i][j][e] * rs);
      }
  }
}

DI void phase_inproj(const Params& p, int l, int Tg, char* smem, int bid, int nblk) {
  const int tid_ = otid(), lane = tid_ & 63, w = tid_ >> 6, wm = w >> 1, wn = w & 1, r = lane & 31, h = lane >> 5;
  const int MT = Tg / 256, NT = PW / 128;
  TILE_WALK_BEGIN(MT, NT, 8, 8)
    const int m0 = mi * 256, n0 = ni * 128;
    f32x16 acc[4][2];
    zero_acc<4, 2>(acc);
    gemm_acc<256, 128>(p.h + htile(m0), 64, 16384, p.W + (size_t)l * LAYER_W + WIN_OFF + wtile(n0, D_), 64, 8192, D_, acc, smem);
#pragma unroll
    for (int i = 0; i < 4; ++i)
#pragma unroll
      for (int e = 0; e < 16; ++e) {
        const int row = m0 + wm * 128 + 32 * i + crow(e, h);
#pragma unroll
        for (int j = 0; j < 2; ++j) p.P[(size_t)row * PW + n0 + wn * 64 + 32 * j + r] = f2bf(acc[i][j][e]);
      }
  TILE_WALK_END
}

DI void phase_glu(const Params& p, int l, int Tg, char* smem, int bid, int nblk) {
  const int tid_ = otid(), lane = tid_ & 63, w = tid_ >> 6, wm = w >> 1, wn = w & 1, r = lane & 31, h = lane >> 5;
  const float* gb = p.in[24] + (size_t)l * BWID;
  const int ntiles = (Tg / 128) * 4;
  for (int t = bid; t < ntiles; t += nblk) {
    const int m0 = (t >> 2) * 128, n0 = (t & 3) * 128;
    f32x16 acc[2][2];
    zero_acc<2, 2>(acc);
    gemm_acc<128, 128>(p.s5f + (size_t)m0 * BWID, BWID, 64, p.W + (size_t)l * LAYER_W + WGLU_OFF + wtile(n0, BWID), 64, 8192, BWID, acc, smem);
#pragma unroll
    for (int i = 0; i < 2; ++i)
#pragma unroll
      for (int e = 0; e < 16; ++e) {
        const int row = m0 + wm * 64 + 32 * i + crow(e, h);
#pragma unroll
        for (int j = 0; j < 2; ++j) {
          const int col = n0 + wn * 64 + 32 * j + r;
          const float g = bf2f(p.s5f[(size_t)row * BWID + col]);
          const float z = bf2f(p.P[(size_t)row * PW + P_UZ + col]);
          p.o3[(size_t)row * BWID + col] = f2bf(g * sigmoidf_(acc[i][j][e] + gb[col]) * siluf_(z));
        }
      }
  }
}

DI void phase_merge(const Params& p, int l, int Tg, u16* __restrict__ ydst, char* smem, int bid, int nblk) {
  const int tid_ = otid(), lane = tid_ & 63, w = tid_ >> 6, wm = w >> 1, wn = w & 1, r = lane & 31, h = lane >> 5;
  const int MT = Tg / 128, NT = 8;
  const u16* W = p.W + (size_t)l * LAYER_W;
  TILE_WALK_BEGIN(MT, NT, 16, 4)
    const int m0 = mi * 128, n0 = ni * 128;
    f32x16 yacc[2][2];
    zero_acc<2, 2>(yacc);
    for (int br = 0; br < 5; ++br) {
      const u16* ob = (br == 0) ? p.o0 : (br == 1) ? p.o1 : (br == 2) ? p.o2 : (br == 3) ? p.o3 : p.o4;
      unsigned* sG = (unsigned*)(smem + 40 * 1024) + tid_;
      {
        f32x16 ag[2][2];
        zero_acc<2, 2>(ag);
        gemm_acc<128, 128>(p.h + htile(m0), 64, 16384, W + WMG_OFF + (size_t)br * D_ * D_ + wtile(n0, D_), 64, 8192, D_, ag, smem);
#pragma unroll
        for (int j = 0; j < 2; ++j) {
          const float b = p.in[28][((size_t)l * 5 + br) * D_ + n0 + wn * 64 + 32 * j + r];
#pragma unroll
          for (int i = 0; i < 2; ++i)
#pragma unroll
            for (int e = 0; e < 8; ++e)
              sG[((i * 2 + j) * 8 + e) * 256] = pk2(sigmoidf_(ag[i][j][2 * e] + b), sigmoidf_(ag[i][j][2 * e + 1] + b));
        }
      }
      f32x16 ap[2][2];
      zero_acc<2, 2>(ap);
      gemm_acc<128, 128>(ob + (size_t)m0 * BWID, BWID, 64, W + WBR_OFF + (size_t)br * D_ * BWID + wtile(n0, BWID), 64, 8192, BWID, ap, smem);
#pragma unroll
      for (int i = 0; i < 2; ++i)
#pragma unroll
        for (int j = 0; j < 2; ++j)
#pragma unroll
          for (int e = 0; e < 8; ++e) {
            const unsigned gv = sG[((i * 2 + j) * 8 + e) * 256];
            yacc[i][j][2 * e] += bflo(gv) * ap[i][j][2 * e];
            yacc[i][j][2 * e + 1] += bfhi(gv) * ap[i][j][2 * e + 1];
          }
    }
#pragma unroll
    for (int i = 0; i < 2; ++i)
#pragma unroll
      for (int e = 0; e < 16; ++e) {
        const int row = m0 + wm * 64 + 32 * i + crow(e, h);
#pragma unroll
        for (int j = 0; j < 2; ++j) ydst[(size_t)row * D_ + n0 + wn * 64 + 32 * j + r] = f2bf(yacc[i][j][e]);
      }
  TILE_WALK_END
}

DI void phase_out(const Params& p, int l, int Tg, const u16* ysrc, const float* xin,
                  float* xout, char* smem, int bid, int nblk) {
  const int tid_ = otid(), lane = tid_ & 63, w = tid_ >> 6, wm = w >> 1, wn = w & 1, r = lane & 31, h = lane >> 5;
  const int MT = Tg / 256, NT = 8;
  TILE_WALK_BEGIN(MT, NT, 8, 8)
    const int m0 = mi * 256, n0 = ni * 128;
    f32x16 acc[4][2];
    zero_acc<4, 2>(acc);
    gemm_acc<256, 128>(ysrc + (size_t)m0 * D_, D_, 64, p.W + (size_t)l * LAYER_W + WOUT_OFF + wtile(n0, D_), 64, 8192, D_, acc, smem);
#pragma unroll
    for (int i = 0; i < 4; ++i)
#pragma unroll
      for (int e = 0; e < 16; ++e) {
        const size_t row = m0 + wm * 128 + 32 * i + crow(e, h);
#pragma unroll
        for (int j = 0; j < 2; ++j) {
          const size_t idx = row * D_ + n0 + wn * 64 + 32 * j + r;
          xout[idx] = xin[idx] + acc[i][j][e];
        }
      }
  TILE_WALK_END
}

DI void phase_conv(const Params& p, int l, int Tg, int bid, int nblk) {
  const float* cw = p.in[6] + (size_t)l * 5 * 1024;
  const float* cb = p.in[7] + (size_t)l * 1024;
  const int total = Tg * 128;
  for (int idx = bid * 256 + threadIdx.x; idx < total; idx += nblk * 256) {
    const int tok = idx >> 7, c0 = (idx & 127) * 8;
    const int spos = tok & (S_ - 1);
    float acc[8];
#pragma unroll
    for (int j = 0; j < 8; ++j) acc[j] = cb[c0 + j];
#pragma unroll
    for (int k = 0; k < 5; ++k) {
      const int sp = spos + k - 2;
      if (sp >= 0 && sp < S_) {
        u32x4 v = *(const u32x4*)(p.P + (size_t)(tok + k - 2) * PW + c0);
        float f[8];
        unpack8(v, f);
#pragma unroll
        for (int j = 0; j < 8; ++j) acc[j] += f[j] * cw[k * 1024 + c0 + j];
      }
    }
    u32x4 o;
    o.x = pk2(siluf_(acc[0]), siluf_(acc[1])); o.y = pk2(siluf_(acc[2]), siluf_(acc[3]));
    o.z = pk2(siluf_(acc[4]), siluf_(acc[5])); o.w = pk2(siluf_(acc[6]), siluf_(acc[7]));
    *(u32x4*)(p.xa + (size_t)tok * 1024 + c0) = o;
  }
}

template <int DQK, int DV>
DI void attn_pass(const bf16x8 (&qf)[DQK / 16], const u16* __restrict__ Kg, int ldk, const u16* __restrict__ Vg, int ldv,
                  int kt0, int kt1, int q_pos, int q_lo, const float* lut, int window, float m_init, float l_init,
                  f32x16 (&o)[DV / 32], float& l_out, u16* sK, u16* sV) {
  constexpr int LDK = DQK + 8, LDV = DV + 16, NKC = DQK / 32, NVC = DV / 32;
  const int tid = otid(), lane = tid & 63, r = lane & 31, h = lane >> 5;
  u32x4 rk[NKC], rv[NVC];
#pragma unroll
  for (int d = 0; d < DV / 32; ++d)
#pragma unroll
    for (int e = 0; e < 16; ++e) o[d][e] = 0.f;
  float m = m_init, lsum = (h == 0) ? l_init : 0.f;
  {
#pragma unroll
    for (int i = 0; i < NKC; ++i) { const int c = tid + 256 * i, row = c / (DQK / 8), col = (c % (DQK / 8)) * 8; rk[i] = *(const u32x4*)(Kg + (size_t)(kt0 * 64 + row) * ldk + col); }
#pragma unroll
    for (int i = 0; i < NVC; ++i) { const int c = tid + 256 * i, row = c / (DV / 8), col = (c % (DV / 8)) * 8; rv[i] = *(const u32x4*)(Vg + (size_t)(kt0 * 64 + row) * ldv + col); }
  }
#pragma unroll 1
  for (int kt = kt0; kt < kt1; ++kt) {
    __syncthreads();
#pragma unroll
    for (int i = 0; i < NKC; ++i) { const int c = tid + 256 * i, row = c / (DQK / 8), col = (c % (DQK / 8)) * 8; *(u32x4*)(sK + row * LDK + col) = rk[i]; }
#pragma unroll
    for (int i = 0; i < NVC; ++i) { const int c = tid + 256 * i, row = c / (DV / 8), col = (c % (DV / 8)) * 8; *(u32x4*)(sV + row * LDV + col) = rv[i]; }
    __syncthreads();
    if (kt + 1 < kt1) {
#pragma unroll
      for (int i = 0; i < NKC; ++i) { const int c = tid + 256 * i, row = c / (DQK / 8), col = (c % (DQK / 8)) * 8; rk[i] = *(const u32x4*)(Kg + (size_t)((kt + 1) * 64 + row) * ldk + col); }
#pragma unroll
      for (int i = 0; i < NVC; ++i) { const int c = tid + 256 * i, row = c / (DV / 8), col = (c % (DV / 8)) * 8; rv[i] = *(const u32x4*)(Vg + (size_t)((kt + 1) * 64 + row) * ldv + col); }
    }
    f32x16 s[2];
#pragma unroll
    for (int t = 0; t < 2; ++t) {
      bf16x8 ka[DQK / 16];
#pragma unroll
      for (int ks = 0; ks < DQK / 16; ++ks) ka[ks] = ldfrag(sK, LDK, 32 * t + r, 16 * ks + 8 * h);
#pragma unroll
      for (int e = 0; e < 16; ++e) s[t][e] = 0.f;
#pragma unroll
      for (int ks = 0; ks < DQK / 16; ++ks) s[t] = MFMA32(ka[ks], qf[ks], s[t]);
    }
    const int kbase = kt * 64;
    if (lut) {
      const bool far_ = (window == 0) && ((kbase - (q_lo + 31) >= 91) || (q_lo - (kbase + 63) >= 91));
      if (far_) {
        const float bconst = lut[kbase - q_lo + 2047];
#pragma unroll
        for (int t = 0; t < 2; ++t)
#pragma unroll
          for (int e = 0; e < 16; ++e) s[t][e] += bconst;
      } else {
#pragma unroll
        for (int t = 0; t < 2; ++t)
#pragma unroll
          for (int e = 0; e < 16; ++e) {
            const int rel = kbase + 32 * t + crow(e, h) - q_pos;
            float v = s[t][e] + lut[rel + 2047];
            if (window > 0 && (rel > window || rel < -window)) v = -INFINITY;
            s[t][e] = v;
          }
      }
    }
    float mx = s[0][0];
#pragma unroll
    for (int t = 0; t < 2; ++t)
#pragma unroll
      for (int e = 0; e < 16; ++e) mx = fmaxf(mx, s[t][e]);
    mx = fmaxf(mx, __shfl_xor(mx, 32, 64));
    if (__builtin_amdgcn_ballot_w64(mx > m + 8.f) != 0ull) {
      const float mn = fmaxf(m, mx);
      const float alpha = __builtin_amdgcn_exp2f(m - mn);
      m = mn;
      lsum *= alpha;
#pragma unroll
      for (int d = 0; d < DV / 32; ++d)
#pragma unroll
        for (int e = 0; e < 16; ++e) o[d][e] *= alpha;
    }
    float ps = 0.f;
#pragma unroll
    for (int t = 0; t < 2; ++t)
#pragma unroll
      for (int e = 0; e < 16; ++e) { const float pv = __builtin_amdgcn_exp2f(s[t][e] - m); s[t][e] = pv; ps += pv; }
    lsum += ps;
    bf16x8 pf[2][2];
#pragma unroll
    for (int t = 0; t < 2; ++t)
#pragma unroll
      for (int s2 = 0; s2 < 2; ++s2) pf[t][s2] = pack8(s[t], s2);
#pragma unroll
    for (int d = 0; d < DV / 32; ++d) {
      bf16x8 va[2][2];
#pragma unroll
      for (int t = 0; t < 2; ++t)
#pragma unroll
        for (int s2 = 0; s2 < 2; ++s2) va[t][s2] = ldfrag_tr_perm(sV, LDV, 32 * t + 16 * s2, 32 * d, lane);
#pragma unroll
      for (int t = 0; t < 2; ++t)
#pragma unroll
        for (int s2 = 0; s2 < 2; ++s2) o[d] = MFMA32(va[t][s2], pf[t][s2], o[d]);
    }
  }
  lsum += __shfl_xor(lsum, 32, 64);
  l_out = lsum;
}

template <int DQK>
DI void load_qfrag(bf16x8 (&qf)[DQK / 16], const u16* qrow, float scale, int h) {
#pragma unroll
  for (int ks = 0; ks < DQK / 16; ++ks) {
    u32x4 v = *(const u32x4*)(qrow + 16 * ks + 8 * h);
    qf[ks] = __builtin_bit_cast(bf16x8, scale8(v, scale));
  }
}

DI void attn_lds(char* smem, u16*& sK, u16*& sV, float*& slut) {
  sK = (u16*)smem; sV = sK + 64 * 136; slut = (float*)(sV + 64 * 144);
}

DI void diff_item(const Params& p, int l, int item, char* smem) {
  const int tid = otid(), lane = tid & 63, w = tid >> 6, r = lane & 31, h = lane >> 5;
  const int bl = item >> 6, hd = (item >> 4) & 3, qb = item & 15;
  u16 *sK, *sV; float* slut;
  attn_lds(smem, sK, sV, slut);
  __syncthreads();
  for (int i = tid; i < 4095; i += 256) slut[i] = p.lut[hd * LUTS + i] * 1.4426950408889634f;
  const float lam_init = 0.8f - 0.6f * expf(-0.3f * (float)l);
  const float* lp = p.in[12] + (size_t)l * 4 * 64;
  const float d1 = wave_sum(lp[lane] * lp[64 + lane]), d2 = wave_sum(lp[128 + lane] * lp[192 + lane]);
  const float lam = expf(d1) - expf(d2) + lam_init;
  const int q_lo = qb * 128 + 32 * w, q_pos = q_lo + r;
  const size_t tokq = (size_t)bl * S_ + q_pos;
  const u16* Pb = p.P + (size_t)bl * S_ * PW;
  f32x16 o[4];
  float lt;
  u16* odst = p.o1 + tokq * BWID + hd * 128;
  {
    bf16x8 qf[4];
    load_qfrag<64>(qf, p.P + tokq * PW + P_DQ + (hd * 2 + 0) * 64, 0.125f * 1.4426950408889634f, h);
    attn_pass<64, 128>(qf, Pb + P_DK + (hd * 2 + 0) * 64, PW, Pb + P_DV + hd * 128, PW, 0, 32, q_pos, q_lo, slut, 0, -INFINITY, 0.f, o, lt, sK, sV);
    const float inv = 1.f / lt;
#pragma unroll
    for (int d = 0; d < 4; ++d)
#pragma unroll
      for (int g4 = 0; g4 < 4; ++g4) {
        u32x2 ov;
        ov.x = pk2(o[d][4 * g4 + 0] * inv, o[d][4 * g4 + 1] * inv);
        ov.y = pk2(o[d][4 * g4 + 2] * inv, o[d][4 * g4 + 3] * inv);
        *(u32x2*)(odst + 32 * d + 8 * g4 + 4 * h) = ov;
      }
  }
  {
    bf16x8 qf[4];
    load_qfrag<64>(qf, p.P + tokq * PW + P_DQ + (hd * 2 + 1) * 64, 0.125f * 1.4426950408889634f, h);
    attn_pass<64, 128>(qf, Pb + P_DK + (hd * 2 + 1) * 64, PW, Pb + P_DV + hd * 128, PW, 0, 32, q_pos, q_lo, slut, 0, -INFINITY, 0.f, o, lt, sK, sV);
    const float inv = lam / lt;
#pragma unroll
    for (int d = 0; d < 4; ++d)
#pragma unroll
      for (int g4 = 0; g4 < 4; ++g4) {
        const u32x2 pv = *(const u32x2*)(odst + 32 * d + 8 * g4 + 4 * h);
        o[d][4 * g4 + 0] = bflo(pv.x) - o[d][4 * g4 + 0] * inv;
        o[d][4 * g4 + 1] = bfhi(pv.x) - o[d][4 * g4 + 1] * inv;
        o[d][4 * g4 + 2] = bflo(pv.y) - o[d][4 * g4 + 2] * inv;
        o[d][4 * g4 + 3] = bfhi(pv.y) - o[d][4 * g4 + 3] * inv;
      }
  }
  float ss = 0.f;
#pragma unroll
  for (int d = 0; d < 4; ++d)
#pragma unroll
    for (int e = 0; e < 16; ++e) ss += o[d][e] * o[d][e];
  ss += __shfl_xor(ss, 32, 64);
  const float rs = rsqrtf(ss / 128.f + EPS_) * (1.f - lam_init);
  const float* sg = p.in[13] + (size_t)l * 128;
#pragma unroll
  for (int d = 0; d < 4; ++d)
#pragma unroll
    for (int g4 = 0; g4 < 4; ++g4) {
      const int dv = 32 * d + 8 * g4 + 4 * h;
      const u32x2 zz = *(const u32x2*)(p.P + tokq * PW + P_DZ + hd * 128 + dv);
      const float z0 = bflo(zz.x), z1 = bfhi(zz.x), z2 = bflo(zz.y), z3 = bfhi(zz.y);
      u32x2 ov;
      ov.x = pk2(o[d][4 * g4 + 0] * rs * sg[dv + 0] * siluf_(z0), o[d][4 * g4 + 1] * rs * sg[dv + 1] * siluf_(z1));
      ov.y = pk2(o[d][4 * g4 + 2] * rs * sg[dv + 2] * siluf_(z2), o[d][4 * g4 + 3] * rs * sg[dv + 3] * siluf_(z3));
      *(u32x2*)(odst + dv) = ov;
    }
}

DI void win_item(const Params& p, int l, int item, char* smem) {
  const int tid = otid(), lane = tid & 63, w = tid >> 6, r = lane & 31, h = lane >> 5;
  const int bl = item >> 7, qh = (item >> 4) & 7, qb = item & 15;
  const int kvh = qh >> 2;
  u16 *sK, *sV; float* slut;
  attn_lds(smem, sK, sV, slut);
  __syncthreads();
  for (int i = tid; i < 4095; i += 256) slut[i] = p.lut[(4 + qh) * LUTS + i] * 1.4426950408889634f;
  const float sink = p.in[14][l * 8 + qh];
  const int q_lo = qb * 128 + 32 * w, q_pos = q_lo + r;
  const size_t tokq = (size_t)bl * S_ + q_pos;
  const u16* Pb = p.P + (size_t)bl * S_ * PW;
  int kt0 = qb * 2 - 2; if (kt0 < 0) kt0 = 0;
  int kt1 = qb * 2 + 4; if (kt1 > 32) kt1 = 32;
  f32x16 o[2];
  float lt;
  bf16x8 qf[4];
  load_qfrag<64>(qf, p.P + tokq * PW + P_CQ + qh * 64, 0.125f * 1.4426950408889634f, h);
  attn_pass<64, 64>(qf, Pb + P_CK + kvh * 64, PW, Pb + P_CV + kvh * 64, PW, kt0, kt1, q_pos, q_lo, slut, 128, sink * 1.4426950408889634f, 1.f, o, lt, sK, sV);
  const float inv = 1.f / lt;
#pragma unroll
  for (int d = 0; d < 2; ++d)
#pragma unroll
    for (int g4 = 0; g4 < 4; ++g4) {
      const int dv = 32 * d + 8 * g4 + 4 * h;
      const u32x2 zz = *(const u32x2*)(p.P + tokq * PW + P_CZ + qh * 64 + dv);
      const float z0 = bflo(zz.x), z1 = bfhi(zz.x), z2 = bflo(zz.y), z3 = bfhi(zz.y);
      u32x2 ov;
      ov.x = pk2(o[d][4 * g4 + 0] * inv * siluf_(z0), o[d][4 * g4 + 1] * inv * siluf_(z1));
      ov.y = pk2(o[d][4 * g4 + 2] * inv * siluf_(z2), o[d][4 * g4 + 3] * inv * siluf_(z3));
      *(u32x2*)(p.o2 + tokq * BWID + qh * 64 + dv) = ov;
    }
}

DI void mem_item(const Params& p, int l, int grp, int item, char* smem) {
  const int tid = otid(), lane = tid & 63, w = tid >> 6, r = lane & 31, h = lane >> 5;
  const int bl = item >> 6, hd = (item >> 4) & 3, qb = item & 15;
  u16 *sK, *sV; float* slut;
  attn_lds(smem, sK, sV, slut);
  const int q_lo = qb * 128 + 32 * w, q_pos = q_lo + r;
  const size_t tokq = (size_t)bl * S_ + q_pos;
  const int bg = grp * p.BG + bl;
  const u16* kv = p.KV + ((size_t)l * NBATCH + bg) * MEML * D_;
  f32x16 o[4];
  float lt;
  bf16x8 qf[8];
  load_qfrag<128>(qf, p.P + tokq * PW + P_MQ + hd * 128, 0.08838834764831845f * 1.4426950408889634f, h);
  attn_pass<128, 128>(qf, kv + hd * 128, D_, kv + 512 + hd * 128, D_, 0, 4, q_pos, q_lo, nullptr, 0, -INFINITY, 0.f, o, lt, sK, sV);
  const float inv = 1.f / lt;
#pragma unroll
  for (int d = 0; d < 4; ++d)
#pragma unroll
    for (int g4 = 0; g4 < 4; ++g4) {
      const int dv = 32 * d + 8 * g4 + 4 * h;
      const u32x2 zz = *(const u32x2*)(p.P + tokq * PW + P_MZ + hd * 128 + dv);
      const float z0 = bflo(zz.x), z1 = bfhi(zz.x), z2 = bflo(zz.y), z3 = bfhi(zz.y);
      u32x2 ov;
      ov.x = pk2(o[d][4 * g4 + 0] * inv * siluf_(z0), o[d][4 * g4 + 1] * inv * siluf_(z1));
      ov.y = pk2(o[d][4 * g4 + 2] * inv * siluf_(z2), o[d][4 * g4 + 3] * inv * siluf_(z3));
      *(u32x2*)(p.o4 + tokq * BWID + hd * 128 + dv) = ov;
    }
}

DI void ssd_item(const Params& p, int l, int item, char* smem) {
  const int tid = otid(), lane = tid & 63, w = tid >> 6, r = lane & 31, h = lane >> 5;
  const int bl = item >> 4, hd = (item >> 1) & 7, dir = item & 1;
  const int gq = hd >> 2, lt = w & 1, ph = w >> 1;
  u16* sB = (u16*)smem;
  u16* sC = sB + 64 * 136;
  u16* sX1 = sC + 64 * 136;
  u16* sX2 = sX1 + 64 * 80;
  u16* sS = sX2 + 64 * 80;
  float* sW = (float*)(sS + 64 * 136);
  float* sDt = sW + 64;
  const float Aneg = -expf(p.in[9][(l * 2 + dir) * 8 + hd]);
  const float dtb = p.in[8][(l * 2 + dir) * 8 + hd];
  u16* ydst = dir ? p.syb : p.o0;
  const u16* Pb = p.P + (size_t)bl * S_ * PW;
  const u16* xab = p.xa + (size_t)bl * S_ * 1024;
  __syncthreads();
  for (int i = tid; i < 64 * 136 / 2; i += 256) ((unsigned*)sS)[i] = 0u;
  f32x16 accS[2];
#pragma unroll
  for (int i = 0; i < 2; ++i)
#pragma unroll
    for (int e = 0; e < 16; ++e) accS[i][e] = 0.f;
  u32x4 rB[4], rC[4], rX[2];
  float rdt = 0.f;
  auto prefetch = [&](int cc) {
    if (tid < 64) {
      const int pp = 64 * cc + tid, tok = dir ? (S_ - 1 - pp) : pp;
      rdt = bf2f(Pb[(size_t)tok * PW + P_DT + dir * 8 + hd]);
    }
#pragma unroll
    for (int i = 0; i < 4; ++i) {
      const int c = tid + 256 * i, row = c >> 4, col = (c & 15) * 8;
      const int pp = 64 * cc + row, tok = dir ? (S_ - 1 - pp) : pp;
      rB[i] = *(const u32x4*)(xab + (size_t)tok * 1024 + 512 + gq * 128 + col);
      rC[i] = *(const u32x4*)(xab + (size_t)tok * 1024 + 768 + gq * 128 + col);
    }
#pragma unroll
    for (int i = 0; i < 2; ++i) {
      const int c = tid + 256 * i, row = c >> 3, col = (c & 7) * 8;
      const int pp = 64 * cc + row, tok = dir ? (S_ - 1 - pp) : pp;
      rX[i] = *(const u32x4*)(xab + (size_t)tok * 1024 + hd * 64 + col);
    }
  };
  prefetch(0);
#pragma unroll 1
  for (int cc = 0; cc < 32; ++cc) {
    __syncthreads();
    if (tid < 64) {
      const float x = rdt + dtb;
      const float dt = x > 20.f ? x : log1pf(expf(x));
      float a = dt * Aneg;
#pragma unroll
      for (int o = 1; o < 64; o <<= 1) { const float t = __shfl_up(a, o, 64); if (lane >= o) a += t; }
      sW[tid] = a;
      sDt[tid] = dt;
    }
#pragma unroll
    for (int i = 0; i < 4; ++i) {
      const int c = tid + 256 * i, row = c >> 4, col = (c & 15) * 8;
      *(u32x4*)(sB + row * 136 + col) = rB[i];
      *(u32x4*)(sC + row * 136 + col) = rC[i];
    }
    __syncthreads();
    const float wlast = sW[63];
#pragma unroll
    for (int i = 0; i < 2; ++i) {
      const int c = tid + 256 * i, row = c >> 3, col = (c & 7) * 8;
      const float f1 = sDt[row], f2 = f1 * __expf(wlast - sW[row]);
      *(u32x4*)(sX1 + row * 80 + col) = scale8(rX[i], f1);
      *(u32x4*)(sX2 + row * 80 + col) = scale8(rX[i], f2);
    }
    __syncthreads();
    if (cc + 1 < 32) prefetch(cc + 1);
    f32x16 ay;
#pragma unroll
    for (int e = 0; e < 16; ++e) ay[e] = 0.f;
#pragma unroll
    for (int ks = 0; ks < 8; ++ks) {
      bf16x8 a = ldfrag(sS, 136, 32 * ph + r, 16 * ks + 8 * h);
      bf16x8 b = ldfrag(sC, 136, 32 * lt + r, 16 * ks + 8 * h);
      ay = MFMA32(a, b, ay);
    }
    const float wl = sW[32 * lt + r];
    {
      const float ewl = __expf(wl);
#pragma unroll
      for (int e = 0; e < 16; ++e) ay[e] *= ewl;
    }
    for (int st = 0; st <= lt; ++st) {
      f32x16 g;
#pragma unroll
      for (int e = 0; e < 16; ++e) g[e] = 0.f;
#pragma unroll
      for (int ks = 0; ks < 8; ++ks) {
        bf16x8 a = ldfrag(sB, 136, 32 * st + r, 16 * ks + 8 * h);
        bf16x8 b = ldfrag(sC, 136, 32 * lt + r, 16 * ks + 8 * h);
        g = MFMA32(a, b, g);
      }
#pragma unroll
      for (int e = 0; e < 16; ++e) {
        const int sidx = 32 * st + crow(e, h);
        const float f = (sidx <= 32 * lt + r) ? __expf(wl - sW[sidx]) : 0.f;
        g[e] *= f;
      }
#pragma unroll
      for (int s2 = 0; s2 < 2; ++s2) {
        bf16x8 pfr = pack8(g, s2);
        bf16x8 a = ldfrag_tr_perm(sX1, 80, 32 * st + 16 * s2, 32 * ph, lane);
        ay = MFMA32(a, pfr, ay);
      }
    }
    {
      const int pp = 64 * cc + 32 * lt + r, tok = dir ? (S_ - 1 - pp) : pp;
      u16* yd = ydst + ((size_t)bl * S_ + tok) * BWID + hd * 64 + 32 * ph + 4 * h;
#pragma unroll
      for (int g4 = 0; g4 < 4; ++g4) {
        u32x2 ov; ov.x = pk2(ay[4 * g4 + 0], ay[4 * g4 + 1]); ov.y = pk2(ay[4 * g4 + 2], ay[4 * g4 + 3]);
        *(u32x2*)(yd + 8 * g4) = ov;
      }
    }
    {
      const float ew = __expf(wlast);
#pragma unroll
      for (int pt = 0; pt < 2; ++pt)
#pragma unroll
        for (int e = 0; e < 16; ++e) accS[pt][e] *= ew;
#pragma unroll
      for (int ks = 0; ks < 4; ++ks) {
        bf16x8 b = ldfrag_tr_nat(sB, 136, 16 * ks, 32 * w, lane);
#pragma unroll
        for (int pt = 0; pt < 2; ++pt) {
          bf16x8 a = ldfrag_tr_nat(sX2, 80, 16 * ks, 32 * pt, lane);
          accS[pt] = MFMA32(a, b, accS[pt]);
        }
      }
    }
    __syncthreads();
#pragma unroll
    for (int pt = 0; pt < 2; ++pt)
#pragma unroll
      for (int e = 0; e < 16; ++e) sS[(32 * pt + crow(e, h)) * 136 + 32 * w + r] = f2bf(accS[pt][e]);
  }
}

DI void s5_item(const Params& p, int l, int item, char* smem) {
  const int tid = otid(), lane = tid & 63, w = tid >> 6;
  const int wi = item * 4 + w;
  const int bl = wi >> 6, g = (wi >> 1) & 31, dir = wi & 1;
  float* sBu = (float*)(smem + w * 12800);
  u16* sX = (u16*)(smem + w * 12800 + 8448);
  const int c16 = lane & 15, kg = lane >> 4;
  const float* lre = p.in[15] + ((size_t)(l * 2 + dir) * 32 + g) * 64;
  const float* lim = p.in[16] + ((size_t)(l * 2 + dir) * 32 + g) * 64;
  const float dt = expf(p.in[17][(l * 2 + dir) * 32 + g]);
  const float* bre = p.in[18] + ((size_t)l * 32 + g) * 64 * 16;
  const float* bim = p.in[19] + ((size_t)l * 32 + g) * 64 * 16;
  const float* cre = p.in[20] + (((size_t)(l * 2 + dir) * 32 + g) * 16) * 64;
  const float* cim = p.in[21] + (((size_t)(l * 2 + dir) * 32 + g) * 16) * 64;
  float ar, ai;
  {
    const float lr = lre[lane], li = lim[lane];
    const float mag = expf(lr * dt);
    ar = mag * cosf(li * dt); ai = mag * sinf(li * dt);
  }
  bf16x8 bfr[8];
#pragma unroll
  for (int ct = 0; ct < 4; ++ct) {
    const int st = 16 * ct + c16;
    const float lr = lre[st], li = lim[st];
    const float mag = expf(lr * dt);
    const float a_r = mag * cosf(li * dt), a_i = mag * sinf(li * dt);
    const float den = lr * lr + li * li;
    const float fr = ((a_r - 1.f) * lr + a_i * li) / den, fi = (a_i * lr - (a_r - 1.f) * li) / den;
    float vr[8], vi[8];
#pragma unroll
    for (int j = 0; j < 8; ++j) {
      float br_ = 0.f, bi_ = 0.f;
      if (kg < 2) { br_ = bre[st * 16 + 8 * kg + j]; bi_ = bim[st * 16 + 8 * kg + j]; }
      vr[j] = fr * br_ - fi * bi_;
      vi[j] = fr * bi_ + fi * br_;
    }
    u32x4 ur, ui;
    ur.x = pk2(vr[0], vr[1]); ur.y = pk2(vr[2], vr[3]); ur.z = pk2(vr[4], vr[5]); ur.w = pk2(vr[6], vr[7]);
    ui.x = pk2(vi[0], vi[1]); ui.y = pk2(vi[2], vi[3]); ui.z = pk2(vi[4], vi[5]); ui.w = pk2(vi[6], vi[7]);
    bfr[ct] = __builtin_bit_cast(bf16x8, ur);
    bfr[4 + ct] = __builtin_bit_cast(bf16x8, ui);
  }
  bf16x8 cfr[4];
#pragma unroll
  for (int ks = 0; ks < 4; ++ks) {
    const float* src = (ks < 2) ? (cre + c16 * 64 + 32 * ks + 8 * kg) : (cim + c16 * 64 + 32 * (ks - 2) + 8 * kg);
    const float sg = (ks < 2) ? 1.f : -1.f;
    u32x4 u;
    u.x = pk2(sg * src[0], sg * src[1]); u.y = pk2(sg * src[2], sg * src[3]);
    u.z = pk2(sg * src[4], sg * src[5]); u.w = pk2(sg * src[6], sg * src[7]);
    cfr[ks] = __builtin_bit_cast(bf16x8, u);
  }
  u16* ydst = dir ? p.o3 : p.s5f;
  const u16* Pb = p.P + (size_t)bl * S_ * PW + P_UIN + g * 16;
  float xr = 0.f, xi = 0.f;
  u32x4 unext = (u32x4){0u, 0u, 0u, 0u};
  {
    const int tok = dir ? (S_ - 1 - c16) : c16;
    if (kg < 2) unext = *(const u32x4*)(Pb + (size_t)tok * PW + 8 * kg);
  }
  for (int cc = 0; cc < S_ / 16; ++cc) {
    const bf16x8 ua = __builtin_bit_cast(bf16x8, unext);
    if (cc + 1 < S_ / 16) {
      const int pp = 16 * (cc + 1) + c16, tok = dir ? (S_ - 1 - pp) : pp;
      if (kg < 2) unext = *(const u32x4*)(Pb + (size_t)tok * PW + 8 * kg);
    }
    wave_lds_sync();
#pragma unroll
    for (int ct = 0; ct < 8; ++ct) {
      f32x4 d = {0.f, 0.f, 0.f, 0.f};
      d = MFMA16(ua, bfr[ct], d);
#pragma unroll
      for (int e = 0; e < 4; ++e) sBu[(4 * kg + e) * 132 + 16 * ct + c16] = d[e];
    }
    wave_lds_sync();
#pragma unroll
    for (int t = 0; t < 16; ++t) {
      const float bur = sBu[t * 132 + lane], bui = sBu[t * 132 + 64 + lane];
      const float nr = ar * xr - ai * xi + bur;
      const float ni = ar * xi + ai * xr + bui;
      xr = nr; xi = ni;
      sX[t * 136 + lane] = f2bf(xr);
      sX[t * 136 + 64 + lane] = f2bf(xi);
    }
    wave_lds_sync();
    f32x4 y = {0.f, 0.f, 0.f, 0.f};
#pragma unroll
    for (int ks = 0; ks < 4; ++ks) {
      bf16x8 a = ldfrag(sX, 136, c16, 32 * ks + 8 * kg);
      y = MFMA16(a, cfr[ks], y);
    }
#pragma unroll
    for (int e = 0; e < 4; ++e) {
      const int pp = 16 * cc + 4 * kg + e, tok = dir ? (S_ - 1 - pp) : pp;
      ydst[((size_t)bl * S_ + tok) * BWID + g * 16 + c16] = f2bf(y[e]);
    }
  }
}

DI void phase_finalize(const Params& p, int l, int Tg, int bid, int nblk) {
  const int tid_ = otid(), lane = tid_ & 63, w = tid_ >> 6;
  const float* dsk = p.in[10] + l * 8;
  const float* ng = p.in[11] + (size_t)l * BWID;
  const float* s5d = p.in[22] + (size_t)l * BWID;
  const int c0 = lane * 8;
  for (int tok = bid * 4 + w; tok < Tg; tok += nblk * 4) {
    float yf[8], yb[8], xs[8], z[8];
    unpack8(*(const u32x4*)(p.o0 + (size_t)tok * BWID + c0), yf);
    unpack8(*(const u32x4*)(p.syb + (size_t)tok * BWID + c0), yb);
    unpack8(*(const u32x4*)(p.xa + (size_t)tok * 1024 + c0), xs);
    unpack8(*(const u32x4*)(p.P + (size_t)tok * PW + P_SZ + c0), z);
    const float dk = dsk[c0 >> 6];
    float v[8], ss = 0.f;
#pragma unroll
    for (int j = 0; j < 8; ++j) { v[j] = (yf[j] + yb[j] + dk * xs[j]) * siluf_(z[j]); ss += v[j] * v[j]; }
    ss = wave_sum(ss);
    const float rs = rsqrtf(ss / (float)BWID + EPS_);
    u32x4 o;
    o.x = pk2(v[0] * rs * ng[c0 + 0], v[1] * rs * ng[c0 + 1]); o.y = pk2(v[2] * rs * ng[c0 + 2], v[3] * rs * ng[c0 + 3]);
    o.z = pk2(v[4] * rs * ng[c0 + 4], v[5] * rs * ng[c0 + 5]); o.w = pk2(v[6] * rs * ng[c0 + 6], v[7] * rs * ng[c0 + 7]);
    *(u32x4*)(p.o0 + (size_t)tok * BWID + c0) = o;
    float sf[8], sb[8], u[8], gq[8];
    unpack8(*(const u32x4*)(p.s5f + (size_t)tok * BWID + c0), sf);
    unpack8(*(const u32x4*)(p.o3 + (size_t)tok * BWID + c0), sb);
    unpack8(*(const u32x4*)(p.P + (size_t)tok * PW + P_UIN + c0), u);
#pragma unroll
    for (int j = 0; j < 8; ++j) {
      const float y = sf[j] + sb[j] + s5d[c0 + j] * u[j];
      const float t = tanhf(0.7978845608028654f * (y + 0.044715f * y * y * y));
      gq[j] = 0.5f * y * (1.f + t);
    }
    u32x4 o2;
    o2.x = pk2(gq[0], gq[1]); o2.y = pk2(gq[2], gq[3]); o2.z = pk2(gq[4], gq[5]); o2.w = pk2(gq[6], gq[7]);
    *(u32x4*)(p.s5f + (size_t)tok * BWID + c0) = o2;
  }
}

DI void phase_mixers(const Params& p, int l, int grp, int* ctr, char* smem, volatile int* s_itemp) {
  const int BG = p.BG;
  const int n_ssd = BG * 16, n_s5 = BG * 16, n_diff = BG * 64, n_mem = BG * 64, n_win = BG * 128;
  const int total = n_ssd + n_s5 + n_diff + n_mem + n_win;
  for (;;) {
    __syncthreads();
    if (threadIdx.x == 0) *s_itemp = atomicAdd(ctr, 1);
    __syncthreads();
    int it = *s_itemp;
    if (it >= total) break;
    if (it < n_ssd) { if (MX & 1) ssd_item(p, l, it, smem); continue; }
    it -= n_ssd;
    if (it < n_s5) { if (MX & 2) s5_item(p, l, it, smem); continue; }
    it -= n_s5;
    if (it < n_diff) { if (MX & 4) diff_item(p, l, it, smem); continue; }
    it -= n_diff;
    if (it < n_mem) { if (MX & 8) mem_item(p, l, grp, it, smem); continue; }
    it -= n_mem;
    if (MX & 16) win_item(p, l, it, smem);
  }
}

__global__ void __launch_bounds__(256, 2) fwd_megakernel(Params p) {
  extern __shared__ __attribute__((aligned(16))) char smem[];
  __shared__ __attribute__((aligned(16))) unsigned s_misc[8];
  cg::grid_group grid = cg::this_grid();
  const int bid = blockIdx.x, nblk = gridDim.x;
  const int BG = p.BG, Tg = BG * S_, ngrp = NBATCH / BG;
  if (threadIdx.x < 8) s_misc[threadIdx.x] = 0u;
  __syncthreads();
  XcdBarrier xb = xcd_barrier_post(p.bar, (volatile LAS unsigned*)s_misc);
  if (PH & 1) phase_prologue(p, smem, bid, nblk);
  if (p.BG < 0) grid.sync();
  xcd_barrier(xb);
  if (PH & 2) phase_kv(p, smem, bid, nblk);
  for (int grp = 0; grp < ngrp; ++grp) {
    const size_t rowoff = (size_t)grp * Tg * D_;
    for (int l = 0; l < 2; ++l) {
      const float* xin = (l == 0 ? p.in[0] : (const float*)p.out) + rowoff;
      if (PH & 4) phase_norm(xin, p.in[4] + (size_t)l * D_, p.h, Tg, bid, nblk);
      if (DUP & 4) phase_norm(xin, p.in[4] + (size_t)l * D_, p.h, Tg, bid, nblk);
      xcd_barrier(xb);
      if (PH & 8) phase_inproj(p, l, Tg, smem, bid, nblk);
      xcd_barrier(xb);
      if (PH & 16) phase_conv(p, l, Tg, bid, nblk);
      if (DUP & 16) phase_conv(p, l, Tg, bid, nblk);
      xcd_barrier(xb);
      if (PH & 32) phase_mixers(p, l, grp, p.ctr + grp * 2 + l, smem, (volatile int*)&s_misc[4]);
      xcd_barrier(xb);
      if (PH & 64) phase_finalize(p, l, Tg, bid, nblk);
      xcd_barrier(xb);
      if (PH & 128) phase_glu(p, l, Tg, smem, bid, nblk);
      if (DUP & 128) phase_glu(p, l, Tg, smem, bid, nblk);
      xcd_barrier(xb);
      if (PH & 256) phase_merge(p, l, Tg, p.P, smem, bid, nblk);
      xcd_barrier(xb);
      if (PH & 512) phase_out(p, l, Tg, p.P, xin, p.out + rowoff, smem, bid, nblk);
      xcd_barrier(xb);
    }
  }
  if (PH & 1024) phase_final(p.out, p.in[3], NBATCH * S_, bid, nblk);
}

extern "C" void kernel_launch(void* const* d_in, const int* in_sizes, int n_in, void* d_out, int out_size, void* d_ws,
                              size_t ws_size, hipStream_t stream) {
  static int grid_blocks = 0;
  if (!grid_blocks) {
    int dev = 0, cus = 0, per_cu = 0;
    hipGetDevice(&dev);
    hipDeviceGetAttribute(&cus, hipDeviceAttributeMultiprocessorCount, dev);
    hipFuncSetAttribute((const void*)fwd_megakernel, hipFuncAttributeMaxDynamicSharedMemorySize, SMEM_BYTES);
    hipOccupancyMaxActiveBlocksPerMultiprocessor(&per_cu, fwd_megakernel, 256, SMEM_BYTES);
    if (per_cu > 2) per_cu = 2;
    if (per_cu < 1) per_cu = 1;
    grid_blocks = cus * per_cu;
  }
  Params p{};
  for (int i = 0; i < 31; ++i) p.in[i] = (const float*)d_in[i];
  p.out = (float*)d_out;
  char* ws = (char*)d_ws;
  size_t off = 0;
  auto take = [&](size_t bytes) { char* r = ws + off; off += (bytes + 255) & ~(size_t)255; return r; };
  p.W = (u16*)take(2 * LAYER_W * 2);
  p.KV = (u16*)take((size_t)2 * NBATCH * MEML * D_ * 2);
  p.memb = (u16*)take((size_t)NBATCH * MEML * D_ * 2);
  p.memrs = (float*)take(NBATCH * MEML * 4);
  p.lut = (float*)take(12 * LUTS * 4);
  p.ctr = (int*)take(4096);
  p.bar = (unsigned*)take(XCD_BAR_WORDS * 4);
  const size_t fixed = off;
  int BG = 8;
  auto need = [&](int bg) { size_t tg = (size_t)bg * S_; return fixed + tg * (D_ * 2 + (size_t)PW * 2 + 1024 * 2 + 7 * BWID * 2) + 16 * 256; };
  while (BG > 1 && need(BG) > ws_size) BG >>= 1;
  const size_t Tg = (size_t)BG * S_;
  p.h = (u16*)take(Tg * D_ * 2);
  p.P = (u16*)take(Tg * PW * 2);
  p.xa = (u16*)take(Tg * 1024 * 2);
  p.o0 = (u16*)take(Tg * BWID * 2);
  p.o1 = (u16*)take(Tg * BWID * 2);
  p.o2 = (u16*)take(Tg * BWID * 2);
  p.o3 = (u16*)take(Tg * BWID * 2);
  p.o4 = (u16*)take(Tg * BWID * 2);
  p.syb = (u16*)take(Tg * BWID * 2);
  p.s5f = (u16*)take(Tg * BWID * 2);
  p.BG = BG;
  p.pad = 0;
  hipMemsetAsync(p.ctr, 0, 4096 + ((XCD_BAR_WORDS * 4 + 255) & ~255), stream);
  void* args[] = {&p};
  hipError_t e = hipLaunchCooperativeKernel((const void*)fwd_megakernel, dim3(grid_blocks), dim3(256), args, SMEM_BYTES, stream);
  if (e != hipSuccess) fprintf(stderr, "cooperative launch failed: %s (grid %d)\n", hipGetErrorString(e), grid_blocks);
}
```

```cpp
#include <hip/hip_runtime.h>
#include <hip/hip_cooperative_groups.h>
#include <cstdio>
namespace cg = cooperative_groups;

#define DI __device__ __forceinline__
typedef unsigned short u16;
typedef __attribute__((ext_vector_type(8))) short bf16x8;
typedef __attribute__((ext_vector_type(4))) short s16x4;
typedef __attribute__((ext_vector_type(16))) float f32x16;
typedef __attribute__((ext_vector_type(4))) float f32x4;
typedef __attribute__((ext_vector_type(2))) float f32x2;
typedef __attribute__((ext_vector_type(4))) unsigned u32x4;
typedef __attribute__((ext_vector_type(2))) unsigned u32x2;
typedef __attribute__((ext_vector_type(2))) __bf16 bf2_t;

constexpr int S_ = 2048, D_ = 1024, NBATCH = 16, BWID = 512, MEML = 256;
constexpr int PW = 7040;
constexpr int P_XBC = 0, P_SZ = 1024, P_DQ = 1536, P_DK = 2048, P_DV = 2560, P_DZ = 3072, P_CQ = 3584, P_CK = 4096,
              P_CV = 4224, P_CZ = 4352, P_UIN = 4864, P_UZ = 5376, P_MQ = 5888, P_MZ = 6400, P_DT = 6912;
constexpr size_t WIN_OFF = 0, WMG_OFF = 7208960, WBR_OFF = 12451840, WOUT_OFF = 15073280, WGLU_OFF = 16121856,
                 WKV_OFF = 16384000, LAYER_W = 17432576;
constexpr int LUTS = 4096;
constexpr int SMEM_BYTES = 75 * 1024;
constexpr float EPS_ = 1e-6f;
#ifndef PH
#define PH 0xffff
#endif
#ifndef MX
#define MX 0xff
#endif
#ifndef DUP
#define DUP 0
#endif

struct Params {
  const float* in[31];
  float* out;
  u16* W; u16* KV; u16* memb; float* memrs; float* lut; int* ctr; unsigned* bar;
  u16* h; u16* P; u16* xa; u16* o0; u16* o1; u16* o2; u16* o3; u16* o4; u16* syb; u16* s5f;
  int BG; int pad;
};

DI unsigned pk2(float a, float b) { bf2_t r = __builtin_convertvector((f32x2){a, b}, bf2_t); return __builtin_bit_cast(unsigned, r); }
DI u16 f2bf(float a) { return (u16)(pk2(a, 0.f) & 0xffffu); }
DI float bf2f(u16 v) { return __uint_as_float(((unsigned)v) << 16); }
DI float bflo(unsigned v) { return __uint_as_float(v << 16); }
DI float bfhi(unsigned v) { return __uint_as_float(v & 0xffff0000u); }
DI float sigmoidf_(float x) { return 1.f / (1.f + __expf(-x)); }
DI float siluf_(float x) { return x / (1.f + __expf(-x)); }
DI int crow(int reg, int h) { return (reg & 3) + 8 * (reg >> 2) + 4 * h; }
DI int otid() { int t = threadIdx.x; asm volatile("" : "+v"(t)); return t; }
DI float wave_sum(float v) { for (int o = 32; o > 0; o >>= 1) v += __shfl_xor(v, o, 64); return v; }
#define MFMA32(a, b, c) __builtin_amdgcn_mfma_f32_32x32x16_bf16((a), (b), (c), 0, 0, 0)
#define MFMA16(a, b, c) __builtin_amdgcn_mfma_f32_16x16x32_bf16((a), (b), (c), 0, 0, 0)

DI bf16x8 ldfrag(const u16* base, int stride, int row, int col) { return *reinterpret_cast<const bf16x8*>(base + row * stride + col); }
DI s16x4 tr4(const u16* base, int stride, int krow0, int col0, int lane) {
  const int i16 = lane & 15, q = i16 >> 2, pp = i16 & 3, blk = (lane >> 4) & 1;
  const u16* a = base + (krow0 + q) * stride + col0 + 16 * blk + 4 * pp;
  return __builtin_amdgcn_ds_read_tr16_b64_v4i16((__attribute__((address_space(3))) s16x4*)(a));
}
DI bf16x8 ldfrag_tr_nat(const u16* base, int stride, int k0, int col0, int lane) {
  const int h = lane >> 5;
  s16x4 lo = tr4(base, stride, k0 + 8 * h, col0, lane), hi = tr4(base, stride, k0 + 8 * h + 4, col0, lane);
  return __builtin_shufflevector(lo, hi, 0, 1, 2, 3, 4, 5, 6, 7);
}
DI bf16x8 ldfrag_tr_perm(const u16* base, int stride, int k0, int col0, int lane) {
  const int h = lane >> 5;
  s16x4 lo = tr4(base, stride, k0 + 4 * h, col0, lane), hi = tr4(base, stride, k0 + 8 + 4 * h, col0, lane);
  return __builtin_shufflevector(lo, hi, 0, 1, 2, 3, 4, 5, 6, 7);
}
DI bf16x8 pack8(const f32x16& x, int s) {
  u32x4 u;
  u.x = pk2(x[8 * s + 0], x[8 * s + 1]); u.y = pk2(x[8 * s + 2], x[8 * s + 3]);
  u.z = pk2(x[8 * s + 4], x[8 * s + 5]); u.w = pk2(x[8 * s + 6], x[8 * s + 7]);
  return __builtin_bit_cast(bf16x8, u);
}
DI u32x4 scale8(u32x4 v, float f) {
  u32x4 o;
  o.x = pk2(bflo(v.x) * f, bfhi(v.x) * f); o.y = pk2(bflo(v.y) * f, bfhi(v.y) * f);
  o.z = pk2(bflo(v.z) * f, bfhi(v.z) * f); o.w = pk2(bflo(v.w) * f, bfhi(v.w) * f);
  return o;
}
DI void unpack8(u32x4 v, float* f) {
  f[0] = bflo(v.x); f[1] = bfhi(v.x); f[2] = bflo(v.y); f[3] = bfhi(v.y);
  f[4] = bflo(v.z); f[5] = bfhi(v.z); f[6] = bflo(v.w); f[7] = bfhi(v.w);
}
DI void wave_lds_sync() {
  __builtin_amdgcn_fence(__ATOMIC_RELEASE, "wavefront");
  __builtin_amdgcn_wave_barrier();
  __builtin_amdgcn_fence(__ATOMIC_ACQUIRE, "wavefront");
}


#define XB_TMO      128
#define XB_XCNT(j)  (256  + 64 * (j))
#define XB_XSUB(j)  (1280 + 64 * (j))
#define XB_XGEN(j)  (2304 + 64 * (j))
#define XB_TOP      3328
#define XB_TOPGEN   3392
#define XCD_BAR_WORDS 3456
#define XB_SPIN_CAP (1u << 24)
#define LAS __attribute__((address_space(3)))
DI unsigned xb_ld(unsigned* p) { return __hip_atomic_load(p, __ATOMIC_RELAXED, __HIP_MEMORY_SCOPE_AGENT); }
DI unsigned xb_add(unsigned* p, unsigned v) { return __hip_atomic_fetch_add(p, v, __ATOMIC_RELAXED, __HIP_MEMORY_SCOPE_AGENT); }
DI unsigned xb_xcc_id() { return (unsigned)__builtin_amdgcn_s_getreg((3 << 11) | 20) & 0xFu; }
#define XB_SPIN(cond, bar) do { unsigned _sp = 0; while (cond) { __builtin_amdgcn_s_sleep(1); \
    if ((++_sp & 255u) == 0u) { if (xb_ld(&(bar)[XB_TMO])) break; if (_sp > XB_SPIN_CAP) { atomicAdd(&(bar)[XB_TMO], 1u); break; } } } } while (0)
struct XcdBarrier { unsigned* bar; unsigned x; volatile LAS unsigned* st; };
DI XcdBarrier xcd_barrier_post(unsigned* bar, volatile LAS unsigned* st) {
  XcdBarrier b; b.bar = bar; b.x = xb_xcc_id(); b.st = st;
  if (threadIdx.x == 0) (void)xb_add(&bar[XB_XCNT(b.x)], 1u);
  return b;
}
DI void xcd_barrier_complete(unsigned* bar, unsigned x, unsigned& nloc, unsigned& nx) {
  const unsigned G = gridDim.x * gridDim.y * gridDim.z;
  unsigned sum, cnt, mine, sp = 0u;
  for (;;) {
    sum = 0u; cnt = 0u; mine = 0u;
#pragma unroll
    for (unsigned j = 0; j < 16; ++j) { const unsigned c = xb_ld(&bar[XB_XCNT(j)]); sum += c; cnt += (c > 0u) ? 1u : 0u; mine = (j == x) ? c : mine; }
    if (sum == G) break;
    __builtin_amdgcn_s_sleep(1);
    if ((++sp & 255u) == 0u) { if (xb_ld(&bar[XB_TMO])) break; if (sp > XB_SPIN_CAP) { atomicAdd(&bar[XB_TMO], 1u); break; } }
  }
  nloc = mine > 0u ? mine : 1u; nx = cnt > 0u ? cnt : 1u;
}
DI void xcd_barrier(const XcdBarrier& b) {
  asm volatile("s_waitcnt vmcnt(0)" ::: "memory");
  __syncthreads();
  if (threadIdx.x == 0) {
    unsigned* bar = b.bar;
    __builtin_amdgcn_s_waitcnt(0);
    unsigned nloc = b.st[0], nx = b.st[1];
    if (nloc == 0u) { xcd_barrier_complete(bar, b.x, nloc, nx); b.st[0] = nloc; b.st[1] = nx; }
    const unsigned old = xb_add(&bar[XB_XSUB(b.x)], 1u);
    const unsigned gen = old / nloc;
    if (old + 1u == (gen + 1u) * nloc) {
      __builtin_amdgcn_fence(__ATOMIC_RELEASE, "agent");
      asm volatile("s_waitcnt vmcnt(0)" ::: "memory");
      const unsigned og = xb_add(&bar[XB_TOP], 1u);
      const unsigned tg = og / nx;
      if (og + 1u == (tg + 1u) * nx) xb_add(&bar[XB_TOPGEN], 1u);
      else XB_SPIN(xb_ld(&bar[XB_TOPGEN]) == tg, bar);
      __builtin_amdgcn_fence(__ATOMIC_ACQUIRE, "agent");
      xb_add(&bar[XB_XGEN(b.x)], 1u);
      asm volatile("s_waitcnt vmcnt(0)" ::: "memory");
    } else {
      XB_SPIN(xb_ld(&bar[XB_XGEN(b.x)]) == gen, bar);
      __builtin_amdgcn_fence(__ATOMIC_ACQUIRE, "agent");
      asm volatile("s_waitcnt vmcnt(0)" ::: "memory");
    }
  }
  __syncthreads();
}

template <int BM, int BN>
DI void gemm_acc(const u16* __restrict__ A, int lda, int kstrA, const u16* __restrict__ Bt, int ldb, int kstrB, int K,
                 f32x16 (&acc)[BM / 64][BN / 64], char* smem) {
  constexpr int MI = BM / 64, NJ = BN / 64, NAC = BM / 32, NBC = BN / 32;
  u16* sA = (u16*)smem;
  u16* sB = sA + BM * 72;
  const int tid = otid(), lane = tid & 63, w = tid >> 6, wm = w >> 1, wn = w & 1, r = lane & 31, h = lane >> 5;
  u32x4 ra[NAC], rb[NBC];
  const int crow_ = tid >> 3, ccol = (tid & 7) * 8;
  const u16* Ap = A + (size_t)crow_ * lda + ccol;
  const u16* Bp = Bt + (size_t)crow_ * ldb + ccol;
#pragma unroll
  for (int i = 0; i < NAC; ++i) ra[i] = *(const u32x4*)(Ap + (size_t)(32 * i) * lda);
#pragma unroll
  for (int i = 0; i < NBC; ++i) rb[i] = *(const u32x4*)(Bp + (size_t)(32 * i) * ldb);
  const int nk = K >> 6;
  for (int kt = 0; kt < nk; ++kt) {
    __syncthreads();
#pragma unroll
    for (int i = 0; i < NAC; ++i) *(u32x4*)(sA + (crow_ + 32 * i) * 72 + ccol) = ra[i];
#pragma unroll
    for (int i = 0; i < NBC; ++i) *(u32x4*)(sB + (crow_ + 32 * i) * 72 + ccol) = rb[i];
    __syncthreads();
    if (kt + 1 < nk) {
      const size_t koA = (size_t)(kt + 1) * kstrA, koB = (size_t)(kt + 1) * kstrB;
#pragma unroll
      for (int i = 0; i < NAC; ++i) ra[i] = *(const u32x4*)(Ap + (size_t)(32 * i) * lda + koA);
#pragma unroll
      for (int i = 0; i < NBC; ++i) rb[i] = *(const u32x4*)(Bp + (size_t)(32 * i) * ldb + koB);
    }
#pragma unroll
    for (int ks = 0; ks < 4; ++ks) {
      bf16x8 b[NJ];
#pragma unroll
      for (int j = 0; j < NJ; ++j) b[j] = ldfrag(sB, 72, wn * (BN / 2) + 32 * j + r, ks * 16 + 8 * h);
#pragma unroll
      for (int i = 0; i < MI; ++i) {
        const bf16x8 a = ldfrag(sA, 72, wm * (BM / 2) + 32 * i + r, ks * 16 + 8 * h);
#pragma unroll
        for (int j = 0; j < NJ; ++j) acc[i][j] = MFMA32(a, b[j], acc[i][j]);
      }
    }
  }
}

DI size_t wtile(int n0, int K) { return (size_t)(n0 >> 7) * (size_t)(K >> 6) * 8192; }
DI size_t htile(int m0) { return (size_t)(m0 >> 8) * 16 * 16384 + (size_t)(m0 & 255) * 64; }

template <int MI, int NJ>
DI void zero_acc(f32x16 (&acc)[MI][NJ]) {
#pragma unroll
  for (int i = 0; i < MI; ++i)
#pragma unroll
    for (int j = 0; j < NJ; ++j)
#pragma unroll
      for (int e = 0; e < 16; ++e) acc[i][j][e] = 0.f;
}

#define TILE_WALK_BEGIN(MT, NT, SM, SN)                                                   \
  {                                                                                       \
    const int xg_ = bid & 7, loc_ = bid >> 3, nloc_ = nblk >> 3;                          \
    const int nsn_ = ((NT) + (SN) - 1) / (SN), nst_ = (((MT) + (SM) - 1) / (SM)) * nsn_;  \
    for (int st_ = xg_; st_ < nst_; st_ += 8)                                             \
      for (int j_ = loc_; j_ < (SM) * (SN); j_ += nloc_) {                                \
        const int mi = (st_ / nsn_) * (SM) + j_ / (SN), ni = (st_ % nsn_) * (SN) + j_ % (SN); \
        if (mi >= (MT) || ni >= (NT)) continue;
#define TILE_WALK_END }}

DI int t5_bucket(int rel) {
  int n = rel < 0 ? -rel : rel;
  float nf = (float)(n > 1 ? n : 1);
  int large = 8 + (int)(logf(nf / 8.f) / logf(16.f) * 8.f);
  large = large < 15 ? large : 15;
  return (rel > 0 ? 16 : 0) + (n < 8 ? n : large);
}

DI void prep_job(const float* __restrict__ src, int K, int Nsrc, u16* __restrict__ dst, int Ndst, int mode,
                 const float* __restrict__ scale, char* smem, int bid, int nblk) {
  u16* sT = (u16*)smem;
  const int tid = otid();
  const int ntn = Ndst >> 6, ntk = K >> 6;
  float v[16];
  auto gl = [&](int t) {
    const int n0 = (t / ntk) << 6, k0 = (t % ntk) << 6;
    const int n = n0 + (tid & 63);
    int sc = n;
    if (mode == 1) sc = (n < 1536) ? n : (n < 6912 ? n + 16 : (n < 6928 ? n - 6912 + 1536 : -1));
#pragma unroll
    for (int i = 0; i < 16; ++i) {
      const int k = i * 4 + (tid >> 6);
      float x = 0.f;
      if (sc >= 0) x = src[(size_t)(k0 + k) * Nsrc + sc];
      if (scale) x *= scale[k0 + k];
      v[i] = x;
    }
  };
  if (bid < ntn * ntk) gl(bid);
  for (int t = bid; t < ntn * ntk; t += nblk) {
    const int n0 = (t / ntk) << 6, k0 = (t % ntk) << 6;
    __syncthreads();
#pragma unroll
    for (int i = 0; i < 16; ++i) sT[(tid & 63) * 72 + i * 4 + (tid >> 6)] = f2bf(v[i]);
    if (t + nblk < ntn * ntk) gl(t + nblk);
    __syncthreads();
    const int nn = tid >> 2, ks = (tid & 3) * 16;
    u32x4 v0 = *(const u32x4*)(sT + nn * 72 + ks), v1 = *(const u32x4*)(sT + nn * 72 + ks + 8);
    u16* d = dst + ((size_t)((n0 + nn) >> 7) * (size_t)(K >> 6) + (size_t)(k0 >> 6)) * 8192 + (size_t)((n0 + nn) & 127) * 64 + ks;
    *(u32x4*)d = v0;
    *(u32x4*)(d + 8) = v1;
  }
}

DI void phase_prologue(const Params& p, char* smem, int bid, int nblk) {
  const int tid = otid(), lane = tid & 63, w = tid >> 6;
  for (int i = bid * 256 + tid; i < 12 * 4095; i += nblk * 256) {
    const int hd = i / 4095, idx = i % 4095;
    p.lut[hd * LUTS + idx] = p.in[2][t5_bucket(idx - 2047) * 12 + hd];
  }
  for (int row = bid * 4 + w; row < NBATCH * MEML; row += nblk * 4) {
    const float* src = p.in[1] + (size_t)row * D_;
    float ss = 0.f;
#pragma unroll
    for (int i = 0; i < 4; ++i) {
      f32x4 v = *(const f32x4*)(src + i * 256 + lane * 4);
      ss += v[0] * v[0] + v[1] * v[1] + v[2] * v[2] + v[3] * v[3];
      u32x2 o; o.x = pk2(v[0], v[1]); o.y = pk2(v[2], v[3]);
      *(u32x2*)(p.memb + (size_t)row * D_ + i * 256 + lane * 4) = o;
    }
    ss = wave_sum(ss);
    if (lane == 0) p.memrs[row] = rsqrtf(ss / (float)D_ + EPS_);
  }
  for (int l = 0; l < 2; ++l) {
    u16* W = p.W + (size_t)l * LAYER_W;
    prep_job(p.in[5] + (size_t)l * D_ * 6928, D_, 6928, W + WIN_OFF, PW, 1, nullptr, smem, bid, nblk);
    for (int i = 0; i < 5; ++i)
      prep_job(p.in[27] + ((size_t)l * 5 + i) * D_ * D_, D_, D_, W + WMG_OFF + (size_t)i * D_ * D_, D_, 0, nullptr, smem, bid, nblk);
    for (int i = 0; i < 5; ++i)
      prep_job(p.in[29] + ((size_t)l * 5 + i) * BWID * D_, BWID, D_, W + WBR_OFF + (size_t)i * D_ * BWID, D_, 0, nullptr, smem, bid, nblk);
    prep_job(p.in[30] + (size_t)l * D_ * D_, D_, D_, W + WOUT_OFF, D_, 0, nullptr, smem, bid, nblk);
    prep_job(p.in[23] + (size_t)l * BWID * BWID, BWID, BWID, W + WGLU_OFF, BWID, 0, nullptr, smem, bid, nblk);
    prep_job(p.in[26] + (size_t)l * D_ * D_, D_, D_, W + WKV_OFF, D_, 0, p.in[25] + (size_t)l * D_, smem, bid, nblk);
  }
}

DI void phase_norm(const float* __restrict__ x, const float* __restrict__ g, u16* __restrict__ hdst, int nrows, int bid, int nblk) {
  const int tid_ = otid(), lane = tid_ & 63, w = tid_ >> 6;
  const int stride = nblk * 4;
  for (int row0 = bid * 4 + w; row0 < nrows; row0 += 4 * stride) {
    f32x4 v[4][4];
    float ss[4] = {0.f, 0.f, 0.f, 0.f};
#pragma unroll
    for (int u = 0; u < 4; ++u) {
      const int row = row0 + u * stride;
      if (row < nrows) {
        const float* src = x + (size_t)row * D_;
#pragma unroll
        for (int i = 0; i < 4; ++i) v[u][i] = *(const f32x4*)(src + i * 256 + lane * 4);
      }
    }
#pragma unroll
    for (int u = 0; u < 4; ++u) {
      const int row = row0 + u * stride;
      if (row < nrows) {
#pragma unroll
        for (int i = 0; i < 4; ++i) ss[u] += v[u][i][0] * v[u][i][0] + v[u][i][1] * v[u][i][1] + v[u][i][2] * v[u][i][2] + v[u][i][3] * v[u][i][3];
        ss[u] = wave_sum(ss[u]);
        const float rs = rsqrtf(ss[u] / (float)D_ + EPS_);
#pragma unroll
        for (int i = 0; i < 4; ++i) {
          f32x4 gg = *(const f32x4*)(g + i * 256 + lane * 4);
          u32x2 o; o.x = pk2(v[u][i][0] * rs * gg[0], v[u][i][1] * rs * gg[1]); o.y = pk2(v[u][i][2] * rs * gg[2], v[u][i][3] * rs * gg[3]);
          const int c = i * 256 + lane * 4;
          *(u32x2*)(hdst + ((size_t)(row >> 8) * 16 + (c >> 6)) * 16384 + (size_t)(row & 255) * 64 + (c & 63)) = o;
        }
      }
    }
  }
}

DI void phase_final(float* __restrict__ x, const float* __restrict__ g, int nrows, int bid, int nblk) {
  const int tid_ = otid(), lane = tid_ & 63, w = tid_ >> 6;
  const int stride = nblk * 4;
  for (int row0 = bid * 4 + w; row0 < nrows; row0 += 4 * stride) {
    f32x4 v[4][4];
    float ss[4] = {0.f, 0.f, 0.f, 0.f};
#pragma unroll
    for (int u = 0; u < 4; ++u) {
      const int row = row0 + u * stride;
      if (row < nrows) {
        const float* src = x + (size_t)row * D_;
#pragma unroll
        for (int i = 0; i < 4; ++i) v[u][i] = *(const f32x4*)(src + i * 256 + lane * 4);
      }
    }
#pragma unroll
    for (int u = 0; u < 4; ++u) {
      const int row = row0 + u * stride;
      if (row < nrows) {
        float* src = x + (size_t)row * D_;
#pragma unroll
        for (int i = 0; i < 4; ++i) ss[u] += v[u][i][0] * v[u][i][0] + v[u][i][1] * v[u][i][1] + v[u][i][2] * v[u][i][2] + v[u][i][3] * v[u][i][3];
        ss[u] = wave_sum(ss[u]);
        const float rs = rsqrtf(ss[u] / (float)D_ + EPS_);
#pragma unroll
        for (int i = 0; i < 4; ++i) {
          f32x4 gg = *(const f32x4*)(g + i * 256 + lane * 4);
          f32x4 o; o[0] = v[u][i][0] * rs * gg[0]; o[1] = v[u][i][1] * rs * gg[1]; o[2] = v[u][i][2] * rs * gg[2]; o[3] = v[u][i][3] * rs * gg[3];
          *(f32x4*)(src + i * 256 + lane * 4) = o;
        }
      }
    }
  }
}

DI void phase_kv(const Params& p, char* smem, int bid, int nblk) {
  const int tid_ = otid(), lane = tid_ & 63, w = tid_ >> 6, wm = w >> 1, wn = w & 1, r = lane & 31, h = lane >> 5;
  for (int t = bid; t < 2 * 32 * 8; t += nblk) {
    const int l = t >> 8, tt = t & 255, m0 = (tt >> 3) * 128, n0 = (tt & 7) * 128;
    f32x16 acc[2][2];
    zero_acc<2, 2>(acc);
    gemm_acc<128, 128>(p.memb + (size_t)m0 * D_, D_, 64, p.W + (size_t)l * LAYER_W + WKV_OFF + wtile(n0, D_), 64, 8192, D_, acc, smem);
    u16* dst = p.KV + (size_t)l * NBATCH * MEML * D_;
#pragma unroll
    for (int i = 0; i < 2; ++i)
#pragma unroll
      for (int e = 0; e < 16; ++e) {
        const int row = m0 + wm * 64 + 32 * i + crow(e, h);
        const float rs = p.memrs[row];
#pragma unroll
        for (int j = 0; j < 2; ++j) dst[(size_t)row * D_ + n0 + wn * 64 + 32 * j + r] = f2bf(acc[i][j][e] * rs);
      }
  }
}

DI void phase_inproj(const Params& p, int l, int Tg, char* smem, int bid, int nblk) {
  const int tid_ = otid(), lane = tid_ & 63, w = tid_ >> 6, wm = w >> 1, wn = w & 1, r = lane & 31, h = lane >> 5;
  const int MT = Tg / 256, NT = PW / 128;
  TILE_WALK_BEGIN(MT, NT, 8, 8)
    const int m0 = mi * 256, n0 = ni * 128;
    f32x16 acc[4][2];
    zero_acc<4, 2>(acc);
    gemm_acc<256, 128>(p.h + htile(m0), 64, 16384, p.W + (size_t)l * LAYER_W + WIN_OFF + wtile(n0, D_), 64, 8192, D_, acc, smem);
#pragma unroll
    for (int i = 0; i < 4; ++i)
#pragma unroll
      for (int e = 0; e < 16; ++e) {
        const int row = m0 + wm * 128 + 32 * i + crow(e, h);
#pragma unroll
        for (int j = 0; j < 2; ++j) p.P[(size_t)row * PW + n0 + wn * 64 + 32 * j + r] = f2bf(acc[i][j][e]);
      }
  TILE_WALK_END
}

DI void phase_glu(const Params& p, int l, int Tg, char* smem, int bid, int nblk) {
  const int tid_ = otid(), lane = tid_ & 63, w = tid_ >> 6, wm = w >> 1, wn = w & 1, r = lane & 31, h = lane >> 5;
  const float* gb = p.in[24] + (size_t)l * BWID;
  const int ntiles = (Tg / 128) * 4;
  for (int t = bid; t < ntiles; t += nblk) {
    const int m0 = (t >> 2) * 128, n0 = (t & 3) * 128;
    f32x16 acc[2][2];
    zero_acc<2, 2>(acc);
    gemm_acc<128, 128>(p.s5f + (size_t)m0 * BWID, BWID, 64, p.W + (size_t)l * LAYER_W + WGLU_OFF + wtile(n0, BWID), 64, 8192, BWID, acc, smem);
#pragma unroll
    for (int i = 0; i < 2; ++i)
#pragma unroll
      for (int e = 0; e < 16; ++e) {
        const int row = m0 + wm * 64 + 32 * i + crow(e, h);
#pragma unroll
        for (int j = 0; j < 2; ++j) {
          const int col = n0 + wn * 64 + 32 * j + r;
          const float g = bf2f(p.s5f[(size_t)row * BWID + col]);
          const float z = bf2f(p.P[(size_t)row * PW + P_UZ + col]);
          p.o3[(size_t)row * BWID + col] = f2bf(g * sigmoidf_(acc[i][j][e] + gb[col]) * siluf_(z));
        }
      }
  }
}

DI void phase_merge(const Params& p, int l, int Tg, u16* __restrict__ ydst, char* smem, int bid, int nblk) {
  const int tid_ = otid(), lane = tid_ & 63, w = tid_ >> 6, wm = w >> 1, wn = w & 1, r = lane & 31, h = lane >> 5;
  const int MT = Tg / 128, NT = 8;
  const u16* W = p.W + (size_t)l * LAYER_W;
  TILE_WALK_BEGIN(MT, NT, 16, 4)
    const int m0 = mi * 128, n0 = ni * 128;
    f32x16 yacc[2][2];
    zero_acc<2, 2>(yacc);
    for (int br = 0; br < 5; ++br) {
      const u16* ob = (br == 0) ? p.o0 : (br == 1) ? p.o1 : (br == 2) ? p.o2 : (br == 3) ? p.o3 : p.o4;
      unsigned* sG = (unsigned*)(smem + 40 * 1024) + tid_;
      {
        f32x16 ag[2][2];
        zero_acc<2, 2>(ag);
        gemm_acc<128, 128>(p.h + htile(m0), 64, 16384, W + WMG_OFF + (size_t)br * D_ * D_ + wtile(n0, D_), 64, 8192, D_, ag, smem);
#pragma unroll
        for (int j = 0; j < 2; ++j) {
          const float b = p.in[28][((size_t)l * 5 + br) * D_ + n0 + wn * 64 + 32 * j + r];
#pragma unroll
          for (int i = 0; i < 2; ++i)
#pragma unroll
            for (int e = 0; e < 8; ++e)
              sG[((i * 2 + j) * 8 + e) * 256] = pk2(sigmoidf_(ag[i][j][2 * e] + b), sigmoidf_(ag[i][j][2 * e + 1] + b));
        }
      }
      f32x16 ap[2][2];
      zero_acc<2, 2>(ap);
      gemm_acc<128, 128>(ob + (size_t)m0 * BWID, BWID, 64, W + WBR_OFF + (size_t)br * D_ * BWID + wtile(n0, BWID), 64, 8192, BWID, ap, smem);
#pragma unroll
      for (int i = 0; i < 2; ++i)
#pragma unroll
        for (int j = 0; j < 2; ++j)
#pragma unroll
          for (int e = 0; e < 8; ++e) {
            const unsigned gv = sG[((i * 2 + j) * 8 + e) * 256];
            yacc[i][j][2 * e] += bflo(gv) * ap[i][j][2 * e];
            yacc[i][j][2 * e + 1] += bfhi(gv) * ap[i][j][2 * e + 1];
          }
    }
#pragma unroll
    for (int i = 0; i < 2; ++i)
#pragma unroll
      for (int e = 0; e < 16; ++e) {
        const int row = m0 + wm * 64 + 32 * i + crow(e, h);
#pragma unroll
        for (int j = 0; j < 2; ++j) ydst[(size_t)row * D_ + n0 + wn * 64 + 32 * j + r] = f2bf(yacc[i][j][e]);
      }
  TILE_WALK_END
}

DI void phase_out(const Params& p, int l, int Tg, const u16* ysrc, const float* xin,
                  float* xout, char* smem, int bid, int nblk) {
  const int tid_ = otid(), lane = tid_ & 63, w = tid_ >> 6, wm = w >> 1, wn = w & 1, r = lane & 31, h = lane >> 5;
  const int MT = Tg / 256, NT = 8;
  TILE_WALK_BEGIN(MT, NT, 8, 8)
    const int m0 = mi * 256, n0 = ni * 128;
    f32x16 acc[4][2];
    zero_acc<4, 2>(acc);
    gemm_acc<256, 128>(ysrc + (size_t)m0 * D_, D_, 64, p.W + (size_t)l * LAYER_W + WOUT_OFF + wtile(n0, D_), 64, 8192, D_, acc, smem);
#pragma unroll
    for (int i = 0; i < 4; ++i)
#pragma unroll
      for (int e = 0; e < 16; ++e) {
        const size_t row = m0 + wm * 128 + 32 * i + crow(e, h);
#pragma unroll
        for (int j = 0; j < 2; ++j) {
          const size_t idx = row * D_ + n0 + wn * 64 + 32 * j + r;
          xout[idx] = xin[idx] + acc[i][j][e];
        }
      }
  TILE_WALK_END
}

DI void phase_conv(const Params& p, int l, int Tg, int bid, int nblk) {
  const float* cw = p.in[6] + (size_t)l * 5 * 1024;
  const float* cb = p.in[7] + (size_t)l * 1024;
  const int total = Tg * 128, stride = nblk * 256;
  for (int idx0 = bid * 256 + otid(); idx0 < total; idx0 += 2 * stride) {
    const int c0 = (idx0 & 127) * 8;
    u32x4 xin[2][5];
    bool ok[2][5];
#pragma unroll
    for (int u = 0; u < 2; ++u) {
      const int idx = idx0 + u * stride;
      const int tok = idx >> 7, spos = tok & (S_ - 1);
#pragma unroll
      for (int k = 0; k < 5; ++k) {
        const int sp = spos + k - 2;
        ok[u][k] = (idx < total) && sp >= 0 && sp < S_;
        xin[u][k] = (u32x4){0u, 0u, 0u, 0u};
        if (ok[u][k]) xin[u][k] = *(const u32x4*)(p.P + (size_t)(tok + k - 2) * PW + c0);
      }
    }
    float acc[2][8];
#pragma unroll
    for (int j = 0; j < 8; ++j) { acc[0][j] = cb[c0 + j]; acc[1][j] = acc[0][j]; }
#pragma unroll
    for (int k = 0; k < 5; ++k) {
      float wv[8], f0[8], f1[8];
#pragma unroll
      for (int j = 0; j < 8; ++j) wv[j] = cw[k * 1024 + c0 + j];
      unpack8(xin[0][k], f0);
      unpack8(xin[1][k], f1);
#pragma unroll
      for (int j = 0; j < 8; ++j) { acc[0][j] += f0[j] * wv[j]; acc[1][j] += f1[j] * wv[j]; }
    }
#pragma unroll
    for (int u = 0; u < 2; ++u) {
      const int idx = idx0 + u * stride;
      if (idx < total) {
        u32x4 o;
        o.x = pk2(siluf_(acc[u][0]), siluf_(acc[u][1])); o.y = pk2(siluf_(acc[u][2]), siluf_(acc[u][3]));
        o.z = pk2(siluf_(acc[u][4]), siluf_(acc[u][5])); o.w = pk2(siluf_(acc[u][6]), siluf_(acc[u][7]));
        *(u32x4*)(p.xa + (size_t)(idx >> 7) * 1024 + c0) = o;
      }
    }
  }
}

template <int DQK, int DV>
DI void attn_pass(const bf16x8 (&qf)[DQK / 16], const u16* __restrict__ Kg, int ldk, const u16* __restrict__ Vg, int ldv,
                  int kt0, int kt1, int q_pos, int q_lo, const float* lut, int window, float m_init, float l_init,
                  f32x16 (&o)[DV / 32], float& l_out, u16* sK, u16* sV) {
  constexpr int LDK = DQK + 8, LDV = DV + 16, NKC = DQK / 32, NVC = DV / 32;
  const int tid = otid(), lane = tid & 63, r = lane & 31, h = lane >> 5;
  u32x4 rk[NKC], rv[NVC];
#pragma unroll
  for (int d = 0; d < DV / 32; ++d)
#pragma unroll
    for (int e = 0; e < 16; ++e) o[d][e] = 0.f;
  float m = m_init, lsum = (h == 0) ? l_init : 0.f;
  {
#pragma unroll
    for (int i = 0; i < NKC; ++i) { const int c = tid + 256 * i, row = c / (DQK / 8), col = (c % (DQK / 8)) * 8; rk[i] = *(const u32x4*)(Kg + (size_t)(kt0 * 64 + row) * ldk + col); }
#pragma unroll
    for (int i = 0; i < NVC; ++i) { const int c = tid + 256 * i, row = c / (DV / 8), col = (c % (DV / 8)) * 8; rv[i] = *(const u32x4*)(Vg + (size_t)(kt0 * 64 + row) * ldv + col); }
  }
#pragma unroll 1
  for (int kt = kt0; kt < kt1; ++kt) {
    __syncthreads();
#pragma unroll
    for (int i = 0; i < NKC; ++i) { const int c = tid + 256 * i, row = c / (DQK / 8), col = (c % (DQK / 8)) * 8; *(u32x4*)(sK + row * LDK + col) = rk[i]; }
#pragma unroll
    for (int i = 0; i < NVC; ++i) { const int c = tid + 256 * i, row = c / (DV / 8), col = (c % (DV / 8)) * 8; *(u32x4*)(sV + row * LDV + col) = rv[i]; }
    __syncthreads();
    if (kt + 1 < kt1) {
#pragma unroll
      for (int i = 0; i < NKC; ++i) { const int c = tid + 256 * i, row = c / (DQK / 8), col = (c % (DQK / 8)) * 8; rk[i] = *(const u32x4*)(Kg + (size_t)((kt + 1) * 64 + row) * ldk + col); }
#pragma unroll
      for (int i = 0; i < NVC; ++i) { const int c = tid + 256 * i, row = c / (DV / 8), col = (c % (DV / 8)) * 8; rv[i] = *(const u32x4*)(Vg + (size_t)((kt + 1) * 64 + row) * ldv + col); }
    }
    f32x16 s[2];
#pragma unroll
    for (int t = 0; t < 2; ++t) {
      bf16x8 ka[DQK / 16];
#pragma unroll
      for (int ks = 0; ks < DQK / 16; ++ks) ka[ks] = ldfrag(sK, LDK, 32 * t + r, 16 * ks + 8 * h);
#pragma unroll
      for (int e = 0; e < 16; ++e) s[t][e] = 0.f;
#pragma unroll
      for (int ks = 0; ks < DQK / 16; ++ks) s[t] = MFMA32(ka[ks], qf[ks], s[t]);
    }
    const int kbase = kt * 64;
    if (lut) {
      const bool far_ = (window == 0) && ((kbase - (q_lo + 31) >= 91) || (q_lo - (kbase + 63) >= 91));
      if (far_) {
        const float bconst = lut[kbase - q_lo + 2047];
#pragma unroll
        for (int t = 0; t < 2; ++t)
#pragma unroll
          for (int e = 0; e < 16; ++e) s[t][e] += bconst;
      } else {
#pragma unroll
        for (int t = 0; t < 2; ++t)
#pragma unroll
          for (int e = 0; e < 16; ++e) {
            const int rel = kbase + 32 * t + crow(e, h) - q_pos;
            float v = s[t][e] + lut[rel + 2047];
            if (window > 0 && (rel > window || rel < -window)) v = -INFINITY;
            s[t][e] = v;
          }
      }
    }
    float mx = s[0][0];
#pragma unroll
    for (int t = 0; t < 2; ++t)
#pragma unroll
      for (int e = 0; e < 16; ++e) mx = fmaxf(mx, s[t][e]);
    mx = fmaxf(mx, __shfl_xor(mx, 32, 64));
    if (__builtin_amdgcn_ballot_w64(mx > m + 8.f) != 0ull) {
      const float mn = fmaxf(m, mx);
      const float alpha = __builtin_amdgcn_exp2f(m - mn);
      m = mn;
      lsum *= alpha;
#pragma unroll
      for (int d = 0; d < DV / 32; ++d)
#pragma unroll
        for (int e = 0; e < 16; ++e) o[d][e] *= alpha;
    }
    float ps = 0.f;
#pragma unroll
    for (int t = 0; t < 2; ++t)
#pragma unroll
      for (int e = 0; e < 16; ++e) { const float pv = __builtin_amdgcn_exp2f(s[t][e] - m); s[t][e] = pv; ps += pv; }
    lsum += ps;
    bf16x8 pf[2][2];
#pragma unroll
    for (int t = 0; t < 2; ++t)
#pragma unroll
      for (int s2 = 0; s2 < 2; ++s2) pf[t][s2] = pack8(s[t], s2);
#pragma unroll
    for (int d = 0; d < DV / 32; ++d) {
      bf16x8 va[2][2];
#pragma unroll
      for (int t = 0; t < 2; ++t)
#pragma unroll
        for (int s2 = 0; s2 < 2; ++s2) va[t][s2] = ldfrag_tr_perm(sV, LDV, 32 * t + 16 * s2, 32 * d, lane);
#pragma unroll
      for (int t = 0; t < 2; ++t)
#pragma unroll
        for (int s2 = 0; s2 < 2; ++s2) o[d] = MFMA32(va[t][s2], pf[t][s2], o[d]);
    }
  }
  lsum += __shfl_xor(lsum, 32, 64);
  l_out = lsum;
}

template <int DQK>
DI void load_qfrag(bf16x8 (&qf)[DQK / 16], const u16* qrow, float scale, int h) {
#pragma unroll
  for (int ks = 0; ks < DQK / 16; ++ks) {
    u32x4 v = *(const u32x4*)(qrow + 16 * ks + 8 * h);
    qf[ks] = __builtin_bit_cast(bf16x8, scale8(v, scale));
  }
}

DI void attn_lds(char* smem, u16*& sK, u16*& sV, float*& slut) {
  sK = (u16*)smem; sV = sK + 64 * 136; slut = (float*)(sV + 64 * 144);
}

DI void diff_item(const Params& p, int l, int item, char* smem) {
  const int tid = otid(), lane = tid & 63, w = tid >> 6, r = lane & 31, h = lane >> 5;
  const int bl = item >> 6, hd = (item >> 4) & 3, qb = item & 15;
  u16 *sK, *sV; float* slut;
  attn_lds(smem, sK, sV, slut);
  __syncthreads();
  for (int i = tid; i < 4095; i += 256) slut[i] = p.lut[hd * LUTS + i] * 1.4426950408889634f;
  const float lam_init = 0.8f - 0.6f * expf(-0.3f * (float)l);
  const float* lp = p.in[12] + (size_t)l * 4 * 64;
  const float d1 = wave_sum(lp[lane] * lp[64 + lane]), d2 = wave_sum(lp[128 + lane] * lp[192 + lane]);
  const float lam = expf(d1) - expf(d2) + lam_init;
  const int q_lo = qb * 128 + 32 * w, q_pos = q_lo + r;
  const size_t tokq = (size_t)bl * S_ + q_pos;
  const u16* Pb = p.P + (size_t)bl * S_ * PW;
  f32x16 o[4];
  float lt;
  u16* odst = p.o1 + tokq * BWID + hd * 128;
  {
    bf16x8 qf[4];
    load_qfrag<64>(qf, p.P + tokq * PW + P_DQ + (hd * 2 + 0) * 64, 0.125f * 1.4426950408889634f, h);
    attn_pass<64, 128>(qf, Pb + P_DK + (hd * 2 + 0) * 64, PW, Pb + P_DV + hd * 128, PW, 0, 32, q_pos, q_lo, slut, 0, -INFINITY, 0.f, o, lt, sK, sV);
    const float inv = 1.f / lt;
#pragma unroll
    for (int d = 0; d < 4; ++d)
#pragma unroll
      for (int g4 = 0; g4 < 4; ++g4) {
        u32x2 ov;
        ov.x = pk2(o[d][4 * g4 + 0] * inv, o[d][4 * g4 + 1] * inv);
        ov.y = pk2(o[d][4 * g4 + 2] * inv, o[d][4 * g4 + 3] * inv);
        *(u32x2*)(odst + 32 * d + 8 * g4 + 4 * h) = ov;
      }
  }
  {
    bf16x8 qf[4];
    load_qfrag<64>(qf, p.P + tokq * PW + P_DQ + (hd * 2 + 1) * 64, 0.125f * 1.4426950408889634f, h);
    attn_pass<64, 128>(qf, Pb + P_DK + (hd * 2 + 1) * 64, PW, Pb + P_DV + hd * 128, PW, 0, 32, q_pos, q_lo, slut, 0, -INFINITY, 0.f, o, lt, sK, sV);
    const float inv = lam / lt;
#pragma unroll
    for (int d = 0; d < 4; ++d)
#pragma unroll
      for (int g4 = 0; g4 < 4; ++g4) {
        const u32x2 pv = *(const u32x2*)(odst + 32 * d + 8 * g4 + 4 * h);
        o[d][4 * g4 + 0] = bflo(pv.x) - o[d][4 * g4 + 0] * inv;
        o[d][4 * g4 + 1] = bfhi(pv.x) - o[d][4 * g4 + 1] * inv;
        o[d][4 * g4 + 2] = bflo(pv.y) - o[d][4 * g4 + 2] * inv;
        o[d][4 * g4 + 3] = bfhi(pv.y) - o[d][4 * g4 + 3] * inv;
      }
  }
  float ss = 0.f;
#pragma unroll
  for (int d = 0; d < 4; ++d)
#pragma unroll
    for (int e = 0; e < 16; ++e) ss += o[d][e] * o[d][e];
  ss += __shfl_xor(ss, 32, 64);
  const float rs = rsqrtf(ss / 128.f + EPS_) * (1.f - lam_init);
  const float* sg = p.in[13] + (size_t)l * 128;
#pragma unroll
  for (int d = 0; d < 4; ++d)
#pragma unroll
    for (int g4 = 0; g4 < 4; ++g4) {
      const int dv = 32 * d + 8 * g4 + 4 * h;
      const u32x2 zz = *(const u32x2*)(p.P + tokq * PW + P_DZ + hd * 128 + dv);
      const float z0 = bflo(zz.x), z1 = bfhi(zz.x), z2 = bflo(zz.y), z3 = bfhi(zz.y);
      u32x2 ov;
      ov.x = pk2(o[d][4 * g4 + 0] * rs * sg[dv + 0] * siluf_(z0), o[d][4 * g4 + 1] * rs * sg[dv + 1] * siluf_(z1));
      ov.y = pk2(o[d][4 * g4 + 2] * rs * sg[dv + 2] * siluf_(z2), o[d][4 * g4 + 3] * rs * sg[dv + 3] * siluf_(z3));
      *(u32x2*)(odst + dv) = ov;
    }
}

DI void win_item(const Params& p, int l, int item, char* smem) {
  const int tid = otid(), lane = tid & 63, w = tid >> 6, r = lane & 31, h = lane >> 5;
  const int bl = item >> 7, qh = (item >> 4) & 7, qb = item & 15;
  const int kvh = qh >> 2;
  u16 *sK, *sV; float* slut;
  attn_lds(smem, sK, sV, slut);
  __syncthreads();
  for (int i = tid; i < 4095; i += 256) slut[i] = p.lut[(4 + qh) * LUTS + i] * 1.4426950408889634f;
  const float sink = p.in[14][l * 8 + qh];
  const int q_lo = qb * 128 + 32 * w, q_pos = q_lo + r;
  const size_t tokq = (size_t)bl * S_ + q_pos;
  const u16* Pb = p.P + (size_t)bl * S_ * PW;
  int kt0 = qb * 2 - 2; if (kt0 < 0) kt0 = 0;
  int kt1 = qb * 2 + 4; if (kt1 > 32) kt1 = 32;
  f32x16 o[2];
  float lt;
  bf16x8 qf[4];
  load_qfrag<64>(qf, p.P + tokq * PW + P_CQ + qh * 64, 0.125f * 1.4426950408889634f, h);
  attn_pass<64, 64>(qf, Pb + P_CK + kvh * 64, PW, Pb + P_CV + kvh * 64, PW, kt0, kt1, q_pos, q_lo, slut, 128, sink * 1.4426950408889634f, 1.f, o, lt, sK, sV);
  const float inv = 1.f / lt;
#pragma unroll
  for (int d = 0; d < 2; ++d)
#pragma unroll
    for (int g4 = 0; g4 < 4; ++g4) {
      const int dv = 32 * d + 8 * g4 + 4 * h;
      const u32x2 zz = *(const u32x2*)(p.P + tokq * PW + P_CZ + qh * 64 + dv);
      const float z0 = bflo(zz.x), z1 = bfhi(zz.x), z2 = bflo(zz.y), z3 = bfhi(zz.y);
      u32x2 ov;
      ov.x = pk2(o[d][4 * g4 + 0] * inv * siluf_(z0), o[d][4 * g4 + 1] * inv * siluf_(z1));
      ov.y = pk2(o[d][4 * g4 + 2] * inv * siluf_(z2), o[d][4 * g4 + 3] * inv * siluf_(z3));
      *(u32x2*)(p.o2 + tokq * BWID + qh * 64 + dv) = ov;
    }
}

DI void mem_item(const Params& p, int l, int grp, int item, char* smem) {
  const int tid = otid(), lane = tid & 63, w = tid >> 6, r = lane & 31, h = lane >> 5;
  const int bl = item >> 6, hd = (item >> 4) & 3, qb = item & 15;
  u16 *sK, *sV; float* slut;
  attn_lds(smem, sK, sV, slut);
  const int q_lo = qb * 128 + 32 * w, q_pos = q_lo + r;
  const size_t tokq = (size_t)bl * S_ + q_pos;
  const int bg = grp * p.BG + bl;
  const u16* kv = p.KV + ((size_t)l * NBATCH + bg) * MEML * D_;
  f32x16 o[4];
  float lt;
  bf16x8 qf[8];
  load_qfrag<128>(qf, p.P + tokq * PW + P_MQ + hd * 128, 0.08838834764831845f * 1.4426950408889634f, h);
  attn_pass<128, 128>(qf, kv + hd * 128, D_, kv + 512 + hd * 128, D_, 0, 4, q_pos, q_lo, nullptr, 0, -INFINITY, 0.f, o, lt, sK, sV);
  const float inv = 1.f / lt;
#pragma unroll
  for (int d = 0; d < 4; ++d)
#pragma unroll
    for (int g4 = 0; g4 < 4; ++g4) {
      const int dv = 32 * d + 8 * g4 + 4 * h;
      const u32x2 zz = *(const u32x2*)(p.P + tokq * PW + P_MZ + hd * 128 + dv);
      const float z0 = bflo(zz.x), z1 = bfhi(zz.x), z2 = bflo(zz.y), z3 = bfhi(zz.y);
      u32x2 ov;
      ov.x = pk2(o[d][4 * g4 + 0] * inv * siluf_(z0), o[d][4 * g4 + 1] * inv * siluf_(z1));
      ov.y = pk2(o[d][4 * g4 + 2] * inv * siluf_(z2), o[d][4 * g4 + 3] * inv * siluf_(z3));
      *(u32x2*)(p.o4 + tokq * BWID + hd * 128 + dv) = ov;
    }
}

DI void ssd_item(const Params& p, int l, int item, char* smem) {
  const int tid = otid(), lane = tid & 63, w = tid >> 6, r = lane & 31, h = lane >> 5;
  const int bl = item >> 4, hd = (item >> 1) & 7, dir = item & 1;
  const int gq = hd >> 2, lt = w & 1, ph = w >> 1;
  u16* sB = (u16*)smem;
  u16* sC = sB + 64 * 136;
  u16* sX1 = sC + 64 * 136;
  u16* sX2 = sX1 + 64 * 80;
  u16* sS = sX2 + 64 * 80;
  float* sW = (float*)(sS + 64 * 136);
  float* sDt = sW + 64;
  const float Aneg = -expf(p.in[9][(l * 2 + dir) * 8 + hd]);
  const float dtb = p.in[8][(l * 2 + dir) * 8 + hd];
  u16* ydst = dir ? p.syb : p.o0;
  const u16* Pb = p.P + (size_t)bl * S_ * PW;
  const u16* xab = p.xa + (size_t)bl * S_ * 1024;
  __syncthreads();
  for (int i = tid; i < 64 * 136 / 2; i += 256) ((unsigned*)sS)[i] = 0u;
  f32x16 accS[2];
#pragma unroll
  for (int i = 0; i < 2; ++i)
#pragma unroll
    for (int e = 0; e < 16; ++e) accS[i][e] = 0.f;
  u32x4 rB[4], rC[4], rX[2];
  float rdt = 0.f;
  auto prefetch = [&](int cc) {
    if (tid < 64) {
      const int pp = 64 * cc + tid, tok = dir ? (S_ - 1 - pp) : pp;
      rdt = bf2f(Pb[(size_t)tok * PW + P_DT + dir * 8 + hd]);
    }
#pragma unroll
    for (int i = 0; i < 4; ++i) {
      const int c = tid + 256 * i, row = c >> 4, col = (c & 15) * 8;
      const int pp = 64 * cc + row, tok = dir ? (S_ - 1 - pp) : pp;
      rB[i] = *(const u32x4*)(xab + (size_t)tok * 1024 + 512 + gq * 128 + col);
      rC[i] = *(const u32x4*)(xab + (size_t)tok * 1024 + 768 + gq * 128 + col);
    }
#pragma unroll
    for (int i = 0; i < 2; ++i) {
      const int c = tid + 256 * i, row = c >> 3, col = (c & 7) * 8;
      const int pp = 64 * cc + row, tok = dir ? (S_ - 1 - pp) : pp;
      rX[i] = *(const u32x4*)(xab + (size_t)tok * 1024 + hd * 64 + col);
    }
  };
  prefetch(0);
#pragma unroll 1
  for (int cc = 0; cc < 32; ++cc) {
    __syncthreads();
    if (tid < 64) {
      const float x = rdt + dtb;
      const float dt = x > 20.f ? x : log1pf(expf(x));
      float a = dt * Aneg;
#pragma unroll
      for (int o = 1; o < 64; o <<= 1) { const float t = __shfl_up(a, o, 64); if (lane >= o) a += t; }
      sW[tid] = a;
      sDt[tid] = dt;
    }
#pragma unroll
    for (int i = 0; i < 4; ++i) {
      const int c = tid + 256 * i, row = c >> 4, col = (c & 15) * 8;
      *(u32x4*)(sB + row * 136 + col) = rB[i];
      *(u32x4*)(sC + row * 136 + col) = rC[i];
    }
    __syncthreads();
    const float wlast = sW[63];
#pragma unroll
    for (int i = 0; i < 2; ++i) {
      const int c = tid + 256 * i, row = c >> 3, col = (c & 7) * 8;
      const float f1 = sDt[row], f2 = f1 * __expf(wlast - sW[row]);
      *(u32x4*)(sX1 + row * 80 + col) = scale8(rX[i], f1);
      *(u32x4*)(sX2 + row * 80 + col) = scale8(rX[i], f2);
    }
    __syncthreads();
    if (cc + 1 < 32) prefetch(cc + 1);
    f32x16 ay;
#pragma unroll
    for (int e = 0; e < 16; ++e) ay[e] = 0.f;
#pragma unroll
    for (int ks = 0; ks < 8; ++ks) {
      bf16x8 a = ldfrag(sS, 136, 32 * ph + r, 16 * ks + 8 * h);
      bf16x8 b = ldfrag(sC, 136, 32 * lt + r, 16 * ks + 8 * h);
      ay = MFMA32(a, b, ay);
    }
    const float wl = sW[32 * lt + r];
    {
      const float ewl = __expf(wl);
#pragma unroll
      for (int e = 0; e < 16; ++e) ay[e] *= ewl;
    }
    for (int st = 0; st <= lt; ++st) {
      f32x16 g;
#pragma unroll
      for (int e = 0; e < 16; ++e) g[e] = 0.f;
#pragma unroll
      for (int ks = 0; ks < 8; ++ks) {
        bf16x8 a = ldfrag(sB, 136, 32 * st + r, 16 * ks + 8 * h);
        bf16x8 b = ldfrag(sC, 136, 32 * lt + r, 16 * ks + 8 * h);
        g = MFMA32(a, b, g);
      }
#pragma unroll
      for (int e = 0; e < 16; ++e) {
        const int sidx = 32 * st + crow(e, h);
        const float f = (sidx <= 32 * lt + r) ? __expf(wl - sW[sidx]) : 0.f;
        g[e] *= f;
      }
#pragma unroll
      for (int s2 = 0; s2 < 2; ++s2) {
        bf16x8 pfr = pack8(g, s2);
        bf16x8 a = ldfrag_tr_perm(sX1, 80, 32 * st + 16 * s2, 32 * ph, lane);
        ay = MFMA32(a, pfr, ay);
      }
    }
    {
      const int pp = 64 * cc + 32 * lt + r, tok = dir ? (S_ - 1 - pp) : pp;
      u16* yd = ydst + ((size_t)bl * S_ + tok) * BWID + hd * 64 + 32 * ph + 4 * h;
#pragma unroll
      for (int g4 = 0; g4 < 4; ++g4) {
        u32x2 ov; ov.x = pk2(ay[4 * g4 + 0], ay[4 * g4 + 1]); ov.y = pk2(ay[4 * g4 + 2], ay[4 * g4 + 3]);
        *(u32x2*)(yd + 8 * g4) = ov;
      }
    }
    {
      const float ew = __expf(wlast);
#pragma unroll
      for (int pt = 0; pt < 2; ++pt)
#pragma unroll
        for (int e = 0; e < 16; ++e) accS[pt][e] *= ew;
#pragma unroll
      for (int ks = 0; ks < 4; ++ks) {
        bf16x8 b = ldfrag_tr_nat(sB, 136, 16 * ks, 32 * w, lane);
#pragma unroll
        for (int pt = 0; pt < 2; ++pt) {
          bf16x8 a = ldfrag_tr_nat(sX2, 80, 16 * ks, 32 * pt, lane);
          accS[pt] = MFMA32(a, b, accS[pt]);
        }
      }
    }
    __syncthreads();
#pragma unroll
    for (int pt = 0; pt < 2; ++pt)
#pragma unroll
      for (int e = 0; e < 16; ++e) sS[(32 * pt + crow(e, h)) * 136 + 32 * w + r] = f2bf(accS[pt][e]);
  }
}

DI void s5_item(const Params& p, int l, int item, char* smem) {
  const int tid = otid(), lane = tid & 63, w = tid >> 6;
  const int wi = item * 4 + w;
  const int bl = wi >> 6, g = (wi >> 1) & 31, dir = wi & 1;
  float* sBu = (float*)(smem + w * 12800);
  u16* sX = (u16*)(smem + w * 12800 + 8448);
  const int c16 = lane & 15, kg = lane >> 4;
  const float* lre = p.in[15] + ((size_t)(l * 2 + dir) * 32 + g) * 64;
  const float* lim = p.in[16] + ((size_t)(l * 2 + dir) * 32 + g) * 64;
  const float dt = expf(p.in[17][(l * 2 + dir) * 32 + g]);
  const float* bre = p.in[18] + ((size_t)l * 32 + g) * 64 * 16;
  const float* bim = p.in[19] + ((size_t)l * 32 + g) * 64 * 16;
  const float* cre = p.in[20] + (((size_t)(l * 2 + dir) * 32 + g) * 16) * 64;
  const float* cim = p.in[21] + (((size_t)(l * 2 + dir) * 32 + g) * 16) * 64;
  float ar, ai;
  {
    const float lr = lre[lane], li = lim[lane];
    const float mag = expf(lr * dt);
    ar = mag * cosf(li * dt); ai = mag * sinf(li * dt);
  }
  bf16x8 bfr[8];
#pragma unroll
  for (int ct = 0; ct < 4; ++ct) {
    const int st = 16 * ct + c16;
    const float lr = lre[st], li = lim[st];
    const float mag = expf(lr * dt);
    const float a_r = mag * cosf(li * dt), a_i = mag * sinf(li * dt);
    const float den = lr * lr + li * li;
    const float fr = ((a_r - 1.f) * lr + a_i * li) / den, fi = (a_i * lr - (a_r - 1.f) * li) / den;
    float vr[8], vi[8];
#pragma unroll
    for (int j = 0; j < 8; ++j) {
      float br_ = 0.f, bi_ = 0.f;
      if (kg < 2) { br_ = bre[st * 16 + 8 * kg + j]; bi_ = bim[st * 16 + 8 * kg + j]; }
      vr[j] = fr * br_ - fi * bi_;
      vi[j] = fr * bi_ + fi * br_;
    }
    u32x4 ur, ui;
    ur.x = pk2(vr[0], vr[1]); ur.y = pk2(vr[2], vr[3]); ur.z = pk2(vr[4], vr[5]); ur.w = pk2(vr[6], vr[7]);
    ui.x = pk2(vi[0], vi[1]); ui.y = pk2(vi[2], vi[3]); ui.z = pk2(vi[4], vi[5]); ui.w = pk2(vi[6], vi[7]);
    bfr[ct] = __builtin_bit_cast(bf16x8, ur);
    bfr[4 + ct] = __builtin_bit_cast(bf16x8, ui);
  }
  bf16x8 cfr[4];
#pragma unroll
  for (int ks = 0; ks < 4; ++ks) {
    const float* src = (ks < 2) ? (cre + c16 * 64 + 32 * ks + 8 * kg) : (cim + c16 * 64 + 32 * (ks - 2) + 8 * kg);
    const float sg = (ks < 2) ? 1.f : -1.f;
    u32x4 u;
    u.x = pk2(sg * src[0], sg * src[1]); u.y = pk2(sg * src[2], sg * src[3]);
    u.z = pk2(sg * src[4], sg * src[5]); u.w = pk2(sg * src[6], sg * src[7]);
    cfr[ks] = __builtin_bit_cast(bf16x8, u);
  }
  u16* ydst = dir ? p.o3 : p.s5f;
  const u16* Pb = p.P + (size_t)bl * S_ * PW + P_UIN + g * 16;
  float xr = 0.f, xi = 0.f;
  u32x4 ring[8];
#pragma unroll
  for (int j = 0; j < 8; ++j) {
    ring[j] = (u32x4){0u, 0u, 0u, 0u};
    const int pp = 16 * j + c16, tok = dir ? (S_ - 1 - pp) : pp;
    if (kg < 2) ring[j] = *(const u32x4*)(Pb + (size_t)tok * PW + 8 * kg);
  }
#pragma unroll 1
  for (int cc0 = 0; cc0 < S_ / 16; cc0 += 8)
#pragma unroll
  for (int j8 = 0; j8 < 8; ++j8) {
    const int cc = cc0 + j8;
    const bf16x8 ua = __builtin_bit_cast(bf16x8, ring[j8]);
    if (cc + 8 < S_ / 16) {
      const int pp = 16 * (cc + 8) + c16, tok = dir ? (S_ - 1 - pp) : pp;
      if (kg < 2) ring[j8] = *(const u32x4*)(Pb + (size_t)tok * PW + 8 * kg);
    }
    wave_lds_sync();
#pragma unroll
    for (int ct = 0; ct < 8; ++ct) {
      f32x4 d = {0.f, 0.f, 0.f, 0.f};
      d = MFMA16(ua, bfr[ct], d);
#pragma unroll
      for (int e = 0; e < 4; ++e) sBu[(4 * kg + e) * 132 + 16 * ct + c16] = d[e];
    }
    wave_lds_sync();
#pragma unroll
    for (int t = 0; t < 16; ++t) {
      const float bur = sBu[t * 132 + lane], bui = sBu[t * 132 + 64 + lane];
      const float nr = ar * xr - ai * xi + bur;
      const float ni = ar * xi + ai * xr + bui;
      xr = nr; xi = ni;
      sX[t * 136 + lane] = f2bf(xr);
      sX[t * 136 + 64 + lane] = f2bf(xi);
    }
    wave_lds_sync();
    f32x4 y = {0.f, 0.f, 0.f, 0.f};
#pragma unroll
    for (int ks = 0; ks < 4; ++ks) {
      bf16x8 a = ldfrag(sX, 136, c16, 32 * ks + 8 * kg);
      y = MFMA16(a, cfr[ks], y);
    }
#pragma unroll
    for (int e = 0; e < 4; ++e) {
      const int pp = 16 * cc + 4 * kg + e, tok = dir ? (S_ - 1 - pp) : pp;
      ydst[((size_t)bl * S_ + tok) * BWID + g * 16 + c16] = f2bf(y[e]);
    }
  }
}

DI void phase_finalize(const Params& p, int l, int Tg, int bid, int nblk) {
  const int tid_ = otid(), lane = tid_ & 63, w = tid_ >> 6;
  const float* dsk = p.in[10] + l * 8;
  const float* ng = p.in[11] + (size_t)l * BWID;
  const float* s5d = p.in[22] + (size_t)l * BWID;
  const int c0 = lane * 8;
  for (int tok = bid * 4 + w; tok < Tg; tok += nblk * 4) {
    float yf[8], yb[8], xs[8], z[8];
    unpack8(*(const u32x4*)(p.o0 + (size_t)tok * BWID + c0), yf);
    unpack8(*(const u32x4*)(p.syb + (size_t)tok * BWID + c0), yb);
    unpack8(*(const u32x4*)(p.xa + (size_t)tok * 1024 + c0), xs);
    unpack8(*(const u32x4*)(p.P + (size_t)tok * PW + P_SZ + c0), z);
    const float dk = dsk[c0 >> 6];
    float v[8], ss = 0.f;
#pragma unroll
    for (int j = 0; j < 8; ++j) { v[j] = (yf[j] + yb[j] + dk * xs[j]) * siluf_(z[j]); ss += v[j] * v[j]; }
    ss = wave_sum(ss);
    const float rs = rsqrtf(ss / (float)BWID + EPS_);
    u32x4 o;
    o.x = pk2(v[0] * rs * ng[c0 + 0], v[1] * rs * ng[c0 + 1]); o.y = pk2(v[2] * rs * ng[c0 + 2], v[3] * rs * ng[c0 + 3]);
    o.z = pk2(v[4] * rs * ng[c0 + 4], v[5] * rs * ng[c0 + 5]); o.w = pk2(v[6] * rs * ng[c0 + 6], v[7] * rs * ng[c0 + 7]);
    *(u32x4*)(p.o0 + (size_t)tok * BWID + c0) = o;
    float sf[8], sb[8], u[8], gq[8];
    unpack8(*(const u32x4*)(p.s5f + (size_t)tok * BWID + c0), sf);
    unpack8(*(const u32x4*)(p.o3 + (size_t)tok * BWID + c0), sb);
    unpack8(*(const u32x4*)(p.P + (size_t)tok * PW + P_UIN + c0), u);
#pragma unroll
    for (int j = 0; j < 8; ++j) {
      const float y = sf[j] + sb[j] + s5d[c0 + j] * u[j];
      const float t = tanhf(0.7978845608028654f * (y + 0.044715f * y * y * y));
      gq[j] = 0.5f * y * (1.f + t);
    }
    u32x4 o2;
    o2.x = pk2(gq[0], gq[1]); o2.y = pk2(gq[2], gq[3]); o2.z = pk2(gq[4], gq[5]); o2.w = pk2(gq[6], gq[7]);
    *(u32x4*)(p.s5f + (size_t)tok * BWID + c0) = o2;
  }
}

DI void phase_mixers(const Params& p, int l, int grp, int* ctr, char* smem, volatile int* s_itemp) {
  const int BG = p.BG;
  const int n_ssd = BG * 16, n_s5 = BG * 16, n_diff = BG * 64, n_mem = BG * 64, n_win = BG * 128;
  const int total = n_ssd + n_s5 + n_diff + n_mem + n_win;
  for (;;) {
    __syncthreads();
    if (threadIdx.x == 0) *s_itemp = atomicAdd(ctr, 1);
    __syncthreads();
    int it = *s_itemp;
    if (it >= total) break;
    if (it < n_ssd) { if (MX & 1) ssd_item(p, l, it, smem); continue; }
    it -= n_ssd;
    if (it < n_s5) { if (MX & 2) s5_item(p, l, it, smem); continue; }
    it -= n_s5;
    if (it < n_diff) { if (MX & 4) diff_item(p, l, it, smem); continue; }
    it -= n_diff;
    if (it < n_mem) { if (MX & 8) mem_item(p, l, grp, it, smem); continue; }
    it -= n_mem;
    if (MX & 16) win_item(p, l, it, smem);
  }
}

__global__ void __launch_bounds__(256, 2) fwd_megakernel(Params p) {
  extern __shared__ __attribute__((aligned(16))) char smem[];
  __shared__ __attribute__((aligned(16))) unsigned s_misc[8];
  cg::grid_group grid = cg::this_grid();
  const int bid = blockIdx.x, nblk = gridDim.x;
  const int BG = p.BG, Tg = BG * S_, ngrp = NBATCH / BG;
  if (threadIdx.x < 8) s_misc[threadIdx.x] = 0u;
  __syncthreads();
  XcdBarrier xb = xcd_barrier_post(p.bar, (volatile LAS unsigned*)s_misc);
  if (PH & 1) phase_prologue(p, smem, bid, nblk);
  if (p.BG < 0) grid.sync();
  xcd_barrier(xb);
  if (PH & 2) phase_kv(p, smem, bid, nblk);
  for (int grp = 0; grp < ngrp; ++grp) {
    const size_t rowoff = (size_t)grp * Tg * D_;
    for (int l = 0; l < 2; ++l) {
      const float* xin = (l == 0 ? p.in[0] : (const float*)p.out) + rowoff;
      if (PH & 4) phase_norm(xin, p.in[4] + (size_t)l * D_, p.h, Tg, bid, nblk);
      if (DUP & 4) phase_norm(xin, p.in[4] + (size_t)l * D_, p.h, Tg, bid, nblk);
      xcd_barrier(xb);
      if (PH & 8) phase_inproj(p, l, Tg, smem, bid, nblk);
      xcd_barrier(xb);
      if (PH & 16) phase_conv(p, l, Tg, bid, nblk);
      if (DUP & 16) phase_conv(p, l, Tg, bid, nblk);
      xcd_barrier(xb);
      if (PH & 32) phase_mixers(p, l, grp, p.ctr + grp * 2 + l, smem, (volatile int*)&s_misc[4]);
      xcd_barrier(xb);
      if (PH & 64) phase_finalize(p, l, Tg, bid, nblk);
      xcd_barrier(xb);
      if (PH & 128) phase_glu(p, l, Tg, smem, bid, nblk);
      if (DUP & 128) phase_glu(p, l, Tg, smem, bid, nblk);
      xcd_barrier(xb);
      if (PH & 256) phase_merge(p, l, Tg, p.P, smem, bid, nblk);
      xcd_barrier(xb);
      if (PH & 512) phase_out(p, l, Tg, p.P, xin, p.out + rowoff, smem, bid, nblk);
      xcd_barrier(xb);
    }
  }
  if (PH & 1024) phase_final(p.out, p.in[3], NBATCH * S_, bid, nblk);
}

extern "C" void kernel_launch(void* const* d_in, const int* in_sizes, int n_in, void* d_out, int out_size, void* d_ws,
                              size_t ws_size, hipStream_t stream) {
  static int grid_blocks = 0;
  if (!grid_blocks) {
    int dev = 0, cus = 0, per_cu = 0;
    hipGetDevice(&dev);
    hipDeviceGetAttribute(&cus, hipDeviceAttributeMultiprocessorCount, dev);
    hipFuncSetAttribute((const void*)fwd_megakernel, hipFuncAttributeMaxDynamicSharedMemorySize, SMEM_BYTES);
    hipOccupancyMaxActiveBlocksPerMultiprocessor(&per_cu, fwd_megakernel, 256, SMEM_BYTES);
    if (per_cu > 2) per_cu = 2;
    if (per_cu < 1) per_cu = 1;
    grid_blocks = cus * per_cu;
  }
  Params p{};
  for (int i = 0; i < 31; ++i) p.in[i] = (const float*)d_in[i];
  p.out = (float*)d_out;
  char* ws = (char*)d_ws;
  size_t off = 0;
  auto take = [&](size_t bytes) { char* r = ws + off; off += (bytes + 255) & ~(size_t)255; return r; };
  p.W = (u16*)take(2 * LAYER_W * 2);
  p.KV = (u16*)take((size_t)2 * NBATCH * MEML * D_ * 2);
  p.memb = (u16*)take((size_t)NBATCH * MEML * D_ * 2);
  p.memrs = (float*)take(NBATCH * MEML * 4);
  p.lut = (float*)take(12 * LUTS * 4);
  p.ctr = (int*)take(4096);
  p.bar = (unsigned*)take(XCD_BAR_WORDS * 4);
  const size_t fixed = off;
  int BG = 8;
  auto need = [&](int bg) { size_t tg = (size_t)bg * S_; return fixed + tg * (D_ * 2 + (size_t)PW * 2 + 1024 * 2 + 7 * BWID * 2) + 16 * 256; };
  while (BG > 1 && need(BG) > ws_size) BG >>= 1;
  const size_t Tg = (size_t)BG * S_;
  p.h = (u16*)take(Tg * D_ * 2);
  p.P = (u16*)take(Tg * PW * 2);
  p.xa = (u16*)take(Tg * 1024 * 2);
  p.o0 = (u16*)take(Tg * BWID * 2);
  p.o1 = (u16*)take(Tg * BWID * 2);
  p.o2 = (u16*)take(Tg * BWID * 2);
  p.o3 = (u16*)take(Tg * BWID * 2);
  p.o4 = (u16*)take(Tg * BWID * 2);
  p.syb = (u16*)take(Tg * BWID * 2);
  p.s5f = (u16*)take(Tg * BWID * 2);
  p.BG = BG;
  p.pad = 0;
  hipMemsetAsync(p.ctr, 0, 4096 + ((XCD_BAR_WORDS * 4 + 255) & ~255), stream);
  void* args[] = {&p};
  hipError_t e = hipLaunchCooperativeKernel((const void*)fwd_megakernel, dim3(grid_blocks), dim3(256), args, SMEM_BYTES, stream);
  if (e != hipSuccess) fprintf(stderr, "cooperative launch failed: %s (grid %d)\n", hipGetErrorString(e), grid_blocks);
}
```

```cpp
#include <hip/hip_runtime.h>
#include <hip/hip_cooperative_groups.h>
#include <cstdio>
namespace cg = cooperative_groups;

#define DI __device__ __forceinline__
typedef unsigned short u16;
typedef __attribute__((ext_vector_type(8))) short bf16x8;
typedef __attribute__((ext_vector_type(4))) short s16x4;
typedef __attribute__((ext_vector_type(16))) float f32x16;
typedef __attribute__((ext_vector_type(4))) float f32x4;
typedef __attribute__((ext_vector_type(2))) float f32x2;
typedef __attribute__((ext_vector_type(4))) unsigned u32x4;
typedef __attribute__((ext_vector_type(2))) unsigned u32x2;
typedef __attribute__((ext_vector_type(2))) __bf16 bf2_t;

constexpr int S_ = 2048, D_ = 1024, NBATCH = 16, BWID = 512, MEML = 256;
constexpr int PW = 7040;
constexpr int P_XBC = 0, P_SZ = 1024, P_DQ = 1536, P_DK = 2048, P_DV = 2560, P_DZ = 3072, P_CQ = 3584, P_CK = 4096,
              P_CV = 4224, P_CZ = 4352, P_UIN = 4864, P_UZ = 5376, P_MQ = 5888, P_MZ = 6400, P_DT = 6912;
constexpr size_t WIN_OFF = 0, WMG_OFF = 7208960, WBR_OFF = 12451840, WOUT_OFF = 15073280, WGLU_OFF = 16121856,
                 WKV_OFF = 16384000, LAYER_W = 17432576;
constexpr int LUTS = 4096;
constexpr int HALF_SMEM = 75 * 1024;
constexpr int SMEM_BYTES = 2 * HALF_SMEM;
constexpr float EPS_ = 1e-6f;
#ifndef PH
#define PH 0xffff
#endif
#ifndef MX
#define MX 0xff
#endif
#ifndef DUP
#define DUP 0
#endif

struct Params {
  const float* in[31];
  float* out;
  u16* W; u16* KV; u16* memb; float* memrs; float* lut; int* ctr; unsigned* bar;
  u16* h; u16* P; u16* xa; u16* o0; u16* o1; u16* o2; u16* o3; u16* o4; u16* syb; u16* s5f;
  int BG; int pad;
};

DI unsigned pk2(float a, float b) { bf2_t r = __builtin_convertvector((f32x2){a, b}, bf2_t); return __builtin_bit_cast(unsigned, r); }
DI u16 f2bf(float a) { return (u16)(pk2(a, 0.f) & 0xffffu); }
DI float bf2f(u16 v) { return __uint_as_float(((unsigned)v) << 16); }
DI float bflo(unsigned v) { return __uint_as_float(v << 16); }
DI float bfhi(unsigned v) { return __uint_as_float(v & 0xffff0000u); }
DI float sigmoidf_(float x) { return __builtin_amdgcn_rcpf(1.f + __builtin_amdgcn_exp2f(-1.4426950408889634f * x)); }
DI float siluf_(float x) { return x * __builtin_amdgcn_rcpf(1.f + __builtin_amdgcn_exp2f(-1.4426950408889634f * x)); }
DI int crow(int reg, int h) { return (reg & 3) + 8 * (reg >> 2) + 4 * h; }
DI int otid() { int t = threadIdx.x & 255; asm volatile("" : "+v"(t)); return t; }
DI int rtid() { int t = threadIdx.x; asm volatile("" : "+v"(t)); return t; }
DI float wave_sum(float v) { for (int o = 32; o > 0; o >>= 1) v += __shfl_xor(v, o, 64); return v; }
#define MFMA32(a, b, c) __builtin_amdgcn_mfma_f32_32x32x16_bf16((a), (b), (c), 0, 0, 0)
#define MFMA16(a, b, c) __builtin_amdgcn_mfma_f32_16x16x32_bf16((a), (b), (c), 0, 0, 0)

DI bf16x8 ldfrag(const u16* base, int stride, int row, int col) { return *reinterpret_cast<const bf16x8*>(base + row * stride + col); }
DI s16x4 tr4(const u16* base, int stride, int krow0, int col0, int lane) {
  const int i16 = lane & 15, q = i16 >> 2, pp = i16 & 3, blk = (lane >> 4) & 1;
  const u16* a = base + (krow0 + q) * stride + col0 + 16 * blk + 4 * pp;
  return __builtin_amdgcn_ds_read_tr16_b64_v4i16((__attribute__((address_space(3))) s16x4*)(a));
}
DI bf16x8 ldfrag_tr_nat(const u16* base, int stride, int k0, int col0, int lane) {
  const int h = lane >> 5;
  s16x4 lo = tr4(base, stride, k0 + 8 * h, col0, lane), hi = tr4(base, stride, k0 + 8 * h + 4, col0, lane);
  return __builtin_shufflevector(lo, hi, 0, 1, 2, 3, 4, 5, 6, 7);
}
DI bf16x8 ldfrag_tr_perm(const u16* base, int stride, int k0, int col0, int lane) {
  const int h = lane >> 5;
  s16x4 lo = tr4(base, stride, k0 + 4 * h, col0, lane), hi = tr4(base, stride, k0 + 8 + 4 * h, col0, lane);
  return __builtin_shufflevector(lo, hi, 0, 1, 2, 3, 4, 5, 6, 7);
}
DI bf16x8 pack8(const f32x16& x, int s) {
  u32x4 u;
  u.x = pk2(x[8 * s + 0], x[8 * s + 1]); u.y = pk2(x[8 * s + 2], x[8 * s + 3]);
  u.z = pk2(x[8 * s + 4], x[8 * s + 5]); u.w = pk2(x[8 * s + 6], x[8 * s + 7]);
  return __builtin_bit_cast(bf16x8, u);
}
DI u32x4 scale8(u32x4 v, float f) {
  u32x4 o;
  o.x = pk2(bflo(v.x) * f, bfhi(v.x) * f); o.y = pk2(bflo(v.y) * f, bfhi(v.y) * f);
  o.z = pk2(bflo(v.z) * f, bfhi(v.z) * f); o.w = pk2(bflo(v.w) * f, bfhi(v.w) * f);
  return o;
}
DI void unpack8(u32x4 v, float* f) {
  f[0] = bflo(v.x); f[1] = bfhi(v.x); f[2] = bflo(v.y); f[3] = bfhi(v.y);
  f[4] = bflo(v.z); f[5] = bfhi(v.z); f[6] = bflo(v.w); f[7] = bfhi(v.w);
}
DI void wave_lds_sync() {
  __builtin_amdgcn_fence(__ATOMIC_RELEASE, "wavefront");
  __builtin_amdgcn_wave_barrier();
  __builtin_amdgcn_fence(__ATOMIC_ACQUIRE, "wavefront");
}


#define XB_TMO      128
#define XB_XCNT(j)  (256  + 64 * (j))
#define XB_XSUB(j)  (1280 + 64 * (j))
#define XB_XGEN(j)  (2304 + 64 * (j))
#define XB_TOP      3328
#define XB_TOPGEN   3392
#define XCD_BAR_WORDS 3456
#define XB_SPIN_CAP (1u << 24)
#define LAS __attribute__((address_space(3)))
DI unsigned xb_ld(unsigned* p) { return __hip_atomic_load(p, __ATOMIC_RELAXED, __HIP_MEMORY_SCOPE_AGENT); }
DI unsigned xb_add(unsigned* p, unsigned v) { return __hip_atomic_fetch_add(p, v, __ATOMIC_RELAXED, __HIP_MEMORY_SCOPE_AGENT); }
DI unsigned xb_xcc_id() { return (unsigned)__builtin_amdgcn_s_getreg((3 << 11) | 20) & 0xFu; }
#define XB_SPIN(cond, bar) do { unsigned _sp = 0; while (cond) { __builtin_amdgcn_s_sleep(1); \
    if ((++_sp & 255u) == 0u) { if (xb_ld(&(bar)[XB_TMO])) break; if (_sp > XB_SPIN_CAP) { atomicAdd(&(bar)[XB_TMO], 1u); break; } } } } while (0)
struct XcdBarrier { unsigned* bar; unsigned x; volatile LAS unsigned* st; };
DI XcdBarrier xcd_barrier_post(unsigned* bar, volatile LAS unsigned* st) {
  XcdBarrier b; b.bar = bar; b.x = xb_xcc_id(); b.st = st;
  if (threadIdx.x == 0) (void)xb_add(&bar[XB_XCNT(b.x)], 1u);
  return b;
}
DI void xcd_barrier_complete(unsigned* bar, unsigned x, unsigned& nloc, unsigned& nx) {
  const unsigned G = gridDim.x * gridDim.y * gridDim.z;
  unsigned sum, cnt, mine, sp = 0u;
  for (;;) {
    sum = 0u; cnt = 0u; mine = 0u;
#pragma unroll
    for (unsigned j = 0; j < 16; ++j) { const unsigned c = xb_ld(&bar[XB_XCNT(j)]); sum += c; cnt += (c > 0u) ? 1u : 0u; mine = (j == x) ? c : mine; }
    if (sum == G) break;
    __builtin_amdgcn_s_sleep(1);
    if ((++sp & 255u) == 0u) { if (xb_ld(&bar[XB_TMO])) break; if (sp > XB_SPIN_CAP) { atomicAdd(&bar[XB_TMO], 1u); break; } }
  }
  nloc = mine > 0u ? mine : 1u; nx = cnt > 0u ? cnt : 1u;
}
DI void xcd_barrier(const XcdBarrier& b) {
  asm volatile("s_waitcnt vmcnt(0)" ::: "memory");
  __syncthreads();
  if (threadIdx.x == 0) {
    unsigned* bar = b.bar;
    __builtin_amdgcn_s_waitcnt(0);
    unsigned nloc = b.st[0], nx = b.st[1];
    if (nloc == 0u) { xcd_barrier_complete(bar, b.x, nloc, nx); b.st[0] = nloc; b.st[1] = nx; }
    const unsigned old = xb_add(&bar[XB_XSUB(b.x)], 1u);
    const unsigned gen = old / nloc;
    if (old + 1u == (gen + 1u) * nloc) {
      __builtin_amdgcn_fence(__ATOMIC_RELEASE, "agent");
      asm volatile("s_waitcnt vmcnt(0)" ::: "memory");
      const unsigned og = xb_add(&bar[XB_TOP], 1u);
      const unsigned tg = og / nx;
      if (og + 1u == (tg + 1u) * nx) xb_add(&bar[XB_TOPGEN], 1u);
      else XB_SPIN(xb_ld(&bar[XB_TOPGEN]) == tg, bar);
      __builtin_amdgcn_fence(__ATOMIC_ACQUIRE, "agent");
      xb_add(&bar[XB_XGEN(b.x)], 1u);
      asm volatile("s_waitcnt vmcnt(0)" ::: "memory");
    } else {
      XB_SPIN(xb_ld(&bar[XB_XGEN(b.x)]) == gen, bar);
      __builtin_amdgcn_fence(__ATOMIC_ACQUIRE, "agent");
      asm volatile("s_waitcnt vmcnt(0)" ::: "memory");
    }
  }
  __syncthreads();
}

template <int BM, int BN>
DI void gemm_acc(const u16* __restrict__ A, int lda, int kstrA, const u16* __restrict__ Bt, int ldb, int kstrB, int K,
                 f32x16 (&acc)[BM / 64][BN / 64], char* smem) {
  constexpr int MI = BM / 64, NJ = BN / 64, NAC = BM / 32, NBC = BN / 32;
  u16* sA = (u16*)smem;
  u16* sB = sA + BM * 72;
  const int tid = otid(), lane = tid & 63, w = tid >> 6, wm = w >> 1, wn = w & 1, r = lane & 31, h = lane >> 5;
  u32x4 ra[NAC], rb[NBC];
  const int crow_ = tid >> 3, ccol = (tid & 7) * 8;
  const u16* Ap = A + (size_t)crow_ * lda + ccol;
  const u16* Bp = Bt + (size_t)crow_ * ldb + ccol;
#pragma unroll
  for (int i = 0; i < NAC; ++i) ra[i] = *(const u32x4*)(Ap + (size_t)(32 * i) * lda);
#pragma unroll
  for (int i = 0; i < NBC; ++i) rb[i] = *(const u32x4*)(Bp + (size_t)(32 * i) * ldb);
  const int nk = K >> 6;
  for (int kt = 0; kt < nk; ++kt) {
    __syncthreads();
#pragma unroll
    for (int i = 0; i < NAC; ++i) *(u32x4*)(sA + (crow_ + 32 * i) * 72 + ccol) = ra[i];
#pragma unroll
    for (int i = 0; i < NBC; ++i) *(u32x4*)(sB + (crow_ + 32 * i) * 72 + ccol) = rb[i];
    __syncthreads();
    if (kt + 1 < nk) {
      const size_t koA = (size_t)(kt + 1) * kstrA, koB = (size_t)(kt + 1) * kstrB;
#pragma unroll
      for (int i = 0; i < NAC; ++i) ra[i] = *(const u32x4*)(Ap + (size_t)(32 * i) * lda + koA);
#pragma unroll
      for (int i = 0; i < NBC; ++i) rb[i] = *(const u32x4*)(Bp + (size_t)(32 * i) * ldb + koB);
    }
#pragma unroll
    for (int ks = 0; ks < 4; ++ks) {
      bf16x8 b[NJ];
#pragma unroll
      for (int j = 0; j < NJ; ++j) b[j] = ldfrag(sB, 72, wn * (BN / 2) + 32 * j + r, ks * 16 + 8 * h);
#pragma unroll
      for (int i = 0; i < MI; ++i) {
        const bf16x8 a = ldfrag(sA, 72, wm * (BM / 2) + 32 * i + r, ks * 16 + 8 * h);
#pragma unroll
        for (int j = 0; j < NJ; ++j) acc[i][j] = MFMA32(a, b[j], acc[i][j]);
      }
    }
  }
}

template <int BM, int BN>
DI void gemm8(const u16* __restrict__ A, int lda, int kstrA, const u16* __restrict__ Bt, size_t bpanel, int K,
              f32x16 (&acc)[BM / 64][BN / 128], char* smem) {
  constexpr int MI = BM / 64, NJ = BN / 128, NAC = BM / 64, NBC = BN / 64;
  u16* sA = (u16*)smem;
  u16* sB = sA + BM * 72;
  const int tid = rtid(), lane = tid & 63, w = tid >> 6, wm = w >> 2, wn = w & 3, r = lane & 31, h = lane >> 5;
  u32x4 ra[NAC], rb[NBC];
  const int crow_ = tid >> 3, ccol = (tid & 7) * 8;
  const u16* Ap = A + (size_t)crow_ * lda + ccol;
  const u16* Bp = Bt + (size_t)crow_ * 64 + ccol;
#pragma unroll
  for (int i = 0; i < NAC; ++i) ra[i] = *(const u32x4*)(Ap + (size_t)(64 * i) * lda);
#pragma unroll
  for (int i = 0; i < NBC; ++i) rb[i] = *(const u32x4*)(Bp + (size_t)(i >> 1) * bpanel + (size_t)(64 * (i & 1)) * 64);
  const int nk = K >> 6;
#pragma unroll 1
  for (int kt = 0; kt < nk; ++kt) {
    __syncthreads();
#pragma unroll
    for (int i = 0; i < NAC; ++i) *(u32x4*)(sA + (crow_ + 64 * i) * 72 + ccol) = ra[i];
#pragma unroll
    for (int i = 0; i < NBC; ++i) *(u32x4*)(sB + (crow_ + 64 * i) * 72 + ccol) = rb[i];
    __syncthreads();
    if (kt + 1 < nk) {
      const size_t koA = (size_t)(kt + 1) * kstrA, koB = (size_t)(kt + 1) * 8192;
#pragma unroll
      for (int i = 0; i < NAC; ++i) ra[i] = *(const u32x4*)(Ap + (size_t)(64 * i) * lda + koA);
#pragma unroll
      for (int i = 0; i < NBC; ++i) rb[i] = *(const u32x4*)(Bp + (size_t)(i >> 1) * bpanel + (size_t)(64 * (i & 1)) * 64 + koB);
    }
#pragma unroll
    for (int ks = 0; ks < 4; ++ks) {
      bf16x8 b[NJ];
#pragma unroll
      for (int j = 0; j < NJ; ++j) b[j] = ldfrag(sB, 72, wn * (BN / 4) + 32 * j + r, ks * 16 + 8 * h);
#pragma unroll
      for (int i = 0; i < MI; ++i) {
        const bf16x8 a = ldfrag(sA, 72, wm * (BM / 2) + 32 * i + r, ks * 16 + 8 * h);
#pragma unroll
        for (int j = 0; j < NJ; ++j) acc[i][j] = MFMA32(a, b[j], acc[i][j]);
      }
    }
  }
}

template <int BM, int BN>
DI void gemm8db(const u16* __restrict__ A, int lda, int kstrA, const u16* __restrict__ Bt, size_t bpanel, int K,
                f32x16 (&acc)[BM / 64][BN / 128], char* smem) {
  constexpr int MI = BM / 64, NJ = BN / 128, NAC = BM / 64, NBC = BN / 64, STAGE = (BM + BN) * 72;
  u16* sA0 = (u16*)smem;
  u16* sB0 = sA0 + BM * 72;
  u16* sA1 = sA0 + STAGE;
  u16* sB1 = sA1 + BM * 72;
  const int tid = rtid(), lane = tid & 63, w = tid >> 6, wm = w >> 2, wn = w & 3, r = lane & 31, h = lane >> 5;
  u32x4 ra0[NAC], rb0[NBC], ra1[NAC], rb1[NBC];
  const int crow_ = tid >> 3, ccol = (tid & 7) * 8;
  const u16* Ap = A + (size_t)crow_ * lda + ccol;
  const u16* Bp = Bt + (size_t)crow_ * 64 + ccol;
  const int nk = K >> 6;
#define G_LOAD(RA, RB, KT)                                                                          \
  {                                                                                                 \
    const size_t koA_ = (size_t)(KT) * kstrA, koB_ = (size_t)(KT) * 8192;                           \
    _Pragma("unroll") for (int i = 0; i < NAC; ++i) RA[i] = *(const u32x4*)(Ap + (size_t)(64 * i) * lda + koA_); \
    _Pragma("unroll") for (int i = 0; i < NBC; ++i) RB[i] = *(const u32x4*)(Bp + (size_t)(i >> 1) * bpanel + (size_t)(64 * (i & 1)) * 64 + koB_); \
  }
#define G_WRITE(RA, RB, SA, SB)                                                                     \
  {                                                                                                 \
    _Pragma("unroll") for (int i = 0; i < NAC; ++i) *(u32x4*)(SA + (crow_ + 64 * i) * 72 + ccol) = RA[i]; \
    _Pragma("unroll") for (int i = 0; i < NBC; ++i) *(u32x4*)(SB + (crow_ + 64 * i) * 72 + ccol) = RB[i]; \
  }
#define G_COMPUTE(SA, SB)                                                                           \
  {                                                                                                 \
    _Pragma("unroll") for (int ks = 0; ks < 4; ++ks) {                                              \
      bf16x8 b_[NJ];                                                                                \
      _Pragma("unroll") for (int j = 0; j < NJ; ++j) b_[j] = ldfrag(SB, 72, wn * (BN / 4) + 32 * j + r, ks * 16 + 8 * h); \
      _Pragma("unroll") for (int i = 0; i < MI; ++i) {                                              \
        const bf16x8 a_ = ldfrag(SA, 72, wm * (BM / 2) + 32 * i + r, ks * 16 + 8 * h);             \
        _Pragma("unroll") for (int j = 0; j < NJ; ++j) acc[i][j] = MFMA32(a_, b_[j], acc[i][j]);    \
      }                                                                                             \
    }                                                                                               \
  }
  G_LOAD(ra0, rb0, 0);
  G_LOAD(ra1, rb1, 1);
  __syncthreads();
  G_WRITE(ra0, rb0, sA0, sB0);
  if (nk > 2) G_LOAD(ra0, rb0, 2);
  __syncthreads();
#pragma unroll 1
  for (int kt = 0; kt < nk; kt += 2) {
    G_COMPUTE(sA0, sB0);
    G_WRITE(ra1, rb1, sA1, sB1);
    if (kt + 3 < nk) G_LOAD(ra1, rb1, kt + 3);
    __syncthreads();
    G_COMPUTE(sA1, sB1);
    if (kt + 2 < nk) G_WRITE(ra0, rb0, sA0, sB0);
    if (kt + 4 < nk) G_LOAD(ra0, rb0, kt + 4);
    __syncthreads();
  }
#undef G_LOAD
#undef G_WRITE
#undef G_COMPUTE
}


namespace pg8 {
#define PG8_LAS __attribute__((address_space(3)))
typedef unsigned short bf16_t;
constexpr int BM = 256, BK = 64, HALF = 128, HTB = HALF * BK * 2, STAGE_BYTES = 8 * HTB, NXCD = 8, WGM = 8;
__host__ __device__ __forceinline__ int lds_byte(int r, int c) { const int st = (r >> 4) * 2 + (c >> 5), rr = r & 15, cc = c & 31, ob = rr * 64 + cc * 2; return st * 1024 + (ob ^ (((ob >> 9) & 1) << 5)); }
__host__ __device__ __forceinline__ void stage_rc(int b, int& R, int& C) { const int st = b / 1024, sb = b % 1024, swz = sb ^ (((sb >> 9) & 1) << 5); R = (st >> 1) * 16 + swz / 64; C = (st & 1) * 32 + (swz % 64) / 2; }
__host__ __device__ __forceinline__ int perm32(int rho) { const int n = rho >> 4, i = rho & 15; return 8 * (i >> 2) + 4 * n + (i & 3); }
struct Unit { int pm, pn, br; };
struct Gemm { const bf16_t* A; const bf16_t* Bt; int M, N, K; };
struct StaticOrder {
    int nM, nN, nwg, G, c;
    __host__ __device__ void init(int M, int N, int G_, int c_) { nM = M / BM; nN = N / BM; nwg = nM * nN; G = G_; c = c_; }
    __host__ __device__ bool next(int i, Unit& u) const {
        const long L = (long)i * G + c; if (L >= nwg) return false;
        int wgid = (int)L; { const int q = nwg / NXCD, r = nwg % NXCD, xcd = wgid % NXCD, off = wgid / NXCD; wgid = (xcd < r ? xcd * (q + 1) : r * (q + 1) + (xcd - r) * q) + off; }
        const int nig = WGM * nN, gid = wgid / nig, fm = gid * WGM, gsz = (nM - fm) < WGM ? (nM - fm) : WGM;
        u.pm = fm + ((wgid % nig) % gsz); u.pn = (wgid % nig) / gsz; u.br = 0; return true;
    }
    __device__ __forceinline__ void a_ready(const Unit&) const {}
    __device__ __forceinline__ void done(const Unit&) const {}
    __device__ __forceinline__ const char* pa(const Unit& u, const Gemm& g) const { return (const char*)g.A + (size_t)u.pm * (size_t)(2 * BM) * g.K; }
    __device__ __forceinline__ const char* pb(const Unit& u, const Gemm& g) const { return (const char*)g.Bt + (size_t)u.pn * (size_t)(2 * BM) * g.K; }
};
template <class Epi, class Sched>
__device__ __forceinline__ void gemm_phase(PG8_LAS unsigned char* lds, const Gemm g, const Sched& S, const Epi& E) {
    constexpr bool STAMP = false; unsigned long long* stamps = nullptr;
    const int tid = rtid(), wid = __builtin_amdgcn_readfirstlane(tid >> 6), lane = tid & 63, wr = wid >> 2, wc = wid & 3, fr = lane & 15, fq = lane >> 4;
    const int K = g.K, nt = K / BK;
    int ts_lo = 0, ts_hi = 0, nts = 0; const unsigned long long rt_entry = STAMP ? 0ull : 0ull;
#define PG8_STAMP() do { if (STAMP && wid == 0 && nts < 64) { const unsigned long long _c = 0ull; \
        ts_lo = (lane == nts) ? (int)(unsigned)_c : ts_lo; ts_hi = (lane == nts) ? (int)(unsigned)(_c >> 32) : ts_hi; ++nts; } } while (0)
    PG8_STAMP();
    unsigned voffA[2], voffB[2];
#pragma unroll
    for (int i = 0; i < 2; ++i) { int R, C; stage_rc(tid * 16 + i * 8192, R, C); const int Rb = Epi::PERM ? ((R & ~31) + perm32(R & 31)) : R;
        voffA[i] = (unsigned)(R * K + C) * 2u; voffB[i] = (unsigned)(Rb * K + C) * 2u; }
    const size_t kstep = (size_t)(BK * 2);
    const size_t hstep = (size_t)HALF * K * 2;
    const size_t tstep = 2 * hstep;
    const unsigned ldsw = (unsigned)wid * 1024u;
    const int aoff = lds_byte(wr * 64 + fr, fq * 8), boff = lds_byte(wc * 32 + fr, fq * 8);
#define PG8_SA(b, h) (((b) * 2 + (h)) * HTB)
#define PG8_SB(b, h) ((4 + (b) * 2 + (h)) * HTB)
#define PG8_STAGE(bufoff, gbase, voff) do { _Pragma("unroll") for (int _i = 0; _i < 2; ++_i) \
        __builtin_amdgcn_global_load_lds((const unsigned*)((const char*)(gbase) + (voff)[_i]), (PG8_LAS unsigned*)(lds + (bufoff) + ldsw + _i * 8192), 16, 0, 0); } while (0)
#define PG8_LDA(dst, b, h) do { _Pragma("unroll") for (int m = 0; m < 4; ++m) _Pragma("unroll") for (int k = 0; k < 2; ++k) dst[m][k] = *(const PG8_LAS bf16x8*)(lds + PG8_SA(b, h) + aoff + m * 2048 + k * 1024); } while (0)
#define PG8_LDB(dst, b, h) do { _Pragma("unroll") for (int n = 0; n < 2; ++n) _Pragma("unroll") for (int k = 0; k < 2; ++k) dst[n][k] = *(const PG8_LAS bf16x8*)(lds + PG8_SB(b, h) + boff + n * 2048 + k * 1024); } while (0)
#define PG8_MMA(ai, bj, At, Bt) do { __builtin_amdgcn_s_setprio(1); _Pragma("unroll") for (int m = 0; m < 4; ++m) _Pragma("unroll") for (int n = 0; n < 2; ++n) _Pragma("unroll") for (int k = 0; k < 2; ++k) \
        acc[ai][bj][m][n] = __builtin_amdgcn_mfma_f32_16x16x32_bf16(Bt[n][k], At[m][k], acc[ai][bj][m][n], 0, 0, 0); __builtin_amdgcn_s_setprio(0); } while (0)
#define PG8_WAIT_V(n) asm volatile("s_waitcnt vmcnt(" #n ")" ::: "memory")
#define PG8_WAIT_L(n) asm volatile("s_waitcnt lgkmcnt(" #n ")" ::: "memory")
#define PG8_BAR __builtin_amdgcn_s_barrier()
#define PG8_SCHED __builtin_amdgcn_sched_barrier(0)
    Unit cur, nxt; int ui = 0;
    if (!S.next(0, cur)) return;
    f32x4 acc[2][2][4][2];
#pragma unroll
    for (int a = 0; a < 2; ++a)
#pragma unroll
        for (int b = 0; b < 2; ++b)
#pragma unroll
            for (int m = 0; m < 4; ++m)
#pragma unroll
                for (int n = 0; n < 2; ++n) acc[a][b][m][n] = (f32x4){0.f, 0.f, 0.f, 0.f};
    bf16x8 At[4][2], B0[2][2], B1[2][2];
    const char* cA = S.pa(cur, g); const char* cB = S.pb(cur, g);
    S.a_ready(cur);
    PG8_STAGE(PG8_SB(0, 0), cB, voffB); PG8_STAGE(PG8_SA(0, 0), cA, voffA); PG8_STAGE(PG8_SB(0, 1), cB + hstep, voffB); PG8_STAGE(PG8_SA(0, 1), cA + hstep, voffA);
    if (wr == 1) PG8_BAR;
    PG8_WAIT_V(4); PG8_BAR;
    PG8_STAGE(PG8_SB(1, 0), cB + kstep, voffB); PG8_STAGE(PG8_SA(1, 0), cA + kstep, voffA); PG8_STAGE(PG8_SB(1, 1), cB + hstep + kstep, voffB);
    PG8_WAIT_V(6); PG8_BAR;
    PG8_STAMP();
    for (;;) {
        const bool has_next = S.next(ui + 1, nxt);
        const char* nA = has_next ? S.pa(nxt, g) : cA; const char* nB = has_next ? S.pb(nxt, g) : cB;
        for (int t = 0; t < nt; t += 2) {
            const bool last = (t == nt - 2);
            const char* a1 = cA + (size_t)(t + 1) * kstep;
            const char* a2 = last ? nA : cA + (size_t)(t + 2) * kstep; const char* b2 = last ? nB : cB + (size_t)(t + 2) * kstep;
            const char* a3 = a2 + kstep; const char* b3 = b2 + kstep;
            if (last && has_next) S.a_ready(nxt);
            PG8_LDB(B0, 0, 0); PG8_SCHED; PG8_LDA(At, 0, 0); PG8_STAGE(PG8_SA(1, 1), a1 + hstep, voffA);
            PG8_WAIT_L(8); PG8_BAR; PG8_WAIT_L(0); PG8_MMA(0, 0, At, B0); PG8_BAR; PG8_SCHED;
            PG8_LDB(B1, 0, 1); PG8_STAGE(PG8_SB(0, 0), b2, voffB);
            PG8_BAR; PG8_WAIT_L(0); PG8_MMA(0, 1, At, B1); PG8_BAR;
            PG8_LDA(At, 0, 1); PG8_STAGE(PG8_SA(0, 0), a2, voffA);
            PG8_BAR; PG8_WAIT_L(0); PG8_MMA(1, 0, At, B0); PG8_BAR; PG8_SCHED;
            PG8_STAGE(PG8_SB(0, 1), b2 + hstep, voffB);
            PG8_WAIT_V(6); PG8_BAR; PG8_MMA(1, 1, At, B1); PG8_BAR;
            PG8_LDB(B0, 1, 0); PG8_SCHED; PG8_LDA(At, 1, 0); PG8_STAGE(PG8_SA(0, 1), a2 + hstep, voffA);
            PG8_WAIT_L(8); PG8_BAR; PG8_WAIT_L(0); PG8_MMA(0, 0, At, B0); PG8_BAR; PG8_SCHED;
            PG8_LDB(B1, 1, 1); PG8_STAGE(PG8_SB(1, 0), b3, voffB);
            PG8_BAR; PG8_WAIT_L(0); PG8_MMA(0, 1, At, B1); PG8_BAR;
            PG8_LDA(At, 1, 1); PG8_STAGE(PG8_SA(1, 0), a3, voffA);
            PG8_BAR; PG8_WAIT_L(0); PG8_MMA(1, 0, At, B0); PG8_BAR; PG8_SCHED;
            PG8_STAGE(PG8_SB(1, 1), b3 + hstep, voffB);
            PG8_WAIT_V(6); PG8_BAR; PG8_MMA(1, 1, At, B1); PG8_BAR;
        }
        PG8_STAMP();
        if constexpr (!Epi::AFTER_DRAIN) { E(acc, cur, wr, wc, fr, fq); S.done(cur); }
        PG8_STAMP();
        if (!has_next) break;
#pragma unroll
        for (int a = 0; a < 2; ++a)
#pragma unroll
            for (int b = 0; b < 2; ++b)
#pragma unroll
                for (int m = 0; m < 4; ++m)
#pragma unroll
                    for (int n = 0; n < 2; ++n) acc[a][b][m][n] = (f32x4){0.f, 0.f, 0.f, 0.f};
        cur = nxt; cA = nA; cB = nB; ++ui;
    }
    PG8_WAIT_V(0);
    if (wr == 0) PG8_BAR;
    PG8_BAR;
    if constexpr (Epi::AFTER_DRAIN) { E.fused(acc, cur, wr, wc, fr, fq, lds, wid, lane); S.done(cur); }
    PG8_STAMP();
    if (STAMP && wid == 0) { stamps[lane] = lane < nts ? (((unsigned long long)(unsigned)ts_hi << 32) | (unsigned)ts_lo) : 0ull;
        if (lane == 62) stamps[62] = rt_entry; if (lane == 63) stamps[63] = 0ull; }
#undef PG8_STAMP
#undef PG8_SA
#undef PG8_SB
#undef PG8_STAGE
#undef PG8_LDA
#undef PG8_LDB
#undef PG8_MMA
#undef PG8_WAIT_V
#undef PG8_WAIT_L
#undef PG8_BAR
#undef PG8_SCHED
}

}

struct EpiP {
  static constexpr bool PERM = true, AFTER_DRAIN = false;
  u16* P;
  DI void operator()(const f32x4 (&acc)[2][2][4][2], const pg8::Unit& u, int wr, int wc, int fr, int fq) const {
    const int row0 = u.pm * 256 + wr * 64 + fr, col0 = u.pn * 256 + wc * 32 + 8 * fq;
#pragma unroll
    for (int ai = 0; ai < 2; ++ai)
#pragma unroll
      for (int m = 0; m < 4; ++m) {
        u16* rowp = P + (size_t)(row0 + ai * 128 + m * 16) * PW + col0;
#pragma unroll
        for (int bj = 0; bj < 2; ++bj) {
          if (col0 + bj * 128 < PW) {
            const f32x4 v0 = acc[ai][bj][m][0], v1 = acc[ai][bj][m][1];
            u32x4 w; w.x = pk2(v0[0], v0[1]); w.y = pk2(v0[2], v0[3]); w.z = pk2(v1[0], v1[1]); w.w = pk2(v1[2], v1[3]);
            *(u32x4*)(rowp + bj * 128) = w;
          }
        }
      }
  }
};
struct EpiX {
  static constexpr bool PERM = false, AFTER_DRAIN = false;
  const float* xin; float* xout;
  DI void operator()(const f32x4 (&acc)[2][2][4][2], const pg8::Unit& u, int wr, int wc, int fr, int fq) const {
    const int row0 = u.pm * 256 + wr * 64 + fr, col0 = u.pn * 256 + wc * 32 + 4 * fq;
#pragma unroll
    for (int ai = 0; ai < 2; ++ai)
#pragma unroll
      for (int m = 0; m < 4; ++m) {
        const size_t rb = (size_t)(row0 + ai * 128 + m * 16) * D_ + col0;
#pragma unroll
        for (int bj = 0; bj < 2; ++bj)
#pragma unroll
          for (int n = 0; n < 2; ++n) {
            const size_t idx = rb + bj * 128 + n * 16;
            *(f32x4*)(xout + idx) = *(const f32x4*)(xin + idx) + acc[ai][bj][m][n];
          }
      }
  }
};

DI size_t wtile(int n0, int K) { return (size_t)(n0 >> 7) * (size_t)(K >> 6) * 8192; }
DI size_t htile(int m0) { return (size_t)(m0 >> 8) * 16 * 16384 + (size_t)(m0 & 255) * 64; }

template <int MI, int NJ>
DI void zero_acc(f32x16 (&acc)[MI][NJ]) {
#pragma unroll
  for (int i = 0; i < MI; ++i)
#pragma unroll
    for (int j = 0; j < NJ; ++j)
#pragma unroll
      for (int e = 0; e < 16; ++e) acc[i][j][e] = 0.f;
}

#define TILE_WALK_BEGIN(MT, NT, SM, SN)                                                   \
  {                                                                                       \
    const int xg_ = bid & 7, loc_ = bid >> 3, nloc_ = nblk >> 3;                          \
    const int nsn_ = ((NT) + (SN) - 1) / (SN), nst_ = (((MT) + (SM) - 1) / (SM)) * nsn_;  \
    for (int st_ = xg_; st_ < nst_; st_ += 8)                                             \
      for (int j_ = loc_; j_ < (SM) * (SN); j_ += nloc_) {                                \
        const int mi = (st_ / nsn_) * (SM) + j_ / (SN), ni = (st_ % nsn_) * (SN) + j_ % (SN); \
        if (mi >= (MT) || ni >= (NT)) continue;
#define TILE_WALK_END }}

DI int t5_bucket(int rel) {
  int n = rel < 0 ? -rel : rel;
  float nf = (float)(n > 1 ? n : 1);
  int large = 8 + (int)(logf(nf / 8.f) / logf(16.f) * 8.f);
  large = large < 15 ? large : 15;
  return (rel > 0 ? 16 : 0) + (n < 8 ? n : large);
}

DI void prep_job(const float* __restrict__ src, int K, int Nsrc, u16* __restrict__ dst, int Ndst, int mode,
                 const float* __restrict__ scale, char* smem, int bid, int nblk, bool rowmajor = false) {
  u16* sT = (u16*)smem;
  const int tid = otid();
  const int ntn = Ndst >> 6, ntk = K >> 6;
  float v[16];
  auto gl = [&](int t) {
    const int n0 = (t / ntk) << 6, k0 = (t % ntk) << 6;
    const int n = n0 + (tid & 63);
    int sc = n;
    if (mode == 1) sc = (n < 1536) ? n : (n < 6912 ? n + 16 : (n < 6928 ? n - 6912 + 1536 : -1));
#pragma unroll
    for (int i = 0; i < 16; ++i) {
      const int k = i * 4 + (tid >> 6);
      float x = 0.f;
      if (sc >= 0) x = src[(size_t)(k0 + k) * Nsrc + sc];
      if (scale) x *= scale[k0 + k];
      v[i] = x;
    }
  };
  if (bid < ntn * ntk) gl(bid);
  for (int t = bid; t < ntn * ntk; t += nblk) {
    const int n0 = (t / ntk) << 6, k0 = (t % ntk) << 6;
    __syncthreads();
#pragma unroll
    for (int i = 0; i < 16; ++i) sT[(tid & 63) * 72 + i * 4 + (tid >> 6)] = f2bf(v[i]);
    if (t + nblk < ntn * ntk) gl(t + nblk);
    __syncthreads();
    const int nn = tid >> 2, ks = (tid & 3) * 16;
    u32x4 v0 = *(const u32x4*)(sT + nn * 72 + ks), v1 = *(const u32x4*)(sT + nn * 72 + ks + 8);
    u16* d = rowmajor ? dst + (size_t)(n0 + nn) * K + k0 + ks
                      : dst + ((size_t)((n0 + nn) >> 7) * (size_t)(K >> 6) + (size_t)(k0 >> 6)) * 8192 + (size_t)((n0 + nn) & 127) * 64 + ks;
    *(u32x4*)d = v0;
    *(u32x4*)(d + 8) = v1;
  }
}

DI void phase_prologue(const Params& p, char* smem, int bid, int nblk) {
  const int tid = otid(), lane = tid & 63, w = tid >> 6;
  for (int i = bid * 256 + tid; i < 12 * 4095; i += nblk * 256) {
    const int hd = i / 4095, idx = i % 4095;
    p.lut[hd * LUTS + idx] = p.in[2][t5_bucket(idx - 2047) * 12 + hd];
  }
  for (int row = bid * 4 + w; row < NBATCH * MEML; row += nblk * 4) {
    const float* src = p.in[1] + (size_t)row * D_;
    float ss = 0.f;
#pragma unroll
    for (int i = 0; i < 4; ++i) {
      f32x4 v = *(const f32x4*)(src + i * 256 + lane * 4);
      ss += v[0] * v[0] + v[1] * v[1] + v[2] * v[2] + v[3] * v[3];
      u32x2 o; o.x = pk2(v[0], v[1]); o.y = pk2(v[2], v[3]);
      *(u32x2*)(p.memb + (size_t)row * D_ + i * 256 + lane * 4) = o;
    }
    ss = wave_sum(ss);
    if (lane == 0) p.memrs[row] = rsqrtf(ss / (float)D_ + EPS_);
  }
  for (int l = 0; l < 2; ++l) {
    u16* W = p.W + (size_t)l * LAYER_W;
    prep_job(p.in[5] + (size_t)l * D_ * 6928, D_, 6928, W + WIN_OFF, PW, 1, nullptr, smem, bid, nblk, true);
    for (int i = 0; i < 5; ++i)
      prep_job(p.in[27] + ((size_t)l * 5 + i) * D_ * D_, D_, D_, W + WMG_OFF + (size_t)i * D_ * D_, D_, 0, nullptr, smem, bid, nblk, true);
    for (int i = 0; i < 5; ++i)
      prep_job(p.in[29] + ((size_t)l * 5 + i) * BWID * D_, BWID, D_, W + WBR_OFF + (size_t)i * D_ * BWID, D_, 0, nullptr, smem, bid, nblk, true);
    prep_job(p.in[30] + (size_t)l * D_ * D_, D_, D_, W + WOUT_OFF, D_, 0, nullptr, smem, bid, nblk, true);
    prep_job(p.in[23] + (size_t)l * BWID * BWID, BWID, BWID, W + WGLU_OFF, BWID, 0, nullptr, smem, bid, nblk, true);
    prep_job(p.in[26] + (size_t)l * D_ * D_, D_, D_, W + WKV_OFF, D_, 0, p.in[25] + (size_t)l * D_, smem, bid, nblk);
  }
}

DI void phase_norm(const float* __restrict__ x, const float* __restrict__ g, u16* __restrict__ hdst, int nrows, int bid, int nblk) {
  const int tid_ = otid(), lane = tid_ & 63, w = tid_ >> 6;
  const int stride = nblk * 4;
  for (int row0 = bid * 4 + w; row0 < nrows; row0 += 4 * stride) {
    f32x4 v[4][4];
    float ss[4] = {0.f, 0.f, 0.f, 0.f};
#pragma unroll
    for (int u = 0; u < 4; ++u) {
      const int row = row0 + u * stride;
      if (row < nrows) {
        const float* src = x + (size_t)row * D_;
#pragma unroll
        for (int i = 0; i < 4; ++i) v[u][i] = *(const f32x4*)(src + i * 256 + lane * 4);
      }
    }
#pragma unroll
    for (int u = 0; u < 4; ++u) {
      const int row = row0 + u * stride;
      if (row < nrows) {
#pragma unroll
        for (int i = 0; i < 4; ++i) ss[u] += v[u][i][0] * v[u][i][0] + v[u][i][1] * v[u][i][1] + v[u][i][2] * v[u][i][2] + v[u][i][3] * v[u][i][3];
        ss[u] = wave_sum(ss[u]);
        const float rs = rsqrtf(ss[u] / (float)D_ + EPS_);
#pragma unroll
        for (int i = 0; i < 4; ++i) {
          f32x4 gg = *(const f32x4*)(g + i * 256 + lane * 4);
          u32x2 o; o.x = pk2(v[u][i][0] * rs * gg[0], v[u][i][1] * rs * gg[1]); o.y = pk2(v[u][i][2] * rs * gg[2], v[u][i][3] * rs * gg[3]);
          const int c = i * 256 + lane * 4;
          *(u32x2*)(hdst + (size_t)row * D_ + c) = o;
        }
      }
    }
  }
}

DI void phase_final(float* __restrict__ x, const float* __restrict__ g, int nrows, int bid, int nblk) {
  const int tid_ = otid(), lane = tid_ & 63, w = tid_ >> 6;
  const int stride = nblk * 4;
  for (int row0 = bid * 4 + w; row0 < nrows; row0 += 4 * stride) {
    f32x4 v[4][4];
    float ss[4] = {0.f, 0.f, 0.f, 0.f};
#pragma unroll
    for (int u = 0; u < 4; ++u) {
      const int row = row0 + u * stride;
      if (row < nrows) {
        const float* src = x + (size_t)row * D_;
#pragma unroll
        for (int i = 0; i < 4; ++i) v[u][i] = *(const f32x4*)(src + i * 256 + lane * 4);
      }
    }
#pragma unroll
    for (int u = 0; u < 4; ++u) {
      const int row = row0 + u * stride;
      if (row < nrows) {
        float* src = x + (size_t)row * D_;
#pragma unroll
        for (int i = 0; i < 4; ++i) ss[u] += v[u][i][0] * v[u][i][0] + v[u][i][1] * v[u][i][1] + v[u][i][2] * v[u][i][2] + v[u][i][3] * v[u][i][3];
        ss[u] = wave_sum(ss[u]);
        const float rs = rsqrtf(ss[u] / (float)D_ + EPS_);
#pragma unroll
        for (int i = 0; i < 4; ++i) {
          f32x4 gg = *(const f32x4*)(g + i * 256 + lane * 4);
          f32x4 o; o[0] = v[u][i][0] * rs * gg[0]; o[1] = v[u][i][1] * rs * gg[1]; o[2] = v[u][i][2] * rs * gg[2]; o[3] = v[u][i][3] * rs * gg[3];
          *(f32x4*)(src + i * 256 + lane * 4) = o;
        }
      }
    }
  }
}

DI void phase_kv(const Params& p, char* smem, int bid, int nblk) {
  const int tid_ = otid(), lane = tid_ & 63, w = tid_ >> 6, wm = w >> 1, wn = w & 1, r = lane & 31, h = lane >> 5;
  for (int t = bid; t < 2 * 32 * 8; t += nblk) {
    const int l = t >> 8, tt = t & 255, m0 = (tt >> 3) * 128, n0 = (tt & 7) * 128;
    f32x16 acc[2][2];
    zero_acc<2, 2>(acc);
    gemm_acc<128, 128>(p.memb + (size_t)m0 * D_, D_, 64, p.W + (size_t)l * LAYER_W + WKV_OFF + wtile(n0, D_), 64, 8192, D_, acc, smem);
    u16* dst = p.KV + (size_t)l * NBATCH * MEML * D_;
#pragma unroll
    for (int i = 0; i < 2; ++i)
#pragma unroll
      for (int e = 0; e < 16; ++e) {
        const int row = m0 + wm * 64 + 32 * i + crow(e, h);
        const float rs = p.memrs[row];
#pragma unroll
        for (int j = 0; j < 2; ++j) dst[(size_t)row * D_ + n0 + wn * 64 + 32 * j + r] = f2bf(acc[i][j][e] * rs);
      }
  }
}

DI void phase_inproj(const Params& p, int l, int Tg, char* smem, int bid, int nblk) {
  const pg8::Gemm g{p.h, p.W + (size_t)l * LAYER_W + WIN_OFF, Tg, 7168, D_};
  pg8::StaticOrder S; S.init(Tg, 7168, nblk, bid);
  const EpiP E{p.P};
  pg8::gemm_phase<EpiP, pg8::StaticOrder>((PG8_LAS unsigned char*)smem, g, S, E);
}

struct EpiG {
  static constexpr bool PERM = true, AFTER_DRAIN = false;
  unsigned char* G; const float* bias;
  DI void operator()(const f32x4 (&acc)[2][2][4][2], const pg8::Unit& u, int wr, int wc, int fr, int fq) const {
    int row0 = u.pm * 256 + wr * 64 + fr, col0 = u.pn * 256 + wc * 32 + 8 * fq;
    asm volatile("" : "+v"(row0), "+v"(col0));
    f32x4 bv[2][2];
#pragma unroll
    for (int bj = 0; bj < 2; ++bj)
#pragma unroll
      for (int n = 0; n < 2; ++n) bv[bj][n] = *(const f32x4*)(bias + col0 + bj * 128 + 4 * n);
#pragma unroll
    for (int ai = 0; ai < 2; ++ai)
#pragma unroll
      for (int m = 0; m < 4; ++m) {
        unsigned char* rowp = G + (size_t)(row0 + ai * 128 + m * 16) * (5 * D_) + col0;
#pragma unroll
        for (int bj = 0; bj < 2; ++bj) {
          const f32x4 v0 = acc[ai][bj][m][0] + bv[bj][0], v1 = acc[ai][bj][m][1] + bv[bj][1];
          u32x2 w;
          w.x = (unsigned)(sigmoidf_(v0[0]) * 255.f + 0.5f) | ((unsigned)(sigmoidf_(v0[1]) * 255.f + 0.5f) << 8) |
                ((unsigned)(sigmoidf_(v0[2]) * 255.f + 0.5f) << 16) | ((unsigned)(sigmoidf_(v0[3]) * 255.f + 0.5f) << 24);
          w.y = (unsigned)(sigmoidf_(v1[0]) * 255.f + 0.5f) | ((unsigned)(sigmoidf_(v1[1]) * 255.f + 0.5f) << 8) |
                ((unsigned)(sigmoidf_(v1[2]) * 255.f + 0.5f) << 16) | ((unsigned)(sigmoidf_(v1[3]) * 255.f + 0.5f) << 24);
          *(u32x2*)(rowp + bj * 128) = w;
        }
      }
  }
};

DI void phase_gates(const Params& p, int l, int Tg, unsigned char* G, char* smem, int bid, int nblk) {
  const pg8::Gemm g{p.h, p.W + (size_t)l * LAYER_W + WMG_OFF, Tg, 5 * D_, D_};
  pg8::StaticOrder S; S.init(Tg, 5 * D_, nblk, bid);
  const EpiG E{G, p.in[28] + (size_t)l * 5 * D_};
  pg8::gemm_phase<EpiG, pg8::StaticOrder>((PG8_LAS unsigned char*)smem, g, S, E);
}

struct EpiGLU {
  static constexpr bool PERM = true, AFTER_DRAIN = false;
  const u16* g; const u16* zs; u16* o3; const float* gb;
  DI void operator()(const f32x4 (&acc)[2][2][4][2], const pg8::Unit& u, int wr, int wc, int fr, int fq) const {
    int row0 = u.pm * 256 + wr * 64 + fr, col0 = u.pn * 256 + wc * 32 + 8 * fq;
    asm volatile("" : "+v"(row0), "+v"(col0));
    f32x4 bv[2][2];
#pragma unroll
    for (int bj = 0; bj < 2; ++bj)
#pragma unroll
      for (int n = 0; n < 2; ++n) bv[bj][n] = *(const f32x4*)(gb + col0 + bj * 128 + 4 * n);
#pragma unroll
    for (int ai = 0; ai < 2; ++ai)
#pragma unroll
      for (int m = 0; m < 4; ++m) {
        const size_t row = (size_t)(row0 + ai * 128 + m * 16);
#pragma unroll
        for (int bj = 0; bj < 2; ++bj) {
          const int col = col0 + bj * 128;
          const u32x4 gv = *(const u32x4*)(g + row * BWID + col);
          const u32x4 zv = *(const u32x4*)(zs + row * BWID + col);
          const f32x4 v0 = acc[ai][bj][m][0] + bv[bj][0], v1 = acc[ai][bj][m][1] + bv[bj][1];
          u32x4 w;
          w.x = pk2(bflo(gv.x) * sigmoidf_(v0[0]) * bflo(zv.x), bfhi(gv.x) * sigmoidf_(v0[1]) * bfhi(zv.x));
          w.y = pk2(bflo(gv.y) * sigmoidf_(v0[2]) * bflo(zv.y), bfhi(gv.y) * sigmoidf_(v0[3]) * bfhi(zv.y));
          w.z = pk2(bflo(gv.z) * sigmoidf_(v1[0]) * bflo(zv.z), bfhi(gv.z) * sigmoidf_(v1[1]) * bfhi(zv.z));
          w.w = pk2(bflo(gv.w) * sigmoidf_(v1[2]) * bflo(zv.w), bfhi(gv.w) * sigmoidf_(v1[3]) * bfhi(zv.w));
          *(u32x4*)(o3 + row * BWID + col) = w;
        }
        __builtin_amdgcn_sched_barrier(0);
      }
  }
};

DI void phase_glu(const Params& p, int l, int Tg, char* smem, int bid, int nblk) {
  const pg8::Gemm g{p.s5f, p.W + (size_t)l * LAYER_W + WGLU_OFF, Tg, BWID, BWID};
  pg8::StaticOrder S; S.init(Tg, BWID, nblk, bid);
  const EpiGLU E{p.s5f, p.syb, p.o3, p.in[24] + (size_t)l * BWID};
  pg8::gemm_phase<EpiGLU, pg8::StaticOrder>((PG8_LAS unsigned char*)smem, g, S, E);
}

struct BranchOrder {
  const u16* ob0; size_t ostride; const u16* wbr; int c, ntile, G;
  DI bool next(int i, pg8::Unit& u) const {
    const int t = c + (i / 5) * G;
    if (t >= ntile) return false;
    const int xcd = t & 7, j = t >> 3, per_xcd = ntile >> 5;
    u.pm = xcd * per_xcd + (j >> 2); u.pn = j & 3; u.br = i % 5; return true;
  }
  DI void a_ready(const pg8::Unit&) const {}
  DI void done(const pg8::Unit&) const {}
  DI const char* pa(const pg8::Unit& u, const pg8::Gemm& g) const { return (const char*)(ob0 + (size_t)u.br * ostride + (size_t)u.pm * 256 * BWID); }
  DI const char* pb(const pg8::Unit& u, const pg8::Gemm& g) const { return (const char*)(wbr + (size_t)u.br * D_ * BWID + (size_t)u.pn * 256 * BWID); }
};
struct EpiY {
  static constexpr bool PERM = true, AFTER_DRAIN = false;
  const unsigned char* G; u16* y;
  DI void operator()(const f32x4 (&acc)[2][2][4][2], const pg8::Unit& u, int wr, int wc, int fr, int fq) const {
    int row0 = u.pm * 256 + wr * 64 + fr, col0 = u.pn * 256 + wc * 32 + 8 * fq;
    asm volatile("" : "+v"(row0), "+v"(col0));
#pragma unroll
    for (int ai = 0; ai < 2; ++ai)
#pragma unroll
      for (int m = 0; m < 4; ++m) {
        const size_t row = (size_t)(row0 + ai * 128 + m * 16);
#pragma unroll
        for (int bj = 0; bj < 2; ++bj) {
          const int col = col0 + bj * 128;
          const u32x2 gq = *(const u32x2*)(G + row * (5 * D_) + u.br * D_ + col);
          const float ks_ = 1.f / 255.f;
          const float g0 = (float)(gq.x & 255u) * ks_, g1 = (float)((gq.x >> 8) & 255u) * ks_, g2 = (float)((gq.x >> 16) & 255u) * ks_, g3 = (float)(gq.x >> 24) * ks_;
          const float g4 = (float)(gq.y & 255u) * ks_, g5 = (float)((gq.y >> 8) & 255u) * ks_, g6 = (float)((gq.y >> 16) & 255u) * ks_, g7 = (float)(gq.y >> 24) * ks_;
          u32x4 yv = (u32x4){0u, 0u, 0u, 0u};
          if (u.br > 0) yv = *(const u32x4*)(y + row * D_ + col);
          const f32x4 v0 = acc[ai][bj][m][0], v1 = acc[ai][bj][m][1];
          u32x4 w;
          w.x = pk2(bflo(yv.x) + g0 * v0[0], bfhi(yv.x) + g1 * v0[1]);
          w.y = pk2(bflo(yv.y) + g2 * v0[2], bfhi(yv.y) + g3 * v0[3]);
          w.z = pk2(bflo(yv.z) + g4 * v1[0], bfhi(yv.z) + g5 * v1[1]);
          w.w = pk2(bflo(yv.w) + g6 * v1[2], bfhi(yv.w) + g7 * v1[3]);
          *(u32x4*)(y + row * D_ + col) = w;
        }
        __builtin_amdgcn_sched_barrier(0);
      }
  }
};

DI void phase_merge(const Params& p, int l, int Tg, const unsigned char* G, u16* ydst, char* smem, int bid, int nblk) {
  const pg8::Gemm g{nullptr, nullptr, Tg, D_, BWID};
  BranchOrder S;
  S.ob0 = p.o0; S.ostride = (size_t)Tg * BWID;
  S.wbr = p.W + (size_t)l * LAYER_W + WBR_OFF; S.c = bid; S.G = nblk; S.ntile = (Tg / 256) * 4;
  const EpiY E{G, ydst};
  pg8::gemm_phase<EpiY, BranchOrder>((PG8_LAS unsigned char*)smem, g, S, E);
}

DI void phase_out(const Params& p, int l, int Tg, const u16* ysrc, const float* xin,
                  float* xout, char* smem, int bid, int nblk) {
  const pg8::Gemm g{ysrc, p.W + (size_t)l * LAYER_W + WOUT_OFF, Tg, D_, D_};
  pg8::StaticOrder S; S.init(Tg, D_, nblk, bid);
  const EpiX E{xin, xout};
  pg8::gemm_phase<EpiX, pg8::StaticOrder>((PG8_LAS unsigned char*)smem, g, S, E);
}

DI void phase_conv(const Params& p, int l, int Tg, int bid, int nblk) {
  const float* cw = p.in[6] + (size_t)l * 5 * 1024;
  const float* cb = p.in[7] + (size_t)l * 1024;
  const int total = Tg * 128, stride = nblk * 256;
  for (int idx0 = bid * 256 + otid(); idx0 < total; idx0 += 2 * stride) {
    const int c0 = (idx0 & 127) * 8;
    u32x4 xin[2][5];
    bool ok[2][5];
#pragma unroll
    for (int u = 0; u < 2; ++u) {
      const int idx = idx0 + u * stride;
      const int tok = idx >> 7, spos = tok & (S_ - 1);
#pragma unroll
      for (int k = 0; k < 5; ++k) {
        const int sp = spos + k - 2;
        ok[u][k] = (idx < total) && sp >= 0 && sp < S_;
        xin[u][k] = (u32x4){0u, 0u, 0u, 0u};
        if (ok[u][k]) xin[u][k] = *(const u32x4*)(p.P + (size_t)(tok + k - 2) * PW + c0);
      }
    }
    float acc[2][8];
#pragma unroll
    for (int j = 0; j < 8; ++j) { acc[0][j] = cb[c0 + j]; acc[1][j] = acc[0][j]; }
#pragma unroll
    for (int k = 0; k < 5; ++k) {
      float wv[8], f0[8], f1[8];
#pragma unroll
      for (int j = 0; j < 8; ++j) wv[j] = cw[k * 1024 + c0 + j];
      unpack8(xin[0][k], f0);
      unpack8(xin[1][k], f1);
#pragma unroll
      for (int j = 0; j < 8; ++j) { acc[0][j] += f0[j] * wv[j]; acc[1][j] += f1[j] * wv[j]; }
    }
#pragma unroll
    for (int u = 0; u < 2; ++u) {
      const int idx = idx0 + u * stride;
      if (idx < total) {
        u32x4 o;
        o.x = pk2(siluf_(acc[u][0]), siluf_(acc[u][1])); o.y = pk2(siluf_(acc[u][2]), siluf_(acc[u][3]));
        o.z = pk2(siluf_(acc[u][4]), siluf_(acc[u][5])); o.w = pk2(siluf_(acc[u][6]), siluf_(acc[u][7]));
        *(u32x4*)(p.xa + (size_t)(idx >> 7) * 1024 + c0) = o;
      }
    }
  }
}

template <int DQK, int DV>
DI void attn_pass(const bf16x8 (&qf)[DQK / 16], const u16* __restrict__ Kg, int ldk, const u16* __restrict__ Vg, int ldv,
                  int kt0, int kt1, int q_pos, int q_lo, const float* lut, int window, float m_init, float l_init,
                  f32x16 (&o)[DV / 32], float& l_out, u16* sK, u16* sV) {
  constexpr int LDK = DQK + 8, LDV = DV + 16, NKC = DQK / 32, NVC = DV / 32;
  const int tid = otid(), lane = tid & 63, r = lane & 31, h = lane >> 5;
  u32x4 rk[NKC], rv[NVC];
#pragma unroll
  for (int d = 0; d < DV / 32; ++d)
#pragma unroll
    for (int e = 0; e < 16; ++e) o[d][e] = 0.f;
  float m = m_init, lsum = (h == 0) ? l_init : 0.f;
  {
#pragma unroll
    for (int i = 0; i < NKC; ++i) { const int c = tid + 256 * i, row = c / (DQK / 8), col = (c % (DQK / 8)) * 8; rk[i] = *(const u32x4*)(Kg + (size_t)(kt0 * 64 + row) * ldk + col); }
#pragma unroll
    for (int i = 0; i < NVC; ++i) { const int c = tid + 256 * i, row = c / (DV / 8), col = (c % (DV / 8)) * 8; rv[i] = *(const u32x4*)(Vg + (size_t)(kt0 * 64 + row) * ldv + col); }
  }
#pragma unroll 1
  for (int kt = kt0; kt < kt1; ++kt) {
    __syncthreads();
#pragma unroll
    for (int i = 0; i < NKC; ++i) { const int c = tid + 256 * i, row = c / (DQK / 8), col = (c % (DQK / 8)) * 8; *(u32x4*)(sK + row * LDK + col) = rk[i]; }
#pragma unroll
    for (int i = 0; i < NVC; ++i) { const int c = tid + 256 * i, row = c / (DV / 8), col = (c % (DV / 8)) * 8; *(u32x4*)(sV + row * LDV + col) = rv[i]; }
    __syncthreads();
    if (kt + 1 < kt1) {
#pragma unroll
      for (int i = 0; i < NKC; ++i) { const int c = tid + 256 * i, row = c / (DQK / 8), col = (c % (DQK / 8)) * 8; rk[i] = *(const u32x4*)(Kg + (size_t)((kt + 1) * 64 + row) * ldk + col); }
#pragma unroll
      for (int i = 0; i < NVC; ++i) { const int c = tid + 256 * i, row = c / (DV / 8), col = (c % (DV / 8)) * 8; rv[i] = *(const u32x4*)(Vg + (size_t)((kt + 1) * 64 + row) * ldv + col); }
    }
    f32x16 s[2];
#pragma unroll
    for (int t = 0; t < 2; ++t) {
      bf16x8 ka[DQK / 16];
#pragma unroll
      for (int ks = 0; ks < DQK / 16; ++ks) ka[ks] = ldfrag(sK, LDK, 32 * t + r, 16 * ks + 8 * h);
#pragma unroll
      for (int e = 0; e < 16; ++e) s[t][e] = 0.f;
#pragma unroll
      for (int ks = 0; ks < DQK / 16; ++ks) s[t] = MFMA32(ka[ks], qf[ks], s[t]);
    }
    const int kbase = kt * 64;
    if (lut) {
      const bool far_ = (window == 0) && ((kbase - (q_lo + 31) >= 91) || (q_lo - (kbase + 63) >= 91));
      if (far_) {
        const float bconst = lut[kbase - q_lo + 2047];
#pragma unroll
        for (int t = 0; t < 2; ++t)
#pragma unroll
          for (int e = 0; e < 16; ++e) s[t][e] += bconst;
      } else {
#pragma unroll
        for (int t = 0; t < 2; ++t)
#pragma unroll
          for (int e = 0; e < 16; ++e) {
            const int rel = kbase + 32 * t + crow(e, h) - q_pos;
            float v = s[t][e] + lut[rel + 2047];
            if (window > 0 && (rel > window || rel < -window)) v = -INFINITY;
            s[t][e] = v;
          }
      }
    }
    float mx = s[0][0];
#pragma unroll
    for (int t = 0; t < 2; ++t)
#pragma unroll
      for (int e = 0; e < 16; ++e) mx = fmaxf(mx, s[t][e]);
    mx = fmaxf(mx, __shfl_xor(mx, 32, 64));
    if (__builtin_amdgcn_ballot_w64(mx > m + 8.f) != 0ull) {
      const float mn = fmaxf(m, mx);
      const float alpha = __builtin_amdgcn_exp2f(m - mn);
      m = mn;
      lsum *= alpha;
#pragma unroll
      for (int d = 0; d < DV / 32; ++d)
#pragma unroll
        for (int e = 0; e < 16; ++e) o[d][e] *= alpha;
    }
    float ps = 0.f;
#pragma unroll
    for (int t = 0; t < 2; ++t)
#pragma unroll
      for (int e = 0; e < 16; ++e) { const float pv = __builtin_amdgcn_exp2f(s[t][e] - m); s[t][e] = pv; ps += pv; }
    lsum += ps;
    bf16x8 pf[2][2];
#pragma unroll
    for (int t = 0; t < 2; ++t)
#pragma unroll
      for (int s2 = 0; s2 < 2; ++s2) pf[t][s2] = pack8(s[t], s2);
#pragma unroll
    for (int d = 0; d < DV / 32; ++d) {
      bf16x8 va[2][2];
#pragma unroll
      for (int t = 0; t < 2; ++t)
#pragma unroll
        for (int s2 = 0; s2 < 2; ++s2) va[t][s2] = ldfrag_tr_perm(sV, LDV, 32 * t + 16 * s2, 32 * d, lane);
#pragma unroll
      for (int t = 0; t < 2; ++t)
#pragma unroll
        for (int s2 = 0; s2 < 2; ++s2) o[d] = MFMA32(va[t][s2], pf[t][s2], o[d]);
    }
  }
  lsum += __shfl_xor(lsum, 32, 64);
  l_out = lsum;
}

template <int DQK>
DI void load_qfrag(bf16x8 (&qf)[DQK / 16], const u16* qrow, float scale, int h) {
#pragma unroll
  for (int ks = 0; ks < DQK / 16; ++ks) {
    u32x4 v = *(const u32x4*)(qrow + 16 * ks + 8 * h);
    qf[ks] = __builtin_bit_cast(bf16x8, scale8(v, scale));
  }
}

DI void attn_lds(char* smem, u16*& sK, u16*& sV, float*& slut) {
  sK = (u16*)smem; sV = sK + 64 * 136; slut = (float*)(sV + 64 * 144);
}

DI void diff_item(const Params& p, int l, int item, char* smem) {
  const int tid = otid(), lane = tid & 63, w = tid >> 6, r = lane & 31, h = lane >> 5;
  const int bl = item >> 6, hd = (item >> 4) & 3, qb = item & 15;
  u16 *sK, *sV; float* slut;
  attn_lds(smem, sK, sV, slut);
  __syncthreads();
  for (int i = tid; i < 4095; i += 256) slut[i] = p.lut[hd * LUTS + i] * 1.4426950408889634f;
  const float lam_init = 0.8f - 0.6f * expf(-0.3f * (float)l);
  const float* lp = p.in[12] + (size_t)l * 4 * 64;
  const float d1 = wave_sum(lp[lane] * lp[64 + lane]), d2 = wave_sum(lp[128 + lane] * lp[192 + lane]);
  const float lam = expf(d1) - expf(d2) + lam_init;
  const int q_lo = qb * 128 + 32 * w, q_pos = q_lo + r;
  const size_t tokq = (size_t)bl * S_ + q_pos;
  const u16* Pb = p.P + (size_t)bl * S_ * PW;
  f32x16 o[4];
  float lt;
  u16* odst = p.o1 + tokq * BWID + hd * 128;
  {
    bf16x8 qf[4];
    load_qfrag<64>(qf, p.P + tokq * PW + P_DQ + (hd * 2 + 0) * 64, 0.125f * 1.4426950408889634f, h);
    attn_pass<64, 128>(qf, Pb + P_DK + (hd * 2 + 0) * 64, PW, Pb + P_DV + hd * 128, PW, 0, 32, q_pos, q_lo, slut, 0, -INFINITY, 0.f, o, lt, sK, sV);
    const float inv = 1.f / lt;
#pragma unroll
    for (int d = 0; d < 4; ++d)
#pragma unroll
      for (int g4 = 0; g4 < 4; ++g4) {
        u32x2 ov;
        ov.x = pk2(o[d][4 * g4 + 0] * inv, o[d][4 * g4 + 1] * inv);
        ov.y = pk2(o[d][4 * g4 + 2] * inv, o[d][4 * g4 + 3] * inv);
        *(u32x2*)(odst + 32 * d + 8 * g4 + 4 * h) = ov;
      }
  }
  {
    bf16x8 qf[4];
    load_qfrag<64>(qf, p.P + tokq * PW + P_DQ + (hd * 2 + 1) * 64, 0.125f * 1.4426950408889634f, h);
    attn_pass<64, 128>(qf, Pb + P_DK + (hd * 2 + 1) * 64, PW, Pb + P_DV + hd * 128, PW, 0, 32, q_pos, q_lo, slut, 0, -INFINITY, 0.f, o, lt, sK, sV);
    const float inv = lam / lt;
#pragma unroll
    for (int d = 0; d < 4; ++d)
#pragma unroll
      for (int g4 = 0; g4 < 4; ++g4) {
        const u32x2 pv = *(const u32x2*)(odst + 32 * d + 8 * g4 + 4 * h);
        o[d][4 * g4 + 0] = bflo(pv.x) - o[d][4 * g4 + 0] * inv;
        o[d][4 * g4 + 1] = bfhi(pv.x) - o[d][4 * g4 + 1] * inv;
        o[d][4 * g4 + 2] = bflo(pv.y) - o[d][4 * g4 + 2] * inv;
        o[d][4 * g4 + 3] = bfhi(pv.y) - o[d][4 * g4 + 3] * inv;
      }
  }
  float ss = 0.f;
#pragma unroll
  for (int d = 0; d < 4; ++d)
#pragma unroll
    for (int e = 0; e < 16; ++e) ss += o[d][e] * o[d][e];
  ss += __shfl_xor(ss, 32, 64);
  const float rs = rsqrtf(ss / 128.f + EPS_) * (1.f - lam_init);
  const float* sg = p.in[13] + (size_t)l * 128;
#pragma unroll
  for (int d = 0; d < 4; ++d)
#pragma unroll
    for (int g4 = 0; g4 < 4; ++g4) {
      const int dv = 32 * d + 8 * g4 + 4 * h;
      const u32x2 zz = *(const u32x2*)(p.P + tokq * PW + P_DZ + hd * 128 + dv);
      const float z0 = bflo(zz.x), z1 = bfhi(zz.x), z2 = bflo(zz.y), z3 = bfhi(zz.y);
      u32x2 ov;
      ov.x = pk2(o[d][4 * g4 + 0] * rs * sg[dv + 0] * siluf_(z0), o[d][4 * g4 + 1] * rs * sg[dv + 1] * siluf_(z1));
      ov.y = pk2(o[d][4 * g4 + 2] * rs * sg[dv + 2] * siluf_(z2), o[d][4 * g4 + 3] * rs * sg[dv + 3] * siluf_(z3));
      *(u32x2*)(odst + dv) = ov;
    }
}

DI void win_item(const Params& p, int l, int item, char* smem) {
  const int tid = otid(), lane = tid & 63, w = tid >> 6, r = lane & 31, h = lane >> 5;
  const int bl = item >> 7, qh = (item >> 4) & 7, qb = item & 15;
  const int kvh = qh >> 2;
  u16 *sK, *sV; float* slut;
  attn_lds(smem, sK, sV, slut);
  __syncthreads();
  for (int i = tid; i < 4095; i += 256) slut[i] = p.lut[(4 + qh) * LUTS + i] * 1.4426950408889634f;
  const float sink = p.in[14][l * 8 + qh];
  const int q_lo = qb * 128 + 32 * w, q_pos = q_lo + r;
  const size_t tokq = (size_t)bl * S_ + q_pos;
  const u16* Pb = p.P + (size_t)bl * S_ * PW;
  int kt0 = qb * 2 - 2; if (kt0 < 0) kt0 = 0;
  int kt1 = qb * 2 + 4; if (kt1 > 32) kt1 = 32;
  f32x16 o[2];
  float lt;
  bf16x8 qf[4];
  load_qfrag<64>(qf, p.P + tokq * PW + P_CQ + qh * 64, 0.125f * 1.4426950408889634f, h);
  attn_pass<64, 64>(qf, Pb + P_CK + kvh * 64, PW, Pb + P_CV + kvh * 64, PW, kt0, kt1, q_pos, q_lo, slut, 128, sink * 1.4426950408889634f, 1.f, o, lt, sK, sV);
  const float inv = 1.f / lt;
#pragma unroll
  for (int d = 0; d < 2; ++d)
#pragma unroll
    for (int g4 = 0; g4 < 4; ++g4) {
      const int dv = 32 * d + 8 * g4 + 4 * h;
      const u32x2 zz = *(const u32x2*)(p.P + tokq * PW + P_CZ + qh * 64 + dv);
      const float z0 = bflo(zz.x), z1 = bfhi(zz.x), z2 = bflo(zz.y), z3 = bfhi(zz.y);
      u32x2 ov;
      ov.x = pk2(o[d][4 * g4 + 0] * inv * siluf_(z0), o[d][4 * g4 + 1] * inv * siluf_(z1));
      ov.y = pk2(o[d][4 * g4 + 2] * inv * siluf_(z2), o[d][4 * g4 + 3] * inv * siluf_(z3));
      *(u32x2*)(p.o2 + tokq * BWID + qh * 64 + dv) = ov;
    }
}

DI void mem_item(const Params& p, int l, int grp, int item, char* smem) {
  const int tid = otid(), lane = tid & 63, w = tid >> 6, r = lane & 31, h = lane >> 5;
  const int bl = item >> 6, hd = (item >> 4) & 3, qb = item & 15;
  u16 *sK, *sV; float* slut;
  attn_lds(smem, sK, sV, slut);
  const int q_lo = qb * 128 + 32 * w, q_pos = q_lo + r;
  const size_t tokq = (size_t)bl * S_ + q_pos;
  const int bg = grp * p.BG + bl;
  const u16* kv = p.KV + ((size_t)l * NBATCH + bg) * MEML * D_;
  f32x16 o[4];
  float lt;
  bf16x8 qf[8];
  load_qfrag<128>(qf, p.P + tokq * PW + P_MQ + hd * 128, 0.08838834764831845f * 1.4426950408889634f, h);
  attn_pass<128, 128>(qf, kv + hd * 128, D_, kv + 512 + hd * 128, D_, 0, 4, q_pos, q_lo, nullptr, 0, -INFINITY, 0.f, o, lt, sK, sV);
  const float inv = 1.f / lt;
#pragma unroll
  for (int d = 0; d < 4; ++d)
#pragma unroll
    for (int g4 = 0; g4 < 4; ++g4) {
      const int dv = 32 * d + 8 * g4 + 4 * h;
      const u32x2 zz = *(const u32x2*)(p.P + tokq * PW + P_MZ + hd * 128 + dv);
      const float z0 = bflo(zz.x), z1 = bfhi(zz.x), z2 = bflo(zz.y), z3 = bfhi(zz.y);
      u32x2 ov;
      ov.x = pk2(o[d][4 * g4 + 0] * inv * siluf_(z0), o[d][4 * g4 + 1] * inv * siluf_(z1));
      ov.y = pk2(o[d][4 * g4 + 2] * inv * siluf_(z2), o[d][4 * g4 + 3] * inv * siluf_(z3));
      *(u32x2*)(p.o4 + tokq * BWID + hd * 128 + dv) = ov;
    }
}

DI void ssd_item(const Params& p, int l, int item, char* smem) {
  const int tid = otid(), lane = tid & 63, w = tid >> 6, r = lane & 31, h = lane >> 5;
  const int bl = item >> 4, hd = (item >> 1) & 7, dir = item & 1;
  const int gq = hd >> 2, lt = w & 1, ph = w >> 1;
  u16* sB = (u16*)smem;
  u16* sC = sB + 64 * 136;
  u16* sX1 = sC + 64 * 136;
  u16* sX2 = sX1 + 64 * 80;
  u16* sS = sX2 + 64 * 80;
  float* sW = (float*)(sS + 64 * 136);
  float* sDt = sW + 64;
  const float Aneg = -expf(p.in[9][(l * 2 + dir) * 8 + hd]);
  const float dtb = p.in[8][(l * 2 + dir) * 8 + hd];
  u16* ydst = dir ? p.syb : p.o0;
  const u16* Pb = p.P + (size_t)bl * S_ * PW;
  const u16* xab = p.xa + (size_t)bl * S_ * 1024;
  __syncthreads();
  for (int i = tid; i < 64 * 136 / 2; i += 256) ((unsigned*)sS)[i] = 0u;
  f32x16 accS[2];
#pragma unroll
  for (int i = 0; i < 2; ++i)
#pragma unroll
    for (int e = 0; e < 16; ++e) accS[i][e] = 0.f;
  u32x4 rB[4], rC[4], rX[2];
  float rdt = 0.f;
  auto prefetch = [&](int cc) {
    if (tid < 64) {
      const int pp = 64 * cc + tid, tok = dir ? (S_ - 1 - pp) : pp;
      rdt = bf2f(Pb[(size_t)tok * PW + P_DT + dir * 8 + hd]);
    }
#pragma unroll
    for (int i = 0; i < 4; ++i) {
      const int c = tid + 256 * i, row = c >> 4, col = (c & 15) * 8;
      const int pp = 64 * cc + row, tok = dir ? (S_ - 1 - pp) : pp;
      rB[i] = *(const u32x4*)(xab + (size_t)tok * 1024 + 512 + gq * 128 + col);
      rC[i] = *(const u32x4*)(xab + (size_t)tok * 1024 + 768 + gq * 128 + col);
    }
#pragma unroll
    for (int i = 0; i < 2; ++i) {
      const int c = tid + 256 * i, row = c >> 3, col = (c & 7) * 8;
      const int pp = 64 * cc + row, tok = dir ? (S_ - 1 - pp) : pp;
      rX[i] = *(const u32x4*)(xab + (size_t)tok * 1024 + hd * 64 + col);
    }
  };
  prefetch(0);
#pragma unroll 1
  for (int cc = 0; cc < 32; ++cc) {
    __syncthreads();
    if (tid < 64) {
      const float x = rdt + dtb;
      const float dt = x > 20.f ? x : log1pf(expf(x));
      float a = dt * Aneg;
#pragma unroll
      for (int o = 1; o < 64; o <<= 1) { const float t = __shfl_up(a, o, 64); if (lane >= o) a += t; }
      sW[tid] = a;
      sDt[tid] = dt;
    }
#pragma unroll
    for (int i = 0; i < 4; ++i) {
      const int c = tid + 256 * i, row = c >> 4, col = (c & 15) * 8;
      *(u32x4*)(sB + row * 136 + col) = rB[i];
      *(u32x4*)(sC + row * 136 + col) = rC[i];
    }
    __syncthreads();
    const float wlast = sW[63];
#pragma unroll
    for (int i = 0; i < 2; ++i) {
      const int c = tid + 256 * i, row = c >> 3, col = (c & 7) * 8;
      const float f1 = sDt[row], f2 = f1 * __expf(wlast - sW[row]);
      *(u32x4*)(sX1 + row * 80 + col) = scale8(rX[i], f1);
      *(u32x4*)(sX2 + row * 80 + col) = scale8(rX[i], f2);
    }
    __syncthreads();
    if (cc + 1 < 32) prefetch(cc + 1);
    f32x16 ay;
#pragma unroll
    for (int e = 0; e < 16; ++e) ay[e] = 0.f;
#pragma unroll
    for (int ks = 0; ks < 8; ++ks) {
      bf16x8 a = ldfrag(sS, 136, 32 * ph + r, 16 * ks + 8 * h);
      bf16x8 b = ldfrag(sC, 136, 32 * lt + r, 16 * ks + 8 * h);
      ay = MFMA32(a, b, ay);
    }
    const float wl = sW[32 * lt + r];
    {
      const float ewl = __expf(wl);
#pragma unroll
      for (int e = 0; e < 16; ++e) ay[e] *= ewl;
    }
    for (int st = 0; st <= lt; ++st) {
      f32x16 g;
#pragma unroll
      for (int e = 0; e < 16; ++e) g[e] = 0.f;
#pragma unroll
      for (int ks = 0; ks < 8; ++ks) {
        bf16x8 a = ldfrag(sB, 136, 32 * st + r, 16 * ks + 8 * h);
        bf16x8 b = ldfrag(sC, 136, 32 * lt + r, 16 * ks + 8 * h);
        g = MFMA32(a, b, g);
      }
#pragma unroll
      for (int e = 0; e < 16; ++e) {
        const int sidx = 32 * st + crow(e, h);
        const float f = (sidx <= 32 * lt + r) ? __expf(wl - sW[sidx]) : 0.f;
        g[e] *= f;
      }
#pragma unroll
      for (int s2 = 0; s2 < 2; ++s2) {
        bf16x8 pfr = pack8(g, s2);
        bf16x8 a = ldfrag_tr_perm(sX1, 80, 32 * st + 16 * s2, 32 * ph, lane);
        ay = MFMA32(a, pfr, ay);
      }
    }
    {
      const int pp = 64 * cc + 32 * lt + r, tok = dir ? (S_ - 1 - pp) : pp;
      u16* yd = ydst + ((size_t)bl * S_ + tok) * BWID + hd * 64 + 32 * ph + 4 * h;
#pragma unroll
      for (int g4 = 0; g4 < 4; ++g4) {
        u32x2 ov; ov.x = pk2(ay[4 * g4 + 0], ay[4 * g4 + 1]); ov.y = pk2(ay[4 * g4 + 2], ay[4 * g4 + 3]);
        *(u32x2*)(yd + 8 * g4) = ov;
      }
    }
    {
      const float ew = __expf(wlast);
#pragma unroll
      for (int pt = 0; pt < 2; ++pt)
#pragma unroll
        for (int e = 0; e < 16; ++e) accS[pt][e] *= ew;
#pragma unroll
      for (int ks = 0; ks < 4; ++ks) {
        bf16x8 b = ldfrag_tr_nat(sB, 136, 16 * ks, 32 * w, lane);
#pragma unroll
        for (int pt = 0; pt < 2; ++pt) {
          bf16x8 a = ldfrag_tr_nat(sX2, 80, 16 * ks, 32 * pt, lane);
          accS[pt] = MFMA32(a, b, accS[pt]);
        }
      }
    }
    __syncthreads();
#pragma unroll
    for (int pt = 0; pt < 2; ++pt)
#pragma unroll
      for (int e = 0; e < 16; ++e) sS[(32 * pt + crow(e, h)) * 136 + 32 * w + r] = f2bf(accS[pt][e]);
  }
}

DI void s5_item(const Params& p, int l, int item, char* smem) {
  const int tid = otid(), lane = tid & 63, w = tid >> 6;
  const int wi = item * 4 + w;
  const int bl = wi >> 6, g = (wi >> 1) & 31, dir = wi & 1;
  float* sBu = (float*)(smem + w * 12800);
  u16* sX = (u16*)(smem + w * 12800 + 8448);
  const int c16 = lane & 15, kg = lane >> 4;
  const float* lre = p.in[15] + ((size_t)(l * 2 + dir) * 32 + g) * 64;
  const float* lim = p.in[16] + ((size_t)(l * 2 + dir) * 32 + g) * 64;
  const float dt = expf(p.in[17][(l * 2 + dir) * 32 + g]);
  const float* bre = p.in[18] + ((size_t)l * 32 + g) * 64 * 16;
  const float* bim = p.in[19] + ((size_t)l * 32 + g) * 64 * 16;
  const float* cre = p.in[20] + (((size_t)(l * 2 + dir) * 32 + g) * 16) * 64;
  const float* cim = p.in[21] + (((size_t)(l * 2 + dir) * 32 + g) * 16) * 64;
  float ar, ai;
  {
    const float lr = lre[lane], li = lim[lane];
    const float mag = expf(lr * dt);
    ar = mag * cosf(li * dt); ai = mag * sinf(li * dt);
  }
  bf16x8 bfr[8];
#pragma unroll
  for (int ct = 0; ct < 4; ++ct) {
    const int st = 16 * ct + c16;
    const float lr = lre[st], li = lim[st];
    const float mag = expf(lr * dt);
    const float a_r = mag * cosf(li * dt), a_i = mag * sinf(li * dt);
    const float den = lr * lr + li * li;
    const float fr = ((a_r - 1.f) * lr + a_i * li) / den, fi = (a_i * lr - (a_r - 1.f) * li) / den;
    float vr[8], vi[8];
#pragma unroll
    for (int j = 0; j < 8; ++j) {
      float br_ = 0.f, bi_ = 0.f;
      if (kg < 2) { br_ = bre[st * 16 + 8 * kg + j]; bi_ = bim[st * 16 + 8 * kg + j]; }
      vr[j] = fr * br_ - fi * bi_;
      vi[j] = fr * bi_ + fi * br_;
    }
    u32x4 ur, ui;
    ur.x = pk2(vr[0], vr[1]); ur.y = pk2(vr[2], vr[3]); ur.z = pk2(vr[4], vr[5]); ur.w = pk2(vr[6], vr[7]);
    ui.x = pk2(vi[0], vi[1]); ui.y = pk2(vi[2], vi[3]); ui.z = pk2(vi[4], vi[5]); ui.w = pk2(vi[6], vi[7]);
    bfr[ct] = __builtin_bit_cast(bf16x8, ur);
    bfr[4 + ct] = __builtin_bit_cast(bf16x8, ui);
  }
  bf16x8 cfr[4];
#pragma unroll
  for (int ks = 0; ks < 4; ++ks) {
    const float* src = (ks < 2) ? (cre + c16 * 64 + 32 * ks + 8 * kg) : (cim + c16 * 64 + 32 * (ks - 2) + 8 * kg);
    const float sg = (ks < 2) ? 1.f : -1.f;
    u32x4 u;
    u.x = pk2(sg * src[0], sg * src[1]); u.y = pk2(sg * src[2], sg * src[3]);
    u.z = pk2(sg * src[4], sg * src[5]); u.w = pk2(sg * src[6], sg * src[7]);
    cfr[ks] = __builtin_bit_cast(bf16x8, u);
  }
  u16* ydst = dir ? p.o3 : p.s5f;
  const u16* Pb = p.P + (size_t)bl * S_ * PW + P_UIN + g * 16;
  float xr = 0.f, xi = 0.f;
  u32x4 ring[8];
#pragma unroll
  for (int j = 0; j < 8; ++j) {
    ring[j] = (u32x4){0u, 0u, 0u, 0u};
    const int pp = 16 * j + c16, tok = dir ? (S_ - 1 - pp) : pp;
    if (kg < 2) ring[j] = *(const u32x4*)(Pb + (size_t)tok * PW + 8 * kg);
  }
#pragma unroll 1
  for (int cc0 = 0; cc0 < S_ / 16; cc0 += 8)
#pragma unroll
  for (int j8 = 0; j8 < 8; ++j8) {
    const int cc = cc0 + j8;
    const bf16x8 ua = __builtin_bit_cast(bf16x8, ring[j8]);
    if (cc + 8 < S_ / 16) {
      const int pp = 16 * (cc + 8) + c16, tok = dir ? (S_ - 1 - pp) : pp;
      if (kg < 2) ring[j8] = *(const u32x4*)(Pb + (size_t)tok * PW + 8 * kg);
    }
    wave_lds_sync();
#pragma unroll
    for (int ct = 0; ct < 8; ++ct) {
      f32x4 d = {0.f, 0.f, 0.f, 0.f};
      d = MFMA16(ua, bfr[ct], d);
#pragma unroll
      for (int e = 0; e < 4; ++e) sBu[(4 * kg + e) * 132 + 16 * ct + c16] = d[e];
    }
    wave_lds_sync();
#pragma unroll
    for (int t = 0; t < 16; ++t) {
      const float bur = sBu[t * 132 + lane], bui = sBu[t * 132 + 64 + lane];
      const float nr = ar * xr - ai * xi + bur;
      const float ni = ar * xi + ai * xr + bui;
      xr = nr; xi = ni;
      sX[t * 136 + lane] = f2bf(xr);
      sX[t * 136 + 64 + lane] = f2bf(xi);
    }
    wave_lds_sync();
    f32x4 y = {0.f, 0.f, 0.f, 0.f};
#pragma unroll
    for (int ks = 0; ks < 4; ++ks) {
      bf16x8 a = ldfrag(sX, 136, c16, 32 * ks + 8 * kg);
      y = MFMA16(a, cfr[ks], y);
    }
#pragma unroll
    for (int e = 0; e < 4; ++e) {
      const int pp = 16 * cc + 4 * kg + e, tok = dir ? (S_ - 1 - pp) : pp;
      ydst[((size_t)bl * S_ + tok) * BWID + g * 16 + c16] = f2bf(y[e]);
    }
  }
}

DI void phase_finalize(const Params& p, int l, int Tg, int bid, int nblk) {
  const int tid_ = otid(), lane = tid_ & 63, w = tid_ >> 6;
  const float* dsk = p.in[10] + l * 8;
  const float* ng = p.in[11] + (size_t)l * BWID;
  const float* s5d = p.in[22] + (size_t)l * BWID;
  const int c0 = lane * 8, stride = nblk * 4;
  for (int tok0 = bid * 4 + w; tok0 < Tg; tok0 += 2 * stride) {
    u32x4 r_yf[2], r_yb[2], r_xs[2], r_z[2], r_sf[2], r_sb[2], r_u[2], r_uz[2];
#pragma unroll
    for (int u = 0; u < 2; ++u) {
      const int tok = tok0 + u * stride;
      if (tok < Tg) {
        r_yf[u] = *(const u32x4*)(p.o0 + (size_t)tok * BWID + c0);
        r_yb[u] = *(const u32x4*)(p.syb + (size_t)tok * BWID + c0);
        r_xs[u] = *(const u32x4*)(p.xa + (size_t)tok * 1024 + c0);
        r_z[u] = *(const u32x4*)(p.P + (size_t)tok * PW + P_SZ + c0);
        r_sf[u] = *(const u32x4*)(p.s5f + (size_t)tok * BWID + c0);
        r_sb[u] = *(const u32x4*)(p.o3 + (size_t)tok * BWID + c0);
        r_u[u] = *(const u32x4*)(p.P + (size_t)tok * PW + P_UIN + c0);
        r_uz[u] = *(const u32x4*)(p.P + (size_t)tok * PW + P_UZ + c0);
      }
    }
#pragma unroll
    for (int u = 0; u < 2; ++u) {
      const int tok = tok0 + u * stride;
      if (tok < Tg) {
        float yf[8], yb[8], xs[8], z[8];
        unpack8(r_yf[u], yf); unpack8(r_yb[u], yb); unpack8(r_xs[u], xs); unpack8(r_z[u], z);
        const float dk = dsk[c0 >> 6];
        float v[8], ss = 0.f;
#pragma unroll
        for (int j = 0; j < 8; ++j) { v[j] = (yf[j] + yb[j] + dk * xs[j]) * siluf_(z[j]); ss += v[j] * v[j]; }
        ss = wave_sum(ss);
        const float rs = rsqrtf(ss / (float)BWID + EPS_);
        u32x4 o;
        o.x = pk2(v[0] * rs * ng[c0 + 0], v[1] * rs * ng[c0 + 1]); o.y = pk2(v[2] * rs * ng[c0 + 2], v[3] * rs * ng[c0 + 3]);
        o.z = pk2(v[4] * rs * ng[c0 + 4], v[5] * rs * ng[c0 + 5]); o.w = pk2(v[6] * rs * ng[c0 + 6], v[7] * rs * ng[c0 + 7]);
        *(u32x4*)(p.o0 + (size_t)tok * BWID + c0) = o;
        float sf[8], sb[8], uu[8], gq[8], uz[8];
        unpack8(r_sf[u], sf); unpack8(r_sb[u], sb); unpack8(r_u[u], uu); unpack8(r_uz[u], uz);
#pragma unroll
        for (int j = 0; j < 8; ++j) {
          const float y = sf[j] + sb[j] + s5d[c0 + j] * uu[j];
          const float t = tanhf(0.7978845608028654f * (y + 0.044715f * y * y * y));
          gq[j] = 0.5f * y * (1.f + t);
        }
        u32x4 o2;
        o2.x = pk2(gq[0], gq[1]); o2.y = pk2(gq[2], gq[3]); o2.z = pk2(gq[4], gq[5]); o2.w = pk2(gq[6], gq[7]);
        *(u32x4*)(p.s5f + (size_t)tok * BWID + c0) = o2;
        u32x4 o3v;
        o3v.x = pk2(siluf_(uz[0]), siluf_(uz[1])); o3v.y = pk2(siluf_(uz[2]), siluf_(uz[3]));
        o3v.z = pk2(siluf_(uz[4]), siluf_(uz[5])); o3v.w = pk2(siluf_(uz[6]), siluf_(uz[7]));
        *(u32x4*)(p.syb + (size_t)tok * BWID + c0) = o3v;
      }
    }
  }
}

DI void phase_mixers(const Params& p, int l, int grp, int* ctr, char* smem, volatile int* s_itemp, int half) {
  const int BG = p.BG;
  const int n_ssd = BG * 8, n_s5 = BG * 8, n_diff = BG * 32, n_mem = BG * 32, n_win = BG * 64;
  const int total = n_ssd + n_s5 + n_diff + n_mem + n_win;
  for (;;) {
    __syncthreads();
    if (threadIdx.x == 0) *s_itemp = atomicAdd(ctr, 1);
    __syncthreads();
    int it = __builtin_amdgcn_readfirstlane(*s_itemp);
    if (it >= total) break;
    if (it < n_ssd) { if (MX & 1) ssd_item(p, l, it * 2 + half, smem); continue; }
    it -= n_ssd;
    if (it < n_s5) { if (MX & 2) s5_item(p, l, it * 2 + half, smem); continue; }
    it -= n_s5;
    if (it < n_diff) { if (MX & 4) diff_item(p, l, it * 2 + half, smem); continue; }
    it -= n_diff;
    if (it < n_mem) { if (MX & 8) mem_item(p, l, grp, it * 2 + half, smem); continue; }
    it -= n_mem;
    if (MX & 16) win_item(p, l, ((it >> 4) * 2 + half) * 16 + (it & 15), smem);
  }
}

__global__ void __launch_bounds__(512, 2) fwd_megakernel(Params p) {
  extern __shared__ __attribute__((aligned(16))) char smem[];
  __shared__ __attribute__((aligned(16))) unsigned s_misc[8];
  cg::grid_group grid = cg::this_grid();
  const int bid = blockIdx.x, nblk = gridDim.x;
  const int half = __builtin_amdgcn_readfirstlane((int)(threadIdx.x >> 8));
  const int vbid = bid * 2 + half, vnblk = nblk * 2;
  char* smem_h = smem + half * HALF_SMEM;
  const int BG = p.BG, Tg = BG * S_, ngrp = NBATCH / BG;
  if (threadIdx.x < 8) s_misc[threadIdx.x] = 0u;
  __syncthreads();
  XcdBarrier xb = xcd_barrier_post(p.bar, (volatile LAS unsigned*)s_misc);
  if (PH & 1) phase_prologue(p, smem_h, vbid, vnblk);
  if (p.BG < 0) grid.sync();
  xcd_barrier(xb);
  if (PH & 2) phase_kv(p, smem_h, vbid, vnblk);
  for (int grp = 0; grp < ngrp; ++grp) {
    const size_t rowoff = (size_t)grp * Tg * D_;
    for (int l = 0; l < 2; ++l) {
      const float* xin = (l == 0 ? p.in[0] : (const float*)p.out) + rowoff;
      if (PH & 4) phase_norm(xin, p.in[4] + (size_t)l * D_, p.h, Tg, vbid, vnblk);
      xcd_barrier(xb);
      if (PH & 8) phase_inproj(p, l, Tg, smem, bid, nblk);
      xcd_barrier(xb);
      if (PH & 16) phase_conv(p, l, Tg, vbid, vnblk);
      xcd_barrier(xb);
      if (PH & 32) phase_mixers(p, l, grp, p.ctr + grp * 2 + l, smem_h, (volatile int*)&s_misc[4], half);
      xcd_barrier(xb);
      if (PH & 64) phase_finalize(p, l, Tg, vbid, vnblk);
      xcd_barrier(xb);
      unsigned char* Gbuf = (unsigned char*)(p.P + (size_t)Tg * D_);
      phase_gates(p, l, Tg, Gbuf, smem, bid, nblk);
      if (PH & 128) phase_glu(p, l, Tg, smem, bid, nblk);
      xcd_barrier(xb);
      if (PH & 256) phase_merge(p, l, Tg, Gbuf, p.P, smem, bid, nblk);
      xcd_barrier(xb);
      if (PH & 512) phase_out(p, l, Tg, p.P, xin, p.out + rowoff, smem, bid, nblk);
      xcd_barrier(xb);
    }
  }
  if (PH & 1024) phase_final(p.out, p.in[3], NBATCH * S_, vbid, vnblk);
}

extern "C" void kernel_launch(void* const* d_in, const int* in_sizes, int n_in, void* d_out, int out_size, void* d_ws,
                              size_t ws_size, hipStream_t stream) {
  static int grid_blocks = 0;
  if (!grid_blocks) {
    int dev = 0, cus = 0, per_cu = 0;
    hipGetDevice(&dev);
    hipDeviceGetAttribute(&cus, hipDeviceAttributeMultiprocessorCount, dev);
    hipFuncSetAttribute((const void*)fwd_megakernel, hipFuncAttributeMaxDynamicSharedMemorySize, SMEM_BYTES);
    hipOccupancyMaxActiveBlocksPerMultiprocessor(&per_cu, fwd_megakernel, 512, SMEM_BYTES);
    if (per_cu > 1) per_cu = 1;
    if (per_cu < 1) per_cu = 1;
    grid_blocks = cus * per_cu;
  }
  Params p{};
  for (int i = 0; i < 31; ++i) p.in[i] = (const float*)d_in[i];
  p.out = (float*)d_out;
  char* ws = (char*)d_ws;
  size_t off = 0;
  auto take = [&](size_t bytes) { char* r = ws + off; off += (bytes + 255) & ~(size_t)255; return r; };
  p.W = (u16*)take(2 * LAYER_W * 2);
  p.KV = (u16*)take((size_t)2 * NBATCH * MEML * D_ * 2);
  p.memb = (u16*)take((size_t)NBATCH * MEML * D_ * 2);
  p.memrs = (float*)take(NBATCH * MEML * 4);
  p.lut = (float*)take(12 * LUTS * 4);
  p.ctr = (int*)take(4096);
  p.bar = (unsigned*)take(XCD_BAR_WORDS * 4);
  const size_t fixed = off;
  int BG = 8;
  auto need = [&](int bg) { size_t tg = (size_t)bg * S_; return fixed + tg * (D_ * 2 + (size_t)PW * 2 + 1024 * 2 + 7 * BWID * 2) + 16 * 256; };
  while (BG > 1 && need(BG) > ws_size) BG >>= 1;
  const size_t Tg = (size_t)BG * S_;
  p.h = (u16*)take(Tg * D_ * 2);
  p.P = (u16*)take(Tg * PW * 2);
  p.xa = (u16*)take(Tg * 1024 * 2);
  p.o0 = (u16*)take(Tg * BWID * 2);
  p.o1 = (u16*)take(Tg * BWID * 2);
  p.o2 = (u16*)take(Tg * BWID * 2);
  p.o3 = (u16*)take(Tg * BWID * 2);
  p.o4 = (u16*)take(Tg * BWID * 2);
  p.syb = (u16*)take(Tg * BWID * 2);
  p.s5f = (u16*)take(Tg * BWID * 2);
  p.BG = BG;
  p.pad = 0;
  hipMemsetAsync(p.ctr, 0, 4096 + ((XCD_BAR_WORDS * 4 + 255) & ~255), stream);
  void* args[] = {&p};
  hipError_t e = hipLaunchCooperativeKernel((const void*)fwd_megakernel, dim3(grid_blocks), dim3(512), args, SMEM_BYTES, stream);
  if (e != hipSuccess) fprintf(stderr, "cooperative launch failed: %s (grid %d)\n", hipGetErrorString(e), grid_blocks);
}
```

```cpp
#include <hip/hip_runtime.h>
#include <hip/hip_cooperative_groups.h>
#include <cstdio>
namespace cg = cooperative_groups;

#define DI __device__ __forceinline__
typedef unsigned short u16;
typedef __attribute__((ext_vector_type(8))) short bf16x8;
typedef __attribute__((ext_vector_type(4))) short s16x4;
typedef __attribute__((ext_vector_type(16))) float f32x16;
typedef __attribute__((ext_vector_type(4))) float f32x4;
typedef __attribute__((ext_vector_type(2))) float f32x2;
typedef __attribute__((ext_vector_type(4))) unsigned u32x4;
typedef __attribute__((ext_vector_type(2))) unsigned u32x2;
typedef __attribute__((ext_vector_type(2))) __bf16 bf2_t;

constexpr int S_ = 2048, D_ = 1024, NBATCH = 16, BWID = 512, MEML = 256;
constexpr int PW = 7040;
constexpr int P_XBC = 0, P_SZ = 1024, P_DQ = 1536, P_DK = 2048, P_DV = 2560, P_DZ = 3072, P_CQ = 3584, P_CK = 4096,
              P_CV = 4224, P_CZ = 4352, P_UIN = 4864, P_UZ = 5376, P_MQ = 5888, P_MZ = 6400, P_DT = 6912;
constexpr size_t WIN_OFF = 0, WMG_OFF = 7208960, WBR_OFF = 12451840, WOUT_OFF = 15073280, WGLU_OFF = 16121856,
                 WKV_OFF = 16384000, LAYER_W = 17432576;
constexpr int LUTS = 4096;
constexpr int HALF_SMEM = 75 * 1024;
constexpr int SMEM_BYTES = 2 * HALF_SMEM;
constexpr float EPS_ = 1e-6f;
#ifndef PH
#define PH 0xffff
#endif
#ifndef MX
#define MX 0xff
#endif
#ifndef DUP
#define DUP 0
#endif

struct Params {
  const float* in[31];
  float* out;
  u16* W; u16* KV; u16* memb; float* memrs; float* lut; int* ctr; unsigned* bar;
  u16* h; u16* P; u16* xa; u16* o0; u16* o1; u16* o2; u16* o3; u16* o4; u16* syb; u16* s5f;
  int BG; int pad;
};

DI unsigned pk2(float a, float b) { bf2_t r = __builtin_convertvector((f32x2){a, b}, bf2_t); return __builtin_bit_cast(unsigned, r); }
DI u16 f2bf(float a) { return (u16)(pk2(a, 0.f) & 0xffffu); }
DI float bf2f(u16 v) { return __uint_as_float(((unsigned)v) << 16); }
DI float bflo(unsigned v) { return __uint_as_float(v << 16); }
DI float bfhi(unsigned v) { return __uint_as_float(v & 0xffff0000u); }
DI float sigmoidf_(float x) { return __builtin_amdgcn_rcpf(1.f + __builtin_amdgcn_exp2f(-1.4426950408889634f * x)); }
DI float siluf_(float x) { return x * __builtin_amdgcn_rcpf(1.f + __builtin_amdgcn_exp2f(-1.4426950408889634f * x)); }
DI int crow(int reg, int h) { return (reg & 3) + 8 * (reg >> 2) + 4 * h; }
DI int otid() { int t = threadIdx.x & 255; asm volatile("" : "+v"(t)); return t; }
DI int rtid() { int t = threadIdx.x; asm volatile("" : "+v"(t)); return t; }
DI float wave_sum(float v) { for (int o = 32; o > 0; o >>= 1) v += __shfl_xor(v, o, 64); return v; }
#define MFMA32(a, b, c) __builtin_amdgcn_mfma_f32_32x32x16_bf16((a), (b), (c), 0, 0, 0)
#define MFMA16(a, b, c) __builtin_amdgcn_mfma_f32_16x16x32_bf16((a), (b), (c), 0, 0, 0)

DI bf16x8 ldfrag(const u16* base, int stride, int row, int col) { return *reinterpret_cast<const bf16x8*>(base + row * stride + col); }
DI s16x4 tr4(const u16* base, int stride, int krow0, int col0, int lane) {
  const int i16 = lane & 15, q = i16 >> 2, pp = i16 & 3, blk = (lane >> 4) & 1;
  const u16* a = base + (krow0 + q) * stride + col0 + 16 * blk + 4 * pp;
  return __builtin_amdgcn_ds_read_tr16_b64_v4i16((__attribute__((address_space(3))) s16x4*)(a));
}
DI bf16x8 ldfrag_tr_nat(const u16* base, int stride, int k0, int col0, int lane) {
  const int h = lane >> 5;
  s16x4 lo = tr4(base, stride, k0 + 8 * h, col0, lane), hi = tr4(base, stride, k0 + 8 * h + 4, col0, lane);
  return __builtin_shufflevector(lo, hi, 0, 1, 2, 3, 4, 5, 6, 7);
}
DI bf16x8 ldfrag_tr_perm(const u16* base, int stride, int k0, int col0, int lane) {
  const int h = lane >> 5;
  s16x4 lo = tr4(base, stride, k0 + 4 * h, col0, lane), hi = tr4(base, stride, k0 + 8 + 4 * h, col0, lane);
  return __builtin_shufflevector(lo, hi, 0, 1, 2, 3, 4, 5, 6, 7);
}
DI bf16x8 pack8(const f32x16& x, int s) {
  u32x4 u;
  u.x = pk2(x[8 * s + 0], x[8 * s + 1]); u.y = pk2(x[8 * s + 2], x[8 * s + 3]);
  u.z = pk2(x[8 * s + 4], x[8 * s + 5]); u.w = pk2(x[8 * s + 6], x[8 * s + 7]);
  return __builtin_bit_cast(bf16x8, u);
}
DI u32x4 scale8(u32x4 v, float f) {
  u32x4 o;
  o.x = pk2(bflo(v.x) * f, bfhi(v.x) * f); o.y = pk2(bflo(v.y) * f, bfhi(v.y) * f);
  o.z = pk2(bflo(v.z) * f, bfhi(v.z) * f); o.w = pk2(bflo(v.w) * f, bfhi(v.w) * f);
  return o;
}
DI void unpack8(u32x4 v, float* f) {
  f[0] = bflo(v.x); f[1] = bfhi(v.x); f[2] = bflo(v.y); f[3] = bfhi(v.y);
  f[4] = bflo(v.z); f[5] = bfhi(v.z); f[6] = bflo(v.w); f[7] = bfhi(v.w);
}
DI void wave_lds_sync() {
  __builtin_amdgcn_fence(__ATOMIC_RELEASE, "wavefront");
  __builtin_amdgcn_wave_barrier();
  __builtin_amdgcn_fence(__ATOMIC_ACQUIRE, "wavefront");
}


#define XB_TMO      128
#define XB_XCNT(j)  (256  + 64 * (j))
#define XB_XSUB(j)  (1280 + 64 * (j))
#define XB_XGEN(j)  (2304 + 64 * (j))
#define XB_TOP      3328
#define XB_TOPGEN   3392
#define XCD_BAR_WORDS 3456
#define XB_SPIN_CAP (1u << 24)
#define LAS __attribute__((address_space(3)))
DI unsigned xb_ld(unsigned* p) { return __hip_atomic_load(p, __ATOMIC_RELAXED, __HIP_MEMORY_SCOPE_AGENT); }
DI unsigned xb_add(unsigned* p, unsigned v) { return __hip_atomic_fetch_add(p, v, __ATOMIC_RELAXED, __HIP_MEMORY_SCOPE_AGENT); }
DI unsigned xb_xcc_id() { return (unsigned)__builtin_amdgcn_s_getreg((3 << 11) | 20) & 0xFu; }
#define XB_SPIN(cond, bar) do { unsigned _sp = 0; while (cond) { __builtin_amdgcn_s_sleep(1); \
    if ((++_sp & 255u) == 0u) { if (xb_ld(&(bar)[XB_TMO])) break; if (_sp > XB_SPIN_CAP) { atomicAdd(&(bar)[XB_TMO], 1u); break; } } } } while (0)
struct XcdBarrier { unsigned* bar; unsigned x; volatile LAS unsigned* st; };
DI XcdBarrier xcd_barrier_post(unsigned* bar, volatile LAS unsigned* st) {
  XcdBarrier b; b.bar = bar; b.x = xb_xcc_id(); b.st = st;
  if (threadIdx.x == 0) (void)xb_add(&bar[XB_XCNT(b.x)], 1u);
  return b;
}
DI void xcd_barrier_complete(unsigned* bar, unsigned x, unsigned& nloc, unsigned& nx) {
  const unsigned G = gridDim.x * gridDim.y * gridDim.z;
  unsigned sum, cnt, mine, sp = 0u;
  for (;;) {
    sum = 0u; cnt = 0u; mine = 0u;
#pragma unroll
    for (unsigned j = 0; j < 16; ++j) { const unsigned c = xb_ld(&bar[XB_XCNT(j)]); sum += c; cnt += (c > 0u) ? 1u : 0u; mine = (j == x) ? c : mine; }
    if (sum == G) break;
    __builtin_amdgcn_s_sleep(1);
    if ((++sp & 255u) == 0u) { if (xb_ld(&bar[XB_TMO])) break; if (sp > XB_SPIN_CAP) { atomicAdd(&bar[XB_TMO], 1u); break; } }
  }
  nloc = mine > 0u ? mine : 1u; nx = cnt > 0u ? cnt : 1u;
}
DI void xcd_barrier(const XcdBarrier& b) {
  asm volatile("s_waitcnt vmcnt(0)" ::: "memory");
  __syncthreads();
  if (threadIdx.x == 0) {
    unsigned* bar = b.bar;
    __builtin_amdgcn_s_waitcnt(0);
    unsigned nloc = b.st[0], nx = b.st[1];
    if (nloc == 0u) { xcd_barrier_complete(bar, b.x, nloc, nx); b.st[0] = nloc; b.st[1] = nx; }
    const unsigned old = xb_add(&bar[XB_XSUB(b.x)], 1u);
    const unsigned gen = old / nloc;
    if (old + 1u == (gen + 1u) * nloc) {
      __builtin_amdgcn_fence(__ATOMIC_RELEASE, "agent");
      asm volatile("s_waitcnt vmcnt(0)" ::: "memory");
      const unsigned og = xb_add(&bar[XB_TOP], 1u);
      const unsigned tg = og / nx;
      if (og + 1u == (tg + 1u) * nx) xb_add(&bar[XB_TOPGEN], 1u);
      else XB_SPIN(xb_ld(&bar[XB_TOPGEN]) == tg, bar);
      __builtin_amdgcn_fence(__ATOMIC_ACQUIRE, "agent");
      xb_add(&bar[XB_XGEN(b.x)], 1u);
      asm volatile("s_waitcnt vmcnt(0)" ::: "memory");
    } else {
      XB_SPIN(xb_ld(&bar[XB_XGEN(b.x)]) == gen, bar);
      __builtin_amdgcn_fence(__ATOMIC_ACQUIRE, "agent");
      asm volatile("s_waitcnt vmcnt(0)" ::: "memory");
    }
  }
  __syncthreads();
}

template <int BM, int BN>
DI void gemm_acc(const u16* __restrict__ A, int lda, int kstrA, const u16* __restrict__ Bt, int ldb, int kstrB, int K,
                 f32x16 (&acc)[BM / 64][BN / 64], char* smem) {
  constexpr int MI = BM / 64, NJ = BN / 64, NAC = BM / 32, NBC = BN / 32;
  u16* sA = (u16*)smem;
  u16* sB = sA + BM * 72;
  const int tid = otid(), lane = tid & 63, w = tid >> 6, wm = w >> 1, wn = w & 1, r = lane & 31, h = lane >> 5;
  u32x4 ra[NAC], rb[NBC];
  const int crow_ = tid >> 3, ccol = (tid & 7) * 8;
  const u16* Ap = A + (size_t)crow_ * lda + ccol;
  const u16* Bp = Bt + (size_t)crow_ * ldb + ccol;
#pragma unroll
  for (int i = 0; i < NAC; ++i) ra[i] = *(const u32x4*)(Ap + (size_t)(32 * i) * lda);
#pragma unroll
  for (int i = 0; i < NBC; ++i) rb[i] = *(const u32x4*)(Bp + (size_t)(32 * i) * ldb);
  const int nk = K >> 6;
  for (int kt = 0; kt < nk; ++kt) {
    __syncthreads();
#pragma unroll
    for (int i = 0; i < NAC; ++i) *(u32x4*)(sA + (crow_ + 32 * i) * 72 + ccol) = ra[i];
#pragma unroll
    for (int i = 0; i < NBC; ++i) *(u32x4*)(sB + (crow_ + 32 * i) * 72 + ccol) = rb[i];
    __syncthreads();
    if (kt + 1 < nk) {
      const size_t koA = (size_t)(kt + 1) * kstrA, koB = (size_t)(kt + 1) * kstrB;
#pragma unroll
      for (int i = 0; i < NAC; ++i) ra[i] = *(const u32x4*)(Ap + (size_t)(32 * i) * lda + koA);
#pragma unroll
      for (int i = 0; i < NBC; ++i) rb[i] = *(const u32x4*)(Bp + (size_t)(32 * i) * ldb + koB);
    }
#pragma unroll
    for (int ks = 0; ks < 4; ++ks) {
      bf16x8 b[NJ];
#pragma unroll
      for (int j = 0; j < NJ; ++j) b[j] = ldfrag(sB, 72, wn * (BN / 2) + 32 * j + r, ks * 16 + 8 * h);
#pragma unroll
      for (int i = 0; i < MI; ++i) {
        const bf16x8 a = ldfrag(sA, 72, wm * (BM / 2) + 32 * i + r, ks * 16 + 8 * h);
#pragma unroll
        for (int j = 0; j < NJ; ++j) acc[i][j] = MFMA32(a, b[j], acc[i][j]);
      }
    }
  }
}

template <int BM, int BN>
DI void gemm8(const u16* __restrict__ A, int lda, int kstrA, const u16* __restrict__ Bt, size_t bpanel, int K,
              f32x16 (&acc)[BM / 64][BN / 128], char* smem) {
  constexpr int MI = BM / 64, NJ = BN / 128, NAC = BM / 64, NBC = BN / 64;
  u16* sA = (u16*)smem;
  u16* sB = sA + BM * 72;
  const int tid = rtid(), lane = tid & 63, w = tid >> 6, wm = w >> 2, wn = w & 3, r = lane & 31, h = lane >> 5;
  u32x4 ra[NAC], rb[NBC];
  const int crow_ = tid >> 3, ccol = (tid & 7) * 8;
  const u16* Ap = A + (size_t)crow_ * lda + ccol;
  const u16* Bp = Bt + (size_t)crow_ * 64 + ccol;
#pragma unroll
  for (int i = 0; i < NAC; ++i) ra[i] = *(const u32x4*)(Ap + (size_t)(64 * i) * lda);
#pragma unroll
  for (int i = 0; i < NBC; ++i) rb[i] = *(const u32x4*)(Bp + (size_t)(i >> 1) * bpanel + (size_t)(64 * (i & 1)) * 64);
  const int nk = K >> 6;
#pragma unroll 1
  for (int kt = 0; kt < nk; ++kt) {
    __syncthreads();
#pragma unroll
    for (int i = 0; i < NAC; ++i) *(u32x4*)(sA + (crow_ + 64 * i) * 72 + ccol) = ra[i];
#pragma unroll
    for (int i = 0; i < NBC; ++i) *(u32x4*)(sB + (crow_ + 64 * i) * 72 + ccol) = rb[i];
    __syncthreads();
    if (kt + 1 < nk) {
      const size_t koA = (size_t)(kt + 1) * kstrA, koB = (size_t)(kt + 1) * 8192;
#pragma unroll
      for (int i = 0; i < NAC; ++i) ra[i] = *(const u32x4*)(Ap + (size_t)(64 * i) * lda + koA);
#pragma unroll
      for (int i = 0; i < NBC; ++i) rb[i] = *(const u32x4*)(Bp + (size_t)(i >> 1) * bpanel + (size_t)(64 * (i & 1)) * 64 + koB);
    }
#pragma unroll
    for (int ks = 0; ks < 4; ++ks) {
      bf16x8 b[NJ];
#pragma unroll
      for (int j = 0; j < NJ; ++j) b[j] = ldfrag(sB, 72, wn * (BN / 4) + 32 * j + r, ks * 16 + 8 * h);
#pragma unroll
      for (int i = 0; i < MI; ++i) {
        const bf16x8 a = ldfrag(sA, 72, wm * (BM / 2) + 32 * i + r, ks * 16 + 8 * h);
#pragma unroll
        for (int j = 0; j < NJ; ++j) acc[i][j] = MFMA32(a, b[j], acc[i][j]);
      }
    }
  }
}

template <int BM, int BN>
DI void gemm8db(const u16* __restrict__ A, int lda, int kstrA, const u16* __restrict__ Bt, size_t bpanel, int K,
                f32x16 (&acc)[BM / 64][BN / 128], char* smem) {
  constexpr int MI = BM / 64, NJ = BN / 128, NAC = BM / 64, NBC = BN / 64, STAGE = (BM + BN) * 72;
  u16* sA0 = (u16*)smem;
  u16* sB0 = sA0 + BM * 72;
  u16* sA1 = sA0 + STAGE;
  u16* sB1 = sA1 + BM * 72;
  const int tid = rtid(), lane = tid & 63, w = tid >> 6, wm = w >> 2, wn = w & 3, r = lane & 31, h = lane >> 5;
  u32x4 ra0[NAC], rb0[NBC], ra1[NAC], rb1[NBC];
  const int crow_ = tid >> 3, ccol = (tid & 7) * 8;
  const u16* Ap = A + (size_t)crow_ * lda + ccol;
  const u16* Bp = Bt + (size_t)crow_ * 64 + ccol;
  const int nk = K >> 6;
#define G_LOAD(RA, RB, KT)                                                                          \
  {                                                                                                 \
    const size_t koA_ = (size_t)(KT) * kstrA, koB_ = (size_t)(KT) * 8192;                           \
    _Pragma("unroll") for (int i = 0; i < NAC; ++i) RA[i] = *(const u32x4*)(Ap + (size_t)(64 * i) * lda + koA_); \
    _Pragma("unroll") for (int i = 0; i < NBC; ++i) RB[i] = *(const u32x4*)(Bp + (size_t)(i >> 1) * bpanel + (size_t)(64 * (i & 1)) * 64 + koB_); \
  }
#define G_WRITE(RA, RB, SA, SB)                                                                     \
  {                                                                                                 \
    _Pragma("unroll") for (int i = 0; i < NAC; ++i) *(u32x4*)(SA + (crow_ + 64 * i) * 72 + ccol) = RA[i]; \
    _Pragma("unroll") for (int i = 0; i < NBC; ++i) *(u32x4*)(SB + (crow_ + 64 * i) * 72 + ccol) = RB[i]; \
  }
#define G_COMPUTE(SA, SB)                                                                           \
  {                                                                                                 \
    _Pragma("unroll") for (int ks = 0; ks < 4; ++ks) {                                              \
      bf16x8 b_[NJ];                                                                                \
      _Pragma("unroll") for (int j = 0; j < NJ; ++j) b_[j] = ldfrag(SB, 72, wn * (BN / 4) + 32 * j + r, ks * 16 + 8 * h); \
      _Pragma("unroll") for (int i = 0; i < MI; ++i) {                                              \
        const bf16x8 a_ = ldfrag(SA, 72, wm * (BM / 2) + 32 * i + r, ks * 16 + 8 * h);             \
        _Pragma("unroll") for (int j = 0; j < NJ; ++j) acc[i][j] = MFMA32(a_, b_[j], acc[i][j]);    \
      }                                                                                             \
    }                                                                                               \
  }
  G_LOAD(ra0, rb0, 0);
  G_LOAD(ra1, rb1, 1);
  __syncthreads();
  G_WRITE(ra0, rb0, sA0, sB0);
  if (nk > 2) G_LOAD(ra0, rb0, 2);
  __syncthreads();
#pragma unroll 1
  for (int kt = 0; kt < nk; kt += 2) {
    G_COMPUTE(sA0, sB0);
    G_WRITE(ra1, rb1, sA1, sB1);
    if (kt + 3 < nk) G_LOAD(ra1, rb1, kt + 3);
    __syncthreads();
    G_COMPUTE(sA1, sB1);
    if (kt + 2 < nk) G_WRITE(ra0, rb0, sA0, sB0);
    if (kt + 4 < nk) G_LOAD(ra0, rb0, kt + 4);
    __syncthreads();
  }
#undef G_LOAD
#undef G_WRITE
#undef G_COMPUTE
}


namespace pg8 {
#define PG8_LAS __attribute__((address_space(3)))
typedef unsigned short bf16_t;
constexpr int BM = 256, BK = 64, HALF = 128, HTB = HALF * BK * 2, STAGE_BYTES = 8 * HTB, NXCD = 8, WGM = 8;
__host__ __device__ __forceinline__ int lds_byte(int r, int c) { const int st = (r >> 4) * 2 + (c >> 5), rr = r & 15, cc = c & 31, ob = rr * 64 + cc * 2; return st * 1024 + (ob ^ (((ob >> 9) & 1) << 5)); }
__host__ __device__ __forceinline__ void stage_rc(int b, int& R, int& C) { const int st = b / 1024, sb = b % 1024, swz = sb ^ (((sb >> 9) & 1) << 5); R = (st >> 1) * 16 + swz / 64; C = (st & 1) * 32 + (swz % 64) / 2; }
__host__ __device__ __forceinline__ int perm32(int rho) { const int n = rho >> 4, i = rho & 15; return 8 * (i >> 2) + 4 * n + (i & 3); }
struct Unit { int pm, pn, br; };
struct Gemm { const bf16_t* A; const bf16_t* Bt; int M, N, K; };
struct StaticOrder {
    int nM, nN, nwg, G, c;
    __host__ __device__ void init(int M, int N, int G_, int c_) { nM = M / BM; nN = N / BM; nwg = nM * nN; G = G_; c = c_; }
    __host__ __device__ bool next(int i, Unit& u) const {
        const long L = (long)i * G + c; if (L >= nwg) return false;
        int wgid = (int)L; { const int q = nwg / NXCD, r = nwg % NXCD, xcd = wgid % NXCD, off = wgid / NXCD; wgid = (xcd < r ? xcd * (q + 1) : r * (q + 1) + (xcd - r) * q) + off; }
        const int nig = WGM * nN, gid = wgid / nig, fm = gid * WGM, gsz = (nM - fm) < WGM ? (nM - fm) : WGM;
        u.pm = fm + ((wgid % nig) % gsz); u.pn = (wgid % nig) / gsz; u.br = 0; return true;
    }
    __device__ __forceinline__ void a_ready(const Unit&) const {}
    __device__ __forceinline__ void done(const Unit&) const {}
    __device__ __forceinline__ const char* pa(const Unit& u, const Gemm& g) const { return (const char*)g.A + (size_t)u.pm * (size_t)(2 * BM) * g.K; }
    __device__ __forceinline__ const char* pb(const Unit& u, const Gemm& g) const { return (const char*)g.Bt + (size_t)u.pn * (size_t)(2 * BM) * g.K; }
};
template <class Epi, class Sched>
__device__ __forceinline__ void gemm_phase(PG8_LAS unsigned char* lds, const Gemm g, const Sched& S, const Epi& E) {
    constexpr bool STAMP = false; unsigned long long* stamps = nullptr;
    const int tid = rtid(), wid = __builtin_amdgcn_readfirstlane(tid >> 6), lane = tid & 63, wr = wid >> 2, wc = wid & 3, fr = lane & 15, fq = lane >> 4;
    const int K = g.K, nt = K / BK;
    int ts_lo = 0, ts_hi = 0, nts = 0; const unsigned long long rt_entry = STAMP ? 0ull : 0ull;
#define PG8_STAMP() do { if (STAMP && wid == 0 && nts < 64) { const unsigned long long _c = 0ull; \
        ts_lo = (lane == nts) ? (int)(unsigned)_c : ts_lo; ts_hi = (lane == nts) ? (int)(unsigned)(_c >> 32) : ts_hi; ++nts; } } while (0)
    PG8_STAMP();
    unsigned voffA[2], voffB[2];
#pragma unroll
    for (int i = 0; i < 2; ++i) { int R, C; stage_rc(tid * 16 + i * 8192, R, C); const int Rb = Epi::PERM ? ((R & ~31) + perm32(R & 31)) : R;
        voffA[i] = (unsigned)(R * K + C) * 2u; voffB[i] = (unsigned)(Rb * K + C) * 2u; }
    const size_t kstep = (size_t)(BK * 2);
    const size_t hstep = (size_t)HALF * K * 2;
    const size_t tstep = 2 * hstep;
    const unsigned ldsw = (unsigned)wid * 1024u;
    const int aoff = lds_byte(wr * 64 + fr, fq * 8), boff = lds_byte(wc * 32 + fr, fq * 8);
#define PG8_SA(b, h) (((b) * 2 + (h)) * HTB)
#define PG8_SB(b, h) ((4 + (b) * 2 + (h)) * HTB)
#define PG8_STAGE(bufoff, gbase, voff) do { _Pragma("unroll") for (int _i = 0; _i < 2; ++_i) \
        __builtin_amdgcn_global_load_lds((const unsigned*)((const char*)(gbase) + (voff)[_i]), (PG8_LAS unsigned*)(lds + (bufoff) + ldsw + _i * 8192), 16, 0, 0); } while (0)
#define PG8_LDA(dst, b, h) do { _Pragma("unroll") for (int m = 0; m < 4; ++m) _Pragma("unroll") for (int k = 0; k < 2; ++k) dst[m][k] = *(const PG8_LAS bf16x8*)(lds + PG8_SA(b, h) + aoff + m * 2048 + k * 1024); } while (0)
#define PG8_LDB(dst, b, h) do { _Pragma("unroll") for (int n = 0; n < 2; ++n) _Pragma("unroll") for (int k = 0; k < 2; ++k) dst[n][k] = *(const PG8_LAS bf16x8*)(lds + PG8_SB(b, h) + boff + n * 2048 + k * 1024); } while (0)
#define PG8_MMA(ai, bj, At, Bt) do { __builtin_amdgcn_s_setprio(1); _Pragma("unroll") for (int m = 0; m < 4; ++m) _Pragma("unroll") for (int n = 0; n < 2; ++n) _Pragma("unroll") for (int k = 0; k < 2; ++k) \
        acc[ai][bj][m][n] = __builtin_amdgcn_mfma_f32_16x16x32_bf16(Bt[n][k], At[m][k], acc[ai][bj][m][n], 0, 0, 0); __builtin_amdgcn_s_setprio(0); } while (0)
#define PG8_WAIT_V(n) asm volatile("s_waitcnt vmcnt(" #n ")" ::: "memory")
#define PG8_WAIT_L(n) asm volatile("s_waitcnt lgkmcnt(" #n ")" ::: "memory")
#define PG8_BAR __builtin_amdgcn_s_barrier()
#define PG8_SCHED __builtin_amdgcn_sched_barrier(0)
    Unit cur, nxt; int ui = 0;
    if (!S.next(0, cur)) return;
    f32x4 acc[2][2][4][2];
#pragma unroll
    for (int a = 0; a < 2; ++a)
#pragma unroll
        for (int b = 0; b < 2; ++b)
#pragma unroll
            for (int m = 0; m < 4; ++m)
#pragma unroll
                for (int n = 0; n < 2; ++n) acc[a][b][m][n] = (f32x4){0.f, 0.f, 0.f, 0.f};
    bf16x8 At[4][2], B0[2][2], B1[2][2];
    const char* cA = S.pa(cur, g); const char* cB = S.pb(cur, g);
    S.a_ready(cur);
    PG8_STAGE(PG8_SB(0, 0), cB, voffB); PG8_STAGE(PG8_SA(0, 0), cA, voffA); PG8_STAGE(PG8_SB(0, 1), cB + hstep, voffB); PG8_STAGE(PG8_SA(0, 1), cA + hstep, voffA);
    if (wr == 1) PG8_BAR;
    PG8_WAIT_V(4); PG8_BAR;
    PG8_STAGE(PG8_SB(1, 0), cB + kstep, voffB); PG8_STAGE(PG8_SA(1, 0), cA + kstep, voffA); PG8_STAGE(PG8_SB(1, 1), cB + hstep + kstep, voffB);
    PG8_WAIT_V(6); PG8_BAR;
    PG8_STAMP();
    for (;;) {
        const bool has_next = S.next(ui + 1, nxt);
        const char* nA = has_next ? S.pa(nxt, g) : cA; const char* nB = has_next ? S.pb(nxt, g) : cB;
        for (int t = 0; t < nt; t += 2) {
            const bool last = (t == nt - 2);
            const char* a1 = cA + (size_t)(t + 1) * kstep;
            const char* a2 = last ? nA : cA + (size_t)(t + 2) * kstep; const char* b2 = last ? nB : cB + (size_t)(t + 2) * kstep;
            const char* a3 = a2 + kstep; const char* b3 = b2 + kstep;
            if (last && has_next) S.a_ready(nxt);
            PG8_LDB(B0, 0, 0); PG8_SCHED; PG8_LDA(At, 0, 0); PG8_STAGE(PG8_SA(1, 1), a1 + hstep, voffA);
            PG8_WAIT_L(8); PG8_BAR; PG8_WAIT_L(0); PG8_MMA(0, 0, At, B0); PG8_BAR; PG8_SCHED;
            PG8_LDB(B1, 0, 1); PG8_STAGE(PG8_SB(0, 0), b2, voffB);
            PG8_BAR; PG8_WAIT_L(0); PG8_MMA(0, 1, At, B1); PG8_BAR;
            PG8_LDA(At, 0, 1); PG8_STAGE(PG8_SA(0, 0), a2, voffA);
            PG8_BAR; PG8_WAIT_L(0); PG8_MMA(1, 0, At, B0); PG8_BAR; PG8_SCHED;
            PG8_STAGE(PG8_SB(0, 1), b2 + hstep, voffB);
            PG8_WAIT_V(6); PG8_BAR; PG8_MMA(1, 1, At, B1); PG8_BAR;
            PG8_LDB(B0, 1, 0); PG8_SCHED; PG8_LDA(At, 1, 0); PG8_STAGE(PG8_SA(0, 1), a2 + hstep, voffA);
            PG8_WAIT_L(8); PG8_BAR; PG8_WAIT_L(0); PG8_MMA(0, 0, At, B0); PG8_BAR; PG8_SCHED;
            PG8_LDB(B1, 1, 1); PG8_STAGE(PG8_SB(1, 0), b3, voffB);
            PG8_BAR; PG8_WAIT_L(0); PG8_MMA(0, 1, At, B1); PG8_BAR;
            PG8_LDA(At, 1, 1); PG8_STAGE(PG8_SA(1, 0), a3, voffA);
            PG8_BAR; PG8_WAIT_L(0); PG8_MMA(1, 0, At, B0); PG8_BAR; PG8_SCHED;
            PG8_STAGE(PG8_SB(1, 1), b3 + hstep, voffB);
            PG8_WAIT_V(6); PG8_BAR; PG8_MMA(1, 1, At, B1); PG8_BAR;
        }
        PG8_STAMP();
        if constexpr (!Epi::AFTER_DRAIN) { E(acc, cur, wr, wc, fr, fq); S.done(cur); }
        PG8_STAMP();
        if (!has_next) break;
#pragma unroll
        for (int a = 0; a < 2; ++a)
#pragma unroll
            for (int b = 0; b < 2; ++b)
#pragma unroll
                for (int m = 0; m < 4; ++m)
#pragma unroll
                    for (int n = 0; n < 2; ++n) acc[a][b][m][n] = (f32x4){0.f, 0.f, 0.f, 0.f};
        cur = nxt; cA = nA; cB = nB; ++ui;
    }
    PG8_WAIT_V(0);
    if (wr == 0) PG8_BAR;
    PG8_BAR;
    if constexpr (Epi::AFTER_DRAIN) { E.fused(acc, cur, wr, wc, fr, fq, lds, wid, lane); S.done(cur); }
    PG8_STAMP();
    if (STAMP && wid == 0) { stamps[lane] = lane < nts ? (((unsigned long long)(unsigned)ts_hi << 32) | (unsigned)ts_lo) : 0ull;
        if (lane == 62) stamps[62] = rt_entry; if (lane == 63) stamps[63] = 0ull; }
#undef PG8_STAMP
#undef PG8_SA
#undef PG8_SB
#undef PG8_STAGE
#undef PG8_LDA
#undef PG8_LDB
#undef PG8_MMA
#undef PG8_WAIT_V
#undef PG8_WAIT_L
#undef PG8_BAR
#undef PG8_SCHED
}

}

struct EpiP {
  static constexpr bool PERM = true, AFTER_DRAIN = false;
  u16* P;
  DI void operator()(const f32x4 (&acc)[2][2][4][2], const pg8::Unit& u, int wr, int wc, int fr, int fq) const {
    const int row0 = u.pm * 256 + wr * 64 + fr, col0 = u.pn * 256 + wc * 32 + 8 * fq;
#pragma unroll
    for (int ai = 0; ai < 2; ++ai)
#pragma unroll
      for (int m = 0; m < 4; ++m) {
        u16* rowp = P + (size_t)(row0 + ai * 128 + m * 16) * PW + col0;
#pragma unroll
        for (int bj = 0; bj < 2; ++bj) {
          if (col0 + bj * 128 < PW) {
            const f32x4 v0 = acc[ai][bj][m][0], v1 = acc[ai][bj][m][1];
            u32x4 w; w.x = pk2(v0[0], v0[1]); w.y = pk2(v0[2], v0[3]); w.z = pk2(v1[0], v1[1]); w.w = pk2(v1[2], v1[3]);
            *(u32x4*)(rowp + bj * 128) = w;
          }
        }
      }
  }
};
struct EpiX {
  static constexpr bool PERM = false, AFTER_DRAIN = false;
  const float* xin; float* xout;
  DI void operator()(const f32x4 (&acc)[2][2][4][2], const pg8::Unit& u, int wr, int wc, int fr, int fq) const {
    const int row0 = u.pm * 256 + wr * 64 + fr, col0 = u.pn * 256 + wc * 32 + 4 * fq;
#pragma unroll
    for (int ai = 0; ai < 2; ++ai)
#pragma unroll
      for (int m = 0; m < 4; ++m) {
        const size_t rb = (size_t)(row0 + ai * 128 + m * 16) * D_ + col0;
#pragma unroll
        for (int bj = 0; bj < 2; ++bj)
#pragma unroll
          for (int n = 0; n < 2; ++n) {
            const size_t idx = rb + bj * 128 + n * 16;
            *(f32x4*)(xout + idx) = *(const f32x4*)(xin + idx) + acc[ai][bj][m][n];
          }
      }
  }
};

DI size_t wtile(int n0, int K) { return (size_t)(n0 >> 7) * (size_t)(K >> 6) * 8192; }
DI size_t htile(int m0) { return (size_t)(m0 >> 8) * 16 * 16384 + (size_t)(m0 & 255) * 64; }

template <int MI, int NJ>
DI void zero_acc(f32x16 (&acc)[MI][NJ]) {
#pragma unroll
  for (int i = 0; i < MI; ++i)
#pragma unroll
    for (int j = 0; j < NJ; ++j)
#pragma unroll
      for (int e = 0; e < 16; ++e) acc[i][j][e] = 0.f;
}

#define TILE_WALK_BEGIN(MT, NT, SM, SN)                                                   \
  {                                                                                       \
    const int xg_ = bid & 7, loc_ = bid >> 3, nloc_ = nblk >> 3;                          \
    const int nsn_ = ((NT) + (SN) - 1) / (SN), nst_ = (((MT) + (SM) - 1) / (SM)) * nsn_;  \
    for (int st_ = xg_; st_ < nst_; st_ += 8)                                             \
      for (int j_ = loc_; j_ < (SM) * (SN); j_ += nloc_) {                                \
        const int mi = (st_ / nsn_) * (SM) + j_ / (SN), ni = (st_ % nsn_) * (SN) + j_ % (SN); \
        if (mi >= (MT) || ni >= (NT)) continue;
#define TILE_WALK_END }}

DI int t5_bucket(int rel) {
  int n = rel < 0 ? -rel : rel;
  float nf = (float)(n > 1 ? n : 1);
  int large = 8 + (int)(logf(nf / 8.f) / logf(16.f) * 8.f);
  large = large < 15 ? large : 15;
  return (rel > 0 ? 16 : 0) + (n < 8 ? n : large);
}

DI void prep_job(const float* __restrict__ src, int K, int Nsrc, u16* __restrict__ dst, int Ndst, int mode,
                 const float* __restrict__ scale, char* smem, int bid, int nblk, bool rowmajor = false) {
  u16* sT = (u16*)smem;
  const int tid = otid();
  const int ntn = Ndst >> 6, ntk = K >> 6;
  float v[16];
  auto gl = [&](int t) {
    const int n0 = (t / ntk) << 6, k0 = (t % ntk) << 6;
    const int n = n0 + (tid & 63);
    int sc = n;
    if (mode == 1) sc = (n < 1536) ? n : (n < 6912 ? n + 16 : (n < 6928 ? n - 6912 + 1536 : -1));
#pragma unroll
    for (int i = 0; i < 16; ++i) {
      const int k = i * 4 + (tid >> 6);
      float x = 0.f;
      if (sc >= 0) x = src[(size_t)(k0 + k) * Nsrc + sc];
      if (scale) x *= scale[k0 + k];
      v[i] = x;
    }
  };
  if (bid < ntn * ntk) gl(bid);
  for (int t = bid; t < ntn * ntk; t += nblk) {
    const int n0 = (t / ntk) << 6, k0 = (t % ntk) << 6;
    __syncthreads();
#pragma unroll
    for (int i = 0; i < 16; ++i) sT[(tid & 63) * 72 + i * 4 + (tid >> 6)] = f2bf(v[i]);
    if (t + nblk < ntn * ntk) gl(t + nblk);
    __syncthreads();
    const int nn = tid >> 2, ks = (tid & 3) * 16;
    u32x4 v0 = *(const u32x4*)(sT + nn * 72 + ks), v1 = *(const u32x4*)(sT + nn * 72 + ks + 8);
    u16* d = rowmajor ? dst + (size_t)(n0 + nn) * K + k0 + ks
                      : dst + ((size_t)((n0 + nn) >> 7) * (size_t)(K >> 6) + (size_t)(k0 >> 6)) * 8192 + (size_t)((n0 + nn) & 127) * 64 + ks;
    *(u32x4*)d = v0;
    *(u32x4*)(d + 8) = v1;
  }
}

DI void phase_prologue(const Params& p, char* smem, int bid, int nblk) {
  const int tid = otid(), lane = tid & 63, w = tid >> 6;
  for (int i = bid * 256 + tid; i < 12 * 4095; i += nblk * 256) {
    const int hd = i / 4095, idx = i % 4095;
    p.lut[hd * LUTS + idx] = p.in[2][t5_bucket(idx - 2047) * 12 + hd];
  }
  for (int row = bid * 4 + w; row < NBATCH * MEML; row += nblk * 4) {
    const float* src = p.in[1] + (size_t)row * D_;
    float ss = 0.f;
#pragma unroll
    for (int i = 0; i < 4; ++i) {
      f32x4 v = *(const f32x4*)(src + i * 256 + lane * 4);
      ss += v[0] * v[0] + v[1] * v[1] + v[2] * v[2] + v[3] * v[3];
      u32x2 o; o.x = pk2(v[0], v[1]); o.y = pk2(v[2], v[3]);
      *(u32x2*)(p.memb + (size_t)row * D_ + i * 256 + lane * 4) = o;
    }
    ss = wave_sum(ss);
    if (lane == 0) p.memrs[row] = rsqrtf(ss / (float)D_ + EPS_);
  }
  for (int l = 0; l < 2; ++l) {
    u16* W = p.W + (size_t)l * LAYER_W;
    prep_job(p.in[5] + (size_t)l * D_ * 6928, D_, 6928, W + WIN_OFF, PW, 1, nullptr, smem, bid, nblk, true);
    for (int i = 0; i < 5; ++i)
      prep_job(p.in[27] + ((size_t)l * 5 + i) * D_ * D_, D_, D_, W + WMG_OFF + (size_t)i * D_ * D_, D_, 0, nullptr, smem, bid, nblk, true);
    for (int i = 0; i < 5; ++i)
      prep_job(p.in[29] + ((size_t)l * 5 + i) * BWID * D_, BWID, D_, W + WBR_OFF + (size_t)i * D_ * BWID, D_, 0, nullptr, smem, bid, nblk, true);
    prep_job(p.in[30] + (size_t)l * D_ * D_, D_, D_, W + WOUT_OFF, D_, 0, nullptr, smem, bid, nblk, true);
    prep_job(p.in[23] + (size_t)l * BWID * BWID, BWID, BWID, W + WGLU_OFF, BWID, 0, nullptr, smem, bid, nblk, true);
    prep_job(p.in[26] + (size_t)l * D_ * D_, D_, D_, W + WKV_OFF, D_, 0, p.in[25] + (size_t)l * D_, smem, bid, nblk);
  }
}

DI void phase_norm(const float* __restrict__ x, const float* __restrict__ g, u16* __restrict__ hdst, int nrows, int bid, int nblk) {
  const int tid_ = otid(), lane = tid_ & 63, w = tid_ >> 6;
  const int stride = nblk * 4;
  for (int row0 = bid * 4 + w; row0 < nrows; row0 += 4 * stride) {
    f32x4 v[4][4];
    float ss[4] = {0.f, 0.f, 0.f, 0.f};
#pragma unroll
    for (int u = 0; u < 4; ++u) {
      const int row = row0 + u * stride;
      if (row < nrows) {
        const float* src = x + (size_t)row * D_;
#pragma unroll
        for (int i = 0; i < 4; ++i) v[u][i] = *(const f32x4*)(src + i * 256 + lane * 4);
      }
    }
#pragma unroll
    for (int u = 0; u < 4; ++u) {
      const int row = row0 + u * stride;
      if (row < nrows) {
#pragma unroll
        for (int i = 0; i < 4; ++i) ss[u] += v[u][i][0] * v[u][i][0] + v[u][i][1] * v[u][i][1] + v[u][i][2] * v[u][i][2] + v[u][i][3] * v[u][i][3];
        ss[u] = wave_sum(ss[u]);
        const float rs = rsqrtf(ss[u] / (float)D_ + EPS_);
#pragma unroll
        for (int i = 0; i < 4; ++i) {
          f32x4 gg = *(const f32x4*)(g + i * 256 + lane * 4);
          u32x2 o; o.x = pk2(v[u][i][0] * rs * gg[0], v[u][i][1] * rs * gg[1]); o.y = pk2(v[u][i][2] * rs * gg[2], v[u][i][3] * rs * gg[3]);
          const int c = i * 256 + lane * 4;
          *(u32x2*)(hdst + (size_t)row * D_ + c) = o;
        }
      }
    }
  }
}

DI void phase_final(float* __restrict__ x, const float* __restrict__ g, int nrows, int bid, int nblk) {
  const int tid_ = otid(), lane = tid_ & 63, w = tid_ >> 6;
  const int stride = nblk * 4;
  for (int row0 = bid * 4 + w; row0 < nrows; row0 += 4 * stride) {
    f32x4 v[4][4];
    float ss[4] = {0.f, 0.f, 0.f, 0.f};
#pragma unroll
    for (int u = 0; u < 4; ++u) {
      const int row = row0 + u * stride;
      if (row < nrows) {
        const float* src = x + (size_t)row * D_;
#pragma unroll
        for (int i = 0; i < 4; ++i) v[u][i] = *(const f32x4*)(src + i * 256 + lane * 4);
      }
    }
#pragma unroll
    for (int u = 0; u < 4; ++u) {
      const int row = row0 + u * stride;
      if (row < nrows) {
        float* src = x + (size_t)row * D_;
#pragma unroll
        for (int i = 0; i < 4; ++i) ss[u] += v[u][i][0] * v[u][i][0] + v[u][i][1] * v[u][i][1] + v[u][i][2] * v[u][i][2] + v[u][i][3] * v[u][i][3];
        ss[u] = wave_sum(ss[u]);
        const float rs = rsqrtf(ss[u] / (float)D_ + EPS_);
#pragma unroll
        for (int i = 0; i < 4; ++i) {
          f32x4 gg = *(const f32x4*)(g + i * 256 + lane * 4);
          f32x4 o; o[0] = v[u][i][0] * rs * gg[0]; o[1] = v[u][i][1] * rs * gg[1]; o[2] = v[u][i][2] * rs * gg[2]; o[3] = v[u][i][3] * rs * gg[3];
          *(f32x4*)(src + i * 256 + lane * 4) = o;
        }
      }
    }
  }
}

DI void phase_kv(const Params& p, char* smem, int bid, int nblk) {
  const int tid_ = otid(), lane = tid_ & 63, w = tid_ >> 6, wm = w >> 1, wn = w & 1, r = lane & 31, h = lane >> 5;
  for (int t = bid; t < 2 * 32 * 8; t += nblk) {
    const int l = t >> 8, tt = t & 255, m0 = (tt >> 3) * 128, n0 = (tt & 7) * 128;
    f32x16 acc[2][2];
    zero_acc<2, 2>(acc);
    gemm_acc<128, 128>(p.memb + (size_t)m0 * D_, D_, 64, p.W + (size_t)l * LAYER_W + WKV_OFF + wtile(n0, D_), 64, 8192, D_, acc, smem);
    u16* dst = p.KV + (size_t)l * NBATCH * MEML * D_;
#pragma unroll
    for (int i = 0; i < 2; ++i)
#pragma unroll
      for (int e = 0; e < 16; ++e) {
        const int row = m0 + wm * 64 + 32 * i + crow(e, h);
        const float rs = p.memrs[row];
#pragma unroll
        for (int j = 0; j < 2; ++j) dst[(size_t)row * D_ + n0 + wn * 64 + 32 * j + r] = f2bf(acc[i][j][e] * rs);
      }
  }
}

DI void phase_inproj(const Params& p, int l, int Tg, char* smem, int bid, int nblk) {
  const pg8::Gemm g{p.h, p.W + (size_t)l * LAYER_W + WIN_OFF, Tg, 7168, D_};
  pg8::StaticOrder S; S.init(Tg, 7168, nblk, bid);
  const EpiP E{p.P};
  pg8::gemm_phase<EpiP, pg8::StaticOrder>((PG8_LAS unsigned char*)smem, g, S, E);
}

struct EpiG {
  static constexpr bool PERM = true, AFTER_DRAIN = false;
  unsigned char* G; const float* bias;
  DI void operator()(const f32x4 (&acc)[2][2][4][2], const pg8::Unit& u, int wr, int wc, int fr, int fq) const {
    int row0 = u.pm * 256 + wr * 64 + fr, col0 = u.pn * 256 + wc * 32 + 8 * fq;
    asm volatile("" : "+v"(row0), "+v"(col0));
    f32x4 bv[2][2];
#pragma unroll
    for (int bj = 0; bj < 2; ++bj)
#pragma unroll
      for (int n = 0; n < 2; ++n) bv[bj][n] = *(const f32x4*)(bias + col0 + bj * 128 + 4 * n);
#pragma unroll
    for (int ai = 0; ai < 2; ++ai)
#pragma unroll
      for (int m = 0; m < 4; ++m) {
        unsigned char* rowp = G + (size_t)(row0 + ai * 128 + m * 16) * (5 * D_) + col0;
#pragma unroll
        for (int bj = 0; bj < 2; ++bj) {
          const f32x4 v0 = acc[ai][bj][m][0] + bv[bj][0], v1 = acc[ai][bj][m][1] + bv[bj][1];
          u32x2 w;
          w.x = (unsigned)(sigmoidf_(v0[0]) * 255.f + 0.5f) | ((unsigned)(sigmoidf_(v0[1]) * 255.f + 0.5f) << 8) |
                ((unsigned)(sigmoidf_(v0[2]) * 255.f + 0.5f) << 16) | ((unsigned)(sigmoidf_(v0[3]) * 255.f + 0.5f) << 24);
          w.y = (unsigned)(sigmoidf_(v1[0]) * 255.f + 0.5f) | ((unsigned)(sigmoidf_(v1[1]) * 255.f + 0.5f) << 8) |
                ((unsigned)(sigmoidf_(v1[2]) * 255.f + 0.5f) << 16) | ((unsigned)(sigmoidf_(v1[3]) * 255.f + 0.5f) << 24);
          *(u32x2*)(rowp + bj * 128) = w;
        }
      }
  }
};

DI void phase_gates(const Params& p, int l, int Tg, unsigned char* G, char* smem, int bid, int nblk) {
  const pg8::Gemm g{p.h, p.W + (size_t)l * LAYER_W + WMG_OFF, Tg, 5 * D_, D_};
  pg8::StaticOrder S; S.init(Tg, 5 * D_, nblk, bid);
  const EpiG E{G, p.in[28] + (size_t)l * 5 * D_};
  pg8::gemm_phase<EpiG, pg8::StaticOrder>((PG8_LAS unsigned char*)smem, g, S, E);
}

struct EpiGLU {
  static constexpr bool PERM = true, AFTER_DRAIN = false;
  const u16* g; const u16* zs; u16* o3; const float* gb;
  DI void operator()(const f32x4 (&acc)[2][2][4][2], const pg8::Unit& u, int wr, int wc, int fr, int fq) const {
    int row0 = u.pm * 256 + wr * 64 + fr, col0 = u.pn * 256 + wc * 32 + 8 * fq;
    asm volatile("" : "+v"(row0), "+v"(col0));
    f32x4 bv[2][2];
#pragma unroll
    for (int bj = 0; bj < 2; ++bj)
#pragma unroll
      for (int n = 0; n < 2; ++n) bv[bj][n] = *(const f32x4*)(gb + col0 + bj * 128 + 4 * n);
#pragma unroll
    for (int ai = 0; ai < 2; ++ai)
#pragma unroll
      for (int m = 0; m < 4; ++m) {
        const size_t row = (size_t)(row0 + ai * 128 + m * 16);
#pragma unroll
        for (int bj = 0; bj < 2; ++bj) {
          const int col = col0 + bj * 128;
          const u32x4 gv = *(const u32x4*)(g + row * BWID + col);
          const u32x4 zv = *(const u32x4*)(zs + row * BWID + col);
          const f32x4 v0 = acc[ai][bj][m][0] + bv[bj][0], v1 = acc[ai][bj][m][1] + bv[bj][1];
          u32x4 w;
          w.x = pk2(bflo(gv.x) * sigmoidf_(v0[0]) * bflo(zv.x), bfhi(gv.x) * sigmoidf_(v0[1]) * bfhi(zv.x));
          w.y = pk2(bflo(gv.y) * sigmoidf_(v0[2]) * bflo(zv.y), bfhi(gv.y) * sigmoidf_(v0[3]) * bfhi(zv.y));
          w.z = pk2(bflo(gv.z) * sigmoidf_(v1[0]) * bflo(zv.z), bfhi(gv.z) * sigmoidf_(v1[1]) * bfhi(zv.z));
          w.w = pk2(bflo(gv.w) * sigmoidf_(v1[2]) * bflo(zv.w), bfhi(gv.w) * sigmoidf_(v1[3]) * bfhi(zv.w));
          *(u32x4*)(o3 + row * BWID + col) = w;
        }
        __builtin_amdgcn_sched_barrier(0);
      }
  }
};

DI void phase_glu(const Params& p, int l, int Tg, char* smem, int bid, int nblk) {
  const pg8::Gemm g{p.s5f, p.W + (size_t)l * LAYER_W + WGLU_OFF, Tg, BWID, BWID};
  pg8::StaticOrder S; S.init(Tg, BWID, nblk, bid);
  const EpiGLU E{p.s5f, p.syb, p.o3, p.in[24] + (size_t)l * BWID};
  pg8::gemm_phase<EpiGLU, pg8::StaticOrder>((PG8_LAS unsigned char*)smem, g, S, E);
}

struct BranchOrder {
  const u16* ob0; size_t ostride; const u16* wbr; int c, ntile, G;
  DI bool next(int i, pg8::Unit& u) const {
    const int t = c + (i / 5) * G;
    if (t >= ntile) return false;
    u.pm = t >> 2; u.pn = t & 3; u.br = i % 5; return true;
  }
  DI void a_ready(const pg8::Unit&) const {}
  DI void done(const pg8::Unit&) const {}
  DI const char* pa(const pg8::Unit& u, const pg8::Gemm& g) const { return (const char*)(ob0 + (size_t)u.br * ostride + (size_t)u.pm * 256 * BWID); }
  DI const char* pb(const pg8::Unit& u, const pg8::Gemm& g) const { return (const char*)(wbr + (size_t)u.br * D_ * BWID + (size_t)u.pn * 256 * BWID); }
};
struct EpiY {
  static constexpr bool PERM = true, AFTER_DRAIN = false;
  const unsigned char* G; u16* y;
  DI void operator()(const f32x4 (&acc)[2][2][4][2], const pg8::Unit& u, int wr, int wc, int fr, int fq) const {
    int row0 = u.pm * 256 + wr * 64 + fr, col0 = u.pn * 256 + wc * 32 + 8 * fq;
    asm volatile("" : "+v"(row0), "+v"(col0));
#pragma unroll
    for (int ai = 0; ai < 2; ++ai)
#pragma unroll
      for (int m = 0; m < 4; ++m) {
        const size_t row = (size_t)(row0 + ai * 128 + m * 16);
#pragma unroll
        for (int bj = 0; bj < 2; ++bj) {
          const int col = col0 + bj * 128;
          const u32x2 gq = *(const u32x2*)(G + row * (5 * D_) + u.br * D_ + col);
          const float ks_ = 1.f / 255.f;
          const float g0 = (float)(gq.x & 255u) * ks_, g1 = (float)((gq.x >> 8) & 255u) * ks_, g2 = (float)((gq.x >> 16) & 255u) * ks_, g3 = (float)(gq.x >> 24) * ks_;
          const float g4 = (float)(gq.y & 255u) * ks_, g5 = (float)((gq.y >> 8) & 255u) * ks_, g6 = (float)((gq.y >> 16) & 255u) * ks_, g7 = (float)(gq.y >> 24) * ks_;
          u32x4 yv = (u32x4){0u, 0u, 0u, 0u};
          if (u.br > 0) yv = *(const u32x4*)(y + row * D_ + col);
          const f32x4 v0 = acc[ai][bj][m][0], v1 = acc[ai][bj][m][1];
          u32x4 w;
          w.x = pk2(bflo(yv.x) + g0 * v0[0], bfhi(yv.x) + g1 * v0[1]);
          w.y = pk2(bflo(yv.y) + g2 * v0[2], bfhi(yv.y) + g3 * v0[3]);
          w.z = pk2(bflo(yv.z) + g4 * v1[0], bfhi(yv.z) + g5 * v1[1]);
          w.w = pk2(bflo(yv.w) + g6 * v1[2], bfhi(yv.w) + g7 * v1[3]);
          *(u32x4*)(y + row * D_ + col) = w;
        }
        __builtin_amdgcn_sched_barrier(0);
      }
  }
};

DI void phase_merge(const Params& p, int l, int Tg, const unsigned char* G, u16* ydst, char* smem, int bid, int nblk) {
  const pg8::Gemm g{nullptr, nullptr, Tg, D_, BWID};
  BranchOrder S;
  S.ob0 = p.o0; S.ostride = (size_t)Tg * BWID;
  S.wbr = p.W + (size_t)l * LAYER_W + WBR_OFF; S.c = bid; S.G = nblk; S.ntile = (Tg / 256) * 4;
  const EpiY E{G, ydst};
  pg8::gemm_phase<EpiY, BranchOrder>((PG8_LAS unsigned char*)smem, g, S, E);
}

DI void phase_out(const Params& p, int l, int Tg, const u16* ysrc, const float* xin,
                  float* xout, char* smem, int bid, int nblk) {
  const pg8::Gemm g{ysrc, p.W + (size_t)l * LAYER_W + WOUT_OFF, Tg, D_, D_};
  pg8::StaticOrder S; S.init(Tg, D_, nblk, bid);
  const EpiX E{xin, xout};
  pg8::gemm_phase<EpiX, pg8::StaticOrder>((PG8_LAS unsigned char*)smem, g, S, E);
}

DI void phase_conv(const Params& p, int l, int Tg, int bid, int nblk) {
  const float* cw = p.in[6] + (size_t)l * 5 * 1024;
  const float* cb = p.in[7] + (size_t)l * 1024;
  const int total = Tg * 128, stride = nblk * 256;
  for (int idx0 = bid * 256 + otid(); idx0 < total; idx0 += 2 * stride) {
    const int c0 = (idx0 & 127) * 8;
    u32x4 xin[2][5];
    bool ok[2][5];
#pragma unroll
    for (int u = 0; u < 2; ++u) {
      const int idx = idx0 + u * stride;
      const int tok = idx >> 7, spos = tok & (S_ - 1);
#pragma unroll
      for (int k = 0; k < 5; ++k) {
        const int sp = spos + k - 2;
        ok[u][k] = (idx < total) && sp >= 0 && sp < S_;
        xin[u][k] = (u32x4){0u, 0u, 0u, 0u};
        if (ok[u][k]) xin[u][k] = *(const u32x4*)(p.P + (size_t)(tok + k - 2) * PW + c0);
      }
    }
    float acc[2][8];
#pragma unroll
    for (int j = 0; j < 8; ++j) { acc[0][j] = cb[c0 + j]; acc[1][j] = acc[0][j]; }
#pragma unroll
    for (int k = 0; k < 5; ++k) {
      float wv[8], f0[8], f1[8];
#pragma unroll
      for (int j = 0; j < 8; ++j) wv[j] = cw[k * 1024 + c0 + j];
      unpack8(xin[0][k], f0);
      unpack8(xin[1][k], f1);
#pragma unroll
      for (int j = 0; j < 8; ++j) { acc[0][j] += f0[j] * wv[j]; acc[1][j] += f1[j] * wv[j]; }
    }
#pragma unroll
    for (int u = 0; u < 2; ++u) {
      const int idx = idx0 + u * stride;
      if (idx < total) {
        u32x4 o;
        o.x = pk2(siluf_(acc[u][0]), siluf_(acc[u][1])); o.y = pk2(siluf_(acc[u][2]), siluf_(acc[u][3]));
        o.z = pk2(siluf_(acc[u][4]), siluf_(acc[u][5])); o.w = pk2(siluf_(acc[u][6]), siluf_(acc[u][7]));
        *(u32x4*)(p.xa + (size_t)(idx >> 7) * 1024 + c0) = o;
      }
    }
  }
}

template <int DQK, int DV>
DI void attn_pass(const bf16x8 (&qf)[DQK / 16], const u16* __restrict__ Kg, int ldk, const u16* __restrict__ Vg, int ldv,
                  int kt0, int kt1, int q_pos, int q_lo, const float* lut, int window, float m_init, float l_init,
                  f32x16 (&o)[DV / 32], float& l_out, u16* sK, u16* sV) {
  constexpr int LDK = DQK + 8, LDV = DV + 16, NKC = DQK / 32, NVC = DV / 32;
  const int tid = otid(), lane = tid & 63, r = lane & 31, h = lane >> 5;
  u32x4 rk[NKC], rv[NVC];
#pragma unroll
  for (int d = 0; d < DV / 32; ++d)
#pragma unroll
    for (int e = 0; e < 16; ++e) o[d][e] = 0.f;
  float m = m_init, lsum = (h == 0) ? l_init : 0.f;
  {
#pragma unroll
    for (int i = 0; i < NKC; ++i) { const int c = tid + 256 * i, row = c / (DQK / 8), col = (c % (DQK / 8)) * 8; rk[i] = *(const u32x4*)(Kg + (size_t)(kt0 * 64 + row) * ldk + col); }
#pragma unroll
    for (int i = 0; i < NVC; ++i) { const int c = tid + 256 * i, row = c / (DV / 8), col = (c % (DV / 8)) * 8; rv[i] = *(const u32x4*)(Vg + (size_t)(kt0 * 64 + row) * ldv + col); }
  }
#pragma unroll 1
  for (int kt = kt0; kt < kt1; ++kt) {
    __syncthreads();
#pragma unroll
    for (int i = 0; i < NKC; ++i) { const int c = tid + 256 * i, row = c / (DQK / 8), col = (c % (DQK / 8)) * 8; *(u32x4*)(sK + row * LDK + col) = rk[i]; }
#pragma unroll
    for (int i = 0; i < NVC; ++i) { const int c = tid + 256 * i, row = c / (DV / 8), col = (c % (DV / 8)) * 8; *(u32x4*)(sV + row * LDV + col) = rv[i]; }
    __syncthreads();
    if (kt + 1 < kt1) {
#pragma unroll
      for (int i = 0; i < NKC; ++i) { const int c = tid + 256 * i, row = c / (DQK / 8), col = (c % (DQK / 8)) * 8; rk[i] = *(const u32x4*)(Kg + (size_t)((kt + 1) * 64 + row) * ldk + col); }
#pragma unroll
      for (int i = 0; i < NVC; ++i) { const int c = tid + 256 * i, row = c / (DV / 8), col = (c % (DV / 8)) * 8; rv[i] = *(const u32x4*)(Vg + (size_t)((kt + 1) * 64 + row) * ldv + col); }
    }
    f32x16 s[2];
#pragma unroll
    for (int t = 0; t < 2; ++t) {
      bf16x8 ka[DQK / 16];
#pragma unroll
      for (int ks = 0; ks < DQK / 16; ++ks) ka[ks] = ldfrag(sK, LDK, 32 * t + r, 16 * ks + 8 * h);
#pragma unroll
      for (int e = 0; e < 16; ++e) s[t][e] = 0.f;
#pragma unroll
      for (int ks = 0; ks < DQK / 16; ++ks) s[t] = MFMA32(ka[ks], qf[ks], s[t]);
    }
    const int kbase = kt * 64;
    if (lut) {
      const bool far_ = (window == 0) && ((kbase - (q_lo + 31) >= 91) || (q_lo - (kbase + 63) >= 91));
      if (far_) {
        const float bconst = lut[(kbase > q_lo) ? 4000 : 100];
#pragma unroll
        for (int t = 0; t < 2; ++t)
#pragma unroll
          for (int e = 0; e < 16; ++e) s[t][e] += bconst;
      } else {
#pragma unroll
        for (int t = 0; t < 2; ++t)
#pragma unroll
          for (int e = 0; e < 16; ++e) {
            const int rel = kbase + 32 * t + crow(e, h) - q_pos;
            float v = s[t][e] + lut[rel + 2047];
            if (window > 0 && (rel > window || rel < -window)) v = -INFINITY;
            s[t][e] = v;
          }
      }
    }
    float mx = s[0][0];
#pragma unroll
    for (int t = 0; t < 2; ++t)
#pragma unroll
      for (int e = 0; e < 16; ++e) mx = fmaxf(mx, s[t][e]);
    mx = fmaxf(mx, __shfl_xor(mx, 32, 64));
    if (__builtin_amdgcn_ballot_w64(mx > m + 8.f) != 0ull) {
      const float mn = fmaxf(m, mx);
      const float alpha = __builtin_amdgcn_exp2f(m - mn);
      m = mn;
      lsum *= alpha;
#pragma unroll
      for (int d = 0; d < DV / 32; ++d)
#pragma unroll
        for (int e = 0; e < 16; ++e) o[d][e] *= alpha;
    }
    float ps = 0.f;
#pragma unroll
    for (int t = 0; t < 2; ++t)
#pragma unroll
      for (int e = 0; e < 16; ++e) { const float pv = __builtin_amdgcn_exp2f(s[t][e] - m); s[t][e] = pv; ps += pv; }
    lsum += ps;
    bf16x8 pf[2][2];
#pragma unroll
    for (int t = 0; t < 2; ++t)
#pragma unroll
      for (int s2 = 0; s2 < 2; ++s2) pf[t][s2] = pack8(s[t], s2);
#pragma unroll
    for (int d = 0; d < DV / 32; ++d) {
      bf16x8 va[2][2];
#pragma unroll
      for (int t = 0; t < 2; ++t)
#pragma unroll
        for (int s2 = 0; s2 < 2; ++s2) va[t][s2] = ldfrag_tr_perm(sV, LDV, 32 * t + 16 * s2, 32 * d, lane);
#pragma unroll
      for (int t = 0; t < 2; ++t)
#pragma unroll
        for (int s2 = 0; s2 < 2; ++s2) o[d] = MFMA32(va[t][s2], pf[t][s2], o[d]);
    }
  }
  lsum += __shfl_xor(lsum, 32, 64);
  l_out = lsum;
}

template <int DQK>
DI void load_qfrag(bf16x8 (&qf)[DQK / 16], const u16* qrow, float scale, int h) {
#pragma unroll
  for (int ks = 0; ks < DQK / 16; ++ks) {
    u32x4 v = *(const u32x4*)(qrow + 16 * ks + 8 * h);
    qf[ks] = __builtin_bit_cast(bf16x8, scale8(v, scale));
  }
}

DI void attn_lds(char* smem, u16*& sK, u16*& sV, float*& slut) {
  sK = (u16*)smem; sV = sK + 64 * 136; slut = (float*)(sV + 64 * 144);
}

DI void diff_item(const Params& p, int l, int item, char* smem) {
  const int tid = otid(), lane = tid & 63, w = tid >> 6, r = lane & 31, h = lane >> 5;
  const int bl = item >> 6, hd = (item >> 4) & 3, qb = item & 15;
  u16 *sK, *sV; float* slut;
  attn_lds(smem, sK, sV, slut);
  __syncthreads();
  {
    const float* gl = p.lut + hd * LUTS;
    const float v0 = gl[2047 - 256 + tid], v1 = gl[2047 + tid];
    const float vf = (tid < 2) ? gl[tid ? 4000 : 100] : 0.f;
    slut[2047 - 256 + tid] = v0 * 1.4426950408889634f; slut[2047 + tid] = v1 * 1.4426950408889634f;
    if (tid < 2) slut[tid ? 4000 : 100] = vf * 1.4426950408889634f;
  }
  const float lam_init = 0.8f - 0.6f * expf(-0.3f * (float)l);
  const float* lp = p.in[12] + (size_t)l * 4 * 64;
  const float d1 = wave_sum(lp[lane] * lp[64 + lane]), d2 = wave_sum(lp[128 + lane] * lp[192 + lane]);
  const float lam = expf(d1) - expf(d2) + lam_init;
  const int q_lo = qb * 128 + 32 * w, q_pos = q_lo + r;
  const size_t tokq = (size_t)bl * S_ + q_pos;
  const u16* Pb = p.P + (size_t)bl * S_ * PW;
  f32x16 o[4];
  float lt;
  u16* odst = p.o1 + tokq * BWID + hd * 128;
  {
    bf16x8 qf[4];
    load_qfrag<64>(qf, p.P + tokq * PW + P_DQ + (hd * 2 + 0) * 64, 0.125f * 1.4426950408889634f, h);
    attn_pass<64, 128>(qf, Pb + P_DK + (hd * 2 + 0) * 64, PW, Pb + P_DV + hd * 128, PW, 0, 32, q_pos, q_lo, slut, 0, -INFINITY, 0.f, o, lt, sK, sV);
    const float inv = 1.f / lt;
#pragma unroll
    for (int d = 0; d < 4; ++d)
#pragma unroll
      for (int g4 = 0; g4 < 4; ++g4) {
        u32x2 ov;
        ov.x = pk2(o[d][4 * g4 + 0] * inv, o[d][4 * g4 + 1] * inv);
        ov.y = pk2(o[d][4 * g4 + 2] * inv, o[d][4 * g4 + 3] * inv);
        *(u32x2*)(odst + 32 * d + 8 * g4 + 4 * h) = ov;
      }
  }
  {
    bf16x8 qf[4];
    load_qfrag<64>(qf, p.P + tokq * PW + P_DQ + (hd * 2 + 1) * 64, 0.125f * 1.4426950408889634f, h);
    attn_pass<64, 128>(qf, Pb + P_DK + (hd * 2 + 1) * 64, PW, Pb + P_DV + hd * 128, PW, 0, 32, q_pos, q_lo, slut, 0, -INFINITY, 0.f, o, lt, sK, sV);
    const float inv = lam / lt;
#pragma unroll
    for (int d = 0; d < 4; ++d)
#pragma unroll
      for (int g4 = 0; g4 < 4; ++g4) {
        const u32x2 pv = *(const u32x2*)(odst + 32 * d + 8 * g4 + 4 * h);
        o[d][4 * g4 + 0] = bflo(pv.x) - o[d][4 * g4 + 0] * inv;
        o[d][4 * g4 + 1] = bfhi(pv.x) - o[d][4 * g4 + 1] * inv;
        o[d][4 * g4 + 2] = bflo(pv.y) - o[d][4 * g4 + 2] * inv;
        o[d][4 * g4 + 3] = bfhi(pv.y) - o[d][4 * g4 + 3] * inv;
      }
  }
  float ss = 0.f;
#pragma unroll
  for (int d = 0; d < 4; ++d)
#pragma unroll
    for (int e = 0; e < 16; ++e) ss += o[d][e] * o[d][e];
  ss += __shfl_xor(ss, 32, 64);
  const float rs = rsqrtf(ss / 128.f + EPS_) * (1.f - lam_init);
  const float* sg = p.in[13] + (size_t)l * 128;
#pragma unroll
  for (int d = 0; d < 4; ++d)
#pragma unroll
    for (int g4 = 0; g4 < 4; ++g4) {
      const int dv = 32 * d + 8 * g4 + 4 * h;
      const u32x2 zz = *(const u32x2*)(p.P + tokq * PW + P_DZ + hd * 128 + dv);
      const float z0 = bflo(zz.x), z1 = bfhi(zz.x), z2 = bflo(zz.y), z3 = bfhi(zz.y);
      u32x2 ov;
      ov.x = pk2(o[d][4 * g4 + 0] * rs * sg[dv + 0] * siluf_(z0), o[d][4 * g4 + 1] * rs * sg[dv + 1] * siluf_(z1));
      ov.y = pk2(o[d][4 * g4 + 2] * rs * sg[dv + 2] * siluf_(z2), o[d][4 * g4 + 3] * rs * sg[dv + 3] * siluf_(z3));
      *(u32x2*)(odst + dv) = ov;
    }
}

DI void win_item(const Params& p, int l, int item, char* smem) {
  const int tid = otid(), lane = tid & 63, w = tid >> 6, r = lane & 31, h = lane >> 5;
  const int bl = item >> 7, qh = (item >> 4) & 7, qb = item & 15;
  const int kvh = qh >> 2;
  u16 *sK, *sV; float* slut;
  attn_lds(smem, sK, sV, slut);
  __syncthreads();
  {
    const float* gl = p.lut + (4 + qh) * LUTS;
    const float v0 = gl[2047 - 256 + tid], v1 = gl[2047 + tid];
    slut[2047 - 256 + tid] = v0 * 1.4426950408889634f; slut[2047 + tid] = v1 * 1.4426950408889634f;
  }
  const float sink = p.in[14][l * 8 + qh];
  const int q_lo = qb * 128 + 32 * w, q_pos = q_lo + r;
  const size_t tokq = (size_t)bl * S_ + q_pos;
  const u16* Pb = p.P + (size_t)bl * S_ * PW;
  int kt0 = qb * 2 - 2; if (kt0 < 0) kt0 = 0;
  int kt1 = qb * 2 + 4; if (kt1 > 32) kt1 = 32;
  f32x16 o[2];
  float lt;
  bf16x8 qf[4];
  load_qfrag<64>(qf, p.P + tokq * PW + P_CQ + qh * 64, 0.125f * 1.4426950408889634f, h);
  attn_pass<64, 64>(qf, Pb + P_CK + kvh * 64, PW, Pb + P_CV + kvh * 64, PW, kt0, kt1, q_pos, q_lo, slut, 128, sink * 1.4426950408889634f, 1.f, o, lt, sK, sV);
  const float inv = 1.f / lt;
#pragma unroll
  for (int d = 0; d < 2; ++d)
#pragma unroll
    for (int g4 = 0; g4 < 4; ++g4) {
      const int dv = 32 * d + 8 * g4 + 4 * h;
      const u32x2 zz = *(const u32x2*)(p.P + tokq * PW + P_CZ + qh * 64 + dv);
      const float z0 = bflo(zz.x), z1 = bfhi(zz.x), z2 = bflo(zz.y), z3 = bfhi(zz.y);
      u32x2 ov;
      ov.x = pk2(o[d][4 * g4 + 0] * inv * siluf_(z0), o[d][4 * g4 + 1] * inv * siluf_(z1));
      ov.y = pk2(o[d][4 * g4 + 2] * inv * siluf_(z2), o[d][4 * g4 + 3] * inv * siluf_(z3));
      *(u32x2*)(p.o2 + tokq * BWID + qh * 64 + dv) = ov;
    }
}

DI void mem_item(const Params& p, int l, int grp, int item, char* smem) {
  const int tid = otid(), lane = tid & 63, w = tid >> 6, r = lane & 31, h = lane >> 5;
  const int bl = item >> 6, hd = (item >> 4) & 3, qb = item & 15;
  u16 *sK, *sV; float* slut;
  attn_lds(smem, sK, sV, slut);
  const int q_lo = qb * 128 + 32 * w, q_pos = q_lo + r;
  const size_t tokq = (size_t)bl * S_ + q_pos;
  const int bg = grp * p.BG + bl;
  const u16* kv = p.KV + ((size_t)l * NBATCH + bg) * MEML * D_;
  f32x16 o[4];
  float lt;
  bf16x8 qf[8];
  load_qfrag<128>(qf, p.P + tokq * PW + P_MQ + hd * 128, 0.08838834764831845f * 1.4426950408889634f, h);
  attn_pass<128, 128>(qf, kv + hd * 128, D_, kv + 512 + hd * 128, D_, 0, 4, q_pos, q_lo, nullptr, 0, -INFINITY, 0.f, o, lt, sK, sV);
  const float inv = 1.f / lt;
#pragma unroll
  for (int d = 0; d < 4; ++d)
#pragma unroll
    for (int g4 = 0; g4 < 4; ++g4) {
      const int dv = 32 * d + 8 * g4 + 4 * h;
      const u32x2 zz = *(const u32x2*)(p.P + tokq * PW + P_MZ + hd * 128 + dv);
      const float z0 = bflo(zz.x), z1 = bfhi(zz.x), z2 = bflo(zz.y), z3 = bfhi(zz.y);
      u32x2 ov;
      ov.x = pk2(o[d][4 * g4 + 0] * inv * siluf_(z0), o[d][4 * g4 + 1] * inv * siluf_(z1));
      ov.y = pk2(o[d][4 * g4 + 2] * inv * siluf_(z2), o[d][4 * g4 + 3] * inv * siluf_(z3));
      *(u32x2*)(p.o4 + tokq * BWID + hd * 128 + dv) = ov;
    }
}

DI void ssd_item(const Params& p, int l, int item, char* smem) {
  const int tid = otid(), lane = tid & 63, w = tid >> 6, r = lane & 31, h = lane >> 5;
  const int bl = item >> 4, hd = (item >> 1) & 7, dir = item & 1;
  const int gq = hd >> 2, lt = w & 1, ph = w >> 1;
  u16* sB = (u16*)smem;
  u16* sC = sB + 64 * 136;
  u16* sX1 = sC + 64 * 136;
  u16* sX2 = sX1 + 64 * 80;
  u16* sS = sX2 + 64 * 80;
  float* sW = (float*)(sS + 64 * 136);
  float* sDt = sW + 64;
  const float Aneg = -expf(p.in[9][(l * 2 + dir) * 8 + hd]);
  const float dtb = p.in[8][(l * 2 + dir) * 8 + hd];
  u16* ydst = dir ? p.syb : p.o0;
  const u16* Pb = p.P + (size_t)bl * S_ * PW;
  const u16* xab = p.xa + (size_t)bl * S_ * 1024;
  __syncthreads();
  for (int i = tid; i < 64 * 136 / 2; i += 256) ((unsigned*)sS)[i] = 0u;
  f32x16 accS[2];
#pragma unroll
  for (int i = 0; i < 2; ++i)
#pragma unroll
    for (int e = 0; e < 16; ++e) accS[i][e] = 0.f;
  u32x4 rB[4], rC[4], rX[2];
  float rdt = 0.f;
  auto prefetch = [&](int cc) {
    if (tid < 64) {
      const int pp = 64 * cc + tid, tok = dir ? (S_ - 1 - pp) : pp;
      rdt = bf2f(Pb[(size_t)tok * PW + P_DT + dir * 8 + hd]);
    }
#pragma unroll
    for (int i = 0; i < 4; ++i) {
      const int c = tid + 256 * i, row = c >> 4, col = (c & 15) * 8;
      const int pp = 64 * cc + row, tok = dir ? (S_ - 1 - pp) : pp;
      rB[i] = *(const u32x4*)(xab + (size_t)tok * 1024 + 512 + gq * 128 + col);
      rC[i] = *(const u32x4*)(xab + (size_t)tok * 1024 + 768 + gq * 128 + col);
    }
#pragma unroll
    for (int i = 0; i < 2; ++i) {
      const int c = tid + 256 * i, row = c >> 3, col = (c & 7) * 8;
      const int pp = 64 * cc + row, tok = dir ? (S_ - 1 - pp) : pp;
      rX[i] = *(const u32x4*)(xab + (size_t)tok * 1024 + hd * 64 + col);
    }
  };
  prefetch(0);
#pragma unroll 1
  for (int cc = 0; cc < 32; ++cc) {
    __syncthreads();
    if (tid < 64) {
      const float x = rdt + dtb;
      const float dt = x > 20.f ? x : log1pf(expf(x));
      float a = dt * Aneg;
#pragma unroll
      for (int o = 1; o < 64; o <<= 1) { const float t = __shfl_up(a, o, 64); if (lane >= o) a += t; }
      sW[tid] = a;
      sDt[tid] = dt;
    }
#pragma unroll
    for (int i = 0; i < 4; ++i) {
      const int c = tid + 256 * i, row = c >> 4, col = (c & 15) * 8;
      *(u32x4*)(sB + row * 136 + col) = rB[i];
      *(u32x4*)(sC + row * 136 + col) = rC[i];
    }
    __syncthreads();
    const float wlast = sW[63];
#pragma unroll
    for (int i = 0; i < 2; ++i) {
      const int c = tid + 256 * i, row = c >> 3, col = (c & 7) * 8;
      const float f1 = sDt[row], f2 = f1 * __expf(wlast - sW[row]);
      *(u32x4*)(sX1 + row * 80 + col) = scale8(rX[i], f1);
      *(u32x4*)(sX2 + row * 80 + col) = scale8(rX[i], f2);
    }
    __syncthreads();
    if (cc + 1 < 32) prefetch(cc + 1);
    f32x16 ay;
#pragma unroll
    for (int e = 0; e < 16; ++e) ay[e] = 0.f;
#pragma unroll
    for (int ks = 0; ks < 8; ++ks) {
      bf16x8 a = ldfrag(sS, 136, 32 * ph + r, 16 * ks + 8 * h);
      bf16x8 b = ldfrag(sC, 136, 32 * lt + r, 16 * ks + 8 * h);
      ay = MFMA32(a, b, ay);
    }
    const float wl = sW[32 * lt + r];
    {
      const float ewl = __expf(wl);
#pragma unroll
      for (int e = 0; e < 16; ++e) ay[e] *= ewl;
    }
    for (int st = 0; st <= lt; ++st) {
      f32x16 g;
#pragma unroll
      for (int e = 0; e < 16; ++e) g[e] = 0.f;
#pragma unroll
      for (int ks = 0; ks < 8; ++ks) {
        bf16x8 a = ldfrag(sB, 136, 32 * st + r, 16 * ks + 8 * h);
        bf16x8 b = ldfrag(sC, 136, 32 * lt + r, 16 * ks + 8 * h);
        g = MFMA32(a, b, g);
      }
#pragma unroll
      for (int e = 0; e < 16; ++e) {
        const int sidx = 32 * st + crow(e, h);
        const float f = (sidx <= 32 * lt + r) ? __expf(wl - sW[sidx]) : 0.f;
        g[e] *= f;
      }
#pragma unroll
      for (int s2 = 0; s2 < 2; ++s2) {
        bf16x8 pfr = pack8(g, s2);
        bf16x8 a = ldfrag_tr_perm(sX1, 80, 32 * st + 16 * s2, 32 * ph, lane);
        ay = MFMA32(a, pfr, ay);
      }
    }
    {
      const int pp = 64 * cc + 32 * lt + r, tok = dir ? (S_ - 1 - pp) : pp;
      u16* yd = ydst + ((size_t)bl * S_ + tok) * BWID + hd * 64 + 32 * ph + 4 * h;
#pragma unroll
      for (int g4 = 0; g4 < 4; ++g4) {
        u32x2 ov; ov.x = pk2(ay[4 * g4 + 0], ay[4 * g4 + 1]); ov.y = pk2(ay[4 * g4 + 2], ay[4 * g4 + 3]);
        *(u32x2*)(yd + 8 * g4) = ov;
      }
    }
    {
      const float ew = __expf(wlast);
#pragma unroll
      for (int pt = 0; pt < 2; ++pt)
#pragma unroll
        for (int e = 0; e < 16; ++e) accS[pt][e] *= ew;
#pragma unroll
      for (int ks = 0; ks < 4; ++ks) {
        bf16x8 b = ldfrag_tr_nat(sB, 136, 16 * ks, 32 * w, lane);
#pragma unroll
        for (int pt = 0; pt < 2; ++pt) {
          bf16x8 a = ldfrag_tr_nat(sX2, 80, 16 * ks, 32 * pt, lane);
          accS[pt] = MFMA32(a, b, accS[pt]);
        }
      }
    }
    __syncthreads();
#pragma unroll
    for (int pt = 0; pt < 2; ++pt)
#pragma unroll
      for (int e = 0; e < 16; ++e) sS[(32 * pt + crow(e, h)) * 136 + 32 * w + r] = f2bf(accS[pt][e]);
  }
}

DI void s5_item(const Params& p, int l, int item, char* smem) {
  const int tid = otid(), lane = tid & 63, w = tid >> 6;
  const int wi = item * 4 + w;
  const int bl = wi >> 6, g = (wi >> 1) & 31, dir = wi & 1;
  float* sBu = (float*)(smem + w * 12800);
  u16* sX = (u16*)(smem + w * 12800 + 8448);
  const int c16 = lane & 15, kg = lane >> 4;
  const float* lre = p.in[15] + ((size_t)(l * 2 + dir) * 32 + g) * 64;
  const float* lim = p.in[16] + ((size_t)(l * 2 + dir) * 32 + g) * 64;
  const float dt = expf(p.in[17][(l * 2 + dir) * 32 + g]);
  const float* bre = p.in[18] + ((size_t)l * 32 + g) * 64 * 16;
  const float* bim = p.in[19] + ((size_t)l * 32 + g) * 64 * 16;
  const float* cre = p.in[20] + (((size_t)(l * 2 + dir) * 32 + g) * 16) * 64;
  const float* cim = p.in[21] + (((size_t)(l * 2 + dir) * 32 + g) * 16) * 64;
  float ar, ai;
  {
    const float lr = lre[lane], li = lim[lane];
    const float mag = expf(lr * dt);
    ar = mag * cosf(li * dt); ai = mag * sinf(li * dt);
  }
  bf16x8 bfr[8];
#pragma unroll
  for (int ct = 0; ct < 4; ++ct) {
    const int st = 16 * ct + c16;
    const float lr = lre[st], li = lim[st];
    const float mag = expf(lr * dt);
    const float a_r = mag * cosf(li * dt), a_i = mag * sinf(li * dt);
    const float den = lr * lr + li * li;
    const float fr = ((a_r - 1.f) * lr + a_i * li) / den, fi = (a_i * lr - (a_r - 1.f) * li) / den;
    float vr[8], vi[8];
#pragma unroll
    for (int j = 0; j < 8; ++j) {
      float br_ = 0.f, bi_ = 0.f;
      if (kg < 2) { br_ = bre[st * 16 + 8 * kg + j]; bi_ = bim[st * 16 + 8 * kg + j]; }
      vr[j] = fr * br_ - fi * bi_;
      vi[j] = fr * bi_ + fi * br_;
    }
    u32x4 ur, ui;
    ur.x = pk2(vr[0], vr[1]); ur.y = pk2(vr[2], vr[3]); ur.z = pk2(vr[4], vr[5]); ur.w = pk2(vr[6], vr[7]);
    ui.x = pk2(vi[0], vi[1]); ui.y = pk2(vi[2], vi[3]); ui.z = pk2(vi[4], vi[5]); ui.w = pk2(vi[6], vi[7]);
    bfr[ct] = __builtin_bit_cast(bf16x8, ur);
    bfr[4 + ct] = __builtin_bit_cast(bf16x8, ui);
  }
  bf16x8 cfr[4];
#pragma unroll
  for (int ks = 0; ks < 4; ++ks) {
    const float* src = (ks < 2) ? (cre + c16 * 64 + 32 * ks + 8 * kg) : (cim + c16 * 64 + 32 * (ks - 2) + 8 * kg);
    const float sg = (ks < 2) ? 1.f : -1.f;
    u32x4 u;
    u.x = pk2(sg * src[0], sg * src[1]); u.y = pk2(sg * src[2], sg * src[3]);
    u.z = pk2(sg * src[4], sg * src[5]); u.w = pk2(sg * src[6], sg * src[7]);
    cfr[ks] = __builtin_bit_cast(bf16x8, u);
  }
  u16* ydst = dir ? p.o3 : p.s5f;
  const u16* Pb = p.P + (size_t)bl * S_ * PW + P_UIN + g * 16;
  float xr = 0.f, xi = 0.f;
  u32x4 ring[8];
#pragma unroll
  for (int j = 0; j < 8; ++j) {
    ring[j] = (u32x4){0u, 0u, 0u, 0u};
    const int pp = 16 * j + c16, tok = dir ? (S_ - 1 - pp) : pp;
    if (kg < 2) ring[j] = *(const u32x4*)(Pb + (size_t)tok * PW + 8 * kg);
  }
#pragma unroll 1
  for (int cc0 = 0; cc0 < S_ / 16; cc0 += 8)
#pragma unroll
  for (int j8 = 0; j8 < 8; ++j8) {
    const int cc = cc0 + j8;
    const bf16x8 ua = __builtin_bit_cast(bf16x8, ring[j8]);
    if (cc + 8 < S_ / 16) {
      const int pp = 16 * (cc + 8) + c16, tok = dir ? (S_ - 1 - pp) : pp;
      if (kg < 2) ring[j8] = *(const u32x4*)(Pb + (size_t)tok * PW + 8 * kg);
    }
    wave_lds_sync();
#pragma unroll
    for (int ct = 0; ct < 8; ++ct) {
      f32x4 d = {0.f, 0.f, 0.f, 0.f};
      d = MFMA16(ua, bfr[ct], d);
#pragma unroll
      for (int e = 0; e < 4; ++e) sBu[(4 * kg + e) * 132 + 16 * ct + c16] = d[e];
    }
    wave_lds_sync();
#pragma unroll
    for (int t = 0; t < 16; ++t) {
      const float bur = sBu[t * 132 + lane], bui = sBu[t * 132 + 64 + lane];
      const float nr = ar * xr - ai * xi + bur;
      const float ni = ar * xi + ai * xr + bui;
      xr = nr; xi = ni;
      sX[t * 136 + lane] = f2bf(xr);
      sX[t * 136 + 64 + lane] = f2bf(xi);
    }
    wave_lds_sync();
    f32x4 y = {0.f, 0.f, 0.f, 0.f};
#pragma unroll
    for (int ks = 0; ks < 4; ++ks) {
      bf16x8 a = ldfrag(sX, 136, c16, 32 * ks + 8 * kg);
      y = MFMA16(a, cfr[ks], y);
    }
#pragma unroll
    for (int e = 0; e < 4; ++e) {
      const int pp = 16 * cc + 4 * kg + e, tok = dir ? (S_ - 1 - pp) : pp;
      ydst[((size_t)bl * S_ + tok) * BWID + g * 16 + c16] = f2bf(y[e]);
    }
  }
}

DI void phase_finalize(const Params& p, int l, int Tg, int bid, int nblk) {
  const int tid_ = otid(), lane = tid_ & 63, w = tid_ >> 6;
  const float* dsk = p.in[10] + l * 8;
  const float* ng = p.in[11] + (size_t)l * BWID;
  const float* s5d = p.in[22] + (size_t)l * BWID;
  const int c0 = lane * 8, stride = nblk * 4;
  for (int tok0 = bid * 4 + w; tok0 < Tg; tok0 += 2 * stride) {
    u32x4 r_yf[2], r_yb[2], r_xs[2], r_z[2], r_sf[2], r_sb[2], r_u[2], r_uz[2];
#pragma unroll
    for (int u = 0; u < 2; ++u) {
      const int tok = tok0 + u * stride;
      if (tok < Tg) {
        r_yf[u] = *(const u32x4*)(p.o0 + (size_t)tok * BWID + c0);
        r_yb[u] = *(const u32x4*)(p.syb + (size_t)tok * BWID + c0);
        r_xs[u] = *(const u32x4*)(p.xa + (size_t)tok * 1024 + c0);
        r_z[u] = *(const u32x4*)(p.P + (size_t)tok * PW + P_SZ + c0);
        r_sf[u] = *(const u32x4*)(p.s5f + (size_t)tok * BWID + c0);
        r_sb[u] = *(const u32x4*)(p.o3 + (size_t)tok * BWID + c0);
        r_u[u] = *(const u32x4*)(p.P + (size_t)tok * PW + P_UIN + c0);
        r_uz[u] = *(const u32x4*)(p.P + (size_t)tok * PW + P_UZ + c0);
      }
    }
#pragma unroll
    for (int u = 0; u < 2; ++u) {
      const int tok = tok0 + u * stride;
      if (tok < Tg) {
        float yf[8], yb[8], xs[8], z[8];
        unpack8(r_yf[u], yf); unpack8(r_yb[u], yb); unpack8(r_xs[u], xs); unpack8(r_z[u], z);
        const float dk = dsk[c0 >> 6];
        float v[8], ss = 0.f;
#pragma unroll
        for (int j = 0; j < 8; ++j) { v[j] = (yf[j] + yb[j] + dk * xs[j]) * siluf_(z[j]); ss += v[j] * v[j]; }
        ss = wave_sum(ss);
        const float rs = rsqrtf(ss / (float)BWID + EPS_);
        u32x4 o;
        o.x = pk2(v[0] * rs * ng[c0 + 0], v[1] * rs * ng[c0 + 1]); o.y = pk2(v[2] * rs * ng[c0 + 2], v[3] * rs * ng[c0 + 3]);
        o.z = pk2(v[4] * rs * ng[c0 + 4], v[5] * rs * ng[c0 + 5]); o.w = pk2(v[6] * rs * ng[c0 + 6], v[7] * rs * ng[c0 + 7]);
        *(u32x4*)(p.o0 + (size_t)tok * BWID + c0) = o;
        float sf[8], sb[8], uu[8], gq[8], uz[8];
        unpack8(r_sf[u], sf); unpack8(r_sb[u], sb); unpack8(r_u[u], uu); unpack8(r_uz[u], uz);
#pragma unroll
        for (int j = 0; j < 8; ++j) {
          const float y = sf[j] + sb[j] + s5d[c0 + j] * uu[j];
          const float t = tanhf(0.7978845608028654f * (y + 0.044715f * y * y * y));
          gq[j] = 0.5f * y * (1.f + t);
        }
        u32x4 o2;
        o2.x = pk2(gq[0], gq[1]); o2.y = pk2(gq[2], gq[3]); o2.z = pk2(gq[4], gq[5]); o2.w = pk2(gq[6], gq[7]);
        *(u32x4*)(p.s5f + (size_t)tok * BWID + c0) = o2;
        u32x4 o3v;
        o3v.x = pk2(siluf_(uz[0]), siluf_(uz[1])); o3v.y = pk2(siluf_(uz[2]), siluf_(uz[3]));
        o3v.z = pk2(siluf_(uz[4]), siluf_(uz[5])); o3v.w = pk2(siluf_(uz[6]), siluf_(uz[7]));
        *(u32x4*)(p.syb + (size_t)tok * BWID + c0) = o3v;
      }
    }
  }
}

DI void phase_mixers(const Params& p, int l, int grp, int* ctr, char* smem, volatile int* s_itemp, int half) {
  const int BG = p.BG;
  const int n_ssd = BG * 8, n_s5 = BG * 8, n_diff = BG * 32, n_mem = BG * 32, n_win = BG * 64;
  const int total = n_ssd + n_s5 + n_diff + n_mem + n_win;
  for (;;) {
    __syncthreads();
    if (threadIdx.x == 0) *s_itemp = atomicAdd(ctr, 1);
    __syncthreads();
    int it = __builtin_amdgcn_readfirstlane(*s_itemp);
    if (it >= total) break;
    if (it < n_ssd) { if (MX & 1) ssd_item(p, l, it * 2 + half, smem); continue; }
    it -= n_ssd;
    if (it < n_s5) { if (MX & 2) s5_item(p, l, it * 2 + half, smem); continue; }
    it -= n_s5;
    if (it < n_diff) { if (MX & 4) diff_item(p, l, it * 2 + half, smem); continue; }
    it -= n_diff;
    if (it < n_mem) { if (MX & 8) mem_item(p, l, grp, it * 2 + half, smem); continue; }
    it -= n_mem;
    if (MX & 16) win_item(p, l, ((it >> 4) * 2 + half) * 16 + (it & 15), smem);
  }
}

__global__ void __launch_bounds__(512, 2) fwd_megakernel(Params p) {
  extern __shared__ __attribute__((aligned(16))) char smem[];
  __shared__ __attribute__((aligned(16))) unsigned s_misc[8];
  cg::grid_group grid = cg::this_grid();
  const int bid = blockIdx.x, nblk = gridDim.x;
  const int half = __builtin_amdgcn_readfirstlane((int)(threadIdx.x >> 8));
  const int vbid = bid * 2 + half, vnblk = nblk * 2;
  char* smem_h = smem + half * HALF_SMEM;
  const int BG = p.BG, Tg = BG * S_, ngrp = NBATCH / BG;
  if (threadIdx.x < 8) s_misc[threadIdx.x] = 0u;
  __syncthreads();
  XcdBarrier xb = xcd_barrier_post(p.bar, (volatile LAS unsigned*)s_misc);
  if (PH & 1) phase_prologue(p, smem_h, vbid, vnblk);
  if (p.BG < 0) grid.sync();
  xcd_barrier(xb);
  if (PH & 2) phase_kv(p, smem_h, vbid, vnblk);
  for (int grp = 0; grp < ngrp; ++grp) {
    const size_t rowoff = (size_t)grp * Tg * D_;
    for (int l = 0; l < 2; ++l) {
      const float* xin = (l == 0 ? p.in[0] : (const float*)p.out) + rowoff;
      if (PH & 4) phase_norm(xin, p.in[4] + (size_t)l * D_, p.h, Tg, vbid, vnblk);
      xcd_barrier(xb);
      if (PH & 8) phase_inproj(p, l, Tg, smem, bid, nblk);
      xcd_barrier(xb);
      if (PH & 16) phase_conv(p, l, Tg, vbid, vnblk);
      xcd_barrier(xb);
      if (PH & 32) phase_mixers(p, l, grp, p.ctr + grp * 2 + l, smem_h, (volatile int*)&s_misc[4], half);
      xcd_barrier(xb);
      if (PH & 64) phase_finalize(p, l, Tg, vbid, vnblk);
      xcd_barrier(xb);
      unsigned char* Gbuf = (unsigned char*)(p.P + (size_t)Tg * D_);
      phase_gates(p, l, Tg, Gbuf, smem, bid, nblk);
      if (PH & 128) phase_glu(p, l, Tg, smem, bid, nblk);
      xcd_barrier(xb);
      if (PH & 256) phase_merge(p, l, Tg, Gbuf, p.P, smem, bid, nblk);
      xcd_barrier(xb);
      if (PH & 512) phase_out(p, l, Tg, p.P, xin, p.out + rowoff, smem, bid, nblk);
      xcd_barrier(xb);
    }
  }
  if (PH & 1024) phase_final(p.out, p.in[3], NBATCH * S_, vbid, vnblk);
}

extern "C" void kernel_launch(void* const* d_in, const int* in_sizes, int n_in, void* d_out, int out_size, void* d_ws,
                              size_t ws_size, hipStream_t stream) {
  static int grid_blocks = 0;
  if (!grid_blocks) {
    int dev = 0, cus = 0, per_cu = 0;
    hipGetDevice(&dev);
    hipDeviceGetAttribute(&cus, hipDeviceAttributeMultiprocessorCount, dev);
    hipFuncSetAttribute((const void*)fwd_megakernel, hipFuncAttributeMaxDynamicSharedMemorySize, SMEM_BYTES);
    hipOccupancyMaxActiveBlocksPerMultiprocessor(&per_cu, fwd_megakernel, 512, SMEM_BYTES);
    if (per_cu > 1) per_cu = 1;
    if (per_cu < 1) per_cu = 1;
    grid_blocks = cus * per_cu;
  }
  Params p{};
  for (int i = 0; i < 31; ++i) p.in[i] = (const float*)d_in[i];
  p.out = (float*)d_out;
  char* ws = (char*)d_ws;
  size_t off = 0;
  auto take = [&](size_t bytes) { char* r = ws + off; off += (bytes + 255) & ~(size_t)255; return r; };
  p.W = (u16*)take(2 * LAYER_W * 2);
  p.KV = (u16*)take((size_t)2 * NBATCH * MEML * D_ * 2);
  p.memb = (u16*)take((size_t)NBATCH * MEML * D_ * 2);
  p.memrs = (float*)take(NBATCH * MEML * 4);
  p.lut = (float*)take(12 * LUTS * 4);
  p.ctr = (int*)take(4096);
  p.bar = (unsigned*)take(XCD_BAR_WORDS * 4);
  const size_t fixed = off;
  int BG = 8;
  auto need = [&](int bg) { size_t tg = (size_t)bg * S_; return fixed + tg * (D_ * 2 + (size_t)PW * 2 + 1024 * 2 + 7 * BWID * 2) + 16 * 256; };
  while (BG > 1 && need(BG) > ws_size) BG >>= 1;
  const size_t Tg = (size_t)BG * S_;
  p.h = (u16*)take(Tg * D_ * 2);
  p.P = (u16*)take(Tg * PW * 2);
  p.xa = (u16*)take(Tg * 1024 * 2);
  p.o0 = (u16*)take(Tg * BWID * 2);
  p.o1 = (u16*)take(Tg * BWID * 2);
  p.o2 = (u16*)take(Tg * BWID * 2);
  p.o3 = (u16*)take(Tg * BWID * 2);
  p.o4 = (u16*)take(Tg * BWID * 2);
  p.syb = (u16*)take(Tg * BWID * 2);
  p.s5f = (u16*)take(Tg * BWID * 2);
  p.BG = BG;
  p.pad = 0;
  hipMemsetAsync(p.ctr, 0, 4096 + ((XCD_BAR_WORDS * 4 + 255) & ~255), stream);
  void* args[] = {&p};
  hipError_t e = hipLaunchCooperativeKernel((const void*)fwd_megakernel, dim3(grid_blocks), dim3(512), args, SMEM_BYTES, stream);
  if (e != hipSuccess) fprintf(stderr, "cooperative launch failed: %s (grid %d)\n", hipGetErrorString(e), grid_blocks);
}
```

```cpp
#include <hip/hip_runtime.h>
#include <hip/hip_cooperative_groups.h>
#include <cstdio>
namespace cg = cooperative_groups;

#define DI __device__ __forceinline__
typedef unsigned short u16;
typedef __attribute__((ext_vector_type(8))) short bf16x8;
typedef __attribute__((ext_vector_type(4))) short s16x4;
typedef __attribute__((ext_vector_type(16))) float f32x16;
typedef __attribute__((ext_vector_type(4))) float f32x4;
typedef __attribute__((ext_vector_type(2))) float f32x2;
typedef __attribute__((ext_vector_type(4))) unsigned u32x4;
typedef __attribute__((ext_vector_type(2))) unsigned u32x2;
typedef __attribute__((ext_vector_type(2))) __bf16 bf2_t;

constexpr int S_ = 2048, D_ = 1024, NBATCH = 16, BWID = 512, MEML = 256;
constexpr int PW = 7040;
constexpr int P_XBC = 0, P_SZ = 1024, P_DQ = 1536, P_DK = 2048, P_DV = 2560, P_DZ = 3072, P_CQ = 3584, P_CK = 4096,
              P_CV = 4224, P_CZ = 4352, P_UIN = 4864, P_UZ = 5376, P_MQ = 5888, P_MZ = 6400, P_DT = 6912;
constexpr size_t WIN_OFF = 0, WMG_OFF = 7208960, WBR_OFF = 12451840, WOUT_OFF = 15073280, WGLU_OFF = 16121856,
                 WKV_OFF = 16384000, LAYER_W = 17432576;
constexpr int LUTS = 4096;
constexpr int HALF_SMEM = 75 * 1024;
constexpr int SMEM_BYTES = 2 * HALF_SMEM;
constexpr float EPS_ = 1e-6f;
#ifndef PH
#define PH 0xffff
#endif
#ifndef MX
#define MX 0xff
#endif
#ifndef DUP
#define DUP 0
#endif

struct Params {
  const float* in[31];
  float* out;
  u16* W; u16* KV; u16* memb; float* memrs; float* lut; int* ctr; unsigned* bar;
  u16* h; u16* P; u16* xa; u16* o0; u16* o1; u16* o2; u16* o3; u16* o4; u16* syb; u16* s5f;
  int BG; int pad;
};

DI unsigned pk2(float a, float b) { bf2_t r = __builtin_convertvector((f32x2){a, b}, bf2_t); return __builtin_bit_cast(unsigned, r); }
DI u16 f2bf(float a) { return (u16)(pk2(a, 0.f) & 0xffffu); }
DI float bf2f(u16 v) { return __uint_as_float(((unsigned)v) << 16); }
DI float bflo(unsigned v) { return __uint_as_float(v << 16); }
DI float bfhi(unsigned v) { return __uint_as_float(v & 0xffff0000u); }
DI float sigmoidf_(float x) { return __builtin_amdgcn_rcpf(1.f + __builtin_amdgcn_exp2f(-1.4426950408889634f * x)); }
DI float siluf_(float x) { return x * __builtin_amdgcn_rcpf(1.f + __builtin_amdgcn_exp2f(-1.4426950408889634f * x)); }
DI int crow(int reg, int h) { return (reg & 3) + 8 * (reg >> 2) + 4 * h; }
DI int otid() { int t = threadIdx.x & 255; asm volatile("" : "+v"(t)); return t; }
DI int rtid() { int t = threadIdx.x; asm volatile("" : "+v"(t)); return t; }
DI float wave_sum(float v) { for (int o = 32; o > 0; o >>= 1) v += __shfl_xor(v, o, 64); return v; }
#define MFMA32(a, b, c) __builtin_amdgcn_mfma_f32_32x32x16_bf16((a), (b), (c), 0, 0, 0)
#define MFMA16(a, b, c) __builtin_amdgcn_mfma_f32_16x16x32_bf16((a), (b), (c), 0, 0, 0)

DI bf16x8 ldfrag(const u16* base, int stride, int row, int col) { return *reinterpret_cast<const bf16x8*>(base + row * stride + col); }
DI s16x4 tr4(const u16* base, int stride, int krow0, int col0, int lane) {
  const int i16 = lane & 15, q = i16 >> 2, pp = i16 & 3, blk = (lane >> 4) & 1;
  const u16* a = base + (krow0 + q) * stride + col0 + 16 * blk + 4 * pp;
  return __builtin_amdgcn_ds_read_tr16_b64_v4i16((__attribute__((address_space(3))) s16x4*)(a));
}
DI bf16x8 ldfrag_tr_nat(const u16* base, int stride, int k0, int col0, int lane) {
  const int h = lane >> 5;
  s16x4 lo = tr4(base, stride, k0 + 8 * h, col0, lane), hi = tr4(base, stride, k0 + 8 * h + 4, col0, lane);
  return __builtin_shufflevector(lo, hi, 0, 1, 2, 3, 4, 5, 6, 7);
}
DI bf16x8 ldfrag_tr_perm(const u16* base, int stride, int k0, int col0, int lane) {
  const int h = lane >> 5;
  s16x4 lo = tr4(base, stride, k0 + 4 * h, col0, lane), hi = tr4(base, stride, k0 + 8 + 4 * h, col0, lane);
  return __builtin_shufflevector(lo, hi, 0, 1, 2, 3, 4, 5, 6, 7);
}
DI bf16x8 pack8(const f32x16& x, int s) {
  u32x4 u;
  u.x = pk2(x[8 * s + 0], x[8 * s + 1]); u.y = pk2(x[8 * s + 2], x[8 * s + 3]);
  u.z = pk2(x[8 * s + 4], x[8 * s + 5]); u.w = pk2(x[8 * s + 6], x[8 * s + 7]);
  return __builtin_bit_cast(bf16x8, u);
}
DI u32x4 scale8(u32x4 v, float f) {
  u32x4 o;
  o.x = pk2(bflo(v.x) * f, bfhi(v.x) * f); o.y = pk2(bflo(v.y) * f, bfhi(v.y) * f);
  o.z = pk2(bflo(v.z) * f, bfhi(v.z) * f); o.w = pk2(bflo(v.w) * f, bfhi(v.w) * f);
  return o;
}
DI void unpack8(u32x4 v, float* f) {
  f[0] = bflo(v.x); f[1] = bfhi(v.x); f[2] = bflo(v.y); f[3] = bfhi(v.y);
  f[4] = bflo(v.z); f[5] = bfhi(v.z); f[6] = bflo(v.w); f[7] = bfhi(v.w);
}
DI void wave_lds_sync() {
  __builtin_amdgcn_fence(__ATOMIC_RELEASE, "wavefront");
  __builtin_amdgcn_wave_barrier();
  __builtin_amdgcn_fence(__ATOMIC_ACQUIRE, "wavefront");
}


#define XB_TMO      128
#define XB_XCNT(j)  (256  + 64 * (j))
#define XB_XSUB(j)  (1280 + 64 * (j))
#define XB_XGEN(j)  (2304 + 64 * (j))
#define XB_TOP      3328
#define XB_TOPGEN   3392
#define XCD_BAR_WORDS 3456
#define XB_SPIN_CAP (1u << 24)
#define LAS __attribute__((address_space(3)))
DI unsigned xb_ld(unsigned* p) { return __hip_atomic_load(p, __ATOMIC_RELAXED, __HIP_MEMORY_SCOPE_AGENT); }
DI unsigned xb_add(unsigned* p, unsigned v) { return __hip_atomic_fetch_add(p, v, __ATOMIC_RELAXED, __HIP_MEMORY_SCOPE_AGENT); }
DI unsigned xb_xcc_id() { return (unsigned)__builtin_amdgcn_s_getreg((3 << 11) | 20) & 0xFu; }
#define XB_SPIN(cond, bar) do { unsigned _sp = 0; while (cond) { __builtin_amdgcn_s_sleep(1); \
    if ((++_sp & 255u) == 0u) { if (xb_ld(&(bar)[XB_TMO])) break; if (_sp > XB_SPIN_CAP) { atomicAdd(&(bar)[XB_TMO], 1u); break; } } } } while (0)
struct XcdBarrier { unsigned* bar; unsigned x; volatile LAS unsigned* st; };
DI XcdBarrier xcd_barrier_post(unsigned* bar, volatile LAS unsigned* st) {
  XcdBarrier b; b.bar = bar; b.x = xb_xcc_id(); b.st = st;
  if (threadIdx.x == 0) (void)xb_add(&bar[XB_XCNT(b.x)], 1u);
  return b;
}
DI void xcd_barrier_complete(unsigned* bar, unsigned x, unsigned& nloc, unsigned& nx) {
  const unsigned G = gridDim.x * gridDim.y * gridDim.z;
  unsigned sum, cnt, mine, sp = 0u;
  for (;;) {
    sum = 0u; cnt = 0u; mine = 0u;
#pragma unroll
    for (unsigned j = 0; j < 16; ++j) { const unsigned c = xb_ld(&bar[XB_XCNT(j)]); sum += c; cnt += (c > 0u) ? 1u : 0u; mine = (j == x) ? c : mine; }
    if (sum == G) break;
    __builtin_amdgcn_s_sleep(1);
    if ((++sp & 255u) == 0u) { if (xb_ld(&bar[XB_TMO])) break; if (sp > XB_SPIN_CAP) { atomicAdd(&bar[XB_TMO], 1u); break; } }
  }
  nloc = mine > 0u ? mine : 1u; nx = cnt > 0u ? cnt : 1u;
}
DI void xcd_barrier(const XcdBarrier& b) {
  asm volatile("s_waitcnt vmcnt(0)" ::: "memory");
  __syncthreads();
  if (threadIdx.x == 0) {
    unsigned* bar = b.bar;
    __builtin_amdgcn_s_waitcnt(0);
    unsigned nloc = b.st[0], nx = b.st[1];
    if (nloc == 0u) { xcd_barrier_complete(bar, b.x, nloc, nx); b.st[0] = nloc; b.st[1] = nx; }
    const unsigned old = xb_add(&bar[XB_XSUB(b.x)], 1u);
    const unsigned gen = old / nloc;
    if (old + 1u == (gen + 1u) * nloc) {
      __builtin_amdgcn_fence(__ATOMIC_RELEASE, "agent");
      asm volatile("s_waitcnt vmcnt(0)" ::: "memory");
      const unsigned og = xb_add(&bar[XB_TOP], 1u);
      const unsigned tg = og / nx;
      if (og + 1u == (tg + 1u) * nx) xb_add(&bar[XB_TOPGEN], 1u);
      else XB_SPIN(xb_ld(&bar[XB_TOPGEN]) == tg, bar);
      __builtin_amdgcn_fence(__ATOMIC_ACQUIRE, "agent");
      xb_add(&bar[XB_XGEN(b.x)], 1u);
      asm volatile("s_waitcnt vmcnt(0)" ::: "memory");
    } else {
      XB_SPIN(xb_ld(&bar[XB_XGEN(b.x)]) == gen, bar);
      __builtin_amdgcn_fence(__ATOMIC_ACQUIRE, "agent");
      asm volatile("s_waitcnt vmcnt(0)" ::: "memory");
    }
  }
  __syncthreads();
}

template <int BM, int BN>
DI void gemm_acc(const u16* __restrict__ A, int lda, int kstrA, const u16* __restrict__ Bt, int ldb, int kstrB, int K,
                 f32x16 (&acc)[BM / 64][BN / 64], char* smem) {
  constexpr int MI = BM / 64, NJ = BN / 64, NAC = BM / 32, NBC = BN / 32;
  u16* sA = (u16*)smem;
  u16* sB = sA + BM * 72;
  const int tid = otid(), lane = tid & 63, w = tid >> 6, wm = w >> 1, wn = w & 1, r = lane & 31, h = lane >> 5;
  u32x4 ra[NAC], rb[NBC];
  const int crow_ = tid >> 3, ccol = (tid & 7) * 8;
  const u16* Ap = A + (size_t)crow_ * lda + ccol;
  const u16* Bp = Bt + (size_t)crow_ * ldb + ccol;
#pragma unroll
  for (int i = 0; i < NAC; ++i) ra[i] = *(const u32x4*)(Ap + (size_t)(32 * i) * lda);
#pragma unroll
  for (int i = 0; i < NBC; ++i) rb[i] = *(const u32x4*)(Bp + (size_t)(32 * i) * ldb);
  const int nk = K >> 6;
  for (int kt = 0; kt < nk; ++kt) {
    __syncthreads();
#pragma unroll
    for (int i = 0; i < NAC; ++i) *(u32x4*)(sA + (crow_ + 32 * i) * 72 + ccol) = ra[i];
#pragma unroll
    for (int i = 0; i < NBC; ++i) *(u32x4*)(sB + (crow_ + 32 * i) * 72 + ccol) = rb[i];
    __syncthreads();
    if (kt + 1 < nk) {
      const size_t koA = (size_t)(kt + 1) * kstrA, koB = (size_t)(kt + 1) * kstrB;
#pragma unroll
      for (int i = 0; i < NAC; ++i) ra[i] = *(const u32x4*)(Ap + (size_t)(32 * i) * lda + koA);
#pragma unroll
      for (int i = 0; i < NBC; ++i) rb[i] = *(const u32x4*)(Bp + (size_t)(32 * i) * ldb + koB);
    }
#pragma unroll
    for (int ks = 0; ks < 4; ++ks) {
      bf16x8 b[NJ];
#pragma unroll
      for (int j = 0; j < NJ; ++j) b[j] = ldfrag(sB, 72, wn * (BN / 2) + 32 * j + r, ks * 16 + 8 * h);
#pragma unroll
      for (int i = 0; i < MI; ++i) {
        const bf16x8 a = ldfrag(sA, 72, wm * (BM / 2) + 32 * i + r, ks * 16 + 8 * h);
#pragma unroll
        for (int j = 0; j < NJ; ++j) acc[i][j] = MFMA32(a, b[j], acc[i][j]);
      }
    }
  }
}

template <int BM, int BN>
DI void gemm8(const u16* __restrict__ A, int lda, int kstrA, const u16* __restrict__ Bt, size_t bpanel, int K,
              f32x16 (&acc)[BM / 64][BN / 128], char* smem) {
  constexpr int MI = BM / 64, NJ = BN / 128, NAC = BM / 64, NBC = BN / 64;
  u16* sA = (u16*)smem;
  u16* sB = sA + BM * 72;
  const int tid = rtid(), lane = tid & 63, w = tid >> 6, wm = w >> 2, wn = w & 3, r = lane & 31, h = lane >> 5;
  u32x4 ra[NAC], rb[NBC];
  const int crow_ = tid >> 3, ccol = (tid & 7) * 8;
  const u16* Ap = A + (size_t)crow_ * lda + ccol;
  const u16* Bp = Bt + (size_t)crow_ * 64 + ccol;
#pragma unroll
  for (int i = 0; i < NAC; ++i) ra[i] = *(const u32x4*)(Ap + (size_t)(64 * i) * lda);
#pragma unroll
  for (int i = 0; i < NBC; ++i) rb[i] = *(const u32x4*)(Bp + (size_t)(i >> 1) * bpanel + (size_t)(64 * (i & 1)) * 64);
  const int nk = K >> 6;
#pragma unroll 1
  for (int kt = 0; kt < nk; ++kt) {
    __syncthreads();
#pragma unroll
    for (int i = 0; i < NAC; ++i) *(u32x4*)(sA + (crow_ + 64 * i) * 72 + ccol) = ra[i];
#pragma unroll
    for (int i = 0; i < NBC; ++i) *(u32x4*)(sB + (crow_ + 64 * i) * 72 + ccol) = rb[i];
    __syncthreads();
    if (kt + 1 < nk) {
      const size_t koA = (size_t)(kt + 1) * kstrA, koB = (size_t)(kt + 1) * 8192;
#pragma unroll
      for (int i = 0; i < NAC; ++i) ra[i] = *(const u32x4*)(Ap + (size_t)(64 * i) * lda + koA);
#pragma unroll
      for (int i = 0; i < NBC; ++i) rb[i] = *(const u32x4*)(Bp + (size_t)(i >> 1) * bpanel + (size_t)(64 * (i & 1)) * 64 + koB);
    }
#pragma unroll
    for (int ks = 0; ks < 4; ++ks) {
      bf16x8 b[NJ];
#pragma unroll
      for (int j = 0; j < NJ; ++j) b[j] = ldfrag(sB, 72, wn * (BN / 4) + 32 * j + r, ks * 16 + 8 * h);
#pragma unroll
      for (int i = 0; i < MI; ++i) {
        const bf16x8 a = ldfrag(sA, 72, wm * (BM / 2) + 32 * i + r, ks * 16 + 8 * h);
#pragma unroll
        for (int j = 0; j < NJ; ++j) acc[i][j] = MFMA32(a, b[j], acc[i][j]);
      }
    }
  }
}

template <int BM, int BN>
DI void gemm8db(const u16* __restrict__ A, int lda, int kstrA, const u16* __restrict__ Bt, size_t bpanel, int K,
                f32x16 (&acc)[BM / 64][BN / 128], char* smem) {
  constexpr int MI = BM / 64, NJ = BN / 128, NAC = BM / 64, NBC = BN / 64, STAGE = (BM + BN) * 72;
  u16* sA0 = (u16*)smem;
  u16* sB0 = sA0 + BM * 72;
  u16* sA1 = sA0 + STAGE;
  u16* sB1 = sA1 + BM * 72;
  const int tid = rtid(), lane = tid & 63, w = tid >> 6, wm = w >> 2, wn = w & 3, r = lane & 31, h = lane >> 5;
  u32x4 ra0[NAC], rb0[NBC], ra1[NAC], rb1[NBC];
  const int crow_ = tid >> 3, ccol = (tid & 7) * 8;
  const u16* Ap = A + (size_t)crow_ * lda + ccol;
  const u16* Bp = Bt + (size_t)crow_ * 64 + ccol;
  const int nk = K >> 6;
#define G_LOAD(RA, RB, KT)                                                                          \
  {                                                                                                 \
    const size_t koA_ = (size_t)(KT) * kstrA, koB_ = (size_t)(KT) * 8192;                           \
    _Pragma("unroll") for (int i = 0; i < NAC; ++i) RA[i] = *(const u32x4*)(Ap + (size_t)(64 * i) * lda + koA_); \
    _Pragma("unroll") for (int i = 0; i < NBC; ++i) RB[i] = *(const u32x4*)(Bp + (size_t)(i >> 1) * bpanel + (size_t)(64 * (i & 1)) * 64 + koB_); \
  }
#define G_WRITE(RA, RB, SA, SB)                                                                     \
  {                                                                                                 \
    _Pragma("unroll") for (int i = 0; i < NAC; ++i) *(u32x4*)(SA + (crow_ + 64 * i) * 72 + ccol) = RA[i]; \
    _Pragma("unroll") for (int i = 0; i < NBC; ++i) *(u32x4*)(SB + (crow_ + 64 * i) * 72 + ccol) = RB[i]; \
  }
#define G_COMPUTE(SA, SB)                                                                           \
  {                                                                                                 \
    _Pragma("unroll") for (int ks = 0; ks < 4; ++ks) {                                              \
      bf16x8 b_[NJ];                                                                                \
      _Pragma("unroll") for (int j = 0; j < NJ; ++j) b_[j] = ldfrag(SB, 72, wn * (BN / 4) + 32 * j + r, ks * 16 + 8 * h); \
      _Pragma("unroll") for (int i = 0; i < MI; ++i) {                                              \
        const bf16x8 a_ = ldfrag(SA, 72, wm * (BM / 2) + 32 * i + r, ks * 16 + 8 * h);             \
        _Pragma("unroll") for (int j = 0; j < NJ; ++j) acc[i][j] = MFMA32(a_, b_[j], acc[i][j]);    \
      }                                                                                             \
    }                                                                                               \
  }
  G_LOAD(ra0, rb0, 0);
  G_LOAD(ra1, rb1, 1);
  __syncthreads();
  G_WRITE(ra0, rb0, sA0, sB0);
  if (nk > 2) G_LOAD(ra0, rb0, 2);
  __syncthreads();
#pragma unroll 1
  for (int kt = 0; kt < nk; kt += 2) {
    G_COMPUTE(sA0, sB0);
    G_WRITE(ra1, rb1, sA1, sB1);
    if (kt + 3 < nk) G_LOAD(ra1, rb1, kt + 3);
    __syncthreads();
    G_COMPUTE(sA1, sB1);
    if (kt + 2 < nk) G_WRITE(ra0, rb0, sA0, sB0);
    if (kt + 4 < nk) G_LOAD(ra0, rb0, kt + 4);
    __syncthreads();
  }
#undef G_LOAD
#undef G_WRITE
#undef G_COMPUTE
}


namespace pg8 {
#define PG8_LAS __attribute__((address_space(3)))
typedef unsigned short bf16_t;
constexpr int BM = 256, BK = 64, HALF = 128, HTB = HALF * BK * 2, STAGE_BYTES = 8 * HTB, NXCD = 8, WGM = 8;
__host__ __device__ __forceinline__ int lds_byte(int r, int c) { const int st = (r >> 4) * 2 + (c >> 5), rr = r & 15, cc = c & 31, ob = rr * 64 + cc * 2; return st * 1024 + (ob ^ (((ob >> 9) & 1) << 5)); }
__host__ __device__ __forceinline__ void stage_rc(int b, int& R, int& C) { const int st = b / 1024, sb = b % 1024, swz = sb ^ (((sb >> 9) & 1) << 5); R = (st >> 1) * 16 + swz / 64; C = (st & 1) * 32 + (swz % 64) / 2; }
__host__ __device__ __forceinline__ int perm32(int rho) { const int n = rho >> 4, i = rho & 15; return 8 * (i >> 2) + 4 * n + (i & 3); }
struct Unit { int pm, pn, br; };
struct Gemm { const bf16_t* A; const bf16_t* Bt; int M, N, K; };
struct StaticOrder {
    int nM, nN, nwg, G, c;
    __host__ __device__ void init(int M, int N, int G_, int c_) { nM = M / BM; nN = N / BM; nwg = nM * nN; G = G_; c = c_; }
    __host__ __device__ bool next(int i, Unit& u) const {
        const long L = (long)i * G + c; if (L >= nwg) return false;
        int wgid = (int)L; { const int q = nwg / NXCD, r = nwg % NXCD, xcd = wgid % NXCD, off = wgid / NXCD; wgid = (xcd < r ? xcd * (q + 1) : r * (q + 1) + (xcd - r) * q) + off; }
        const int nig = WGM * nN, gid = wgid / nig, fm = gid * WGM, gsz = (nM - fm) < WGM ? (nM - fm) : WGM;
        u.pm = fm + ((wgid % nig) % gsz); u.pn = (wgid % nig) / gsz; u.br = 0; return true;
    }
    __device__ __forceinline__ void a_ready(const Unit&) const {}
    __device__ __forceinline__ void done(const Unit&) const {}
    __device__ __forceinline__ const char* pa(const Unit& u, const Gemm& g) const { return (const char*)g.A + (size_t)u.pm * (size_t)(2 * BM) * g.K; }
    __device__ __forceinline__ const char* pb(const Unit& u, const Gemm& g) const { return (const char*)g.Bt + (size_t)u.pn * (size_t)(2 * BM) * g.K; }
};
template <class Epi, class Sched>
__device__ __forceinline__ void gemm_phase(PG8_LAS unsigned char* lds, const Gemm g, const Sched& S, const Epi& E) {
    constexpr bool STAMP = false; unsigned long long* stamps = nullptr;
    const int tid = rtid(), wid = __builtin_amdgcn_readfirstlane(tid >> 6), lane = tid & 63, wr = wid >> 2, wc = wid & 3, fr = lane & 15, fq = lane >> 4;
    const int K = g.K, nt = K / BK;
    int ts_lo = 0, ts_hi = 0, nts = 0; const unsigned long long rt_entry = STAMP ? 0ull : 0ull;
#define PG8_STAMP() do { if (STAMP && wid == 0 && nts < 64) { const unsigned long long _c = 0ull; \
        ts_lo = (lane == nts) ? (int)(unsigned)_c : ts_lo; ts_hi = (lane == nts) ? (int)(unsigned)(_c >> 32) : ts_hi; ++nts; } } while (0)
    PG8_STAMP();
    unsigned voffA[2], voffB[2];
#pragma unroll
    for (int i = 0; i < 2; ++i) { int R, C; stage_rc(tid * 16 + i * 8192, R, C); const int Rb = Epi::PERM ? ((R & ~31) + perm32(R & 31)) : R;
        voffA[i] = (unsigned)(R * K + C) * 2u; voffB[i] = (unsigned)(Rb * K + C) * 2u; }
    const size_t kstep = (size_t)(BK * 2);
    const size_t hstep = (size_t)HALF * K * 2;
    const size_t tstep = 2 * hstep;
    const unsigned ldsw = (unsigned)wid * 1024u;
    const int aoff = lds_byte(wr * 64 + fr, fq * 8), boff = lds_byte(wc * 32 + fr, fq * 8);
#define PG8_SA(b, h) (((b) * 2 + (h)) * HTB)
#define PG8_SB(b, h) ((4 + (b) * 2 + (h)) * HTB)
#define PG8_STAGE(bufoff, gbase, voff) do { _Pragma("unroll") for (int _i = 0; _i < 2; ++_i) \
        __builtin_amdgcn_global_load_lds((const unsigned*)((const char*)(gbase) + (voff)[_i]), (PG8_LAS unsigned*)(lds + (bufoff) + ldsw + _i * 8192), 16, 0, 0); } while (0)
#define PG8_LDA(dst, b, h) do { _Pragma("unroll") for (int m = 0; m < 4; ++m) _Pragma("unroll") for (int k = 0; k < 2; ++k) dst[m][k] = *(const PG8_LAS bf16x8*)(lds + PG8_SA(b, h) + aoff + m * 2048 + k * 1024); } while (0)
#define PG8_LDB(dst, b, h) do { _Pragma("unroll") for (int n = 0; n < 2; ++n) _Pragma("unroll") for (int k = 0; k < 2; ++k) dst[n][k] = *(const PG8_LAS bf16x8*)(lds + PG8_SB(b, h) + boff + n * 2048 + k * 1024); } while (0)
#define PG8_MMA(ai, bj, At, Bt) do { __builtin_amdgcn_s_setprio(1); _Pragma("unroll") for (int m = 0; m < 4; ++m) _Pragma("unroll") for (int n = 0; n < 2; ++n) _Pragma("unroll") for (int k = 0; k < 2; ++k) \
        acc[ai][bj][m][n] = __builtin_amdgcn_mfma_f32_16x16x32_bf16(Bt[n][k], At[m][k], acc[ai][bj][m][n], 0, 0, 0); __builtin_amdgcn_s_setprio(0); } while (0)
#define PG8_WAIT_V(n) asm volatile("s_waitcnt vmcnt(" #n ")" ::: "memory")
#define PG8_WAIT_L(n) asm volatile("s_waitcnt lgkmcnt(" #n ")" ::: "memory")
#define PG8_BAR __builtin_amdgcn_s_barrier()
#define PG8_SCHED __builtin_amdgcn_sched_barrier(0)
    Unit cur, nxt; int ui = 0;
    if (!S.next(0, cur)) return;
    f32x4 acc[2][2][4][2];
#pragma unroll
    for (int a = 0; a < 2; ++a)
#pragma unroll
        for (int b = 0; b < 2; ++b)
#pragma unroll
            for (int m = 0; m < 4; ++m)
#pragma unroll
                for (int n = 0; n < 2; ++n) acc[a][b][m][n] = (f32x4){0.f, 0.f, 0.f, 0.f};
    bf16x8 At[4][2], B0[2][2], B1[2][2];
    const char* cA = S.pa(cur, g); const char* cB = S.pb(cur, g);
    S.a_ready(cur);
    PG8_STAGE(PG8_SB(0, 0), cB, voffB); PG8_STAGE(PG8_SA(0, 0), cA, voffA); PG8_STAGE(PG8_SB(0, 1), cB + hstep, voffB); PG8_STAGE(PG8_SA(0, 1), cA + hstep, voffA);
    if (wr == 1) PG8_BAR;
    PG8_WAIT_V(4); PG8_BAR;
    PG8_STAGE(PG8_SB(1, 0), cB + kstep, voffB); PG8_STAGE(PG8_SA(1, 0), cA + kstep, voffA); PG8_STAGE(PG8_SB(1, 1), cB + hstep + kstep, voffB);
    PG8_WAIT_V(6); PG8_BAR;
    PG8_STAMP();
    for (;;) {
        const bool has_next = S.next(ui + 1, nxt);
        const char* nA = has_next ? S.pa(nxt, g) : cA; const char* nB = has_next ? S.pb(nxt, g) : cB;
        for (int t = 0; t < nt; t += 2) {
            const bool last = (t == nt - 2);
            const char* a1 = cA + (size_t)(t + 1) * kstep;
            const char* a2 = last ? nA : cA + (size_t)(t + 2) * kstep; const char* b2 = last ? nB : cB + (size_t)(t + 2) * kstep;
            const char* a3 = a2 + kstep; const char* b3 = b2 + kstep;
            if (last && has_next) S.a_ready(nxt);
            PG8_LDB(B0, 0, 0); PG8_SCHED; PG8_LDA(At, 0, 0); PG8_STAGE(PG8_SA(1, 1), a1 + hstep, voffA);
            PG8_WAIT_L(8); PG8_BAR; PG8_WAIT_L(0); PG8_MMA(0, 0, At, B0); PG8_BAR; PG8_SCHED;
            PG8_LDB(B1, 0, 1); PG8_STAGE(PG8_SB(0, 0), b2, voffB);
            PG8_BAR; PG8_WAIT_L(0); PG8_MMA(0, 1, At, B1); PG8_BAR;
            PG8_LDA(At, 0, 1); PG8_STAGE(PG8_SA(0, 0), a2, voffA);
            PG8_BAR; PG8_WAIT_L(0); PG8_MMA(1, 0, At, B0); PG8_BAR; PG8_SCHED;
            PG8_STAGE(PG8_SB(0, 1), b2 + hstep, voffB);
            PG8_WAIT_V(6); PG8_BAR; PG8_MMA(1, 1, At, B1); PG8_BAR;
            PG8_LDB(B0, 1, 0); PG8_SCHED; PG8_LDA(At, 1, 0); PG8_STAGE(PG8_SA(0, 1), a2 + hstep, voffA);
            PG8_WAIT_L(8); PG8_BAR; PG8_WAIT_L(0); PG8_MMA(0, 0, At, B0); PG8_BAR; PG8_SCHED;
            PG8_LDB(B1, 1, 1); PG8_STAGE(PG8_SB(1, 0), b3, voffB);
            PG8_BAR; PG8_WAIT_L(0); PG8_MMA(0, 1, At, B1); PG8_BAR;
            PG8_LDA(At, 1, 1); PG8_STAGE(PG8_SA(1, 0), a3, voffA);
            PG8_BAR; PG8_WAIT_L(0); PG8_MMA(1, 0, At, B0); PG8_BAR; PG8_SCHED;
            PG8_STAGE(PG8_SB(1, 1), b3 + hstep, voffB);
            PG8_WAIT_V(6); PG8_BAR; PG8_MMA(1, 1, At, B1); PG8_BAR;
        }
        PG8_STAMP();
        if constexpr (!Epi::AFTER_DRAIN) { E(acc, cur, wr, wc, fr, fq); S.done(cur); }
        PG8_STAMP();
        if (!has_next) break;
#pragma unroll
        for (int a = 0; a < 2; ++a)
#pragma unroll
            for (int b = 0; b < 2; ++b)
#pragma unroll
                for (int m = 0; m < 4; ++m)
#pragma unroll
                    for (int n = 0; n < 2; ++n) acc[a][b][m][n] = (f32x4){0.f, 0.f, 0.f, 0.f};
        cur = nxt; cA = nA; cB = nB; ++ui;
    }
    PG8_WAIT_V(0);
    if (wr == 0) PG8_BAR;
    PG8_BAR;
    if constexpr (Epi::AFTER_DRAIN) { E.fused(acc, cur, wr, wc, fr, fq, lds, wid, lane); S.done(cur); }
    PG8_STAMP();
    if (STAMP && wid == 0) { stamps[lane] = lane < nts ? (((unsigned long long)(unsigned)ts_hi << 32) | (unsigned)ts_lo) : 0ull;
        if (lane == 62) stamps[62] = rt_entry; if (lane == 63) stamps[63] = 0ull; }
#undef PG8_STAMP
#undef PG8_SA
#undef PG8_SB
#undef PG8_STAGE
#undef PG8_LDA
#undef PG8_LDB
#undef PG8_MMA
#undef PG8_WAIT_V
#undef PG8_WAIT_L
#undef PG8_BAR
#undef PG8_SCHED
}

}

struct EpiP {
  static constexpr bool PERM = true, AFTER_DRAIN = false;
  u16* P;
  DI void operator()(const f32x4 (&acc)[2][2][4][2], const pg8::Unit& u, int wr, int wc, int fr, int fq) const {
    const int row0 = u.pm * 256 + wr * 64 + fr, col0 = u.pn * 256 + wc * 32 + 8 * fq;
#pragma unroll
    for (int ai = 0; ai < 2; ++ai)
#pragma unroll
      for (int m = 0; m < 4; ++m) {
        u16* rowp = P + (size_t)(row0 + ai * 128 + m * 16) * PW + col0;
#pragma unroll
        for (int bj = 0; bj < 2; ++bj) {
          if (col0 + bj * 128 < PW) {
            const f32x4 v0 = acc[ai][bj][m][0], v1 = acc[ai][bj][m][1];
            u32x4 w; w.x = pk2(v0[0], v0[1]); w.y = pk2(v0[2], v0[3]); w.z = pk2(v1[0], v1[1]); w.w = pk2(v1[2], v1[3]);
            *(u32x4*)(rowp + bj * 128) = w;
          }
        }
      }
  }
};
struct EpiX {
  static constexpr bool PERM = false, AFTER_DRAIN = false;
  const float* xin; float* xout;
  DI void operator()(const f32x4 (&acc)[2][2][4][2], const pg8::Unit& u, int wr, int wc, int fr, int fq) const {
    int row0 = u.pm * 256 + wr * 64 + fr, col0 = u.pn * 256 + wc * 32 + 4 * fq;
    asm volatile("" : "+v"(row0), "+v"(col0));
#pragma unroll
    for (int am = 0; am < 4; ++am) {
      const int ai = am >> 1, mb = (am & 1) * 2;
      f32x4 xv[4][2][2];
#pragma unroll
      for (int m = mb; m < mb + 2; ++m)
#pragma unroll
        for (int bj = 0; bj < 2; ++bj)
#pragma unroll
          for (int n = 0; n < 2; ++n)
            xv[m][bj][n] = *(const f32x4*)(xin + (size_t)(row0 + ai * 128 + m * 16) * D_ + col0 + bj * 128 + n * 16);
#pragma unroll
      for (int m = mb; m < mb + 2; ++m)
#pragma unroll
        for (int bj = 0; bj < 2; ++bj)
#pragma unroll
          for (int n = 0; n < 2; ++n)
            *(f32x4*)(xout + (size_t)(row0 + ai * 128 + m * 16) * D_ + col0 + bj * 128 + n * 16) = xv[m][bj][n] + acc[ai][bj][m][n];
      __builtin_amdgcn_sched_barrier(0);
    }
  }
};

DI size_t wtile(int n0, int K) { return (size_t)(n0 >> 7) * (size_t)(K >> 6) * 8192; }
DI size_t htile(int m0) { return (size_t)(m0 >> 8) * 16 * 16384 + (size_t)(m0 & 255) * 64; }

template <int MI, int NJ>
DI void zero_acc(f32x16 (&acc)[MI][NJ]) {
#pragma unroll
  for (int i = 0; i < MI; ++i)
#pragma unroll
    for (int j = 0; j < NJ; ++j)
#pragma unroll
      for (int e = 0; e < 16; ++e) acc[i][j][e] = 0.f;
}

#define TILE_WALK_BEGIN(MT, NT, SM, SN)                                                   \
  {                                                                                       \
    const int xg_ = bid & 7, loc_ = bid >> 3, nloc_ = nblk >> 3;                          \
    const int nsn_ = ((NT) + (SN) - 1) / (SN), nst_ = (((MT) + (SM) - 1) / (SM)) * nsn_;  \
    for (int st_ = xg_; st_ < nst_; st_ += 8)                                             \
      for (int j_ = loc_; j_ < (SM) * (SN); j_ += nloc_) {                                \
        const int mi = (st_ / nsn_) * (SM) + j_ / (SN), ni = (st_ % nsn_) * (SN) + j_ % (SN); \
        if (mi >= (MT) || ni >= (NT)) continue;
#define TILE_WALK_END }}

DI int t5_bucket(int rel) {
  int n = rel < 0 ? -rel : rel;
  float nf = (float)(n > 1 ? n : 1);
  int large = 8 + (int)(logf(nf / 8.f) / logf(16.f) * 8.f);
  large = large < 15 ? large : 15;
  return (rel > 0 ? 16 : 0) + (n < 8 ? n : large);
}

DI void prep_job(const float* __restrict__ src, int K, int Nsrc, u16* __restrict__ dst, int Ndst, int mode,
                 const float* __restrict__ scale, char* smem, int bid, int nblk, bool rowmajor = false) {
  u16* sT = (u16*)smem;
  const int tid = otid();
  const int ntn = Ndst >> 6, ntk = K >> 6;
  float v[16];
  auto gl = [&](int t) {
    const int n0 = (t / ntk) << 6, k0 = (t % ntk) << 6;
    const int n = n0 + (tid & 63);
    int sc = n;
    if (mode == 1) sc = (n < 1536) ? n : (n < 6912 ? n + 16 : (n < 6928 ? n - 6912 + 1536 : -1));
#pragma unroll
    for (int i = 0; i < 16; ++i) {
      const int k = i * 4 + (tid >> 6);
      float x = 0.f;
      if (sc >= 0) x = src[(size_t)(k0 + k) * Nsrc + sc];
      if (scale) x *= scale[k0 + k];
      v[i] = x;
    }
  };
  if (bid < ntn * ntk) gl(bid);
  for (int t = bid; t < ntn * ntk; t += nblk) {
    const int n0 = (t / ntk) << 6, k0 = (t % ntk) << 6;
    __syncthreads();
#pragma unroll
    for (int i = 0; i < 16; ++i) sT[(tid & 63) * 72 + i * 4 + (tid >> 6)] = f2bf(v[i]);
    if (t + nblk < ntn * ntk) gl(t + nblk);
    __syncthreads();
    const int nn = tid >> 2, ks = (tid & 3) * 16;
    u32x4 v0 = *(const u32x4*)(sT + nn * 72 + ks), v1 = *(const u32x4*)(sT + nn * 72 + ks + 8);
    u16* d = rowmajor ? dst + (size_t)(n0 + nn) * K + k0 + ks
                      : dst + ((size_t)((n0 + nn) >> 7) * (size_t)(K >> 6) + (size_t)(k0 >> 6)) * 8192 + (size_t)((n0 + nn) & 127) * 64 + ks;
    *(u32x4*)d = v0;
    *(u32x4*)(d + 8) = v1;
  }
}

DI void phase_prologue(const Params& p, char* smem, int bid, int nblk) {
  const int tid = otid(), lane = tid & 63, w = tid >> 6;
  for (int i = bid * 256 + tid; i < 12 * 4095; i += nblk * 256) {
    const int hd = i / 4095, idx = i % 4095;
    p.lut[hd * LUTS + idx] = p.in[2][t5_bucket(idx - 2047) * 12 + hd];
  }
  for (int row = bid * 4 + w; row < NBATCH * MEML; row += nblk * 4) {
    const float* src = p.in[1] + (size_t)row * D_;
    float ss = 0.f;
#pragma unroll
    for (int i = 0; i < 4; ++i) {
      f32x4 v = *(const f32x4*)(src + i * 256 + lane * 4);
      ss += v[0] * v[0] + v[1] * v[1] + v[2] * v[2] + v[3] * v[3];
      u32x2 o; o.x = pk2(v[0], v[1]); o.y = pk2(v[2], v[3]);
      *(u32x2*)(p.memb + (size_t)row * D_ + i * 256 + lane * 4) = o;
    }
    ss = wave_sum(ss);
    if (lane == 0) p.memrs[row] = rsqrtf(ss / (float)D_ + EPS_);
  }
  for (int l = 0; l < 2; ++l) {
    u16* W = p.W + (size_t)l * LAYER_W;
    prep_job(p.in[5] + (size_t)l * D_ * 6928, D_, 6928, W + WIN_OFF, PW, 1, nullptr, smem, bid, nblk, true);
    for (int i = 0; i < 5; ++i)
      prep_job(p.in[27] + ((size_t)l * 5 + i) * D_ * D_, D_, D_, W + WMG_OFF + (size_t)i * D_ * D_, D_, 0, nullptr, smem, bid, nblk, true);
    for (int i = 0; i < 5; ++i)
      prep_job(p.in[29] + ((size_t)l * 5 + i) * BWID * D_, BWID, D_, W + WBR_OFF + (size_t)i * D_ * BWID, D_, 0, nullptr, smem, bid, nblk, true);
    prep_job(p.in[30] + (size_t)l * D_ * D_, D_, D_, W + WOUT_OFF, D_, 0, nullptr, smem, bid, nblk, true);
    prep_job(p.in[23] + (size_t)l * BWID * BWID, BWID, BWID, W + WGLU_OFF, BWID, 0, nullptr, smem, bid, nblk, true);
    prep_job(p.in[26] + (size_t)l * D_ * D_, D_, D_, W + WKV_OFF, D_, 0, p.in[25] + (size_t)l * D_, smem, bid, nblk);
  }
}

DI void phase_norm(const float* __restrict__ x, const float* __restrict__ g, u16* __restrict__ hdst, int nrows, int bid, int nblk) {
  const int tid_ = otid(), lane = tid_ & 63, w = tid_ >> 6;
  const int stride = nblk * 4;
  for (int row0 = bid * 4 + w; row0 < nrows; row0 += 4 * stride) {
    f32x4 v[4][4];
    float ss[4] = {0.f, 0.f, 0.f, 0.f};
#pragma unroll
    for (int u = 0; u < 4; ++u) {
      const int row = row0 + u * stride;
      if (row < nrows) {
        const float* src = x + (size_t)row * D_;
#pragma unroll
        for (int i = 0; i < 4; ++i) v[u][i] = *(const f32x4*)(src + i * 256 + lane * 4);
      }
    }
#pragma unroll
    for (int u = 0; u < 4; ++u) {
      const int row = row0 + u * stride;
      if (row < nrows) {
#pragma unroll
        for (int i = 0; i < 4; ++i) ss[u] += v[u][i][0] * v[u][i][0] + v[u][i][1] * v[u][i][1] + v[u][i][2] * v[u][i][2] + v[u][i][3] * v[u][i][3];
        ss[u] = wave_sum(ss[u]);
        const float rs = rsqrtf(ss[u] / (float)D_ + EPS_);
#pragma unroll
        for (int i = 0; i < 4; ++i) {
          f32x4 gg = *(const f32x4*)(g + i * 256 + lane * 4);
          u32x2 o; o.x = pk2(v[u][i][0] * rs * gg[0], v[u][i][1] * rs * gg[1]); o.y = pk2(v[u][i][2] * rs * gg[2], v[u][i][3] * rs * gg[3]);
          const int c = i * 256 + lane * 4;
          *(u32x2*)(hdst + (size_t)row * D_ + c) = o;
        }
      }
    }
  }
}

DI void phase_final(float* __restrict__ x, const float* __restrict__ g, int nrows, int bid, int nblk) {
  const int tid_ = otid(), lane = tid_ & 63, w = tid_ >> 6;
  const int stride = nblk * 4;
  for (int row0 = bid * 4 + w; row0 < nrows; row0 += 4 * stride) {
    f32x4 v[4][4];
    float ss[4] = {0.f, 0.f, 0.f, 0.f};
#pragma unroll
    for (int u = 0; u < 4; ++u) {
      const int row = row0 + u * stride;
      if (row < nrows) {
        const float* src = x + (size_t)row * D_;
#pragma unroll
        for (int i = 0; i < 4; ++i) v[u][i] = *(const f32x4*)(src + i * 256 + lane * 4);
      }
    }
#pragma unroll
    for (int u = 0; u < 4; ++u) {
      const int row = row0 + u * stride;
      if (row < nrows) {
        float* src = x + (size_t)row * D_;
#pragma unroll
        for (int i = 0; i < 4; ++i) ss[u] += v[u][i][0] * v[u][i][0] + v[u][i][1] * v[u][i][1] + v[u][i][2] * v[u][i][2] + v[u][i][3] * v[u][i][3];
        ss[u] = wave_sum(ss[u]);
        const float rs = rsqrtf(ss[u] / (float)D_ + EPS_);
#pragma unroll
        for (int i = 0; i < 4; ++i) {
          f32x4 gg = *(const f32x4*)(g + i * 256 + lane * 4);
          f32x4 o; o[0] = v[u][i][0] * rs * gg[0]; o[1] = v[u][i][1] * rs * gg[1]; o[2] = v[u][i][2] * rs * gg[2]; o[3] = v[u][i][3] * rs * gg[3];
          *(f32x4*)(src + i * 256 + lane * 4) = o;
        }
      }
    }
  }
}

DI void phase_kv(const Params& p, char* smem, int bid, int nblk) {
  const int tid_ = otid(), lane = tid_ & 63, w = tid_ >> 6, wm = w >> 1, wn = w & 1, r = lane & 31, h = lane >> 5;
  for (int t = bid; t < 2 * 32 * 8; t += nblk) {
    const int l = t >> 8, tt = t & 255, m0 = (tt >> 3) * 128, n0 = (tt & 7) * 128;
    f32x16 acc[2][2];
    zero_acc<2, 2>(acc);
    gemm_acc<128, 128>(p.memb + (size_t)m0 * D_, D_, 64, p.W + (size_t)l * LAYER_W + WKV_OFF + wtile(n0, D_), 64, 8192, D_, acc, smem);
    u16* dst = p.KV + (size_t)l * NBATCH * MEML * D_;
#pragma unroll
    for (int i = 0; i < 2; ++i)
#pragma unroll
      for (int e = 0; e < 16; ++e) {
        const int row = m0 + wm * 64 + 32 * i + crow(e, h);
        const float rs = p.memrs[row];
#pragma unroll
        for (int j = 0; j < 2; ++j) dst[(size_t)row * D_ + n0 + wn * 64 + 32 * j + r] = f2bf(acc[i][j][e] * rs);
      }
  }
}

DI void phase_inproj(const Params& p, int l, int Tg, char* smem, int bid, int nblk) {
  const pg8::Gemm g{p.h, p.W + (size_t)l * LAYER_W + WIN_OFF, Tg, 7168, D_};
  pg8::StaticOrder S; S.init(Tg, 7168, nblk, bid);
  const EpiP E{p.P};
  pg8::gemm_phase<EpiP, pg8::StaticOrder>((PG8_LAS unsigned char*)smem, g, S, E);
}

struct EpiG {
  static constexpr bool PERM = true, AFTER_DRAIN = false;
  unsigned char* G; const float* bias;
  DI void operator()(const f32x4 (&acc)[2][2][4][2], const pg8::Unit& u, int wr, int wc, int fr, int fq) const {
    int row0 = u.pm * 256 + wr * 64 + fr, col0 = u.pn * 256 + wc * 32 + 8 * fq;
    asm volatile("" : "+v"(row0), "+v"(col0));
    f32x4 bv[2][2];
#pragma unroll
    for (int bj = 0; bj < 2; ++bj)
#pragma unroll
      for (int n = 0; n < 2; ++n) bv[bj][n] = *(const f32x4*)(bias + col0 + bj * 128 + 4 * n);
#pragma unroll
    for (int ai = 0; ai < 2; ++ai)
#pragma unroll
      for (int m = 0; m < 4; ++m) {
        unsigned char* rowp = G + (size_t)(row0 + ai * 128 + m * 16) * (5 * D_) + col0;
#pragma unroll
        for (int bj = 0; bj < 2; ++bj) {
          const f32x4 v0 = acc[ai][bj][m][0] + bv[bj][0], v1 = acc[ai][bj][m][1] + bv[bj][1];
          u32x2 w;
          w.x = (unsigned)(sigmoidf_(v0[0]) * 255.f + 0.5f) | ((unsigned)(sigmoidf_(v0[1]) * 255.f + 0.5f) << 8) |
                ((unsigned)(sigmoidf_(v0[2]) * 255.f + 0.5f) << 16) | ((unsigned)(sigmoidf_(v0[3]) * 255.f + 0.5f) << 24);
          w.y = (unsigned)(sigmoidf_(v1[0]) * 255.f + 0.5f) | ((unsigned)(sigmoidf_(v1[1]) * 255.f + 0.5f) << 8) |
                ((unsigned)(sigmoidf_(v1[2]) * 255.f + 0.5f) << 16) | ((unsigned)(sigmoidf_(v1[3]) * 255.f + 0.5f) << 24);
          *(u32x2*)(rowp + bj * 128) = w;
        }
      }
  }
};

DI void phase_gates(const Params& p, int l, int Tg, unsigned char* G, char* smem, int bid, int nblk) {
  const pg8::Gemm g{p.h, p.W + (size_t)l * LAYER_W + WMG_OFF, Tg, 5 * D_, D_};
  pg8::StaticOrder S; S.init(Tg, 5 * D_, nblk, bid);
  const EpiG E{G, p.in[28] + (size_t)l * 5 * D_};
  pg8::gemm_phase<EpiG, pg8::StaticOrder>((PG8_LAS unsigned char*)smem, g, S, E);
}

struct EpiGLU {
  static constexpr bool PERM = true, AFTER_DRAIN = false;
  const u16* g; const u16* zs; u16* o3; const float* gb;
  DI void operator()(const f32x4 (&acc)[2][2][4][2], const pg8::Unit& u, int wr, int wc, int fr, int fq) const {
    int row0 = u.pm * 256 + wr * 64 + fr, col0 = u.pn * 256 + wc * 32 + 8 * fq;
    asm volatile("" : "+v"(row0), "+v"(col0));
    f32x4 bv[2][2];
#pragma unroll
    for (int bj = 0; bj < 2; ++bj)
#pragma unroll
      for (int n = 0; n < 2; ++n) bv[bj][n] = *(const f32x4*)(gb + col0 + bj * 128 + 4 * n);
#pragma unroll
    for (int am = 0; am < 4; ++am) {
      const int ai = am >> 1, mb = (am & 1) * 2;
      u32x4 gvv[4][2], zvv[4][2];
#pragma unroll
      for (int m = mb; m < mb + 2; ++m)
#pragma unroll
        for (int bj = 0; bj < 2; ++bj) {
          const size_t row = (size_t)(row0 + ai * 128 + m * 16);
          const int col = col0 + bj * 128;
          gvv[m][bj] = *(const u32x4*)(g + row * BWID + col);
          zvv[m][bj] = *(const u32x4*)(zs + row * BWID + col);
        }
#pragma unroll
      for (int m = mb; m < mb + 2; ++m)
#pragma unroll
        for (int bj = 0; bj < 2; ++bj) {
          const size_t row = (size_t)(row0 + ai * 128 + m * 16);
          const int col = col0 + bj * 128;
          const u32x4 gv = gvv[m][bj], zv = zvv[m][bj];
          const f32x4 v0 = acc[ai][bj][m][0] + bv[bj][0], v1 = acc[ai][bj][m][1] + bv[bj][1];
          u32x4 w;
          w.x = pk2(bflo(gv.x) * sigmoidf_(v0[0]) * bflo(zv.x), bfhi(gv.x) * sigmoidf_(v0[1]) * bfhi(zv.x));
          w.y = pk2(bflo(gv.y) * sigmoidf_(v0[2]) * bflo(zv.y), bfhi(gv.y) * sigmoidf_(v0[3]) * bfhi(zv.y));
          w.z = pk2(bflo(gv.z) * sigmoidf_(v1[0]) * bflo(zv.z), bfhi(gv.z) * sigmoidf_(v1[1]) * bfhi(zv.z));
          w.w = pk2(bflo(gv.w) * sigmoidf_(v1[2]) * bflo(zv.w), bfhi(gv.w) * sigmoidf_(v1[3]) * bfhi(zv.w));
          *(u32x4*)(o3 + row * BWID + col) = w;
        }
      __builtin_amdgcn_sched_barrier(0);
    }
  }
};

DI void phase_glu(const Params& p, int l, int Tg, char* smem, int bid, int nblk) {
  const pg8::Gemm g{p.s5f, p.W + (size_t)l * LAYER_W + WGLU_OFF, Tg, BWID, BWID};
  pg8::StaticOrder S; S.init(Tg, BWID, nblk, bid);
  const EpiGLU E{p.s5f, p.syb, p.o3, p.in[24] + (size_t)l * BWID};
  pg8::gemm_phase<EpiGLU, pg8::StaticOrder>((PG8_LAS unsigned char*)smem, g, S, E);
}

struct BranchOrder {
  const u16* ob0; size_t ostride; const u16* wbr; int c, ntile, G;
  DI bool next(int i, pg8::Unit& u) const {
    const int t = c + (i / 5) * G;
    if (t >= ntile) return false;
    u.pm = t >> 2; u.pn = t & 3; u.br = i % 5; return true;
  }
  DI void a_ready(const pg8::Unit&) const {}
  DI void done(const pg8::Unit&) const {}
  DI const char* pa(const pg8::Unit& u, const pg8::Gemm& g) const { return (const char*)(ob0 + (size_t)u.br * ostride + (size_t)u.pm * 256 * BWID); }
  DI const char* pb(const pg8::Unit& u, const pg8::Gemm& g) const { return (const char*)(wbr + (size_t)u.br * D_ * BWID + (size_t)u.pn * 256 * BWID); }
};
struct EpiY {
  static constexpr bool PERM = true, AFTER_DRAIN = false;
  const unsigned char* G; u16* y;
  DI void operator()(const f32x4 (&acc)[2][2][4][2], const pg8::Unit& u, int wr, int wc, int fr, int fq) const {
    int row0 = u.pm * 256 + wr * 64 + fr, col0 = u.pn * 256 + wc * 32 + 8 * fq;
    asm volatile("" : "+v"(row0), "+v"(col0));
    const float ks_ = 1.f / 255.f;
#pragma unroll
    for (int ai = 0; ai < 2; ++ai) {
      u32x2 gq[4][2]; u32x4 yv[4][2];
#pragma unroll
      for (int m = 0; m < 4; ++m)
#pragma unroll
        for (int bj = 0; bj < 2; ++bj) {
          const size_t row = (size_t)(row0 + ai * 128 + m * 16);
          const int col = col0 + bj * 128;
          gq[m][bj] = *(const u32x2*)(G + row * (5 * D_) + u.br * D_ + col);
          yv[m][bj] = (u32x4){0u, 0u, 0u, 0u};
          if (u.br > 0) yv[m][bj] = *(const u32x4*)(y + row * D_ + col);
        }
#pragma unroll
      for (int m = 0; m < 4; ++m)
#pragma unroll
        for (int bj = 0; bj < 2; ++bj) {
          const size_t row = (size_t)(row0 + ai * 128 + m * 16);
          const int col = col0 + bj * 128;
          const u32x2 g = gq[m][bj]; const u32x4 yy = yv[m][bj];
          const float g0 = (float)(g.x & 255u) * ks_, g1 = (float)((g.x >> 8) & 255u) * ks_, g2 = (float)((g.x >> 16) & 255u) * ks_, g3 = (float)(g.x >> 24) * ks_;
          const float g4 = (float)(g.y & 255u) * ks_, g5 = (float)((g.y >> 8) & 255u) * ks_, g6 = (float)((g.y >> 16) & 255u) * ks_, g7 = (float)(g.y >> 24) * ks_;
          const f32x4 v0 = acc[ai][bj][m][0], v1 = acc[ai][bj][m][1];
          u32x4 w;
          w.x = pk2(bflo(yy.x) + g0 * v0[0], bfhi(yy.x) + g1 * v0[1]);
          w.y = pk2(bflo(yy.y) + g2 * v0[2], bfhi(yy.y) + g3 * v0[3]);
          w.z = pk2(bflo(yy.z) + g4 * v1[0], bfhi(yy.z) + g5 * v1[1]);
          w.w = pk2(bflo(yy.w) + g6 * v1[2], bfhi(yy.w) + g7 * v1[3]);
          *(u32x4*)(y + row * D_ + col) = w;
        }
      __builtin_amdgcn_sched_barrier(0);
    }
  }
};

DI void phase_merge(const Params& p, int l, int Tg, const unsigned char* G, u16* ydst, char* smem, int bid, int nblk) {
  const pg8::Gemm g{nullptr, nullptr, Tg, D_, BWID};
  BranchOrder S;
  S.ob0 = p.o0; S.ostride = (size_t)Tg * BWID;
  S.wbr = p.W + (size_t)l * LAYER_W + WBR_OFF; S.c = bid; S.G = nblk; S.ntile = (Tg / 256) * 4;
  const EpiY E{G, ydst};
  pg8::gemm_phase<EpiY, BranchOrder>((PG8_LAS unsigned char*)smem, g, S, E);
}

DI void phase_out(const Params& p, int l, int Tg, const u16* ysrc, const float* xin,
                  float* xout, char* smem, int bid, int nblk) {
  const pg8::Gemm g{ysrc, p.W + (size_t)l * LAYER_W + WOUT_OFF, Tg, D_, D_};
  pg8::StaticOrder S; S.init(Tg, D_, nblk, bid);
  const EpiX E{xin, xout};
  pg8::gemm_phase<EpiX, pg8::StaticOrder>((PG8_LAS unsigned char*)smem, g, S, E);
}

DI void phase_conv(const Params& p, int l, int Tg, int bid, int nblk) {
  const float* cw = p.in[6] + (size_t)l * 5 * 1024;
  const float* cb = p.in[7] + (size_t)l * 1024;
  const int total = Tg * 128, stride = nblk * 256;
  for (int idx0 = bid * 256 + otid(); idx0 < total; idx0 += 2 * stride) {
    const int c0 = (idx0 & 127) * 8;
    u32x4 xin[2][5];
    bool ok[2][5];
#pragma unroll
    for (int u = 0; u < 2; ++u) {
      const int idx = idx0 + u * stride;
      const int tok = idx >> 7, spos = tok & (S_ - 1);
#pragma unroll
      for (int k = 0; k < 5; ++k) {
        const int sp = spos + k - 2;
        ok[u][k] = (idx < total) && sp >= 0 && sp < S_;
        xin[u][k] = (u32x4){0u, 0u, 0u, 0u};
        if (ok[u][k]) xin[u][k] = *(const u32x4*)(p.P + (size_t)(tok + k - 2) * PW + c0);
      }
    }
    float acc[2][8];
#pragma unroll
    for (int j = 0; j < 8; ++j) { acc[0][j] = cb[c0 + j]; acc[1][j] = acc[0][j]; }
#pragma unroll
    for (int k = 0; k < 5; ++k) {
      float wv[8], f0[8], f1[8];
#pragma unroll
      for (int j = 0; j < 8; ++j) wv[j] = cw[k * 1024 + c0 + j];
      unpack8(xin[0][k], f0);
      unpack8(xin[1][k], f1);
#pragma unroll
      for (int j = 0; j < 8; ++j) { acc[0][j] += f0[j] * wv[j]; acc[1][j] += f1[j] * wv[j]; }
    }
#pragma unroll
    for (int u = 0; u < 2; ++u) {
      const int idx = idx0 + u * stride;
      if (idx < total) {
        u32x4 o;
        o.x = pk2(siluf_(acc[u][0]), siluf_(acc[u][1])); o.y = pk2(siluf_(acc[u][2]), siluf_(acc[u][3]));
        o.z = pk2(siluf_(acc[u][4]), siluf_(acc[u][5])); o.w = pk2(siluf_(acc[u][6]), siluf_(acc[u][7]));
        *(u32x4*)(p.xa + (size_t)(idx >> 7) * 1024 + c0) = o;
      }
    }
  }
}

template <int DQK, int DV>
DI void attn_pass(const bf16x8 (&qf)[DQK / 16], const u16* __restrict__ Kg, int ldk, const u16* __restrict__ Vg, int ldv,
                  int kt0, int kt1, int q_pos, int q_lo, const float* lut, int window, float m_init, float l_init,
                  f32x16 (&o)[DV / 32], float& l_out, u16* sK, u16* sV) {
  constexpr int LDK = DQK + 8, LDV = DV + 16, NKC = DQK / 32, NVC = DV / 32;
  const int tid = otid(), lane = tid & 63, r = lane & 31, h = lane >> 5;
  u32x4 rk[NKC], rv[NVC];
#pragma unroll
  for (int d = 0; d < DV / 32; ++d)
#pragma unroll
    for (int e = 0; e < 16; ++e) o[d][e] = 0.f;
  float m = m_init, lsum = (h == 0) ? l_init : 0.f;
  {
#pragma unroll
    for (int i = 0; i < NKC; ++i) { const int c = tid + 256 * i, row = c / (DQK / 8), col = (c % (DQK / 8)) * 8; rk[i] = *(const u32x4*)(Kg + (size_t)(kt0 * 64 + row) * ldk + col); }
#pragma unroll
    for (int i = 0; i < NVC; ++i) { const int c = tid + 256 * i, row = c / (DV / 8), col = (c % (DV / 8)) * 8; rv[i] = *(const u32x4*)(Vg + (size_t)(kt0 * 64 + row) * ldv + col); }
  }
#pragma unroll 1
  for (int kt = kt0; kt < kt1; ++kt) {
    __syncthreads();
#pragma unroll
    for (int i = 0; i < NKC; ++i) { const int c = tid + 256 * i, row = c / (DQK / 8), col = (c % (DQK / 8)) * 8; *(u32x4*)(sK + row * LDK + col) = rk[i]; }
#pragma unroll
    for (int i = 0; i < NVC; ++i) { const int c = tid + 256 * i, row = c / (DV / 8), col = (c % (DV / 8)) * 8; *(u32x4*)(sV + row * LDV + col) = rv[i]; }
    __syncthreads();
    if (kt + 1 < kt1) {
#pragma unroll
      for (int i = 0; i < NKC; ++i) { const int c = tid + 256 * i, row = c / (DQK / 8), col = (c % (DQK / 8)) * 8; rk[i] = *(const u32x4*)(Kg + (size_t)((kt + 1) * 64 + row) * ldk + col); }
#pragma unroll
      for (int i = 0; i < NVC; ++i) { const int c = tid + 256 * i, row = c / (DV / 8), col = (c % (DV / 8)) * 8; rv[i] = *(const u32x4*)(Vg + (size_t)((kt + 1) * 64 + row) * ldv + col); }
    }
    f32x16 s[2];
#pragma unroll
    for (int t = 0; t < 2; ++t) {
      bf16x8 ka[DQK / 16];
#pragma unroll
      for (int ks = 0; ks < DQK / 16; ++ks) ka[ks] = ldfrag(sK, LDK, 32 * t + r, 16 * ks + 8 * h);
#pragma unroll
      for (int e = 0; e < 16; ++e) s[t][e] = 0.f;
#pragma unroll
      for (int ks = 0; ks < DQK / 16; ++ks) s[t] = MFMA32(ka[ks], qf[ks], s[t]);
    }
    const int kbase = kt * 64;
    if (lut) {
      const bool far_ = (window == 0) && ((kbase - (q_lo + 31) >= 91) || (q_lo - (kbase + 63) >= 91));
      if (far_) {
        const float bconst = lut[(kbase > q_lo) ? 4000 : 100];
#pragma unroll
        for (int t = 0; t < 2; ++t)
#pragma unroll
          for (int e = 0; e < 16; ++e) s[t][e] += bconst;
      } else {
#pragma unroll
        for (int t = 0; t < 2; ++t)
#pragma unroll
          for (int e = 0; e < 16; ++e) {
            const int rel = kbase + 32 * t + crow(e, h) - q_pos;
            float v = s[t][e] + lut[rel + 2047];
            if (window > 0 && (rel > window || rel < -window)) v = -INFINITY;
            s[t][e] = v;
          }
      }
    }
    float mx = s[0][0];
#pragma unroll
    for (int t = 0; t < 2; ++t)
#pragma unroll
      for (int e = 0; e < 16; ++e) mx = fmaxf(mx, s[t][e]);
    mx = fmaxf(mx, __shfl_xor(mx, 32, 64));
    if (__builtin_amdgcn_ballot_w64(mx > m + 8.f) != 0ull) {
      const float mn = fmaxf(m, mx);
      const float alpha = __builtin_amdgcn_exp2f(m - mn);
      m = mn;
      lsum *= alpha;
#pragma unroll
      for (int d = 0; d < DV / 32; ++d)
#pragma unroll
        for (int e = 0; e < 16; ++e) o[d][e] *= alpha;
    }
    float ps = 0.f;
#pragma unroll
    for (int t = 0; t < 2; ++t)
#pragma unroll
      for (int e = 0; e < 16; ++e) { const float pv = __builtin_amdgcn_exp2f(s[t][e] - m); s[t][e] = pv; ps += pv; }
    lsum += ps;
    bf16x8 pf[2][2];
#pragma unroll
    for (int t = 0; t < 2; ++t)
#pragma unroll
      for (int s2 = 0; s2 < 2; ++s2) pf[t][s2] = pack8(s[t], s2);
#pragma unroll
    for (int d = 0; d < DV / 32; ++d) {
      bf16x8 va[2][2];
#pragma unroll
      for (int t = 0; t < 2; ++t)
#pragma unroll
        for (int s2 = 0; s2 < 2; ++s2) va[t][s2] = ldfrag_tr_perm(sV, LDV, 32 * t + 16 * s2, 32 * d, lane);
#pragma unroll
      for (int t = 0; t < 2; ++t)
#pragma unroll
        for (int s2 = 0; s2 < 2; ++s2) o[d] = MFMA32(va[t][s2], pf[t][s2], o[d]);
    }
  }
  lsum += __shfl_xor(lsum, 32, 64);
  l_out = lsum;
}

template <int DQK>
DI void load_qfrag(bf16x8 (&qf)[DQK / 16], const u16* qrow, float scale, int h) {
#pragma unroll
  for (int ks = 0; ks < DQK / 16; ++ks) {
    u32x4 v = *(const u32x4*)(qrow + 16 * ks + 8 * h);
    qf[ks] = __builtin_bit_cast(bf16x8, scale8(v, scale));
  }
}

DI void attn_lds(char* smem, u16*& sK, u16*& sV, float*& slut) {
  sK = (u16*)smem; sV = sK + 64 * 136; slut = (float*)(sV + 64 * 144);
}

DI void diff_item(const Params& p, int l, int item, char* smem) {
  const int tid = otid(), lane = tid & 63, w = tid >> 6, r = lane & 31, h = lane >> 5;
  const int bl = item >> 6, hd = (item >> 4) & 3, qb = item & 15;
  u16 *sK, *sV; float* slut;
  attn_lds(smem, sK, sV, slut);
  __syncthreads();
  {
    const float* gl = p.lut + hd * LUTS;
    const float v0 = gl[2047 - 256 + tid], v1 = gl[2047 + tid];
    const float vf = (tid < 2) ? gl[tid ? 4000 : 100] : 0.f;
    slut[2047 - 256 + tid] = v0 * 1.4426950408889634f; slut[2047 + tid] = v1 * 1.4426950408889634f;
    if (tid < 2) slut[tid ? 4000 : 100] = vf * 1.4426950408889634f;
  }
  const float lam_init = 0.8f - 0.6f * expf(-0.3f * (float)l);
  const float* lp = p.in[12] + (size_t)l * 4 * 64;
  const float d1 = wave_sum(lp[lane] * lp[64 + lane]), d2 = wave_sum(lp[128 + lane] * lp[192 + lane]);
  const float lam = expf(d1) - expf(d2) + lam_init;
  const int q_lo = qb * 128 + 32 * w, q_pos = q_lo + r;
  const size_t tokq = (size_t)bl * S_ + q_pos;
  const u16* Pb = p.P + (size_t)bl * S_ * PW;
  f32x16 o[4];
  float lt;
  u16* odst = p.o1 + tokq * BWID + hd * 128;
  {
    bf16x8 qf[4];
    load_qfrag<64>(qf, p.P + tokq * PW + P_DQ + (hd * 2 + 0) * 64, 0.125f * 1.4426950408889634f, h);
    attn_pass<64, 128>(qf, Pb + P_DK + (hd * 2 + 0) * 64, PW, Pb + P_DV + hd * 128, PW, 0, 32, q_pos, q_lo, slut, 0, -INFINITY, 0.f, o, lt, sK, sV);
    const float inv = 1.f / lt;
#pragma unroll
    for (int d = 0; d < 4; ++d)
#pragma unroll
      for (int g4 = 0; g4 < 4; ++g4) {
        u32x2 ov;
        ov.x = pk2(o[d][4 * g4 + 0] * inv, o[d][4 * g4 + 1] * inv);
        ov.y = pk2(o[d][4 * g4 + 2] * inv, o[d][4 * g4 + 3] * inv);
        *(u32x2*)(odst + 32 * d + 8 * g4 + 4 * h) = ov;
      }
  }
  {
    bf16x8 qf[4];
    load_qfrag<64>(qf, p.P + tokq * PW + P_DQ + (hd * 2 + 1) * 64, 0.125f * 1.4426950408889634f, h);
    attn_pass<64, 128>(qf, Pb + P_DK + (hd * 2 + 1) * 64, PW, Pb + P_DV + hd * 128, PW, 0, 32, q_pos, q_lo, slut, 0, -INFINITY, 0.f, o, lt, sK, sV);
    const float inv = lam / lt;
#pragma unroll
    for (int d = 0; d < 4; ++d)
#pragma unroll
      for (int g4 = 0; g4 < 4; ++g4) {
        const u32x2 pv = *(const u32x2*)(odst + 32 * d + 8 * g4 + 4 * h);
        o[d][4 * g4 + 0] = bflo(pv.x) - o[d][4 * g4 + 0] * inv;
        o[d][4 * g4 + 1] = bfhi(pv.x) - o[d][4 * g4 + 1] * inv;
        o[d][4 * g4 + 2] = bflo(pv.y) - o[d][4 * g4 + 2] * inv;
        o[d][4 * g4 + 3] = bfhi(pv.y) - o[d][4 * g4 + 3] * inv;
      }
  }
  float ss = 0.f;
#pragma unroll
  for (int d = 0; d < 4; ++d)
#pragma unroll
    for (int e = 0; e < 16; ++e) ss += o[d][e] * o[d][e];
  ss += __shfl_xor(ss, 32, 64);
  const float rs = rsqrtf(ss / 128.f + EPS_) * (1.f - lam_init);
  const float* sg = p.in[13] + (size_t)l * 128;
#pragma unroll
  for (int d = 0; d < 4; ++d)
#pragma unroll
    for (int g4 = 0; g4 < 4; ++g4) {
      const int dv = 32 * d + 8 * g4 + 4 * h;
      const u32x2 zz = *(const u32x2*)(p.P + tokq * PW + P_DZ + hd * 128 + dv);
      const float z0 = bflo(zz.x), z1 = bfhi(zz.x), z2 = bflo(zz.y), z3 = bfhi(zz.y);
      u32x2 ov;
      ov.x = pk2(o[d][4 * g4 + 0] * rs * sg[dv + 0] * siluf_(z0), o[d][4 * g4 + 1] * rs * sg[dv + 1] * siluf_(z1));
      ov.y = pk2(o[d][4 * g4 + 2] * rs * sg[dv + 2] * siluf_(z2), o[d][4 * g4 + 3] * rs * sg[dv + 3] * siluf_(z3));
      *(u32x2*)(odst + dv) = ov;
    }
}

DI void win_item(const Params& p, int l, int item, char* smem) {
  const int tid = otid(), lane = tid & 63, w = tid >> 6, r = lane & 31, h = lane >> 5;
  const int bl = item >> 7, qh = (item >> 4) & 7, qb = item & 15;
  const int kvh = qh >> 2;
  u16 *sK, *sV; float* slut;
  attn_lds(smem, sK, sV, slut);
  __syncthreads();
  {
    const float* gl = p.lut + (4 + qh) * LUTS;
    const float v0 = gl[2047 - 256 + tid], v1 = gl[2047 + tid];
    slut[2047 - 256 + tid] = v0 * 1.4426950408889634f; slut[2047 + tid] = v1 * 1.4426950408889634f;
  }
  const float sink = p.in[14][l * 8 + qh];
  const int q_lo = qb * 128 + 32 * w, q_pos = q_lo + r;
  const size_t tokq = (size_t)bl * S_ + q_pos;
  const u16* Pb = p.P + (size_t)bl * S_ * PW;
  int kt0 = qb * 2 - 2; if (kt0 < 0) kt0 = 0;
  int kt1 = qb * 2 + 4; if (kt1 > 32) kt1 = 32;
  f32x16 o[2];
  float lt;
  bf16x8 qf[4];
  load_qfrag<64>(qf, p.P + tokq * PW + P_CQ + qh * 64, 0.125f * 1.4426950408889634f, h);
  attn_pass<64, 64>(qf, Pb + P_CK + kvh * 64, PW, Pb + P_CV + kvh * 64, PW, kt0, kt1, q_pos, q_lo, slut, 128, sink * 1.4426950408889634f, 1.f, o, lt, sK, sV);
  const float inv = 1.f / lt;
#pragma unroll
  for (int d = 0; d < 2; ++d)
#pragma unroll
    for (int g4 = 0; g4 < 4; ++g4) {
      const int dv = 32 * d + 8 * g4 + 4 * h;
      const u32x2 zz = *(const u32x2*)(p.P + tokq * PW + P_CZ + qh * 64 + dv);
      const float z0 = bflo(zz.x), z1 = bfhi(zz.x), z2 = bflo(zz.y), z3 = bfhi(zz.y);
      u32x2 ov;
      ov.x = pk2(o[d][4 * g4 + 0] * inv * siluf_(z0), o[d][4 * g4 + 1] * inv * siluf_(z1));
      ov.y = pk2(o[d][4 * g4 + 2] * inv * siluf_(z2), o[d][4 * g4 + 3] * inv * siluf_(z3));
      *(u32x2*)(p.o2 + tokq * BWID + qh * 64 + dv) = ov;
    }
}

DI void mem_item(const Params& p, int l, int grp, int item, char* smem) {
  const int tid = otid(), lane = tid & 63, w = tid >> 6, r = lane & 31, h = lane >> 5;
  const int bl = item >> 6, hd = (item >> 4) & 3, qb = item & 15;
  u16 *sK, *sV; float* slut;
  attn_lds(smem, sK, sV, slut);
  const int q_lo = qb * 128 + 32 * w, q_pos = q_lo + r;
  const size_t tokq = (size_t)bl * S_ + q_pos;
  const int bg = grp * p.BG + bl;
  const u16* kv = p.KV + ((size_t)l * NBATCH + bg) * MEML * D_;
  f32x16 o[4];
  float lt;
  bf16x8 qf[8];
  load_qfrag<128>(qf, p.P + tokq * PW + P_MQ + hd * 128, 0.08838834764831845f * 1.4426950408889634f, h);
  attn_pass<128, 128>(qf, kv + hd * 128, D_, kv + 512 + hd * 128, D_, 0, 4, q_pos, q_lo, nullptr, 0, -INFINITY, 0.f, o, lt, sK, sV);
  const float inv = 1.f / lt;
#pragma unroll
  for (int d = 0; d < 4; ++d)
#pragma unroll
    for (int g4 = 0; g4 < 4; ++g4) {
      const int dv = 32 * d + 8 * g4 + 4 * h;
      const u32x2 zz = *(const u32x2*)(p.P + tokq * PW + P_MZ + hd * 128 + dv);
      const float z0 = bflo(zz.x), z1 = bfhi(zz.x), z2 = bflo(zz.y), z3 = bfhi(zz.y);
      u32x2 ov;
      ov.x = pk2(o[d][4 * g4 + 0] * inv * siluf_(z0), o[d][4 * g4 + 1] * inv * siluf_(z1));
      ov.y = pk2(o[d][4 * g4 + 2] * inv * siluf_(z2), o[d][4 * g4 + 3] * inv * siluf_(z3));
      *(u32x2*)(p.o4 + tokq * BWID + hd * 128 + dv) = ov;
    }
}

DI void ssd_item(const Params& p, int l, int item, char* smem) {
  const int tid = otid(), lane = tid & 63, w = tid >> 6, r = lane & 31, h = lane >> 5;
  const int bl = item >> 4, hd = (item >> 1) & 7, dir = item & 1;
  const int gq = hd >> 2, lt = w & 1, ph = w >> 1;
  u16* sB = (u16*)smem;
  u16* sC = sB + 64 * 136;
  u16* sX1 = sC + 64 * 136;
  u16* sX2 = sX1 + 64 * 80;
  u16* sS = sX2 + 64 * 80;
  float* sW = (float*)(sS + 64 * 136);
  float* sDt = sW + 64;
  const float Aneg = -expf(p.in[9][(l * 2 + dir) * 8 + hd]);
  const float dtb = p.in[8][(l * 2 + dir) * 8 + hd];
  u16* ydst = dir ? p.syb : p.o0;
  const u16* Pb = p.P + (size_t)bl * S_ * PW;
  const u16* xab = p.xa + (size_t)bl * S_ * 1024;
  __syncthreads();
  for (int i = tid; i < 64 * 136 / 2; i += 256) ((unsigned*)sS)[i] = 0u;
  f32x16 accS[2];
#pragma unroll
  for (int i = 0; i < 2; ++i)
#pragma unroll
    for (int e = 0; e < 16; ++e) accS[i][e] = 0.f;
  u32x4 rB[4], rC[4], rX[2];
  float rdt = 0.f;
  auto prefetch = [&](int cc) {
    if (tid < 64) {
      const int pp = 64 * cc + tid, tok = dir ? (S_ - 1 - pp) : pp;
      rdt = bf2f(Pb[(size_t)tok * PW + P_DT + dir * 8 + hd]);
    }
#pragma unroll
    for (int i = 0; i < 4; ++i) {
      const int c = tid + 256 * i, row = c >> 4, col = (c & 15) * 8;
      const int pp = 64 * cc + row, tok = dir ? (S_ - 1 - pp) : pp;
      rB[i] = *(const u32x4*)(xab + (size_t)tok * 1024 + 512 + gq * 128 + col);
      rC[i] = *(const u32x4*)(xab + (size_t)tok * 1024 + 768 + gq * 128 + col);
    }
#pragma unroll
    for (int i = 0; i < 2; ++i) {
      const int c = tid + 256 * i, row = c >> 3, col = (c & 7) * 8;
      const int pp = 64 * cc + row, tok = dir ? (S_ - 1 - pp) : pp;
      rX[i] = *(const u32x4*)(xab + (size_t)tok * 1024 + hd * 64 + col);
    }
  };
  prefetch(0);
#pragma unroll 1
  for (int cc = 0; cc < 32; ++cc) {
    __syncthreads();
    if (tid < 64) {
      const float x = rdt + dtb;
      const float dt = x > 20.f ? x : log1pf(expf(x));
      float a = dt * Aneg;
#pragma unroll
      for (int o = 1; o < 64; o <<= 1) { const float t = __shfl_up(a, o, 64); if (lane >= o) a += t; }
      sW[tid] = a;
      sDt[tid] = dt;
    }
#pragma unroll
    for (int i = 0; i < 4; ++i) {
      const int c = tid + 256 * i, row = c >> 4, col = (c & 15) * 8;
      *(u32x4*)(sB + row * 136 + col) = rB[i];
      *(u32x4*)(sC + row * 136 + col) = rC[i];
    }
    __syncthreads();
    const float wlast = sW[63];
#pragma unroll
    for (int i = 0; i < 2; ++i) {
      const int c = tid + 256 * i, row = c >> 3, col = (c & 7) * 8;
      const float f1 = sDt[row], f2 = f1 * __expf(wlast - sW[row]);
      *(u32x4*)(sX1 + row * 80 + col) = scale8(rX[i], f1);
      *(u32x4*)(sX2 + row * 80 + col) = scale8(rX[i], f2);
    }
    __syncthreads();
    if (cc + 1 < 32) prefetch(cc + 1);
    f32x16 ay;
#pragma unroll
    for (int e = 0; e < 16; ++e) ay[e] = 0.f;
#pragma unroll
    for (int ks = 0; ks < 8; ++ks) {
      bf16x8 a = ldfrag(sS, 136, 32 * ph + r, 16 * ks + 8 * h);
      bf16x8 b = ldfrag(sC, 136, 32 * lt + r, 16 * ks + 8 * h);
      ay = MFMA32(a, b, ay);
    }
    const float wl = sW[32 * lt + r];
    {
      const float ewl = __expf(wl);
#pragma unroll
      for (int e = 0; e < 16; ++e) ay[e] *= ewl;
    }
    for (int st = 0; st <= lt; ++st) {
      f32x16 g;
#pragma unroll
      for (int e = 0; e < 16; ++e) g[e] = 0.f;
#pragma unroll
      for (int ks = 0; ks < 8; ++ks) {
        bf16x8 a = ldfrag(sB, 136, 32 * st + r, 16 * ks + 8 * h);
        bf16x8 b = ldfrag(sC, 136, 32 * lt + r, 16 * ks + 8 * h);
        g = MFMA32(a, b, g);
      }
#pragma unroll
      for (int e = 0; e < 16; ++e) {
        const int sidx = 32 * st + crow(e, h);
        const float f = (sidx <= 32 * lt + r) ? __expf(wl - sW[sidx]) : 0.f;
        g[e] *= f;
      }
#pragma unroll
      for (int s2 = 0; s2 < 2; ++s2) {
        bf16x8 pfr = pack8(g, s2);
        bf16x8 a = ldfrag_tr_perm(sX1, 80, 32 * st + 16 * s2, 32 * ph, lane);
        ay = MFMA32(a, pfr, ay);
      }
    }
    {
      const int pp = 64 * cc + 32 * lt + r, tok = dir ? (S_ - 1 - pp) : pp;
      u16* yd = ydst + ((size_t)bl * S_ + tok) * BWID + hd * 64 + 32 * ph + 4 * h;
#pragma unroll
      for (int g4 = 0; g4 < 4; ++g4) {
        u32x2 ov; ov.x = pk2(ay[4 * g4 + 0], ay[4 * g4 + 1]); ov.y = pk2(ay[4 * g4 + 2], ay[4 * g4 + 3]);
        *(u32x2*)(yd + 8 * g4) = ov;
      }
    }
    {
      const float ew = __expf(wlast);
#pragma unroll
      for (int pt = 0; pt < 2; ++pt)
#pragma unroll
        for (int e = 0; e < 16; ++e) accS[pt][e] *= ew;
#pragma unroll
      for (int ks = 0; ks < 4; ++ks) {
        bf16x8 b = ldfrag_tr_nat(sB, 136, 16 * ks, 32 * w, lane);
#pragma unroll
        for (int pt = 0; pt < 2; ++pt) {
          bf16x8 a = ldfrag_tr_nat(sX2, 80, 16 * ks, 32 * pt, lane);
          accS[pt] = MFMA32(a, b, accS[pt]);
        }
      }
    }
    __syncthreads();
#pragma unroll
    for (int pt = 0; pt < 2; ++pt)
#pragma unroll
      for (int e = 0; e < 16; ++e) sS[(32 * pt + crow(e, h)) * 136 + 32 * w + r] = f2bf(accS[pt][e]);
  }
}

DI void s5_item(const Params& p, int l, int item, char* smem) {
  const int tid = otid(), lane = tid & 63, w = tid >> 6;
  const int wi = item * 4 + w;
  const int bl = wi >> 6, g = (wi >> 1) & 31, dir = wi & 1;
  float* sBu = (float*)(smem + w * 12800);
  u16* sX = (u16*)(smem + w * 12800 + 8448);
  const int c16 = lane & 15, kg = lane >> 4;
  const float* lre = p.in[15] + ((size_t)(l * 2 + dir) * 32 + g) * 64;
  const float* lim = p.in[16] + ((size_t)(l * 2 + dir) * 32 + g) * 64;
  const float dt = expf(p.in[17][(l * 2 + dir) * 32 + g]);
  const float* bre = p.in[18] + ((size_t)l * 32 + g) * 64 * 16;
  const float* bim = p.in[19] + ((size_t)l * 32 + g) * 64 * 16;
  const float* cre = p.in[20] + (((size_t)(l * 2 + dir) * 32 + g) * 16) * 64;
  const float* cim = p.in[21] + (((size_t)(l * 2 + dir) * 32 + g) * 16) * 64;
  float ar, ai;
  {
    const float lr = lre[lane], li = lim[lane];
    const float mag = expf(lr * dt);
    ar = mag * cosf(li * dt); ai = mag * sinf(li * dt);
  }
  bf16x8 bfr[8];
#pragma unroll
  for (int ct = 0; ct < 4; ++ct) {
    const int st = 16 * ct + c16;
    const float lr = lre[st], li = lim[st];
    const float mag = expf(lr * dt);
    const float a_r = mag * cosf(li * dt), a_i = mag * sinf(li * dt);
    const float den = lr * lr + li * li;
    const float fr = ((a_r - 1.f) * lr + a_i * li) / den, fi = (a_i * lr - (a_r - 1.f) * li) / den;
    float vr[8], vi[8];
#pragma unroll
    for (int j = 0; j < 8; ++j) {
      float br_ = 0.f, bi_ = 0.f;
      if (kg < 2) { br_ = bre[st * 16 + 8 * kg + j]; bi_ = bim[st * 16 + 8 * kg + j]; }
      vr[j] = fr * br_ - fi * bi_;
      vi[j] = fr * bi_ + fi * br_;
    }
    u32x4 ur, ui;
    ur.x = pk2(vr[0], vr[1]); ur.y = pk2(vr[2], vr[3]); ur.z = pk2(vr[4], vr[5]); ur.w = pk2(vr[6], vr[7]);
    ui.x = pk2(vi[0], vi[1]); ui.y = pk2(vi[2], vi[3]); ui.z = pk2(vi[4], vi[5]); ui.w = pk2(vi[6], vi[7]);
    bfr[ct] = __builtin_bit_cast(bf16x8, ur);
    bfr[4 + ct] = __builtin_bit_cast(bf16x8, ui);
  }
  bf16x8 cfr[4];
#pragma unroll
  for (int ks = 0; ks < 4; ++ks) {
    const float* src = (ks < 2) ? (cre + c16 * 64 + 32 * ks + 8 * kg) : (cim + c16 * 64 + 32 * (ks - 2) + 8 * kg);
    const float sg = (ks < 2) ? 1.f : -1.f;
    u32x4 u;
    u.x = pk2(sg * src[0], sg * src[1]); u.y = pk2(sg * src[2], sg * src[3]);
    u.z = pk2(sg * src[4], sg * src[5]); u.w = pk2(sg * src[6], sg * src[7]);
    cfr[ks] = __builtin_bit_cast(bf16x8, u);
  }
  u16* ydst = dir ? p.o3 : p.s5f;
  const u16* Pb = p.P + (size_t)bl * S_ * PW + P_UIN + g * 16;
  float xr = 0.f, xi = 0.f;
  u32x4 ring[8];
#pragma unroll
  for (int j = 0; j < 8; ++j) {
    ring[j] = (u32x4){0u, 0u, 0u, 0u};
    const int pp = 16 * j + c16, tok = dir ? (S_ - 1 - pp) : pp;
    if (kg < 2) ring[j] = *(const u32x4*)(Pb + (size_t)tok * PW + 8 * kg);
  }
#pragma unroll 1
  for (int cc0 = 0; cc0 < S_ / 16; cc0 += 8)
#pragma unroll
  for (int j8 = 0; j8 < 8; ++j8) {
    const int cc = cc0 + j8;
    const bf16x8 ua = __builtin_bit_cast(bf16x8, ring[j8]);
    if (cc + 8 < S_ / 16) {
      const int pp = 16 * (cc + 8) + c16, tok = dir ? (S_ - 1 - pp) : pp;
      if (kg < 2) ring[j8] = *(const u32x4*)(Pb + (size_t)tok * PW + 8 * kg);
    }
    wave_lds_sync();
#pragma unroll
    for (int ct = 0; ct < 8; ++ct) {
      f32x4 d = {0.f, 0.f, 0.f, 0.f};
      d = MFMA16(ua, bfr[ct], d);
#pragma unroll
      for (int e = 0; e < 4; ++e) sBu[(4 * kg + e) * 132 + 16 * ct + c16] = d[e];
    }
    wave_lds_sync();
#pragma unroll
    for (int t = 0; t < 16; ++t) {
      const float bur = sBu[t * 132 + lane], bui = sBu[t * 132 + 64 + lane];
      const float nr = ar * xr - ai * xi + bur;
      const float ni = ar * xi + ai * xr + bui;
      xr = nr; xi = ni;
      sX[t * 136 + lane] = f2bf(xr);
      sX[t * 136 + 64 + lane] = f2bf(xi);
    }
    wave_lds_sync();
    f32x4 y = {0.f, 0.f, 0.f, 0.f};
#pragma unroll
    for (int ks = 0; ks < 4; ++ks) {
      bf16x8 a = ldfrag(sX, 136, c16, 32 * ks + 8 * kg);
      y = MFMA16(a, cfr[ks], y);
    }
#pragma unroll
    for (int e = 0; e < 4; ++e) {
      const int pp = 16 * cc + 4 * kg + e, tok = dir ? (S_ - 1 - pp) : pp;
      ydst[((size_t)bl * S_ + tok) * BWID + g * 16 + c16] = f2bf(y[e]);
    }
  }
}

DI void phase_finalize(const Params& p, int l, int Tg, int bid, int nblk) {
  const int tid_ = otid(), lane = tid_ & 63, w = tid_ >> 6;
  const float* dsk = p.in[10] + l * 8;
  const float* ng = p.in[11] + (size_t)l * BWID;
  const float* s5d = p.in[22] + (size_t)l * BWID;
  const int c0 = lane * 8, stride = nblk * 4;
  for (int tok0 = bid * 4 + w; tok0 < Tg; tok0 += 2 * stride) {
    u32x4 r_yf[2], r_yb[2], r_xs[2], r_z[2], r_sf[2], r_sb[2], r_u[2], r_uz[2];
#pragma unroll
    for (int u = 0; u < 2; ++u) {
      const int tok = tok0 + u * stride;
      if (tok < Tg) {
        r_yf[u] = *(const u32x4*)(p.o0 + (size_t)tok * BWID + c0);
        r_yb[u] = *(const u32x4*)(p.syb + (size_t)tok * BWID + c0);
        r_xs[u] = *(const u32x4*)(p.xa + (size_t)tok * 1024 + c0);
        r_z[u] = *(const u32x4*)(p.P + (size_t)tok * PW + P_SZ + c0);
        r_sf[u] = *(const u32x4*)(p.s5f + (size_t)tok * BWID + c0);
        r_sb[u] = *(const u32x4*)(p.o3 + (size_t)tok * BWID + c0);
        r_u[u] = *(const u32x4*)(p.P + (size_t)tok * PW + P_UIN + c0);
        r_uz[u] = *(const u32x4*)(p.P + (size_t)tok * PW + P_UZ + c0);
      }
    }
#pragma unroll
    for (int u = 0; u < 2; ++u) {
      const int tok = tok0 + u * stride;
      if (tok < Tg) {
        float yf[8], yb[8], xs[8], z[8];
        unpack8(r_yf[u], yf); unpack8(r_yb[u], yb); unpack8(r_xs[u], xs); unpack8(r_z[u], z);
        const float dk = dsk[c0 >> 6];
        float v[8], ss = 0.f;
#pragma unroll
        for (int j = 0; j < 8; ++j) { v[j] = (yf[j] + yb[j] + dk * xs[j]) * siluf_(z[j]); ss += v[j] * v[j]; }
        ss = wave_sum(ss);
        const float rs = rsqrtf(ss / (float)BWID + EPS_);
        u32x4 o;
        o.x = pk2(v[0] * rs * ng[c0 + 0], v[1] * rs * ng[c0 + 1]); o.y = pk2(v[2] * rs * ng[c0 + 2], v[3] * rs * ng[c0 + 3]);
        o.z = pk2(v[4] * rs * ng[c0 + 4], v[5] * rs * ng[c0 + 5]); o.w = pk2(v[6] * rs * ng[c0 + 6], v[7] * rs * ng[c0 + 7]);
        *(u32x4*)(p.o0 + (size_t)tok * BWID + c0) = o;
        float sf[8], sb[8], uu[8], gq[8], uz[8];
        unpack8(r_sf[u], sf); unpack8(r_sb[u], sb); unpack8(r_u[u], uu); unpack8(r_uz[u], uz);
#pragma unroll
        for (int j = 0; j < 8; ++j) {
          const float y = sf[j] + sb[j] + s5d[c0 + j] * uu[j];
          const float t = tanhf(0.7978845608028654f * (y + 0.044715f * y * y * y));
          gq[j] = 0.5f * y * (1.f + t);
        }
        u32x4 o2;
        o2.x = pk2(gq[0], gq[1]); o2.y = pk2(gq[2], gq[3]); o2.z = pk2(gq[4], gq[5]); o2.w = pk2(gq[6], gq[7]);
        *(u32x4*)(p.s5f + (size_t)tok * BWID + c0) = o2;
        u32x4 o3v;
        o3v.x = pk2(siluf_(uz[0]), siluf_(uz[1])); o3v.y = pk2(siluf_(uz[2]), siluf_(uz[3]));
        o3v.z = pk2(siluf_(uz[4]), siluf_(uz[5])); o3v.w = pk2(siluf_(uz[6]), siluf_(uz[7]));
        *(u32x4*)(p.syb + (size_t)tok * BWID + c0) = o3v;
      }
    }
  }
}

DI void phase_mixers(const Params& p, int l, int grp, int* ctr, char* smem, volatile int* s_itemp, int half) {
  const int BG = p.BG;
  const int n_ssd = BG * 8, n_s5 = BG * 8, n_diff = BG * 32, n_mem = BG * 32, n_win = BG * 64;
  const int total = n_ssd + n_s5 + n_diff + n_mem + n_win;
  for (;;) {
    __syncthreads();
    if (threadIdx.x == 0) *s_itemp = atomicAdd(ctr, 1);
    __syncthreads();
    int it = __builtin_amdgcn_readfirstlane(*s_itemp);
    if (it >= total) break;
    if (it < n_ssd) { if (MX & 1) ssd_item(p, l, it * 2 + half, smem); continue; }
    it -= n_ssd;
    if (it < n_s5) { if (MX & 2) s5_item(p, l, it * 2 + half, smem); continue; }
    it -= n_s5;
    if (it < n_diff) { if (MX & 4) diff_item(p, l, it * 2 + half, smem); continue; }
    it -= n_diff;
    if (it < n_mem) { if (MX & 8) mem_item(p, l, grp, it * 2 + half, smem); continue; }
    it -= n_mem;
    if (MX & 16) win_item(p, l, ((it >> 4) * 2 + half) * 16 + (it & 15), smem);
  }
}

__global__ void __launch_bounds__(512, 2) fwd_megakernel(Params p) {
  extern __shared__ __attribute__((aligned(16))) char smem[];
  __shared__ __attribute__((aligned(16))) unsigned s_misc[8];
  cg::grid_group grid = cg::this_grid();
  const int bid = blockIdx.x, nblk = gridDim.x;
  const int half = __builtin_amdgcn_readfirstlane((int)(threadIdx.x >> 8));
  const int vbid = bid * 2 + half, vnblk = nblk * 2;
  char* smem_h = smem + half * HALF_SMEM;
  const int BG = p.BG, Tg = BG * S_, ngrp = NBATCH / BG;
  if (threadIdx.x < 8) s_misc[threadIdx.x] = 0u;
  __syncthreads();
  XcdBarrier xb = xcd_barrier_post(p.bar, (volatile LAS unsigned*)s_misc);
  if (PH & 1) phase_prologue(p, smem_h, vbid, vnblk);
  if (p.BG < 0) grid.sync();
  xcd_barrier(xb);
  if (PH & 2) phase_kv(p, smem_h, vbid, vnblk);
  for (int grp = 0; grp < ngrp; ++grp) {
    const size_t rowoff = (size_t)grp * Tg * D_;
    for (int l = 0; l < 2; ++l) {
      const float* xin = (l == 0 ? p.in[0] : (const float*)p.out) + rowoff;
      if (PH & 4) phase_norm(xin, p.in[4] + (size_t)l * D_, p.h, Tg, vbid, vnblk);
      xcd_barrier(xb);
      if (PH & 8) phase_inproj(p, l, Tg, smem, bid, nblk);
      xcd_barrier(xb);
      if (PH & 16) phase_conv(p, l, Tg, vbid, vnblk);
      xcd_barrier(xb);
      if (PH & 32) phase_mixers(p, l, grp, p.ctr + grp * 2 + l, smem_h, (volatile int*)&s_misc[4], half);
      xcd_barrier(xb);
      if (PH & 64) phase_finalize(p, l, Tg, vbid, vnblk);
      xcd_barrier(xb);
      unsigned char* Gbuf = (unsigned char*)(p.P + (size_t)Tg * D_);
      phase_gates(p, l, Tg, Gbuf, smem, bid, nblk);
      if (PH & 128) phase_glu(p, l, Tg, smem, bid, nblk);
      xcd_barrier(xb);
      if (PH & 256) phase_merge(p, l, Tg, Gbuf, p.P, smem, bid, nblk);
      xcd_barrier(xb);
      if (PH & 512) phase_out(p, l, Tg, p.P, xin, p.out + rowoff, smem, bid, nblk);
      xcd_barrier(xb);
    }
  }
  if (PH & 1024) phase_final(p.out, p.in[3], NBATCH * S_, vbid, vnblk);
}

extern "C" void kernel_launch(void* const* d_in, const int* in_sizes, int n_in, void* d_out, int out_size, void* d_ws,
                              size_t ws_size, hipStream_t stream) {
  static int grid_blocks = 0;
  if (!grid_blocks) {
    int dev = 0, cus = 0, per_cu = 0;
    hipGetDevice(&dev);
    hipDeviceGetAttribute(&cus, hipDeviceAttributeMultiprocessorCount, dev);
    hipFuncSetAttribute((const void*)fwd_megakernel, hipFuncAttributeMaxDynamicSharedMemorySize, SMEM_BYTES);
    hipOccupancyMaxActiveBlocksPerMultiprocessor(&per_cu, fwd_megakernel, 512, SMEM_BYTES);
    if (per_cu > 1) per_cu = 1;
    if (per_cu < 1) per_cu = 1;
    grid_blocks = cus * per_cu;
  }
  Params p{};
  for (int i = 0; i < 31; ++i) p.in[i] = (const float*)d_in[i];
  p.out = (float*)d_out;
  char* ws = (char*)d_ws;
  size_t off = 0;
  auto take = [&](size_t bytes) { char* r = ws + off; off += (bytes + 255) & ~(size_t)255; return r; };
  p.W = (u16*)take(2 * LAYER_W * 2);
  p.KV = (u16*)take((size_t)2 * NBATCH * MEML * D_ * 2);
  p.memb = (u16*)take((size_t)NBATCH * MEML * D_ * 2);
  p.memrs = (float*)take(NBATCH * MEML * 4);
  p.lut = (float*)take(12 * LUTS * 4);
  p.ctr = (int*)take(4096);
  p.bar = (unsigned*)take(XCD_BAR_WORDS * 4);
  const size_t fixed = off;
  int BG = 8;
  auto need = [&](int bg) { size_t tg = (size_t)bg * S_; return fixed + tg * (D_ * 2 + (size_t)PW * 2 + 1024 * 2 + 7 * BWID * 2) + 16 * 256; };
  while (BG > 1 && need(BG) > ws_size) BG >>= 1;
  const size_t Tg = (size_t)BG * S_;
  p.h = (u16*)take(Tg * D_ * 2);
  p.P = (u16*)take(Tg * PW * 2);
  p.xa = (u16*)take(Tg * 1024 * 2);
  p.o0 = (u16*)take(Tg * BWID * 2);
  p.o1 = (u16*)take(Tg * BWID * 2);
  p.o2 = (u16*)take(Tg * BWID * 2);
  p.o3 = (u16*)take(Tg * BWID * 2);
  p.o4 = (u16*)take(Tg * BWID * 2);
  p.syb = (u16*)take(Tg * BWID * 2);
  p.s5f = (u16*)take(Tg * BWID * 2);
  p.BG = BG;
  p.pad = 0;
  hipMemsetAsync(p.ctr, 0, 4096 + ((XCD_BAR_WORDS * 4 + 255) & ~255), stream);
  void* args[] = {&p};
  hipError_t e = hipLaunchCooperativeKernel((const void*)fwd_megakernel, dim3(grid_blocks), dim3(512), args, SMEM_BYTES, stream);
  if (e != hipSuccess) fprintf(stderr, "cooperative launch failed: %s (grid %d)\n", hipGetErrorString(e), grid_blocks);
}
```

```cpp
#include <hip/hip_runtime.h>
#include <hip/hip_cooperative_groups.h>
#include <cstdio>
namespace cg = cooperative_groups;

#define DI __device__ __forceinline__
typedef unsigned short u16;
typedef __attribute__((ext_vector_type(8))) short bf16x8;
typedef __attribute__((ext_vector_type(4))) short s16x4;
typedef __attribute__((ext_vector_type(16))) float f32x16;
typedef __attribute__((ext_vector_type(4))) float f32x4;
typedef __attribute__((ext_vector_type(2))) float f32x2;
typedef __attribute__((ext_vector_type(4))) unsigned u32x4;
typedef __attribute__((ext_vector_type(2))) unsigned u32x2;
typedef __attribute__((ext_vector_type(2))) __bf16 bf2_t;

constexpr int S_ = 2048, D_ = 1024, NBATCH = 16, BWID = 512, MEML = 256;
constexpr int PW = 7040;
constexpr int P_XBC = 0, P_SZ = 1024, P_DQ = 1536, P_DK = 2048, P_DV = 2560, P_DZ = 3072, P_CQ = 3584, P_CK = 4096,
              P_CV = 4224, P_CZ = 4352, P_UIN = 4864, P_UZ = 5376, P_MQ = 5888, P_MZ = 6400, P_DT = 6912;
constexpr size_t WIN_OFF = 0, WMG_OFF = 7208960, WBR_OFF = 12451840, WOUT_OFF = 15073280, WGLU_OFF = 16121856,
                 WKV_OFF = 16384000, LAYER_W = 17432576;
constexpr int LUTS = 4096;
constexpr int HALF_SMEM = 75 * 1024;
constexpr int SMEM_BYTES = 2 * HALF_SMEM;
constexpr float EPS_ = 1e-6f;
#ifndef PH
#define PH 0xffff
#endif
#ifndef MX
#define MX 0xff
#endif
#ifndef DUP
#define DUP 0
#endif

struct Params {
  const float* in[31];
  float* out;
  u16* W; u16* KV; u16* memb; float* memrs; float* lut; int* ctr; unsigned* bar;
  u16* h; u16* P; u16* xa; u16* o0; u16* o1; u16* o2; u16* o3; u16* o4; u16* syb; u16* s5f;
  int BG; int pad;
};

DI unsigned pk2(float a, float b) { bf2_t r = __builtin_convertvector((f32x2){a, b}, bf2_t); return __builtin_bit_cast(unsigned, r); }
DI u16 f2bf(float a) { return (u16)(pk2(a, 0.f) & 0xffffu); }
DI float bf2f(u16 v) { return __uint_as_float(((unsigned)v) << 16); }
DI float bflo(unsigned v) { return __uint_as_float(v << 16); }
DI float bfhi(unsigned v) { return __uint_as_float(v & 0xffff0000u); }
DI float sigmoidf_(float x) { return __builtin_amdgcn_rcpf(1.f + __builtin_amdgcn_exp2f(-1.4426950408889634f * x)); }
DI float siluf_(float x) { return x * __builtin_amdgcn_rcpf(1.f + __builtin_amdgcn_exp2f(-1.4426950408889634f * x)); }
DI int crow(int reg, int h) { return (reg & 3) + 8 * (reg >> 2) + 4 * h; }
DI int otid() { int t = threadIdx.x & 255; asm volatile("" : "+v"(t)); return t; }
DI int rtid() { int t = threadIdx.x; asm volatile("" : "+v"(t)); return t; }
DI float wave_sum(float v) { for (int o = 32; o > 0; o >>= 1) v += __shfl_xor(v, o, 64); return v; }
#define MFMA32(a, b, c) __builtin_amdgcn_mfma_f32_32x32x16_bf16((a), (b), (c), 0, 0, 0)
#define MFMA16(a, b, c) __builtin_amdgcn_mfma_f32_16x16x32_bf16((a), (b), (c), 0, 0, 0)

DI bf16x8 ldfrag(const u16* base, int stride, int row, int col) { return *reinterpret_cast<const bf16x8*>(base + row * stride + col); }
DI s16x4 tr4(const u16* base, int stride, int krow0, int col0, int lane) {
  const int i16 = lane & 15, q = i16 >> 2, pp = i16 & 3, blk = (lane >> 4) & 1;
  const u16* a = base + (krow0 + q) * stride + col0 + 16 * blk + 4 * pp;
  return __builtin_amdgcn_ds_read_tr16_b64_v4i16((__attribute__((address_space(3))) s16x4*)(a));
}
DI bf16x8 ldfrag_tr_nat(const u16* base, int stride, int k0, int col0, int lane) {
  const int h = lane >> 5;
  s16x4 lo = tr4(base, stride, k0 + 8 * h, col0, lane), hi = tr4(base, stride, k0 + 8 * h + 4, col0, lane);
  return __builtin_shufflevector(lo, hi, 0, 1, 2, 3, 4, 5, 6, 7);
}
DI bf16x8 ldfrag_tr_perm(const u16* base, int stride, int k0, int col0, int lane) {
  const int h = lane >> 5;
  s16x4 lo = tr4(base, stride, k0 + 4 * h, col0, lane), hi = tr4(base, stride, k0 + 8 + 4 * h, col0, lane);
  return __builtin_shufflevector(lo, hi, 0, 1, 2, 3, 4, 5, 6, 7);
}
DI bf16x8 pack8(const f32x16& x, int s) {
  u32x4 u;
  u.x = pk2(x[8 * s + 0], x[8 * s + 1]); u.y = pk2(x[8 * s + 2], x[8 * s + 3]);
  u.z = pk2(x[8 * s + 4], x[8 * s + 5]); u.w = pk2(x[8 * s + 6], x[8 * s + 7]);
  return __builtin_bit_cast(bf16x8, u);
}
DI u32x4 scale8(u32x4 v, float f) {
  u32x4 o;
  o.x = pk2(bflo(v.x) * f, bfhi(v.x) * f); o.y = pk2(bflo(v.y) * f, bfhi(v.y) * f);
  o.z = pk2(bflo(v.z) * f, bfhi(v.z) * f); o.w = pk2(bflo(v.w) * f, bfhi(v.w) * f);
  return o;
}
DI void unpack8(u32x4 v, float* f) {
  f[0] = bflo(v.x); f[1] = bfhi(v.x); f[2] = bflo(v.y); f[3] = bfhi(v.y);
  f[4] = bflo(v.z); f[5] = bfhi(v.z); f[6] = bflo(v.w); f[7] = bfhi(v.w);
}
DI void wave_lds_sync() {
  __builtin_amdgcn_fence(__ATOMIC_RELEASE, "wavefront");
  __builtin_amdgcn_wave_barrier();
  __builtin_amdgcn_fence(__ATOMIC_ACQUIRE, "wavefront");
}


#define XB_TMO      128
#define XB_XCNT(j)  (256  + 64 * (j))
#define XB_XSUB(j)  (1280 + 64 * (j))
#define XB_XGEN(j)  (2304 + 64 * (j))
#define XB_TOP      3328
#define XB_TOPGEN   3392
#define XCD_BAR_WORDS 3456
#define XB_SPIN_CAP (1u << 24)
#define LAS __attribute__((address_space(3)))
DI unsigned xb_ld(unsigned* p) { return __hip_atomic_load(p, __ATOMIC_RELAXED, __HIP_MEMORY_SCOPE_AGENT); }
DI unsigned xb_add(unsigned* p, unsigned v) { return __hip_atomic_fetch_add(p, v, __ATOMIC_RELAXED, __HIP_MEMORY_SCOPE_AGENT); }
DI unsigned xb_xcc_id() { return (unsigned)__builtin_amdgcn_s_getreg((3 << 11) | 20) & 0xFu; }
#define XB_SPIN(cond, bar) do { unsigned _sp = 0; while (cond) { __builtin_amdgcn_s_sleep(1); \
    if ((++_sp & 255u) == 0u) { if (xb_ld(&(bar)[XB_TMO])) break; if (_sp > XB_SPIN_CAP) { atomicAdd(&(bar)[XB_TMO], 1u); break; } } } } while (0)
struct XcdBarrier { unsigned* bar; unsigned x; volatile LAS unsigned* st; };
DI XcdBarrier xcd_barrier_post(unsigned* bar, volatile LAS unsigned* st) {
  XcdBarrier b; b.bar = bar; b.x = xb_xcc_id(); b.st = st;
  if (threadIdx.x == 0) (void)xb_add(&bar[XB_XCNT(b.x)], 1u);
  return b;
}
DI void xcd_barrier_complete(unsigned* bar, unsigned x, unsigned& nloc, unsigned& nx) {
  const unsigned G = gridDim.x * gridDim.y * gridDim.z;
  unsigned sum, cnt, mine, sp = 0u;
  for (;;) {
    sum = 0u; cnt = 0u; mine = 0u;
#pragma unroll
    for (unsigned j = 0; j < 16; ++j) { const unsigned c = xb_ld(&bar[XB_XCNT(j)]); sum += c; cnt += (c > 0u) ? 1u : 0u; mine = (j == x) ? c : mine; }
    if (sum == G) break;
    __builtin_amdgcn_s_sleep(1);
    if ((++sp & 255u) == 0u) { if (xb_ld(&bar[XB_TMO])) break; if (sp > XB_SPIN_CAP) { atomicAdd(&bar[XB_TMO], 1u); break; } }
  }
  nloc = mine > 0u ? mine : 1u; nx = cnt > 0u ? cnt : 1u;
}
DI void xcd_barrier(const XcdBarrier& b) {
  asm volatile("s_waitcnt vmcnt(0)" ::: "memory");
  __syncthreads();
  if (threadIdx.x == 0) {
    unsigned* bar = b.bar;
    __builtin_amdgcn_s_waitcnt(0);
    unsigned nloc = b.st[0], nx = b.st[1];
    if (nloc == 0u) { xcd_barrier_complete(bar, b.x, nloc, nx); b.st[0] = nloc; b.st[1] = nx; }
    const unsigned old = xb_add(&bar[XB_XSUB(b.x)], 1u);
    const unsigned gen = old / nloc;
    if (old + 1u == (gen + 1u) * nloc) {
      __builtin_amdgcn_fence(__ATOMIC_RELEASE, "agent");
      asm volatile("s_waitcnt vmcnt(0)" ::: "memory");
      const unsigned og = xb_add(&bar[XB_TOP], 1u);
      const unsigned tg = og / nx;
      if (og + 1u == (tg + 1u) * nx) xb_add(&bar[XB_TOPGEN], 1u);
      else XB_SPIN(xb_ld(&bar[XB_TOPGEN]) == tg, bar);
      __builtin_amdgcn_fence(__ATOMIC_ACQUIRE, "agent");
      xb_add(&bar[XB_XGEN(b.x)], 1u);
      asm volatile("s_waitcnt vmcnt(0)" ::: "memory");
    } else {
      XB_SPIN(xb_ld(&bar[XB_XGEN(b.x)]) == gen, bar);
      __builtin_amdgcn_fence(__ATOMIC_ACQUIRE, "agent");
      asm volatile("s_waitcnt vmcnt(0)" ::: "memory");
    }
  }
  __syncthreads();
}

template <int BM, int BN>
DI void gemm_acc(const u16* __restrict__ A, int lda, int kstrA, const u16* __restrict__ Bt, int ldb, int kstrB, int K,
                 f32x16 (&acc)[BM / 64][BN / 64], char* smem) {
  constexpr int MI = BM / 64, NJ = BN / 64, NAC = BM / 32, NBC = BN / 32;
  u16* sA = (u16*)smem;
  u16* sB = sA + BM * 72;
  const int tid = otid(), lane = tid & 63, w = tid >> 6, wm = w >> 1, wn = w & 1, r = lane & 31, h = lane >> 5;
  u32x4 ra[NAC], rb[NBC];
  const int crow_ = tid >> 3, ccol = (tid & 7) * 8;
  const u16* Ap = A + (size_t)crow_ * lda + ccol;
  const u16* Bp = Bt + (size_t)crow_ * ldb + ccol;
#pragma unroll
  for (int i = 0; i < NAC; ++i) ra[i] = *(const u32x4*)(Ap + (size_t)(32 * i) * lda);
#pragma unroll
  for (int i = 0; i < NBC; ++i) rb[i] = *(const u32x4*)(Bp + (size_t)(32 * i) * ldb);
  const int nk = K >> 6;
  for (int kt = 0; kt < nk; ++kt) {
    __syncthreads();
#pragma unroll
    for (int i = 0; i < NAC; ++i) *(u32x4*)(sA + (crow_ + 32 * i) * 72 + ccol) = ra[i];
#pragma unroll
    for (int i = 0; i < NBC; ++i) *(u32x4*)(sB + (crow_ + 32 * i) * 72 + ccol) = rb[i];
    __syncthreads();
    if (kt + 1 < nk) {
      const size_t koA = (size_t)(kt + 1) * kstrA, koB = (size_t)(kt + 1) * kstrB;
#pragma unroll
      for (int i = 0; i < NAC; ++i) ra[i] = *(const u32x4*)(Ap + (size_t)(32 * i) * lda + koA);
#pragma unroll
      for (int i = 0; i < NBC; ++i) rb[i] = *(const u32x4*)(Bp + (size_t)(32 * i) * ldb + koB);
    }
#pragma unroll
    for (int ks = 0; ks < 4; ++ks) {
      bf16x8 b[NJ];
#pragma unroll
      for (int j = 0; j < NJ; ++j) b[j] = ldfrag(sB, 72, wn * (BN / 2) + 32 * j + r, ks * 16 + 8 * h);
#pragma unroll
      for (int i = 0; i < MI; ++i) {
        const bf16x8 a = ldfrag(sA, 72, wm * (BM / 2) + 32 * i + r, ks * 16 + 8 * h);
#pragma unroll
        for (int j = 0; j < NJ; ++j) acc[i][j] = MFMA32(a, b[j], acc[i][j]);
      }
    }
  }
}

template <int BM, int BN>
DI void gemm8(const u16* __restrict__ A, int lda, int kstrA, const u16* __restrict__ Bt, size_t bpanel, int K,
              f32x16 (&acc)[BM / 64][BN / 128], char* smem) {
  constexpr int MI = BM / 64, NJ = BN / 128, NAC = BM / 64, NBC = BN / 64;
  u16* sA = (u16*)smem;
  u16* sB = sA + BM * 72;
  const int tid = rtid(), lane = tid & 63, w = tid >> 6, wm = w >> 2, wn = w & 3, r = lane & 31, h = lane >> 5;
  u32x4 ra[NAC], rb[NBC];
  const int crow_ = tid >> 3, ccol = (tid & 7) * 8;
  const u16* Ap = A + (size_t)crow_ * lda + ccol;
  const u16* Bp = Bt + (size_t)crow_ * 64 + ccol;
#pragma unroll
  for (int i = 0; i < NAC; ++i) ra[i] = *(const u32x4*)(Ap + (size_t)(64 * i) * lda);
#pragma unroll
  for (int i = 0; i < NBC; ++i) rb[i] = *(const u32x4*)(Bp + (size_t)(i >> 1) * bpanel + (size_t)(64 * (i & 1)) * 64);
  const int nk = K >> 6;
#pragma unroll 1
  for (int kt = 0; kt < nk; ++kt) {
    __syncthreads();
#pragma unroll
    for (int i = 0; i < NAC; ++i) *(u32x4*)(sA + (crow_ + 64 * i) * 72 + ccol) = ra[i];
#pragma unroll
    for (int i = 0; i < NBC; ++i) *(u32x4*)(sB + (crow_ + 64 * i) * 72 + ccol) = rb[i];
    __syncthreads();
    if (kt + 1 < nk) {
      const size_t koA = (size_t)(kt + 1) * kstrA, koB = (size_t)(kt + 1) * 8192;
#pragma unroll
      for (int i = 0; i < NAC; ++i) ra[i] = *(const u32x4*)(Ap + (size_t)(64 * i) * lda + koA);
#pragma unroll
      for (int i = 0; i < NBC; ++i) rb[i] = *(const u32x4*)(Bp + (size_t)(i >> 1) * bpanel + (size_t)(64 * (i & 1)) * 64 + koB);
    }
#pragma unroll
    for (int ks = 0; ks < 4; ++ks) {
      bf16x8 b[NJ];
#pragma unroll
      for (int j = 0; j < NJ; ++j) b[j] = ldfrag(sB, 72, wn * (BN / 4) + 32 * j + r, ks * 16 + 8 * h);
#pragma unroll
      for (int i = 0; i < MI; ++i) {
        const bf16x8 a = ldfrag(sA, 72, wm * (BM / 2) + 32 * i + r, ks * 16 + 8 * h);
#pragma unroll
        for (int j = 0; j < NJ; ++j) acc[i][j] = MFMA32(a, b[j], acc[i][j]);
      }
    }
  }
}

template <int BM, int BN>
DI void gemm8db(const u16* __restrict__ A, int lda, int kstrA, const u16* __restrict__ Bt, size_t bpanel, int K,
                f32x16 (&acc)[BM / 64][BN / 128], char* smem) {
  constexpr int MI = BM / 64, NJ = BN / 128, NAC = BM / 64, NBC = BN / 64, STAGE = (BM + BN) * 72;
  u16* sA0 = (u16*)smem;
  u16* sB0 = sA0 + BM * 72;
  u16* sA1 = sA0 + STAGE;
  u16* sB1 = sA1 + BM * 72;
  const int tid = rtid(), lane = tid & 63, w = tid >> 6, wm = w >> 2, wn = w & 3, r = lane & 31, h = lane >> 5;
  u32x4 ra0[NAC], rb0[NBC], ra1[NAC], rb1[NBC];
  const int crow_ = tid >> 3, ccol = (tid & 7) * 8;
  const u16* Ap = A + (size_t)crow_ * lda + ccol;
  const u16* Bp = Bt + (size_t)crow_ * 64 + ccol;
  const int nk = K >> 6;
#define G_LOAD(RA, RB, KT)                                                                          \
  {                                                                                                 \
    const size_t koA_ = (size_t)(KT) * kstrA, koB_ = (size_t)(KT) * 8192;                           \
    _Pragma("unroll") for (int i = 0; i < NAC; ++i) RA[i] = *(const u32x4*)(Ap + (size_t)(64 * i) * lda + koA_); \
    _Pragma("unroll") for (int i = 0; i < NBC; ++i) RB[i] = *(const u32x4*)(Bp + (size_t)(i >> 1) * bpanel + (size_t)(64 * (i & 1)) * 64 + koB_); \
  }
#define G_WRITE(RA, RB, SA, SB)                                                                     \
  {                                                                                                 \
    _Pragma("unroll") for (int i = 0; i < NAC; ++i) *(u32x4*)(SA + (crow_ + 64 * i) * 72 + ccol) = RA[i]; \
    _Pragma("unroll") for (int i = 0; i < NBC; ++i) *(u32x4*)(SB + (crow_ + 64 * i) * 72 + ccol) = RB[i]; \
  }
#define G_COMPUTE(SA, SB)                                                                           \
  {                                                                                                 \
    _Pragma("unroll") for (int ks = 0; ks < 4; ++ks) {                                              \
      bf16x8 b_[NJ];                                                                                \
      _Pragma("unroll") for (int j = 0; j < NJ; ++j) b_[j] = ldfrag(SB, 72, wn * (BN / 4) + 32 * j + r, ks * 16 + 8 * h); \
      _Pragma("unroll") for (int i = 0; i < MI; ++i) {                                              \
        const bf16x8 a_ = ldfrag(SA, 72, wm * (BM / 2) + 32 * i + r, ks * 16 + 8 * h);             \
        _Pragma("unroll") for (int j = 0; j < NJ; ++j) acc[i][j] = MFMA32(a_, b_[j], acc[i][j]);    \
      }                                                                                             \
    }                                                                                               \
  }
  G_LOAD(ra0, rb0, 0);
  G_LOAD(ra1, rb1, 1);
  __syncthreads();
  G_WRITE(ra0, rb0, sA0, sB0);
  if (nk > 2) G_LOAD(ra0, rb0, 2);
  __syncthreads();
#pragma unroll 1
  for (int kt = 0; kt < nk; kt += 2) {
    G_COMPUTE(sA0, sB0);
    G_WRITE(ra1, rb1, sA1, sB1);
    if (kt + 3 < nk) G_LOAD(ra1, rb1, kt + 3);
    __syncthreads();
    G_COMPUTE(sA1, sB1);
    if (kt + 2 < nk) G_WRITE(ra0, rb0, sA0, sB0);
    if (kt + 4 < nk) G_LOAD(ra0, rb0, kt + 4);
    __syncthreads();
  }
#undef G_LOAD
#undef G_WRITE
#undef G_COMPUTE
}


namespace pg8 {
#define PG8_LAS __attribute__((address_space(3)))
typedef unsigned short bf16_t;
constexpr int BM = 256, BK = 64, HALF = 128, HTB = HALF * BK * 2, STAGE_BYTES = 8 * HTB, NXCD = 8, WGM = 8;
__host__ __device__ __forceinline__ int lds_byte(int r, int c) { const int st = (r >> 4) * 2 + (c >> 5), rr = r & 15, cc = c & 31, ob = rr * 64 + cc * 2; return st * 1024 + (ob ^ (((ob >> 9) & 1) << 5)); }
__host__ __device__ __forceinline__ void stage_rc(int b, int& R, int& C) { const int st = b / 1024, sb = b % 1024, swz = sb ^ (((sb >> 9) & 1) << 5); R = (st >> 1) * 16 + swz / 64; C = (st & 1) * 32 + (swz % 64) / 2; }
__host__ __device__ __forceinline__ int perm32(int rho) { const int n = rho >> 4, i = rho & 15; return 8 * (i >> 2) + 4 * n + (i & 3); }
struct Unit { int pm, pn, br; };
struct Gemm { const bf16_t* A; const bf16_t* Bt; int M, N, K; };
struct StaticOrder {
    int nM, nN, nwg, G, c;
    __host__ __device__ void init(int M, int N, int G_, int c_) { nM = M / BM; nN = N / BM; nwg = nM * nN; G = G_; c = c_; }
    __host__ __device__ bool next(int i, Unit& u) const {
        const long L = (long)i * G + c; if (L >= nwg) return false;
        int wgid = (int)L; { const int q = nwg / NXCD, r = nwg % NXCD, xcd = wgid % NXCD, off = wgid / NXCD; wgid = (xcd < r ? xcd * (q + 1) : r * (q + 1) + (xcd - r) * q) + off; }
        const int nig = WGM * nN, gid = wgid / nig, fm = gid * WGM, gsz = (nM - fm) < WGM ? (nM - fm) : WGM;
        u.pm = fm + ((wgid % nig) % gsz); u.pn = (wgid % nig) / gsz; u.br = 0; return true;
    }
    __device__ __forceinline__ void a_ready(const Unit&) const {}
    __device__ __forceinline__ void done(const Unit&) const {}
    __device__ __forceinline__ const char* pa(const Unit& u, const Gemm& g) const { return (const char*)g.A + (size_t)u.pm * (size_t)(2 * BM) * g.K; }
    __device__ __forceinline__ const char* pb(const Unit& u, const Gemm& g) const { return (const char*)g.Bt + (size_t)u.pn * (size_t)(2 * BM) * g.K; }
};
template <class Epi, class Sched>
__device__ __forceinline__ void gemm_phase(PG8_LAS unsigned char* lds, const Gemm g, const Sched& S, const Epi& E) {
    constexpr bool STAMP = false; unsigned long long* stamps = nullptr;
    const int tid = rtid(), wid = __builtin_amdgcn_readfirstlane(tid >> 6), lane = tid & 63, wr = wid >> 2, wc = wid & 3, fr = lane & 15, fq = lane >> 4;
    const int K = g.K, nt = K / BK;
    int ts_lo = 0, ts_hi = 0, nts = 0; const unsigned long long rt_entry = STAMP ? 0ull : 0ull;
#define PG8_STAMP() do { if (STAMP && wid == 0 && nts < 64) { const unsigned long long _c = 0ull; \
        ts_lo = (lane == nts) ? (int)(unsigned)_c : ts_lo; ts_hi = (lane == nts) ? (int)(unsigned)(_c >> 32) : ts_hi; ++nts; } } while (0)
    PG8_STAMP();
    unsigned voffA[2], voffB[2];
#pragma unroll
    for (int i = 0; i < 2; ++i) { int R, C; stage_rc(tid * 16 + i * 8192, R, C); const int Rb = Epi::PERM ? ((R & ~31) + perm32(R & 31)) : R;
        voffA[i] = (unsigned)(R * K + C) * 2u; voffB[i] = (unsigned)(Rb * K + C) * 2u; }
    const size_t kstep = (size_t)(BK * 2);
    const size_t hstep = (size_t)HALF * K * 2;
    const size_t tstep = 2 * hstep;
    const unsigned ldsw = (unsigned)wid * 1024u;
    const int aoff = lds_byte(wr * 64 + fr, fq * 8), boff = lds_byte(wc * 32 + fr, fq * 8);
#define PG8_SA(b, h) (((b) * 2 + (h)) * HTB)
#define PG8_SB(b, h) ((4 + (b) * 2 + (h)) * HTB)
#define PG8_STAGE(bufoff, gbase, voff) do { _Pragma("unroll") for (int _i = 0; _i < 2; ++_i) \
        __builtin_amdgcn_global_load_lds((const unsigned*)((const char*)(gbase) + (voff)[_i]), (PG8_LAS unsigned*)(lds + (bufoff) + ldsw + _i * 8192), 16, 0, 0); } while (0)
#define PG8_LDA(dst, b, h) do { _Pragma("unroll") for (int m = 0; m < 4; ++m) _Pragma("unroll") for (int k = 0; k < 2; ++k) dst[m][k] = *(const PG8_LAS bf16x8*)(lds + PG8_SA(b, h) + aoff + m * 2048 + k * 1024); } while (0)
#define PG8_LDB(dst, b, h) do { _Pragma("unroll") for (int n = 0; n < 2; ++n) _Pragma("unroll") for (int k = 0; k < 2; ++k) dst[n][k] = *(const PG8_LAS bf16x8*)(lds + PG8_SB(b, h) + boff + n * 2048 + k * 1024); } while (0)
#define PG8_MMA(ai, bj, At, Bt) do { __builtin_amdgcn_s_setprio(1); _Pragma("unroll") for (int m = 0; m < 4; ++m) _Pragma("unroll") for (int n = 0; n < 2; ++n) _Pragma("unroll") for (int k = 0; k < 2; ++k) \
        acc[ai][bj][m][n] = __builtin_amdgcn_mfma_f32_16x16x32_bf16(Bt[n][k], At[m][k], acc[ai][bj][m][n], 0, 0, 0); __builtin_amdgcn_s_setprio(0); } while (0)
#define PG8_WAIT_V(n) asm volatile("s_waitcnt vmcnt(" #n ")" ::: "memory")
#define PG8_WAIT_L(n) asm volatile("s_waitcnt lgkmcnt(" #n ")" ::: "memory")
#define PG8_BAR __builtin_amdgcn_s_barrier()
#define PG8_SCHED __builtin_amdgcn_sched_barrier(0)
    Unit cur, nxt; int ui = 0;
    if (!S.next(0, cur)) return;
    f32x4 acc[2][2][4][2];
#pragma unroll
    for (int a = 0; a < 2; ++a)
#pragma unroll
        for (int b = 0; b < 2; ++b)
#pragma unroll
            for (int m = 0; m < 4; ++m)
#pragma unroll
                for (int n = 0; n < 2; ++n) acc[a][b][m][n] = (f32x4){0.f, 0.f, 0.f, 0.f};
    bf16x8 At[4][2], B0[2][2], B1[2][2];
    const char* cA = S.pa(cur, g); const char* cB = S.pb(cur, g);
    S.a_ready(cur);
    PG8_STAGE(PG8_SB(0, 0), cB, voffB); PG8_STAGE(PG8_SA(0, 0), cA, voffA); PG8_STAGE(PG8_SB(0, 1), cB + hstep, voffB); PG8_STAGE(PG8_SA(0, 1), cA + hstep, voffA);
    if (wr == 1) PG8_BAR;
    PG8_WAIT_V(4); PG8_BAR;
    PG8_STAGE(PG8_SB(1, 0), cB + kstep, voffB); PG8_STAGE(PG8_SA(1, 0), cA + kstep, voffA); PG8_STAGE(PG8_SB(1, 1), cB + hstep + kstep, voffB);
    PG8_WAIT_V(6); PG8_BAR;
    PG8_STAMP();
    for (;;) {
        const bool has_next = S.next(ui + 1, nxt);
        const char* nA = has_next ? S.pa(nxt, g) : cA; const char* nB = has_next ? S.pb(nxt, g) : cB;
        for (int t = 0; t < nt; t += 2) {
            const bool last = (t == nt - 2);
            const char* a1 = cA + (size_t)(t + 1) * kstep;
            const char* a2 = last ? nA : cA + (size_t)(t + 2) * kstep; const char* b2 = last ? nB : cB + (size_t)(t + 2) * kstep;
            const char* a3 = a2 + kstep; const char* b3 = b2 + kstep;
            if (last && has_next) S.a_ready(nxt);
            PG8_LDB(B0, 0, 0); PG8_SCHED; PG8_LDA(At, 0, 0); PG8_STAGE(PG8_SA(1, 1), a1 + hstep, voffA);
            PG8_WAIT_L(8); PG8_BAR; PG8_WAIT_L(0); PG8_MMA(0, 0, At, B0); PG8_BAR; PG8_SCHED;
            PG8_LDB(B1, 0, 1); PG8_STAGE(PG8_SB(0, 0), b2, voffB);
            PG8_BAR; PG8_WAIT_L(0); PG8_MMA(0, 1, At, B1); PG8_BAR;
            PG8_LDA(At, 0, 1); PG8_STAGE(PG8_SA(0, 0), a2, voffA);
            PG8_BAR; PG8_WAIT_L(0); PG8_MMA(1, 0, At, B0); PG8_BAR; PG8_SCHED;
            PG8_STAGE(PG8_SB(0, 1), b2 + hstep, voffB);
            PG8_WAIT_V(6); PG8_BAR; PG8_MMA(1, 1, At, B1); PG8_BAR;
            PG8_LDB(B0, 1, 0); PG8_SCHED; PG8_LDA(At, 1, 0); PG8_STAGE(PG8_SA(0, 1), a2 + hstep, voffA);
            PG8_WAIT_L(8); PG8_BAR; PG8_WAIT_L(0); PG8_MMA(0, 0, At, B0); PG8_BAR; PG8_SCHED;
            PG8_LDB(B1, 1, 1); PG8_STAGE(PG8_SB(1, 0), b3, voffB);
            PG8_BAR; PG8_WAIT_L(0); PG8_MMA(0, 1, At, B1); PG8_BAR;
            PG8_LDA(At, 1, 1); PG8_STAGE(PG8_SA(1, 0), a3, voffA);
            PG8_BAR; PG8_WAIT_L(0); PG8_MMA(1, 0, At, B0); PG8_BAR; PG8_SCHED;
            PG8_STAGE(PG8_SB(1, 1), b3 + hstep, voffB);
            PG8_WAIT_V(6); PG8_BAR; PG8_MMA(1, 1, At, B1); PG8_BAR;
        }
        PG8_STAMP();
        if constexpr (!Epi::AFTER_DRAIN) { E(acc, cur, wr, wc, fr, fq); S.done(cur); }
        PG8_STAMP();
        if (!has_next) break;
#pragma unroll
        for (int a = 0; a < 2; ++a)
#pragma unroll
            for (int b = 0; b < 2; ++b)
#pragma unroll
                for (int m = 0; m < 4; ++m)
#pragma unroll
                    for (int n = 0; n < 2; ++n) acc[a][b][m][n] = (f32x4){0.f, 0.f, 0.f, 0.f};
        cur = nxt; cA = nA; cB = nB; ++ui;
    }
    PG8_WAIT_V(0);
    if (wr == 0) PG8_BAR;
    PG8_BAR;
    if constexpr (Epi::AFTER_DRAIN) { E.fused(acc, cur, wr, wc, fr, fq, lds, wid, lane); S.done(cur); }
    PG8_STAMP();
    if (STAMP && wid == 0) { stamps[lane] = lane < nts ? (((unsigned long long)(unsigned)ts_hi << 32) | (unsigned)ts_lo) : 0ull;
        if (lane == 62) stamps[62] = rt_entry; if (lane == 63) stamps[63] = 0ull; }
#undef PG8_STAMP
#undef PG8_SA
#undef PG8_SB
#undef PG8_STAGE
#undef PG8_LDA
#undef PG8_LDB
#undef PG8_MMA
#undef PG8_WAIT_V
#undef PG8_WAIT_L
#undef PG8_BAR
#undef PG8_SCHED
}

}

struct EpiP {
  static constexpr bool PERM = true, AFTER_DRAIN = false;
  u16* P;
  DI void operator()(const f32x4 (&acc)[2][2][4][2], const pg8::Unit& u, int wr, int wc, int fr, int fq) const {
    const int row0 = u.pm * 256 + wr * 64 + fr, col0 = u.pn * 256 + wc * 32 + 8 * fq;
#pragma unroll
    for (int ai = 0; ai < 2; ++ai)
#pragma unroll
      for (int m = 0; m < 4; ++m) {
        u16* rowp = P + (size_t)(row0 + ai * 128 + m * 16) * PW + col0;
#pragma unroll
        for (int bj = 0; bj < 2; ++bj) {
          if (col0 + bj * 128 < PW) {
            const f32x4 v0 = acc[ai][bj][m][0], v1 = acc[ai][bj][m][1];
            u32x4 w; w.x = pk2(v0[0], v0[1]); w.y = pk2(v0[2], v0[3]); w.z = pk2(v1[0], v1[1]); w.w = pk2(v1[2], v1[3]);
            *(u32x4*)(rowp + bj * 128) = w;
          }
        }
      }
  }
};
struct EpiX {
  static constexpr bool PERM = false, AFTER_DRAIN = false;
  const float* xin; float* xout;
  DI void operator()(const f32x4 (&acc)[2][2][4][2], const pg8::Unit& u, int wr, int wc, int fr, int fq) const {
    int row0 = u.pm * 256 + wr * 64 + fr, col0 = u.pn * 256 + wc * 32 + 4 * fq;
    asm volatile("" : "+v"(row0), "+v"(col0));
#pragma unroll
    for (int am = 0; am < 4; ++am) {
      const int ai = am >> 1, mb = (am & 1) * 2;
      f32x4 xv[4][2][2];
#pragma unroll
      for (int m = mb; m < mb + 2; ++m)
#pragma unroll
        for (int bj = 0; bj < 2; ++bj)
#pragma unroll
          for (int n = 0; n < 2; ++n)
            xv[m][bj][n] = *(const f32x4*)(xin + (size_t)(row0 + ai * 128 + m * 16) * D_ + col0 + bj * 128 + n * 16);
#pragma unroll
      for (int m = mb; m < mb + 2; ++m)
#pragma unroll
        for (int bj = 0; bj < 2; ++bj)
#pragma unroll
          for (int n = 0; n < 2; ++n)
            *(f32x4*)(xout + (size_t)(row0 + ai * 128 + m * 16) * D_ + col0 + bj * 128 + n * 16) = xv[m][bj][n] + acc[ai][bj][m][n];
      __builtin_amdgcn_sched_barrier(0);
    }
  }
};

DI size_t wtile(int n0, int K) { return (size_t)(n0 >> 7) * (size_t)(K >> 6) * 8192; }
DI size_t htile(int m0) { return (size_t)(m0 >> 8) * 16 * 16384 + (size_t)(m0 & 255) * 64; }

template <int MI, int NJ>
DI void zero_acc(f32x16 (&acc)[MI][NJ]) {
#pragma unroll
  for (int i = 0; i < MI; ++i)
#pragma unroll
    for (int j = 0; j < NJ; ++j)
#pragma unroll
      for (int e = 0; e < 16; ++e) acc[i][j][e] = 0.f;
}

#define TILE_WALK_BEGIN(MT, NT, SM, SN)                                                   \
  {                                                                                       \
    const int xg_ = bid & 7, loc_ = bid >> 3, nloc_ = nblk >> 3;                          \
    const int nsn_ = ((NT) + (SN) - 1) / (SN), nst_ = (((MT) + (SM) - 1) / (SM)) * nsn_;  \
    for (int st_ = xg_; st_ < nst_; st_ += 8)                                             \
      for (int j_ = loc_; j_ < (SM) * (SN); j_ += nloc_) {                                \
        const int mi = (st_ / nsn_) * (SM) + j_ / (SN), ni = (st_ % nsn_) * (SN) + j_ % (SN); \
        if (mi >= (MT) || ni >= (NT)) continue;
#define TILE_WALK_END }}

DI int t5_bucket(int rel) {
  int n = rel < 0 ? -rel : rel;
  float nf = (float)(n > 1 ? n : 1);
  int large = 8 + (int)(logf(nf / 8.f) / logf(16.f) * 8.f);
  large = large < 15 ? large : 15;
  return (rel > 0 ? 16 : 0) + (n < 8 ? n : large);
}

DI void prep_job(const float* __restrict__ src, int K, int Nsrc, u16* __restrict__ dst, int Ndst, int mode,
                 const float* __restrict__ scale, char* smem, int bid, int nblk, bool rowmajor = false) {
  u16* sT = (u16*)smem;
  const int tid = otid();
  const int ntn = Ndst >> 6, ntk = K >> 6;
  float v[16];
  auto gl = [&](int t) {
    const int n0 = (t / ntk) << 6, k0 = (t % ntk) << 6;
    const int n = n0 + (tid & 63);
    int sc = n;
    if (mode == 1) sc = (n < 1536) ? n : (n < 6912 ? n + 16 : (n < 6928 ? n - 6912 + 1536 : -1));
#pragma unroll
    for (int i = 0; i < 16; ++i) {
      const int k = i * 4 + (tid >> 6);
      float x = 0.f;
      if (sc >= 0) x = src[(size_t)(k0 + k) * Nsrc + sc];
      if (scale) x *= scale[k0 + k];
      v[i] = x;
    }
  };
  if (bid < ntn * ntk) gl(bid);
  for (int t = bid; t < ntn * ntk; t += nblk) {
    const int n0 = (t / ntk) << 6, k0 = (t % ntk) << 6;
    __syncthreads();
#pragma unroll
    for (int i = 0; i < 16; ++i) sT[(tid & 63) * 72 + i * 4 + (tid >> 6)] = f2bf(v[i]);
    if (t + nblk < ntn * ntk) gl(t + nblk);
    __syncthreads();
    const int nn = tid >> 2, ks = (tid & 3) * 16;
    u32x4 v0 = *(const u32x4*)(sT + nn * 72 + ks), v1 = *(const u32x4*)(sT + nn * 72 + ks + 8);
    u16* d = rowmajor ? dst + (size_t)(n0 + nn) * K + k0 + ks
                      : dst + ((size_t)((n0 + nn) >> 7) * (size_t)(K >> 6) + (size_t)(k0 >> 6)) * 8192 + (size_t)((n0 + nn) & 127) * 64 + ks;
    *(u32x4*)d = v0;
    *(u32x4*)(d + 8) = v1;
  }
}

DI void phase_prologue(const Params& p, char* smem, int bid, int nblk) {
  const int tid = otid(), lane = tid & 63, w = tid >> 6;
  for (int i = bid * 256 + tid; i < 12 * 4095; i += nblk * 256) {
    const int hd = i / 4095, idx = i % 4095;
    p.lut[hd * LUTS + idx] = p.in[2][t5_bucket(idx - 2047) * 12 + hd];
  }
  for (int row = bid * 4 + w; row < NBATCH * MEML; row += nblk * 4) {
    const float* src = p.in[1] + (size_t)row * D_;
    float ss = 0.f;
#pragma unroll
    for (int i = 0; i < 4; ++i) {
      f32x4 v = *(const f32x4*)(src + i * 256 + lane * 4);
      ss += v[0] * v[0] + v[1] * v[1] + v[2] * v[2] + v[3] * v[3];
      u32x2 o; o.x = pk2(v[0], v[1]); o.y = pk2(v[2], v[3]);
      *(u32x2*)(p.memb + (size_t)row * D_ + i * 256 + lane * 4) = o;
    }
    ss = wave_sum(ss);
    if (lane == 0) p.memrs[row] = rsqrtf(ss / (float)D_ + EPS_);
  }
  for (int l = 0; l < 2; ++l) {
    u16* W = p.W + (size_t)l * LAYER_W;
    prep_job(p.in[5] + (size_t)l * D_ * 6928, D_, 6928, W + WIN_OFF, PW, 1, nullptr, smem, bid, nblk, true);
    for (int i = 0; i < 5; ++i)
      prep_job(p.in[27] + ((size_t)l * 5 + i) * D_ * D_, D_, D_, W + WMG_OFF + (size_t)i * D_ * D_, D_, 0, nullptr, smem, bid, nblk, true);
    for (int i = 0; i < 5; ++i)
      prep_job(p.in[29] + ((size_t)l * 5 + i) * BWID * D_, BWID, D_, W + WBR_OFF + (size_t)i * D_ * BWID, D_, 0, nullptr, smem, bid, nblk, true);
    prep_job(p.in[30] + (size_t)l * D_ * D_, D_, D_, W + WOUT_OFF, D_, 0, nullptr, smem, bid, nblk, true);
    prep_job(p.in[23] + (size_t)l * BWID * BWID, BWID, BWID, W + WGLU_OFF, BWID, 0, nullptr, smem, bid, nblk, true);
    prep_job(p.in[26] + (size_t)l * D_ * D_, D_, D_, W + WKV_OFF, D_, 0, p.in[25] + (size_t)l * D_, smem, bid, nblk);
  }
}

DI void phase_norm(const float* __restrict__ x, const float* __restrict__ g, u16* __restrict__ hdst, int nrows, int bid, int nblk) {
  const int tid_ = otid(), lane = tid_ & 63, w = tid_ >> 6;
  const int stride = nblk * 4;
  for (int row0 = bid * 4 + w; row0 < nrows; row0 += 4 * stride) {
    f32x4 v[4][4];
    float ss[4] = {0.f, 0.f, 0.f, 0.f};
#pragma unroll
    for (int u = 0; u < 4; ++u) {
      const int row = row0 + u * stride;
      if (row < nrows) {
        const float* src = x + (size_t)row * D_;
#pragma unroll
        for (int i = 0; i < 4; ++i) v[u][i] = *(const f32x4*)(src + i * 256 + lane * 4);
      }
    }
#pragma unroll
    for (int u = 0; u < 4; ++u) {
      const int row = row0 + u * stride;
      if (row < nrows) {
#pragma unroll
        for (int i = 0; i < 4; ++i) ss[u] += v[u][i][0] * v[u][i][0] + v[u][i][1] * v[u][i][1] + v[u][i][2] * v[u][i][2] + v[u][i][3] * v[u][i][3];
        ss[u] = wave_sum(ss[u]);
        const float rs = rsqrtf(ss[u] / (float)D_ + EPS_);
#pragma unroll
        for (int i = 0; i < 4; ++i) {
          f32x4 gg = *(const f32x4*)(g + i * 256 + lane * 4);
          u32x2 o; o.x = pk2(v[u][i][0] * rs * gg[0], v[u][i][1] * rs * gg[1]); o.y = pk2(v[u][i][2] * rs * gg[2], v[u][i][3] * rs * gg[3]);
          const int c = i * 256 + lane * 4;
          *(u32x2*)(hdst + (size_t)row * D_ + c) = o;
        }
      }
    }
  }
}

DI void phase_final(float* __restrict__ x, const float* __restrict__ g, int nrows, int bid, int nblk) {
  const int tid_ = otid(), lane = tid_ & 63, w = tid_ >> 6;
  const int stride = nblk * 4;
  for (int row0 = bid * 4 + w; row0 < nrows; row0 += 4 * stride) {
    f32x4 v[4][4];
    float ss[4] = {0.f, 0.f, 0.f, 0.f};
#pragma unroll
    for (int u = 0; u < 4; ++u) {
      const int row = row0 + u * stride;
      if (row < nrows) {
        const float* src = x + (size_t)row * D_;
#pragma unroll
        for (int i = 0; i < 4; ++i) v[u][i] = *(const f32x4*)(src + i * 256 + lane * 4);
      }
    }
#pragma unroll
    for (int u = 0; u < 4; ++u) {
      const int row = row0 + u * stride;
      if (row < nrows) {
        float* src = x + (size_t)row * D_;
#pragma unroll
        for (int i = 0; i < 4; ++i) ss[u] += v[u][i][0] * v[u][i][0] + v[u][i][1] * v[u][i][1] + v[u][i][2] * v[u][i][2] + v[u][i][3] * v[u][i][3];
        ss[u] = wave_sum(ss[u]);
        const float rs = rsqrtf(ss[u] / (float)D_ + EPS_);
#pragma unroll
        for (int i = 0; i < 4; ++i) {
          f32x4 gg = *(const f32x4*)(g + i * 256 + lane * 4);
          f32x4 o; o[0] = v[u][i][0] * rs * gg[0]; o[1] = v[u][i][1] * rs * gg[1]; o[2] = v[u][i][2] * rs * gg[2]; o[3] = v[u][i][3] * rs * gg[3];
          *(f32x4*)(src + i * 256 + lane * 4) = o;
        }
      }
    }
  }
}

DI void phase_kv(const Params& p, char* smem, int bid, int nblk) {
  const int tid_ = otid(), lane = tid_ & 63, w = tid_ >> 6, wm = w >> 1, wn = w & 1, r = lane & 31, h = lane >> 5;
  for (int t = bid; t < 2 * 32 * 8; t += nblk) {
    const int l = t >> 8, tt = t & 255, m0 = (tt >> 3) * 128, n0 = (tt & 7) * 128;
    f32x16 acc[2][2];
    zero_acc<2, 2>(acc);
    gemm_acc<128, 128>(p.memb + (size_t)m0 * D_, D_, 64, p.W + (size_t)l * LAYER_W + WKV_OFF + wtile(n0, D_), 64, 8192, D_, acc, smem);
    u16* dst = p.KV + (size_t)l * NBATCH * MEML * D_;
#pragma unroll
    for (int i = 0; i < 2; ++i)
#pragma unroll
      for (int e = 0; e < 16; ++e) {
        const int row = m0 + wm * 64 + 32 * i + crow(e, h);
        const float rs = p.memrs[row];
#pragma unroll
        for (int j = 0; j < 2; ++j) dst[(size_t)row * D_ + n0 + wn * 64 + 32 * j + r] = f2bf(acc[i][j][e] * rs);
      }
  }
}

DI void phase_inproj(const Params& p, int l, int Tg, char* smem, int bid, int nblk) {
  const pg8::Gemm g{p.h, p.W + (size_t)l * LAYER_W + WIN_OFF, Tg, 7168, D_};
  pg8::StaticOrder S; S.init(Tg, 7168, nblk, bid);
  const EpiP E{p.P};
  pg8::gemm_phase<EpiP, pg8::StaticOrder>((PG8_LAS unsigned char*)smem, g, S, E);
}

struct EpiG {
  static constexpr bool PERM = true, AFTER_DRAIN = false;
  unsigned char* G; const float* bias;
  DI void operator()(const f32x4 (&acc)[2][2][4][2], const pg8::Unit& u, int wr, int wc, int fr, int fq) const {
    int row0 = u.pm * 256 + wr * 64 + fr, col0 = u.pn * 256 + wc * 32 + 8 * fq;
    asm volatile("" : "+v"(row0), "+v"(col0));
    f32x4 bv[2][2];
#pragma unroll
    for (int bj = 0; bj < 2; ++bj)
#pragma unroll
      for (int n = 0; n < 2; ++n) bv[bj][n] = *(const f32x4*)(bias + col0 + bj * 128 + 4 * n);
#pragma unroll
    for (int ai = 0; ai < 2; ++ai)
#pragma unroll
      for (int m = 0; m < 4; ++m) {
        unsigned char* rowp = G + (size_t)(row0 + ai * 128 + m * 16) * (5 * D_) + col0;
#pragma unroll
        for (int bj = 0; bj < 2; ++bj) {
          const f32x4 v0 = acc[ai][bj][m][0] + bv[bj][0], v1 = acc[ai][bj][m][1] + bv[bj][1];
          u32x2 w;
          w.x = (unsigned)(sigmoidf_(v0[0]) * 255.f + 0.5f) | ((unsigned)(sigmoidf_(v0[1]) * 255.f + 0.5f) << 8) |
                ((unsigned)(sigmoidf_(v0[2]) * 255.f + 0.5f) << 16) | ((unsigned)(sigmoidf_(v0[3]) * 255.f + 0.5f) << 24);
          w.y = (unsigned)(sigmoidf_(v1[0]) * 255.f + 0.5f) | ((unsigned)(sigmoidf_(v1[1]) * 255.f + 0.5f) << 8) |
                ((unsigned)(sigmoidf_(v1[2]) * 255.f + 0.5f) << 16) | ((unsigned)(sigmoidf_(v1[3]) * 255.f + 0.5f) << 24);
          *(u32x2*)(rowp + bj * 128) = w;
        }
      }
  }
};

DI void phase_gates(const Params& p, int l, int Tg, unsigned char* G, char* smem, int bid, int nblk) {
  const pg8::Gemm g{p.h, p.W + (size_t)l * LAYER_W + WMG_OFF, Tg, 5 * D_, D_};
  pg8::StaticOrder S; S.init(Tg, 5 * D_, nblk, bid);
  const EpiG E{G, p.in[28] + (size_t)l * 5 * D_};
  pg8::gemm_phase<EpiG, pg8::StaticOrder>((PG8_LAS unsigned char*)smem, g, S, E);
}

struct EpiGLU {
  static constexpr bool PERM = true, AFTER_DRAIN = false;
  const u16* g; const u16* zs; u16* o3; const float* gb;
  DI void operator()(const f32x4 (&acc)[2][2][4][2], const pg8::Unit& u, int wr, int wc, int fr, int fq) const {
    int row0 = u.pm * 256 + wr * 64 + fr, col0 = u.pn * 256 + wc * 32 + 8 * fq;
    asm volatile("" : "+v"(row0), "+v"(col0));
    f32x4 bv[2][2];
#pragma unroll
    for (int bj = 0; bj < 2; ++bj)
#pragma unroll
      for (int n = 0; n < 2; ++n) bv[bj][n] = *(const f32x4*)(gb + col0 + bj * 128 + 4 * n);
#pragma unroll
    for (int am = 0; am < 4; ++am) {
      const int ai = am >> 1, mb = (am & 1) * 2;
      u32x4 gvv[4][2], zvv[4][2];
#pragma unroll
      for (int m = mb; m < mb + 2; ++m)
#pragma unroll
        for (int bj = 0; bj < 2; ++bj) {
          const size_t row = (size_t)(row0 + ai * 128 + m * 16);
          const int col = col0 + bj * 128;
          gvv[m][bj] = *(const u32x4*)(g + row * BWID + col);
          zvv[m][bj] = *(const u32x4*)(zs + row * BWID + col);
        }
#pragma unroll
      for (int m = mb; m < mb + 2; ++m)
#pragma unroll
        for (int bj = 0; bj < 2; ++bj) {
          const size_t row = (size_t)(row0 + ai * 128 + m * 16);
          const int col = col0 + bj * 128;
          const u32x4 gv = gvv[m][bj], zv = zvv[m][bj];
          const f32x4 v0 = acc[ai][bj][m][0] + bv[bj][0], v1 = acc[ai][bj][m][1] + bv[bj][1];
          u32x4 w;
          w.x = pk2(bflo(gv.x) * sigmoidf_(v0[0]) * bflo(zv.x), bfhi(gv.x) * sigmoidf_(v0[1]) * bfhi(zv.x));
          w.y = pk2(bflo(gv.y) * sigmoidf_(v0[2]) * bflo(zv.y), bfhi(gv.y) * sigmoidf_(v0[3]) * bfhi(zv.y));
          w.z = pk2(bflo(gv.z) * sigmoidf_(v1[0]) * bflo(zv.z), bfhi(gv.z) * sigmoidf_(v1[1]) * bfhi(zv.z));
          w.w = pk2(bflo(gv.w) * sigmoidf_(v1[2]) * bflo(zv.w), bfhi(gv.w) * sigmoidf_(v1[3]) * bfhi(zv.w));
          *(u32x4*)(o3 + row * BWID + col) = w;
        }
      __builtin_amdgcn_sched_barrier(0);
    }
  }
};

DI void phase_glu(const Params& p, int l, int Tg, char* smem, int bid, int nblk) {
  const pg8::Gemm g{p.s5f, p.W + (size_t)l * LAYER_W + WGLU_OFF, Tg, BWID, BWID};
  pg8::StaticOrder S; S.init(Tg, BWID, nblk, bid);
  const EpiGLU E{p.s5f, p.syb, p.o3, p.in[24] + (size_t)l * BWID};
  pg8::gemm_phase<EpiGLU, pg8::StaticOrder>((PG8_LAS unsigned char*)smem, g, S, E);
}

struct BranchOrder {
  const u16* ob0; size_t ostride; const u16* wbr; int c, ntile, G;
  DI bool next(int i, pg8::Unit& u) const {
    const int t = c + (i / 5) * G;
    if (t >= ntile) return false;
    u.pm = t >> 2; u.pn = t & 3; u.br = i % 5; return true;
  }
  DI void a_ready(const pg8::Unit&) const {}
  DI void done(const pg8::Unit&) const {}
  DI const char* pa(const pg8::Unit& u, const pg8::Gemm& g) const { return (const char*)(ob0 + (size_t)u.br * ostride + (size_t)u.pm * 256 * BWID); }
  DI const char* pb(const pg8::Unit& u, const pg8::Gemm& g) const { return (const char*)(wbr + (size_t)u.br * D_ * BWID + (size_t)u.pn * 256 * BWID); }
};
struct EpiY {
  static constexpr bool PERM = true, AFTER_DRAIN = false;
  const unsigned char* G; u16* y;
  DI void operator()(const f32x4 (&acc)[2][2][4][2], const pg8::Unit& u, int wr, int wc, int fr, int fq) const {
    int row0 = u.pm * 256 + wr * 64 + fr, col0 = u.pn * 256 + wc * 32 + 8 * fq;
    asm volatile("" : "+v"(row0), "+v"(col0));
    const float ks_ = 1.f / 255.f;
#pragma unroll
    for (int ai = 0; ai < 2; ++ai) {
      u32x2 gq[4][2]; u32x4 yv[4][2];
#pragma unroll
      for (int m = 0; m < 4; ++m)
#pragma unroll
        for (int bj = 0; bj < 2; ++bj) {
          const size_t row = (size_t)(row0 + ai * 128 + m * 16);
          const int col = col0 + bj * 128;
          gq[m][bj] = *(const u32x2*)(G + row * (5 * D_) + u.br * D_ + col);
          yv[m][bj] = (u32x4){0u, 0u, 0u, 0u};
          if (u.br > 0) yv[m][bj] = *(const u32x4*)(y + row * D_ + col);
        }
#pragma unroll
      for (int m = 0; m < 4; ++m)
#pragma unroll
        for (int bj = 0; bj < 2; ++bj) {
          const size_t row = (size_t)(row0 + ai * 128 + m * 16);
          const int col = col0 + bj * 128;
          const u32x2 g = gq[m][bj]; const u32x4 yy = yv[m][bj];
          const float g0 = (float)(g.x & 255u) * ks_, g1 = (float)((g.x >> 8) & 255u) * ks_, g2 = (float)((g.x >> 16) & 255u) * ks_, g3 = (float)(g.x >> 24) * ks_;
          const float g4 = (float)(g.y & 255u) * ks_, g5 = (float)((g.y >> 8) & 255u) * ks_, g6 = (float)((g.y >> 16) & 255u) * ks_, g7 = (float)(g.y >> 24) * ks_;
          const f32x4 v0 = acc[ai][bj][m][0], v1 = acc[ai][bj][m][1];
          u32x4 w;
          w.x = pk2(bflo(yy.x) + g0 * v0[0], bfhi(yy.x) + g1 * v0[1]);
          w.y = pk2(bflo(yy.y) + g2 * v0[2], bfhi(yy.y) + g3 * v0[3]);
          w.z = pk2(bflo(yy.z) + g4 * v1[0], bfhi(yy.z) + g5 * v1[1]);
          w.w = pk2(bflo(yy.w) + g6 * v1[2], bfhi(yy.w) + g7 * v1[3]);
          *(u32x4*)(y + row * D_ + col) = w;
        }
      __builtin_amdgcn_sched_barrier(0);
    }
  }
};

DI void phase_merge(const Params& p, int l, int Tg, const unsigned char* G, u16* ydst, char* smem, int bid, int nblk) {
  const pg8::Gemm g{nullptr, nullptr, Tg, D_, BWID};
  BranchOrder S;
  S.ob0 = p.o0; S.ostride = (size_t)Tg * BWID;
  S.wbr = p.W + (size_t)l * LAYER_W + WBR_OFF; S.c = bid; S.G = nblk; S.ntile = (Tg / 256) * 4;
  const EpiY E{G, ydst};
  pg8::gemm_phase<EpiY, BranchOrder>((PG8_LAS unsigned char*)smem, g, S, E);
}

DI void phase_out(const Params& p, int l, int Tg, const u16* ysrc, const float* xin,
                  float* xout, char* smem, int bid, int nblk) {
  const pg8::Gemm g{ysrc, p.W + (size_t)l * LAYER_W + WOUT_OFF, Tg, D_, D_};
  pg8::StaticOrder S; S.init(Tg, D_, nblk, bid);
  const EpiX E{xin, xout};
  pg8::gemm_phase<EpiX, pg8::StaticOrder>((PG8_LAS unsigned char*)smem, g, S, E);
}

DI void phase_conv(const Params& p, int l, int Tg, int bid, int nblk) {
  const float* cw = p.in[6] + (size_t)l * 5 * 1024;
  const float* cb = p.in[7] + (size_t)l * 1024;
  const int total = Tg * 128, stride = nblk * 256;
  for (int idx0 = bid * 256 + otid(); idx0 < total; idx0 += 2 * stride) {
    const int c0 = (idx0 & 127) * 8;
    u32x4 xin[2][5];
    bool ok[2][5];
#pragma unroll
    for (int u = 0; u < 2; ++u) {
      const int idx = idx0 + u * stride;
      const int tok = idx >> 7, spos = tok & (S_ - 1);
#pragma unroll
      for (int k = 0; k < 5; ++k) {
        const int sp = spos + k - 2;
        ok[u][k] = (idx < total) && sp >= 0 && sp < S_;
        xin[u][k] = (u32x4){0u, 0u, 0u, 0u};
        if (ok[u][k]) xin[u][k] = *(const u32x4*)(p.P + (size_t)(tok + k - 2) * PW + c0);
      }
    }
    float acc[2][8];
#pragma unroll
    for (int j = 0; j < 8; ++j) { acc[0][j] = cb[c0 + j]; acc[1][j] = acc[0][j]; }
#pragma unroll
    for (int k = 0; k < 5; ++k) {
      float wv[8], f0[8], f1[8];
#pragma unroll
      for (int j = 0; j < 8; ++j) wv[j] = cw[k * 1024 + c0 + j];
      unpack8(xin[0][k], f0);
      unpack8(xin[1][k], f1);
#pragma unroll
      for (int j = 0; j < 8; ++j) { acc[0][j] += f0[j] * wv[j]; acc[1][j] += f1[j] * wv[j]; }
    }
#pragma unroll
    for (int u = 0; u < 2; ++u) {
      const int idx = idx0 + u * stride;
      if (idx < total) {
        u32x4 o;
        o.x = pk2(siluf_(acc[u][0]), siluf_(acc[u][1])); o.y = pk2(siluf_(acc[u][2]), siluf_(acc[u][3]));
        o.z = pk2(siluf_(acc[u][4]), siluf_(acc[u][5])); o.w = pk2(siluf_(acc[u][6]), siluf_(acc[u][7]));
        *(u32x4*)(p.xa + (size_t)(idx >> 7) * 1024 + c0) = o;
      }
    }
  }
}

template <int DQK, int DV>
DI void attn_pass(const bf16x8 (&qf)[DQK / 16], const u16* __restrict__ Kg, int ldk, const u16* __restrict__ Vg, int ldv,
                  int kt0, int kt1, int q_pos, int q_lo, const float* lut, int window, float m_init, float l_init,
                  f32x16 (&o)[DV / 32], float& l_out, u16* sK, u16* sV) {
  constexpr int LDK = DQK + 8, LDV = DV + 16, NKC = DQK / 32, NVC = DV / 32;
  const int tid = otid(), lane = tid & 63, r = lane & 31, h = lane >> 5;
  u32x4 rk[NKC], rv[NVC];
#pragma unroll
  for (int d = 0; d < DV / 32; ++d)
#pragma unroll
    for (int e = 0; e < 16; ++e) o[d][e] = 0.f;
  float m = m_init, lsum = (h == 0) ? l_init : 0.f;
  {
#pragma unroll
    for (int i = 0; i < NKC; ++i) { const int c = tid + 256 * i, row = c / (DQK / 8), col = (c % (DQK / 8)) * 8; rk[i] = *(const u32x4*)(Kg + (size_t)(kt0 * 64 + row) * ldk + col); }
#pragma unroll
    for (int i = 0; i < NVC; ++i) { const int c = tid + 256 * i, row = c / (DV / 8), col = (c % (DV / 8)) * 8; rv[i] = *(const u32x4*)(Vg + (size_t)(kt0 * 64 + row) * ldv + col); }
  }
#pragma unroll 1
  for (int kt = kt0; kt < kt1; ++kt) {
    __syncthreads();
#pragma unroll
    for (int i = 0; i < NKC; ++i) { const int c = tid + 256 * i, row = c / (DQK / 8), col = (c % (DQK / 8)) * 8; *(u32x4*)(sK + row * LDK + col) = rk[i]; }
#pragma unroll
    for (int i = 0; i < NVC; ++i) { const int c = tid + 256 * i, row = c / (DV / 8), col = (c % (DV / 8)) * 8; *(u32x4*)(sV + row * LDV + col) = rv[i]; }
    __syncthreads();
    if (kt + 1 < kt1) {
#pragma unroll
      for (int i = 0; i < NKC; ++i) { const int c = tid + 256 * i, row = c / (DQK / 8), col = (c % (DQK / 8)) * 8; rk[i] = *(const u32x4*)(Kg + (size_t)((kt + 1) * 64 + row) * ldk + col); }
#pragma unroll
      for (int i = 0; i < NVC; ++i) { const int c = tid + 256 * i, row = c / (DV / 8), col = (c % (DV / 8)) * 8; rv[i] = *(const u32x4*)(Vg + (size_t)((kt + 1) * 64 + row) * ldv + col); }
    }
    f32x16 s[2];
#pragma unroll
    for (int t = 0; t < 2; ++t) {
      bf16x8 ka[DQK / 16];
#pragma unroll
      for (int ks = 0; ks < DQK / 16; ++ks) ka[ks] = ldfrag(sK, LDK, 32 * t + r, 16 * ks + 8 * h);
#pragma unroll
      for (int e = 0; e < 16; ++e) s[t][e] = 0.f;
#pragma unroll
      for (int ks = 0; ks < DQK / 16; ++ks) s[t] = MFMA32(ka[ks], qf[ks], s[t]);
    }
    const int kbase = kt * 64;
    if (lut) {
      const bool far_ = (window == 0) && ((kbase - (q_lo + 31) >= 91) || (q_lo - (kbase + 63) >= 91));
      if (far_) {
        const float bconst = lut[(kbase > q_lo) ? 4000 : 100];
#pragma unroll
        for (int t = 0; t < 2; ++t)
#pragma unroll
          for (int e = 0; e < 16; ++e) s[t][e] += bconst;
      } else {
#pragma unroll
        for (int t = 0; t < 2; ++t)
#pragma unroll
          for (int e = 0; e < 16; ++e) {
            const int rel = kbase + 32 * t + crow(e, h) - q_pos;
            float v = s[t][e] + lut[rel + 2047];
            if (window > 0 && (rel > window || rel < -window)) v = -INFINITY;
            s[t][e] = v;
          }
      }
    }
    float mx = s[0][0];
#pragma unroll
    for (int t = 0; t < 2; ++t)
#pragma unroll
      for (int e = 0; e < 16; ++e) mx = fmaxf(mx, s[t][e]);
    mx = fmaxf(mx, __shfl_xor(mx, 32, 64));
    if (__builtin_amdgcn_ballot_w64(mx > m + 8.f) != 0ull) {
      const float mn = fmaxf(m, mx);
      const float alpha = __builtin_amdgcn_exp2f(m - mn);
      m = mn;
      lsum *= alpha;
#pragma unroll
      for (int d = 0; d < DV / 32; ++d)
#pragma unroll
        for (int e = 0; e < 16; ++e) o[d][e] *= alpha;
    }
    float ps = 0.f;
#pragma unroll
    for (int t = 0; t < 2; ++t)
#pragma unroll
      for (int e = 0; e < 16; ++e) { const float pv = __builtin_amdgcn_exp2f(s[t][e] - m); s[t][e] = pv; ps += pv; }
    lsum += ps;
    bf16x8 pf[2][2];
#pragma unroll
    for (int t = 0; t < 2; ++t)
#pragma unroll
      for (int s2 = 0; s2 < 2; ++s2) pf[t][s2] = pack8(s[t], s2);
#pragma unroll
    for (int d = 0; d < DV / 32; ++d) {
      bf16x8 va[2][2];
#pragma unroll
      for (int t = 0; t < 2; ++t)
#pragma unroll
        for (int s2 = 0; s2 < 2; ++s2) va[t][s2] = ldfrag_tr_perm(sV, LDV, 32 * t + 16 * s2, 32 * d, lane);
#pragma unroll
      for (int t = 0; t < 2; ++t)
#pragma unroll
        for (int s2 = 0; s2 < 2; ++s2) o[d] = MFMA32(va[t][s2], pf[t][s2], o[d]);
    }
  }
  lsum += __shfl_xor(lsum, 32, 64);
  l_out = lsum;
}

template <int DQK>
DI void load_qfrag(bf16x8 (&qf)[DQK / 16], const u16* qrow, float scale, int h) {
#pragma unroll
  for (int ks = 0; ks < DQK / 16; ++ks) {
    u32x4 v = *(const u32x4*)(qrow + 16 * ks + 8 * h);
    qf[ks] = __builtin_bit_cast(bf16x8, scale8(v, scale));
  }
}

DI void attn_lds(char* smem, u16*& sK, u16*& sV, float*& slut) {
  sK = (u16*)smem; sV = sK + 64 * 136; slut = (float*)(sV + 64 * 144);
}

DI void diff_item(const Params& p, int l, int item, char* smem) {
  const int tid = otid(), lane = tid & 63, w = tid >> 6, r = lane & 31, h = lane >> 5;
  const int bl = item >> 6, hd = (item >> 4) & 3, qb = item & 15;
  u16 *sK, *sV; float* slut;
  attn_lds(smem, sK, sV, slut);
  __syncthreads();
  {
    const float* gl = p.lut + hd * LUTS;
    const float v0 = gl[2047 - 256 + tid], v1 = gl[2047 + tid];
    const float vf = (tid < 2) ? gl[tid ? 4000 : 100] : 0.f;
    slut[2047 - 256 + tid] = v0 * 1.4426950408889634f; slut[2047 + tid] = v1 * 1.4426950408889634f;
    if (tid < 2) slut[tid ? 4000 : 100] = vf * 1.4426950408889634f;
  }
  const float lam_init = 0.8f - 0.6f * expf(-0.3f * (float)l);
  const float* lp = p.in[12] + (size_t)l * 4 * 64;
  const float d1 = wave_sum(lp[lane] * lp[64 + lane]), d2 = wave_sum(lp[128 + lane] * lp[192 + lane]);
  const float lam = expf(d1) - expf(d2) + lam_init;
  const int q_lo = qb * 128 + 32 * w, q_pos = q_lo + r;
  const size_t tokq = (size_t)bl * S_ + q_pos;
  const u16* Pb = p.P + (size_t)bl * S_ * PW;
  f32x16 o[4];
  float lt;
  u16* odst = p.o1 + tokq * BWID + hd * 128;
  {
    bf16x8 qf[4];
    load_qfrag<64>(qf, p.P + tokq * PW + P_DQ + (hd * 2 + 0) * 64, 0.125f * 1.4426950408889634f, h);
    attn_pass<64, 128>(qf, Pb + P_DK + (hd * 2 + 0) * 64, PW, Pb + P_DV + hd * 128, PW, 0, 32, q_pos, q_lo, slut, 0, -INFINITY, 0.f, o, lt, sK, sV);
    const float inv = 1.f / lt;
#pragma unroll
    for (int d = 0; d < 4; ++d)
#pragma unroll
      for (int g4 = 0; g4 < 4; ++g4) {
        u32x2 ov;
        ov.x = pk2(o[d][4 * g4 + 0] * inv, o[d][4 * g4 + 1] * inv);
        ov.y = pk2(o[d][4 * g4 + 2] * inv, o[d][4 * g4 + 3] * inv);
        *(u32x2*)(odst + 32 * d + 8 * g4 + 4 * h) = ov;
      }
  }
  {
    bf16x8 qf[4];
    load_qfrag<64>(qf, p.P + tokq * PW + P_DQ + (hd * 2 + 1) * 64, 0.125f * 1.4426950408889634f, h);
    attn_pass<64, 128>(qf, Pb + P_DK + (hd * 2 + 1) * 64, PW, Pb + P_DV + hd * 128, PW, 0, 32, q_pos, q_lo, slut, 0, -INFINITY, 0.f, o, lt, sK, sV);
    const float inv = lam / lt;
#pragma unroll
    for (int d = 0; d < 4; ++d)
#pragma unroll
      for (int g4 = 0; g4 < 4; ++g4) {
        const u32x2 pv = *(const u32x2*)(odst + 32 * d + 8 * g4 + 4 * h);
        o[d][4 * g4 + 0] = bflo(pv.x) - o[d][4 * g4 + 0] * inv;
        o[d][4 * g4 + 1] = bfhi(pv.x) - o[d][4 * g4 + 1] * inv;
        o[d][4 * g4 + 2] = bflo(pv.y) - o[d][4 * g4 + 2] * inv;
        o[d][4 * g4 + 3] = bfhi(pv.y) - o[d][4 * g4 + 3] * inv;
      }
  }
  float ss = 0.f;
#pragma unroll
  for (int d = 0; d < 4; ++d)
#pragma unroll
    for (int e = 0; e < 16; ++e) ss += o[d][e] * o[d][e];
  ss += __shfl_xor(ss, 32, 64);
  const float rs = rsqrtf(ss / 128.f + EPS_) * (1.f - lam_init);
  const float* sg = p.in[13] + (size_t)l * 128;
  u32x2 zall[4][4];
#pragma unroll
  for (int d = 0; d < 4; ++d)
#pragma unroll
    for (int g4 = 0; g4 < 4; ++g4) zall[d][g4] = *(const u32x2*)(p.P + tokq * PW + P_DZ + hd * 128 + 32 * d + 8 * g4 + 4 * h);
#pragma unroll
  for (int d = 0; d < 4; ++d)
#pragma unroll
    for (int g4 = 0; g4 < 4; ++g4) {
      const int dv = 32 * d + 8 * g4 + 4 * h;
      const u32x2 zz = zall[d][g4];
      const float z0 = bflo(zz.x), z1 = bfhi(zz.x), z2 = bflo(zz.y), z3 = bfhi(zz.y);
      u32x2 ov;
      ov.x = pk2(o[d][4 * g4 + 0] * rs * sg[dv + 0] * siluf_(z0), o[d][4 * g4 + 1] * rs * sg[dv + 1] * siluf_(z1));
      ov.y = pk2(o[d][4 * g4 + 2] * rs * sg[dv + 2] * siluf_(z2), o[d][4 * g4 + 3] * rs * sg[dv + 3] * siluf_(z3));
      *(u32x2*)(odst + dv) = ov;
    }
}

DI void win_item(const Params& p, int l, int item, char* smem) {
  const int tid = otid(), lane = tid & 63, w = tid >> 6, r = lane & 31, h = lane >> 5;
  const int bl = item >> 7, qh = (item >> 4) & 7, qb = item & 15;
  const int kvh = qh >> 2;
  u16 *sK, *sV; float* slut;
  attn_lds(smem, sK, sV, slut);
  __syncthreads();
  {
    const float* gl = p.lut + (4 + qh) * LUTS;
    const float v0 = gl[2047 - 256 + tid], v1 = gl[2047 + tid];
    slut[2047 - 256 + tid] = v0 * 1.4426950408889634f; slut[2047 + tid] = v1 * 1.4426950408889634f;
  }
  const float sink = p.in[14][l * 8 + qh];
  const int q_lo = qb * 128 + 32 * w, q_pos = q_lo + r;
  const size_t tokq = (size_t)bl * S_ + q_pos;
  const u16* Pb = p.P + (size_t)bl * S_ * PW;
  int kt0 = qb * 2 - 2; if (kt0 < 0) kt0 = 0;
  int kt1 = qb * 2 + 4; if (kt1 > 32) kt1 = 32;
  f32x16 o[2];
  float lt;
  bf16x8 qf[4];
  load_qfrag<64>(qf, p.P + tokq * PW + P_CQ + qh * 64, 0.125f * 1.4426950408889634f, h);
  attn_pass<64, 64>(qf, Pb + P_CK + kvh * 64, PW, Pb + P_CV + kvh * 64, PW, kt0, kt1, q_pos, q_lo, slut, 128, sink * 1.4426950408889634f, 1.f, o, lt, sK, sV);
  const float inv = 1.f / lt;
  u32x2 zall[2][4];
#pragma unroll
  for (int d = 0; d < 2; ++d)
#pragma unroll
    for (int g4 = 0; g4 < 4; ++g4) zall[d][g4] = *(const u32x2*)(p.P + tokq * PW + P_CZ + qh * 64 + 32 * d + 8 * g4 + 4 * h);
#pragma unroll
  for (int d = 0; d < 2; ++d)
#pragma unroll
    for (int g4 = 0; g4 < 4; ++g4) {
      const int dv = 32 * d + 8 * g4 + 4 * h;
      const u32x2 zz = zall[d][g4];
      const float z0 = bflo(zz.x), z1 = bfhi(zz.x), z2 = bflo(zz.y), z3 = bfhi(zz.y);
      u32x2 ov;
      ov.x = pk2(o[d][4 * g4 + 0] * inv * siluf_(z0), o[d][4 * g4 + 1] * inv * siluf_(z1));
      ov.y = pk2(o[d][4 * g4 + 2] * inv * siluf_(z2), o[d][4 * g4 + 3] * inv * siluf_(z3));
      *(u32x2*)(p.o2 + tokq * BWID + qh * 64 + dv) = ov;
    }
}

DI void mem_item(const Params& p, int l, int grp, int item, char* smem) {
  const int tid = otid(), lane = tid & 63, w = tid >> 6, r = lane & 31, h = lane >> 5;
  const int bl = item >> 6, hd = (item >> 4) & 3, qb = item & 15;
  u16 *sK, *sV; float* slut;
  attn_lds(smem, sK, sV, slut);
  const int q_lo = qb * 128 + 32 * w, q_pos = q_lo + r;
  const size_t tokq = (size_t)bl * S_ + q_pos;
  const int bg = grp * p.BG + bl;
  const u16* kv = p.KV + ((size_t)l * NBATCH + bg) * MEML * D_;
  f32x16 o[4];
  float lt;
  bf16x8 qf[8];
  load_qfrag<128>(qf, p.P + tokq * PW + P_MQ + hd * 128, 0.08838834764831845f * 1.4426950408889634f, h);
  attn_pass<128, 128>(qf, kv + hd * 128, D_, kv + 512 + hd * 128, D_, 0, 4, q_pos, q_lo, nullptr, 0, -INFINITY, 0.f, o, lt, sK, sV);
  const float inv = 1.f / lt;
  u32x2 zall[4][4];
#pragma unroll
  for (int d = 0; d < 4; ++d)
#pragma unroll
    for (int g4 = 0; g4 < 4; ++g4) zall[d][g4] = *(const u32x2*)(p.P + tokq * PW + P_MZ + hd * 128 + 32 * d + 8 * g4 + 4 * h);
#pragma unroll
  for (int d = 0; d < 4; ++d)
#pragma unroll
    for (int g4 = 0; g4 < 4; ++g4) {
      const int dv = 32 * d + 8 * g4 + 4 * h;
      const u32x2 zz = zall[d][g4];
      const float z0 = bflo(zz.x), z1 = bfhi(zz.x), z2 = bflo(zz.y), z3 = bfhi(zz.y);
      u32x2 ov;
      ov.x = pk2(o[d][4 * g4 + 0] * inv * siluf_(z0), o[d][4 * g4 + 1] * inv * siluf_(z1));
      ov.y = pk2(o[d][4 * g4 + 2] * inv * siluf_(z2), o[d][4 * g4 + 3] * inv * siluf_(z3));
      *(u32x2*)(p.o4 + tokq * BWID + hd * 128 + dv) = ov;
    }
}

DI void ssd_item(const Params& p, int l, int item, char* smem) {
  const int tid = otid(), lane = tid & 63, w = tid >> 6, r = lane & 31, h = lane >> 5;
  const int bl = item >> 4, hd = (item >> 1) & 7, dir = item & 1;
  const int gq = hd >> 2, lt = w & 1, ph = w >> 1;
  u16* sB = (u16*)smem;
  u16* sC = sB + 64 * 136;
  u16* sX1 = sC + 64 * 136;
  u16* sX2 = sX1 + 64 * 80;
  u16* sS = sX2 + 64 * 80;
  float* sW = (float*)(sS + 64 * 136);
  float* sDt = sW + 64;
  const float Aneg = -expf(p.in[9][(l * 2 + dir) * 8 + hd]);
  const float dtb = p.in[8][(l * 2 + dir) * 8 + hd];
  u16* ydst = dir ? p.syb : p.o0;
  const u16* Pb = p.P + (size_t)bl * S_ * PW;
  const u16* xab = p.xa + (size_t)bl * S_ * 1024;
  __syncthreads();
  for (int i = tid; i < 64 * 136 / 2; i += 256) ((unsigned*)sS)[i] = 0u;
  f32x16 accS[2];
#pragma unroll
  for (int i = 0; i < 2; ++i)
#pragma unroll
    for (int e = 0; e < 16; ++e) accS[i][e] = 0.f;
  u32x4 rB[4], rC[4], rX[2];
  float rdt = 0.f;
  auto prefetch = [&](int cc) {
    if (tid < 64) {
      const int pp = 64 * cc + tid, tok = dir ? (S_ - 1 - pp) : pp;
      rdt = bf2f(Pb[(size_t)tok * PW + P_DT + dir * 8 + hd]);
    }
#pragma unroll
    for (int i = 0; i < 4; ++i) {
      const int c = tid + 256 * i, row = c >> 4, col = (c & 15) * 8;
      const int pp = 64 * cc + row, tok = dir ? (S_ - 1 - pp) : pp;
      rB[i] = *(const u32x4*)(xab + (size_t)tok * 1024 + 512 + gq * 128 + col);
      rC[i] = *(const u32x4*)(xab + (size_t)tok * 1024 + 768 + gq * 128 + col);
    }
#pragma unroll
    for (int i = 0; i < 2; ++i) {
      const int c = tid + 256 * i, row = c >> 3, col = (c & 7) * 8;
      const int pp = 64 * cc + row, tok = dir ? (S_ - 1 - pp) : pp;
      rX[i] = *(const u32x4*)(xab + (size_t)tok * 1024 + hd * 64 + col);
    }
  };
  prefetch(0);
#pragma unroll 1
  for (int cc = 0; cc < 32; ++cc) {
    __syncthreads();
    if (tid < 64) {
      const float x = rdt + dtb;
      const float dt = x > 20.f ? x : log1pf(expf(x));
      float a = dt * Aneg;
#pragma unroll
      for (int o = 1; o < 64; o <<= 1) { const float t = __shfl_up(a, o, 64); if (lane >= o) a += t; }
      sW[tid] = a;
      sDt[tid] = dt;
    }
#pragma unroll
    for (int i = 0; i < 4; ++i) {
      const int c = tid + 256 * i, row = c >> 4, col = (c & 15) * 8;
      *(u32x4*)(sB + row * 136 + col) = rB[i];
      *(u32x4*)(sC + row * 136 + col) = rC[i];
    }
    __syncthreads();
    const float wlast = sW[63];
#pragma unroll
    for (int i = 0; i < 2; ++i) {
      const int c = tid + 256 * i, row = c >> 3, col = (c & 7) * 8;
      const float f1 = sDt[row], f2 = f1 * __expf(wlast - sW[row]);
      *(u32x4*)(sX1 + row * 80 + col) = scale8(rX[i], f1);
      *(u32x4*)(sX2 + row * 80 + col) = scale8(rX[i], f2);
    }
    __syncthreads();
    if (cc + 1 < 32) prefetch(cc + 1);
    f32x16 ay;
#pragma unroll
    for (int e = 0; e < 16; ++e) ay[e] = 0.f;
#pragma unroll
    for (int ks = 0; ks < 8; ++ks) {
      bf16x8 a = ldfrag(sS, 136, 32 * ph + r, 16 * ks + 8 * h);
      bf16x8 b = ldfrag(sC, 136, 32 * lt + r, 16 * ks + 8 * h);
      ay = MFMA32(a, b, ay);
    }
    const float wl = sW[32 * lt + r];
    {
      const float ewl = __expf(wl);
#pragma unroll
      for (int e = 0; e < 16; ++e) ay[e] *= ewl;
    }
    for (int st = 0; st <= lt; ++st) {
      f32x16 g;
#pragma unroll
      for (int e = 0; e < 16; ++e) g[e] = 0.f;
#pragma unroll
      for (int ks = 0; ks < 8; ++ks) {
        bf16x8 a = ldfrag(sB, 136, 32 * st + r, 16 * ks + 8 * h);
        bf16x8 b = ldfrag(sC, 136, 32 * lt + r, 16 * ks + 8 * h);
        g = MFMA32(a, b, g);
      }
#pragma unroll
      for (int e = 0; e < 16; ++e) {
        const int sidx = 32 * st + crow(e, h);
        const float f = (sidx <= 32 * lt + r) ? __expf(wl - sW[sidx]) : 0.f;
        g[e] *= f;
      }
#pragma unroll
      for (int s2 = 0; s2 < 2; ++s2) {
        bf16x8 pfr = pack8(g, s2);
        bf16x8 a = ldfrag_tr_perm(sX1, 80, 32 * st + 16 * s2, 32 * ph, lane);
        ay = MFMA32(a, pfr, ay);
      }
    }
    {
      const int pp = 64 * cc + 32 * lt + r, tok = dir ? (S_ - 1 - pp) : pp;
      u16* yd = ydst + ((size_t)bl * S_ + tok) * BWID + hd * 64 + 32 * ph + 4 * h;
#pragma unroll
      for (int g4 = 0; g4 < 4; ++g4) {
        u32x2 ov; ov.x = pk2(ay[4 * g4 + 0], ay[4 * g4 + 1]); ov.y = pk2(ay[4 * g4 + 2], ay[4 * g4 + 3]);
        *(u32x2*)(yd + 8 * g4) = ov;
      }
    }
    {
      const float ew = __expf(wlast);
#pragma unroll
      for (int pt = 0; pt < 2; ++pt)
#pragma unroll
        for (int e = 0; e < 16; ++e) accS[pt][e] *= ew;
#pragma unroll
      for (int ks = 0; ks < 4; ++ks) {
        bf16x8 b = ldfrag_tr_nat(sB, 136, 16 * ks, 32 * w, lane);
#pragma unroll
        for (int pt = 0; pt < 2; ++pt) {
          bf16x8 a = ldfrag_tr_nat(sX2, 80, 16 * ks, 32 * pt, lane);
          accS[pt] = MFMA32(a, b, accS[pt]);
        }
      }
    }
    __syncthreads();
#pragma unroll
    for (int pt = 0; pt < 2; ++pt)
#pragma unroll
      for (int e = 0; e < 16; ++e) sS[(32 * pt + crow(e, h)) * 136 + 32 * w + r] = f2bf(accS[pt][e]);
  }
}

DI void s5_item(const Params& p, int l, int item, char* smem) {
  const int tid = otid(), lane = tid & 63, w = tid >> 6;
  const int wi = item * 4 + w;
  const int bl = wi >> 6, g = (wi >> 1) & 31, dir = wi & 1;
  float* sBu = (float*)(smem + w * 12800);
  u16* sX = (u16*)(smem + w * 12800 + 8448);
  const int c16 = lane & 15, kg = lane >> 4;
  const float* lre = p.in[15] + ((size_t)(l * 2 + dir) * 32 + g) * 64;
  const float* lim = p.in[16] + ((size_t)(l * 2 + dir) * 32 + g) * 64;
  const float dt = expf(p.in[17][(l * 2 + dir) * 32 + g]);
  const float* bre = p.in[18] + ((size_t)l * 32 + g) * 64 * 16;
  const float* bim = p.in[19] + ((size_t)l * 32 + g) * 64 * 16;
  const float* cre = p.in[20] + (((size_t)(l * 2 + dir) * 32 + g) * 16) * 64;
  const float* cim = p.in[21] + (((size_t)(l * 2 + dir) * 32 + g) * 16) * 64;
  float ar, ai;
  {
    const float lr = lre[lane], li = lim[lane];
    const float mag = expf(lr * dt);
    ar = mag * cosf(li * dt); ai = mag * sinf(li * dt);
  }
  bf16x8 bfr[8];
#pragma unroll
  for (int ct = 0; ct < 4; ++ct) {
    const int st = 16 * ct + c16;
    const float lr = lre[st], li = lim[st];
    const float mag = expf(lr * dt);
    const float a_r = mag * cosf(li * dt), a_i = mag * sinf(li * dt);
    const float den = lr * lr + li * li;
    const float fr = ((a_r - 1.f) * lr + a_i * li) / den, fi = (a_i * lr - (a_r - 1.f) * li) / den;
    float vr[8], vi[8];
#pragma unroll
    for (int j = 0; j < 8; ++j) {
      float br_ = 0.f, bi_ = 0.f;
      if (kg < 2) { br_ = bre[st * 16 + 8 * kg + j]; bi_ = bim[st * 16 + 8 * kg + j]; }
      vr[j] = fr * br_ - fi * bi_;
      vi[j] = fr * bi_ + fi * br_;
    }
    u32x4 ur, ui;
    ur.x = pk2(vr[0], vr[1]); ur.y = pk2(vr[2], vr[3]); ur.z = pk2(vr[4], vr[5]); ur.w = pk2(vr[6], vr[7]);
    ui.x = pk2(vi[0], vi[1]); ui.y = pk2(vi[2], vi[3]); ui.z = pk2(vi[4], vi[5]); ui.w = pk2(vi[6], vi[7]);
    bfr[ct] = __builtin_bit_cast(bf16x8, ur);
    bfr[4 + ct] = __builtin_bit_cast(bf16x8, ui);
  }
  bf16x8 cfr[4];
#pragma unroll
  for (int ks = 0; ks < 4; ++ks) {
    const float* src = (ks < 2) ? (cre + c16 * 64 + 32 * ks + 8 * kg) : (cim + c16 * 64 + 32 * (ks - 2) + 8 * kg);
    const float sg = (ks < 2) ? 1.f : -1.f;
    u32x4 u;
    u.x = pk2(sg * src[0], sg * src[1]); u.y = pk2(sg * src[2], sg * src[3]);
    u.z = pk2(sg * src[4], sg * src[5]); u.w = pk2(sg * src[6], sg * src[7]);
    cfr[ks] = __builtin_bit_cast(bf16x8, u);
  }
  u16* ydst = dir ? p.o3 : p.s5f;
  const u16* Pb = p.P + (size_t)bl * S_ * PW + P_UIN + g * 16;
  float xr = 0.f, xi = 0.f;
  u32x4 ring[8];
#pragma unroll
  for (int j = 0; j < 8; ++j) {
    ring[j] = (u32x4){0u, 0u, 0u, 0u};
    const int pp = 16 * j + c16, tok = dir ? (S_ - 1 - pp) : pp;
    if (kg < 2) ring[j] = *(const u32x4*)(Pb + (size_t)tok * PW + 8 * kg);
  }
#pragma unroll 1
  for (int cc0 = 0; cc0 < S_ / 16; cc0 += 8)
#pragma unroll
  for (int j8 = 0; j8 < 8; ++j8) {
    const int cc = cc0 + j8;
    const bf16x8 ua = __builtin_bit_cast(bf16x8, ring[j8]);
    if (cc + 8 < S_ / 16) {
      const int pp = 16 * (cc + 8) + c16, tok = dir ? (S_ - 1 - pp) : pp;
      if (kg < 2) ring[j8] = *(const u32x4*)(Pb + (size_t)tok * PW + 8 * kg);
    }
    wave_lds_sync();
#pragma unroll
    for (int ct = 0; ct < 8; ++ct) {
      f32x4 d = {0.f, 0.f, 0.f, 0.f};
      d = MFMA16(ua, bfr[ct], d);
#pragma unroll
      for (int e = 0; e < 4; ++e) sBu[(4 * kg + e) * 132 + 16 * ct + c16] = d[e];
    }
    wave_lds_sync();
#pragma unroll
    for (int t = 0; t < 16; ++t) {
      const float bur = sBu[t * 132 + lane], bui = sBu[t * 132 + 64 + lane];
      const float nr = ar * xr - ai * xi + bur;
      const float ni = ar * xi + ai * xr + bui;
      xr = nr; xi = ni;
      sX[t * 136 + lane] = f2bf(xr);
      sX[t * 136 + 64 + lane] = f2bf(xi);
    }
    wave_lds_sync();
    f32x4 y = {0.f, 0.f, 0.f, 0.f};
#pragma unroll
    for (int ks = 0; ks < 4; ++ks) {
      bf16x8 a = ldfrag(sX, 136, c16, 32 * ks + 8 * kg);
      y = MFMA16(a, cfr[ks], y);
    }
#pragma unroll
    for (int e = 0; e < 4; ++e) {
      const int pp = 16 * cc + 4 * kg + e, tok = dir ? (S_ - 1 - pp) : pp;
      ydst[((size_t)bl * S_ + tok) * BWID + g * 16 + c16] = f2bf(y[e]);
    }
  }
}

DI void phase_finalize(const Params& p, int l, int Tg, int bid, int nblk) {
  const int tid_ = otid(), lane = tid_ & 63, w = tid_ >> 6;
  const float* dsk = p.in[10] + l * 8;
  const float* ng = p.in[11] + (size_t)l * BWID;
  const float* s5d = p.in[22] + (size_t)l * BWID;
  const int c0 = lane * 8, stride = nblk * 4;
  for (int tok0 = bid * 4 + w; tok0 < Tg; tok0 += 2 * stride) {
    u32x4 r_yf[2], r_yb[2], r_xs[2], r_z[2], r_sf[2], r_sb[2], r_u[2], r_uz[2];
#pragma unroll
    for (int u = 0; u < 2; ++u) {
      const int tok = tok0 + u * stride;
      if (tok < Tg) {
        r_yf[u] = *(const u32x4*)(p.o0 + (size_t)tok * BWID + c0);
        r_yb[u] = *(const u32x4*)(p.syb + (size_t)tok * BWID + c0);
        r_xs[u] = *(const u32x4*)(p.xa + (size_t)tok * 1024 + c0);
        r_z[u] = *(const u32x4*)(p.P + (size_t)tok * PW + P_SZ + c0);
        r_sf[u] = *(const u32x4*)(p.s5f + (size_t)tok * BWID + c0);
        r_sb[u] = *(const u32x4*)(p.o3 + (size_t)tok * BWID + c0);
        r_u[u] = *(const u32x4*)(p.P + (size_t)tok * PW + P_UIN + c0);
        r_uz[u] = *(const u32x4*)(p.P + (size_t)tok * PW + P_UZ + c0);
      }
    }
#pragma unroll
    for (int u = 0; u < 2; ++u) {
      const int tok = tok0 + u * stride;
      if (tok < Tg) {
        float yf[8], yb[8], xs[8], z[8];
        unpack8(r_yf[u], yf); unpack8(r_yb[u], yb); unpack8(r_xs[u], xs); unpack8(r_z[u], z);
        const float dk = dsk[c0 >> 6];
        float v[8], ss = 0.f;
#pragma unroll
        for (int j = 0; j < 8; ++j) { v[j] = (yf[j] + yb[j] + dk * xs[j]) * siluf_(z[j]); ss += v[j] * v[j]; }
        ss = wave_sum(ss);
        const float rs = rsqrtf(ss / (float)BWID + EPS_);
        u32x4 o;
        o.x = pk2(v[0] * rs * ng[c0 + 0], v[1] * rs * ng[c0 + 1]); o.y = pk2(v[2] * rs * ng[c0 + 2], v[3] * rs * ng[c0 + 3]);
        o.z = pk2(v[4] * rs * ng[c0 + 4], v[5] * rs * ng[c0 + 5]); o.w = pk2(v[6] * rs * ng[c0 + 6], v[7] * rs * ng[c0 + 7]);
        *(u32x4*)(p.o0 + (size_t)tok * BWID + c0) = o;
        float sf[8], sb[8], uu[8], gq[8], uz[8];
        unpack8(r_sf[u], sf); unpack8(r_sb[u], sb); unpack8(r_u[u], uu); unpack8(r_uz[u], uz);
#pragma unroll
        for (int j = 0; j < 8; ++j) {
          const float y = sf[j] + sb[j] + s5d[c0 + j] * uu[j];
          const float t = tanhf(0.7978845608028654f * (y + 0.044715f * y * y * y));
          gq[j] = 0.5f * y * (1.f + t);
        }
        u32x4 o2;
        o2.x = pk2(gq[0], gq[1]); o2.y = pk2(gq[2], gq[3]); o2.z = pk2(gq[4], gq[5]); o2.w = pk2(gq[6], gq[7]);
        *(u32x4*)(p.s5f + (size_t)tok * BWID + c0) = o2;
        u32x4 o3v;
        o3v.x = pk2(siluf_(uz[0]), siluf_(uz[1])); o3v.y = pk2(siluf_(uz[2]), siluf_(uz[3]));
        o3v.z = pk2(siluf_(uz[4]), siluf_(uz[5])); o3v.w = pk2(siluf_(uz[6]), siluf_(uz[7]));
        *(u32x4*)(p.syb + (size_t)tok * BWID + c0) = o3v;
      }
    }
  }
}

DI void phase_mixers(const Params& p, int l, int grp, int* ctr, char* smem, volatile int* s_itemp, int half) {
  const int BG = p.BG;
  const int n_ssd = BG * 8, n_s5 = BG * 8, n_diff = BG * 32, n_mem = BG * 32, n_win = BG * 64;
  const int total = n_ssd + n_s5 + n_diff + n_mem + n_win;
  for (;;) {
    __syncthreads();
    if (threadIdx.x == 0) *s_itemp = atomicAdd(ctr, 1);
    __syncthreads();
    int it = __builtin_amdgcn_readfirstlane(*s_itemp);
    if (it >= total) break;
    if (it < n_ssd) { if (MX & 1) ssd_item(p, l, it * 2 + half, smem); continue; }
    it -= n_ssd;
    if (it < n_s5) { if (MX & 2) s5_item(p, l, it * 2 + half, smem); continue; }
    it -= n_s5;
    if (it < n_diff) { if (MX & 4) diff_item(p, l, it * 2 + half, smem); continue; }
    it -= n_diff;
    if (it < n_mem) { if (MX & 8) mem_item(p, l, grp, it * 2 + half, smem); continue; }
    it -= n_mem;
    if (MX & 16) win_item(p, l, ((it >> 4) * 2 + half) * 16 + (it & 15), smem);
  }
}

__global__ void __launch_bounds__(512, 2) fwd_megakernel(Params p) {
  extern __shared__ __attribute__((aligned(16))) char smem[];
  __shared__ __attribute__((aligned(16))) unsigned s_misc[8];
  cg::grid_group grid = cg::this_grid();
  const int bid = blockIdx.x, nblk = gridDim.x;
  const int half = __builtin_amdgcn_readfirstlane((int)(threadIdx.x >> 8));
  const int vbid = bid * 2 + half, vnblk = nblk * 2;
  char* smem_h = smem + half * HALF_SMEM;
  const int BG = p.BG, Tg = BG * S_, ngrp = NBATCH / BG;
  if (threadIdx.x < 8) s_misc[threadIdx.x] = 0u;
  __syncthreads();
  XcdBarrier xb = xcd_barrier_post(p.bar, (volatile LAS unsigned*)s_misc);
  if (PH & 1) phase_prologue(p, smem_h, vbid, vnblk);
  if (p.BG < 0) grid.sync();
  xcd_barrier(xb);
  if (PH & 2) phase_kv(p, smem_h, vbid, vnblk);
  for (int grp = 0; grp < ngrp; ++grp) {
    const size_t rowoff = (size_t)grp * Tg * D_;
    for (int l = 0; l < 2; ++l) {
      const float* xin = (l == 0 ? p.in[0] : (const float*)p.out) + rowoff;
      if (PH & 4) phase_norm(xin, p.in[4] + (size_t)l * D_, p.h, Tg, vbid, vnblk);
      xcd_barrier(xb);
      if (PH & 8) phase_inproj(p, l, Tg, smem, bid, nblk);
      xcd_barrier(xb);
      if (PH & 16) phase_conv(p, l, Tg, vbid, vnblk);
      xcd_barrier(xb);
      if (PH & 32) phase_mixers(p, l, grp, p.ctr + grp * 2 + l, smem_h, (volatile int*)&s_misc[4], half);
      xcd_barrier(xb);
      if (PH & 64) phase_finalize(p, l, Tg, vbid, vnblk);
      xcd_barrier(xb);
      unsigned char* Gbuf = (unsigned char*)(p.P + (size_t)Tg * D_);
      phase_gates(p, l, Tg, Gbuf, smem, bid, nblk);
      if (PH & 128) phase_glu(p, l, Tg, smem, bid, nblk);
      xcd_barrier(xb);
      if (PH & 256) phase_merge(p, l, Tg, Gbuf, p.P, smem, bid, nblk);
      xcd_barrier(xb);
      if (PH & 512) phase_out(p, l, Tg, p.P, xin, p.out + rowoff, smem, bid, nblk);
      xcd_barrier(xb);
    }
  }
  if (PH & 1024) phase_final(p.out, p.in[3], NBATCH * S_, vbid, vnblk);
}

extern "C" void kernel_launch(void* const* d_in, const int* in_sizes, int n_in, void* d_out, int out_size, void* d_ws,
                              size_t ws_size, hipStream_t stream) {
  static int grid_blocks = 0;
  if (!grid_blocks) {
    int dev = 0, cus = 0, per_cu = 0;
    hipGetDevice(&dev);
    hipDeviceGetAttribute(&cus, hipDeviceAttributeMultiprocessorCount, dev);
    hipFuncSetAttribute((const void*)fwd_megakernel, hipFuncAttributeMaxDynamicSharedMemorySize, SMEM_BYTES);
    hipOccupancyMaxActiveBlocksPerMultiprocessor(&per_cu, fwd_megakernel, 512, SMEM_BYTES);
    if (per_cu > 1) per_cu = 1;
    if (per_cu < 1) per_cu = 1;
    grid_blocks = cus * per_cu;
  }
  Params p{};
  for (int i = 0; i < 31; ++i) p.in[i] = (const float*)d_in[i];
  p.out = (float*)d_out;
  char* ws = (char*)d_ws;
  size_t off = 0;
  auto take = [&](size_t bytes) { char* r = ws + off; off += (bytes + 255) & ~(size_t)255; return r; };
  p.W = (u16*)take(2 * LAYER_W * 2);
  p.KV = (u16*)take((size_t)2 * NBATCH * MEML * D_ * 2);
  p.memb = (u16*)take((size_t)NBATCH * MEML * D_ * 2);
  p.memrs = (float*)take(NBATCH * MEML * 4);
  p.lut = (float*)take(12 * LUTS * 4);
  p.ctr = (int*)take(4096);
  p.bar = (unsigned*)take(XCD_BAR_WORDS * 4);
  const size_t fixed = off;
  int BG = 8;
  auto need = [&](int bg) { size_t tg = (size_t)bg * S_; return fixed + tg * (D_ * 2 + (size_t)PW * 2 + 1024 * 2 + 7 * BWID * 2) + 16 * 256; };
  while (BG > 1 && need(BG) > ws_size) BG >>= 1;
  const size_t Tg = (size_t)BG * S_;
  p.h = (u16*)take(Tg * D_ * 2);
  p.P = (u16*)take(Tg * PW * 2);
  p.xa = (u16*)take(Tg * 1024 * 2);
  p.o0 = (u16*)take(Tg * BWID * 2);
  p.o1 = (u16*)take(Tg * BWID * 2);
  p.o2 = (u16*)take(Tg * BWID * 2);
  p.o3 = (u16*)take(Tg * BWID * 2);
  p.o4 = (u16*)take(Tg * BWID * 2);
  p.syb = (u16*)take(Tg * BWID * 2);
  p.s5f = (u16*)take(Tg * BWID * 2);
  p.BG = BG;
  p.pad = 0;
  hipMemsetAsync(p.ctr, 0, 4096 + ((XCD_BAR_WORDS * 4 + 255) & ~255), stream);
  void* args[] = {&p};
  hipError_t e = hipLaunchCooperativeKernel((const void*)fwd_megakernel, dim3(grid_blocks), dim3(512), args, SMEM_BYTES, stream);
  if (e != hipSuccess) fprintf(stderr, "cooperative launch failed: %s (grid %d)\n", hipGetErrorString(e), grid_blocks);
}
```

```cpp
#include <hip/hip_runtime.h>
#include <hip/hip_cooperative_groups.h>
#include <cstdio>
namespace cg = cooperative_groups;

#define DI __device__ __forceinline__
typedef unsigned short u16;
typedef __attribute__((ext_vector_type(8))) short bf16x8;
typedef __attribute__((ext_vector_type(4))) short s16x4;
typedef __attribute__((ext_vector_type(16))) float f32x16;
typedef __attribute__((ext_vector_type(4))) float f32x4;
typedef __attribute__((ext_vector_type(2))) float f32x2;
typedef __attribute__((ext_vector_type(4))) unsigned u32x4;
typedef __attribute__((ext_vector_type(2))) unsigned u32x2;
typedef __attribute__((ext_vector_type(2))) __bf16 bf2_t;

constexpr int S_ = 2048, D_ = 1024, NBATCH = 16, BWID = 512, MEML = 256;
constexpr int PW = 7040;
constexpr int P_XBC = 0, P_SZ = 1024, P_DQ = 1536, P_DK = 2048, P_DV = 2560, P_DZ = 3072, P_CQ = 3584, P_CK = 4096,
              P_CV = 4224, P_CZ = 4352, P_UIN = 4864, P_UZ = 5376, P_MQ = 5888, P_MZ = 6400, P_DT = 6912;
constexpr size_t WIN_OFF = 0, WMG_OFF = 7208960, WBR_OFF = 12451840, WOUT_OFF = 15073280, WGLU_OFF = 16121856,
                 WKV_OFF = 16384000, LAYER_W = 17432576;
constexpr int LUTS = 4096;
constexpr int HALF_SMEM = 75 * 1024;
constexpr int SMEM_BYTES = 2 * HALF_SMEM;
constexpr float EPS_ = 1e-6f;
#ifndef PH
#define PH 0xffff
#endif
#ifndef MX
#define MX 0xff
#endif
#ifndef DUP
#define DUP 0
#endif

struct Params {
  const float* in[31];
  float* out;
  u16* W; u16* KV; u16* memb; float* memrs; float* lut; int* ctr; unsigned* bar;
  u16* h; u16* P; u16* xa; u16* o0; u16* o1; u16* o2; u16* o3; u16* o4; u16* syb; u16* s5f;
  int BG; int pad;
};

DI unsigned pk2(float a, float b) { bf2_t r = __builtin_convertvector((f32x2){a, b}, bf2_t); return __builtin_bit_cast(unsigned, r); }
DI u16 f2bf(float a) { return (u16)(pk2(a, 0.f) & 0xffffu); }
DI float bf2f(u16 v) { return __uint_as_float(((unsigned)v) << 16); }
DI float bflo(unsigned v) { return __uint_as_float(v << 16); }
DI float bfhi(unsigned v) { return __uint_as_float(v & 0xffff0000u); }
DI float sigmoidf_(float x) { return __builtin_amdgcn_rcpf(1.f + __builtin_amdgcn_exp2f(-1.4426950408889634f * x)); }
DI float siluf_(float x) { return x * __builtin_amdgcn_rcpf(1.f + __builtin_amdgcn_exp2f(-1.4426950408889634f * x)); }
DI int crow(int reg, int h) { return (reg & 3) + 8 * (reg >> 2) + 4 * h; }
DI int otid() { int t = threadIdx.x & 255; asm volatile("" : "+v"(t)); return t; }
DI int rtid() { int t = threadIdx.x; asm volatile("" : "+v"(t)); return t; }
DI float wave_sum(float v) { for (int o = 32; o > 0; o >>= 1) v += __shfl_xor(v, o, 64); return v; }
#define MFMA32(a, b, c) __builtin_amdgcn_mfma_f32_32x32x16_bf16((a), (b), (c), 0, 0, 0)
#define MFMA16(a, b, c) __builtin_amdgcn_mfma_f32_16x16x32_bf16((a), (b), (c), 0, 0, 0)

DI bf16x8 ldfrag(const u16* base, int stride, int row, int col) { return *reinterpret_cast<const bf16x8*>(base + row * stride + col); }
DI s16x4 tr4(const u16* base, int stride, int krow0, int col0, int lane) {
  const int i16 = lane & 15, q = i16 >> 2, pp = i16 & 3, blk = (lane >> 4) & 1;
  const u16* a = base + (krow0 + q) * stride + col0 + 16 * blk + 4 * pp;
  return __builtin_amdgcn_ds_read_tr16_b64_v4i16((__attribute__((address_space(3))) s16x4*)(a));
}
DI bf16x8 ldfrag_tr_nat(const u16* base, int stride, int k0, int col0, int lane) {
  const int h = lane >> 5;
  s16x4 lo = tr4(base, stride, k0 + 8 * h, col0, lane), hi = tr4(base, stride, k0 + 8 * h + 4, col0, lane);
  return __builtin_shufflevector(lo, hi, 0, 1, 2, 3, 4, 5, 6, 7);
}
DI bf16x8 ldfrag_tr_perm(const u16* base, int stride, int k0, int col0, int lane) {
  const int h = lane >> 5;
  s16x4 lo = tr4(base, stride, k0 + 4 * h, col0, lane), hi = tr4(base, stride, k0 + 8 + 4 * h, col0, lane);
  return __builtin_shufflevector(lo, hi, 0, 1, 2, 3, 4, 5, 6, 7);
}
DI bf16x8 pack8(const f32x16& x, int s) {
  u32x4 u;
  u.x = pk2(x[8 * s + 0], x[8 * s + 1]); u.y = pk2(x[8 * s + 2], x[8 * s + 3]);
  u.z = pk2(x[8 * s + 4], x[8 * s + 5]); u.w = pk2(x[8 * s + 6], x[8 * s + 7]);
  return __builtin_bit_cast(bf16x8, u);
}
DI u32x4 scale8(u32x4 v, float f) {
  u32x4 o;
  o.x = pk2(bflo(v.x) * f, bfhi(v.x) * f); o.y = pk2(bflo(v.y) * f, bfhi(v.y) * f);
  o.z = pk2(bflo(v.z) * f, bfhi(v.z) * f); o.w = pk2(bflo(v.w) * f, bfhi(v.w) * f);
  return o;
}
DI void unpack8(u32x4 v, float* f) {
  f[0] = bflo(v.x); f[1] = bfhi(v.x); f[2] = bflo(v.y); f[3] = bfhi(v.y);
  f[4] = bflo(v.z); f[5] = bfhi(v.z); f[6] = bflo(v.w); f[7] = bfhi(v.w);
}
DI void wave_lds_sync() {
  __builtin_amdgcn_fence(__ATOMIC_RELEASE, "wavefront");
  __builtin_amdgcn_wave_barrier();
  __builtin_amdgcn_fence(__ATOMIC_ACQUIRE, "wavefront");
}


#define XB_TMO      128
#define XB_XCNT(j)  (256  + 64 * (j))
#define XB_XSUB(j)  (1280 + 64 * (j))
#define XB_XGEN(j)  (2304 + 64 * (j))
#define XB_TOP      3328
#define XB_TOPGEN   3392
#define XCD_BAR_WORDS 3456
#define XB_SPIN_CAP (1u << 24)
#define LAS __attribute__((address_space(3)))
DI unsigned xb_ld(unsigned* p) { return __hip_atomic_load(p, __ATOMIC_RELAXED, __HIP_MEMORY_SCOPE_AGENT); }
DI unsigned xb_add(unsigned* p, unsigned v) { return __hip_atomic_fetch_add(p, v, __ATOMIC_RELAXED, __HIP_MEMORY_SCOPE_AGENT); }
DI unsigned xb_xcc_id() { return (unsigned)__builtin_amdgcn_s_getreg((3 << 11) | 20) & 0xFu; }
#define XB_SPIN(cond, bar) do { unsigned _sp = 0; while (cond) { __builtin_amdgcn_s_sleep(1); \
    if ((++_sp & 255u) == 0u) { if (xb_ld(&(bar)[XB_TMO])) break; if (_sp > XB_SPIN_CAP) { atomicAdd(&(bar)[XB_TMO], 1u); break; } } } } while (0)
struct XcdBarrier { unsigned* bar; unsigned x; volatile LAS unsigned* st; };
DI XcdBarrier xcd_barrier_post(unsigned* bar, volatile LAS unsigned* st) {
  XcdBarrier b; b.bar = bar; b.x = xb_xcc_id(); b.st = st;
  if (threadIdx.x == 0) (void)xb_add(&bar[XB_XCNT(b.x)], 1u);
  return b;
}
DI void xcd_barrier_complete(unsigned* bar, unsigned x, unsigned& nloc, unsigned& nx) {
  const unsigned G = gridDim.x * gridDim.y * gridDim.z;
  unsigned sum, cnt, mine, sp = 0u;
  for (;;) {
    sum = 0u; cnt = 0u; mine = 0u;
#pragma unroll
    for (unsigned j = 0; j < 16; ++j) { const unsigned c = xb_ld(&bar[XB_XCNT(j)]); sum += c; cnt += (c > 0u) ? 1u : 0u; mine = (j == x) ? c : mine; }
    if (sum == G) break;
    __builtin_amdgcn_s_sleep(1);
    if ((++sp & 255u) == 0u) { if (xb_ld(&bar[XB_TMO])) break; if (sp > XB_SPIN_CAP) { atomicAdd(&bar[XB_TMO], 1u); break; } }
  }
  nloc = mine > 0u ? mine : 1u; nx = cnt > 0u ? cnt : 1u;
}
DI void xcd_barrier(const XcdBarrier& b) {
  asm volatile("s_waitcnt vmcnt(0)" ::: "memory");
  __syncthreads();
  if (threadIdx.x == 0) {
    unsigned* bar = b.bar;
    __builtin_amdgcn_s_waitcnt(0);
    unsigned nloc = b.st[0], nx = b.st[1];
    if (nloc == 0u) { xcd_barrier_complete(bar, b.x, nloc, nx); b.st[0] = nloc; b.st[1] = nx; }
    const unsigned old = xb_add(&bar[XB_XSUB(b.x)], 1u);
    const unsigned gen = old / nloc;
    if (old + 1u == (gen + 1u) * nloc) {
      __builtin_amdgcn_fence(__ATOMIC_RELEASE, "agent");
      asm volatile("s_waitcnt vmcnt(0)" ::: "memory");
      const unsigned og = xb_add(&bar[XB_TOP], 1u);
      const unsigned tg = og / nx;
      if (og + 1u == (tg + 1u) * nx) xb_add(&bar[XB_TOPGEN], 1u);
      else XB_SPIN(xb_ld(&bar[XB_TOPGEN]) == tg, bar);
      __builtin_amdgcn_fence(__ATOMIC_ACQUIRE, "agent");
      xb_add(&bar[XB_XGEN(b.x)], 1u);
      asm volatile("s_waitcnt vmcnt(0)" ::: "memory");
    } else {
      XB_SPIN(xb_ld(&bar[XB_XGEN(b.x)]) == gen, bar);
      __builtin_amdgcn_fence(__ATOMIC_ACQUIRE, "agent");
      asm volatile("s_waitcnt vmcnt(0)" ::: "memory");
    }
  }
  __syncthreads();
}

template <int BM, int BN>
DI void gemm_acc(const u16* __restrict__ A, int lda, int kstrA, const u16* __restrict__ Bt, int ldb, int kstrB, int K,
                 f32x16 (&acc)[BM / 64][BN / 64], char* smem) {
  constexpr int MI = BM / 64, NJ = BN / 64, NAC = BM / 32, NBC = BN / 32;
  u16* sA = (u16*)smem;
  u16* sB = sA + BM * 72;
  const int tid = otid(), lane = tid & 63, w = tid >> 6, wm = w >> 1, wn = w & 1, r = lane & 31, h = lane >> 5;
  u32x4 ra[NAC], rb[NBC];
  const int crow_ = tid >> 3, ccol = (tid & 7) * 8;
  const u16* Ap = A + (size_t)crow_ * lda + ccol;
  const u16* Bp = Bt + (size_t)crow_ * ldb + ccol;
#pragma unroll
  for (int i = 0; i < NAC; ++i) ra[i] = *(const u32x4*)(Ap + (size_t)(32 * i) * lda);
#pragma unroll
  for (int i = 0; i < NBC; ++i) rb[i] = *(const u32x4*)(Bp + (size_t)(32 * i) * ldb);
  const int nk = K >> 6;
  for (int kt = 0; kt < nk; ++kt) {
    __syncthreads();
#pragma unroll
    for (int i = 0; i < NAC; ++i) *(u32x4*)(sA + (crow_ + 32 * i) * 72 + ccol) = ra[i];
#pragma unroll
    for (int i = 0; i < NBC; ++i) *(u32x4*)(sB + (crow_ + 32 * i) * 72 + ccol) = rb[i];
    __syncthreads();
    if (kt + 1 < nk) {
      const size_t koA = (size_t)(kt + 1) * kstrA, koB = (size_t)(kt + 1) * kstrB;
#pragma unroll
      for (int i = 0; i < NAC; ++i) ra[i] = *(const u32x4*)(Ap + (size_t)(32 * i) * lda + koA);
#pragma unroll
      for (int i = 0; i < NBC; ++i) rb[i] = *(const u32x4*)(Bp + (size_t)(32 * i) * ldb + koB);
    }
#pragma unroll
    for (int ks = 0; ks < 4; ++ks) {
      bf16x8 b[NJ];
#pragma unroll
      for (int j = 0; j < NJ; ++j) b[j] = ldfrag(sB, 72, wn * (BN / 2) + 32 * j + r, ks * 16 + 8 * h);
#pragma unroll
      for (int i = 0; i < MI; ++i) {
        const bf16x8 a = ldfrag(sA, 72, wm * (BM / 2) + 32 * i + r, ks * 16 + 8 * h);
#pragma unroll
        for (int j = 0; j < NJ; ++j) acc[i][j] = MFMA32(a, b[j], acc[i][j]);
      }
    }
  }
}

template <int BM, int BN>
DI void gemm8(const u16* __restrict__ A, int lda, int kstrA, const u16* __restrict__ Bt, size_t bpanel, int K,
              f32x16 (&acc)[BM / 64][BN / 128], char* smem) {
  constexpr int MI = BM / 64, NJ = BN / 128, NAC = BM / 64, NBC = BN / 64;
  u16* sA = (u16*)smem;
  u16* sB = sA + BM * 72;
  const int tid = rtid(), lane = tid & 63, w = tid >> 6, wm = w >> 2, wn = w & 3, r = lane & 31, h = lane >> 5;
  u32x4 ra[NAC], rb[NBC];
  const int crow_ = tid >> 3, ccol = (tid & 7) * 8;
  const u16* Ap = A + (size_t)crow_ * lda + ccol;
  const u16* Bp = Bt + (size_t)crow_ * 64 + ccol;
#pragma unroll
  for (int i = 0; i < NAC; ++i) ra[i] = *(const u32x4*)(Ap + (size_t)(64 * i) * lda);
#pragma unroll
  for (int i = 0; i < NBC; ++i) rb[i] = *(const u32x4*)(Bp + (size_t)(i >> 1) * bpanel + (size_t)(64 * (i & 1)) * 64);
  const int nk = K >> 6;
#pragma unroll 1
  for (int kt = 0; kt < nk; ++kt) {
    __syncthreads();
#pragma unroll
    for (int i = 0; i < NAC; ++i) *(u32x4*)(sA + (crow_ + 64 * i) * 72 + ccol) = ra[i];
#pragma unroll
    for (int i = 0; i < NBC; ++i) *(u32x4*)(sB + (crow_ + 64 * i) * 72 + ccol) = rb[i];
    __syncthreads();
    if (kt + 1 < nk) {
      const size_t koA = (size_t)(kt + 1) * kstrA, koB = (size_t)(kt + 1) * 8192;
#pragma unroll
      for (int i = 0; i < NAC; ++i) ra[i] = *(const u32x4*)(Ap + (size_t)(64 * i) * lda + koA);
#pragma unroll
      for (int i = 0; i < NBC; ++i) rb[i] = *(const u32x4*)(Bp + (size_t)(i >> 1) * bpanel + (size_t)(64 * (i & 1)) * 64 + koB);
    }
#pragma unroll
    for (int ks = 0; ks < 4; ++ks) {
      bf16x8 b[NJ];
#pragma unroll
      for (int j = 0; j < NJ; ++j) b[j] = ldfrag(sB, 72, wn * (BN / 4) + 32 * j + r, ks * 16 + 8 * h);
#pragma unroll
      for (int i = 0; i < MI; ++i) {
        const bf16x8 a = ldfrag(sA, 72, wm * (BM / 2) + 32 * i + r, ks * 16 + 8 * h);
#pragma unroll
        for (int j = 0; j < NJ; ++j) acc[i][j] = MFMA32(a, b[j], acc[i][j]);
      }
    }
  }
}

template <int BM, int BN>
DI void gemm8db(const u16* __restrict__ A, int lda, int kstrA, const u16* __restrict__ Bt, size_t bpanel, int K,
                f32x16 (&acc)[BM / 64][BN / 128], char* smem) {
  constexpr int MI = BM / 64, NJ = BN / 128, NAC = BM / 64, NBC = BN / 64, STAGE = (BM + BN) * 72;
  u16* sA0 = (u16*)smem;
  u16* sB0 = sA0 + BM * 72;
  u16* sA1 = sA0 + STAGE;
  u16* sB1 = sA1 + BM * 72;
  const int tid = rtid(), lane = tid & 63, w = tid >> 6, wm = w >> 2, wn = w & 3, r = lane & 31, h = lane >> 5;
  u32x4 ra0[NAC], rb0[NBC], ra1[NAC], rb1[NBC];
  const int crow_ = tid >> 3, ccol = (tid & 7) * 8;
  const u16* Ap = A + (size_t)crow_ * lda + ccol;
  const u16* Bp = Bt + (size_t)crow_ * 64 + ccol;
  const int nk = K >> 6;
#define G_LOAD(RA, RB, KT)                                                                          \
  {                                                                                                 \
    const size_t koA_ = (size_t)(KT) * kstrA, koB_ = (size_t)(KT) * 8192;                           \
    _Pragma("unroll") for (int i = 0; i < NAC; ++i) RA[i] = *(const u32x4*)(Ap + (size_t)(64 * i) * lda + koA_); \
    _Pragma("unroll") for (int i = 0; i < NBC; ++i) RB[i] = *(const u32x4*)(Bp + (size_t)(i >> 1) * bpanel + (size_t)(64 * (i & 1)) * 64 + koB_); \
  }
#define G_WRITE(RA, RB, SA, SB)                                                                     \
  {                                                                                                 \
    _Pragma("unroll") for (int i = 0; i < NAC; ++i) *(u32x4*)(SA + (crow_ + 64 * i) * 72 + ccol) = RA[i]; \
    _Pragma("unroll") for (int i = 0; i < NBC; ++i) *(u32x4*)(SB + (crow_ + 64 * i) * 72 + ccol) = RB[i]; \
  }
#define G_COMPUTE(SA, SB)                                                                           \
  {                                                                                                 \
    _Pragma("unroll") for (int ks = 0; ks < 4; ++ks) {                                              \
      bf16x8 b_[NJ];                                                                                \
      _Pragma("unroll") for (int j = 0; j < NJ; ++j) b_[j] = ldfrag(SB, 72, wn * (BN / 4) + 32 * j + r, ks * 16 + 8 * h); \
      _Pragma("unroll") for (int i = 0; i < MI; ++i) {                                              \
        const bf16x8 a_ = ldfrag(SA, 72, wm * (BM / 2) + 32 * i + r, ks * 16 + 8 * h);             \
        _Pragma("unroll") for (int j = 0; j < NJ; ++j) acc[i][j] = MFMA32(a_, b_[j], acc[i][j]);    \
      }                                                                                             \
    }                                                                                               \
  }
  G_LOAD(ra0, rb0, 0);
  G_LOAD(ra1, rb1, 1);
  __syncthreads();
  G_WRITE(ra0, rb0, sA0, sB0);
  if (nk > 2) G_LOAD(ra0, rb0, 2);
  __syncthreads();
#pragma unroll 1
  for (int kt = 0; kt < nk; kt += 2) {
    G_COMPUTE(sA0, sB0);
    G_WRITE(ra1, rb1, sA1, sB1);
    if (kt + 3 < nk) G_LOAD(ra1, rb1, kt + 3);
    __syncthreads();
    G_COMPUTE(sA1, sB1);
    if (kt + 2 < nk) G_WRITE(ra0, rb0, sA0, sB0);
    if (kt + 4 < nk) G_LOAD(ra0, rb0, kt + 4);
    __syncthreads();
  }
#undef G_LOAD
#undef G_WRITE
#undef G_COMPUTE
}


namespace pg8 {
#define PG8_LAS __attribute__((address_space(3)))
typedef unsigned short bf16_t;
constexpr int BM = 256, BK = 64, HALF = 128, HTB = HALF * BK * 2, STAGE_BYTES = 8 * HTB, NXCD = 8, WGM = 8;
__host__ __device__ __forceinline__ int lds_byte(int r, int c) { const int st = (r >> 4) * 2 + (c >> 5), rr = r & 15, cc = c & 31, ob = rr * 64 + cc * 2; return st * 1024 + (ob ^ (((ob >> 9) & 1) << 5)); }
__host__ __device__ __forceinline__ void stage_rc(int b, int& R, int& C) { const int st = b / 1024, sb = b % 1024, swz = sb ^ (((sb >> 9) & 1) << 5); R = (st >> 1) * 16 + swz / 64; C = (st & 1) * 32 + (swz % 64) / 2; }
__host__ __device__ __forceinline__ int perm32(int rho) { const int n = rho >> 4, i = rho & 15; return 8 * (i >> 2) + 4 * n + (i & 3); }
struct Unit { int pm, pn, br; };
struct Gemm { const bf16_t* A; const bf16_t* Bt; int M, N, K; };
struct StaticOrder {
    int nM, nN, nwg, G, c;
    __host__ __device__ void init(int M, int N, int G_, int c_) { nM = M / BM; nN = N / BM; nwg = nM * nN; G = G_; c = c_; }
    __host__ __device__ bool next(int i, Unit& u) const {
        const long L = (long)i * G + c; if (L >= nwg) return false;
        int wgid = (int)L; { const int q = nwg / NXCD, r = nwg % NXCD, xcd = wgid % NXCD, off = wgid / NXCD; wgid = (xcd < r ? xcd * (q + 1) : r * (q + 1) + (xcd - r) * q) + off; }
        const int nig = WGM * nN, gid = wgid / nig, fm = gid * WGM, gsz = (nM - fm) < WGM ? (nM - fm) : WGM;
        u.pm = fm + ((wgid % nig) % gsz); u.pn = (wgid % nig) / gsz; u.br = 0; return true;
    }
    __device__ __forceinline__ void a_ready(const Unit&) const {}
    __device__ __forceinline__ void done(const Unit&) const {}
    __device__ __forceinline__ const char* pa(const Unit& u, const Gemm& g) const { return (const char*)g.A + (size_t)u.pm * (size_t)(2 * BM) * g.K; }
    __device__ __forceinline__ const char* pb(const Unit& u, const Gemm& g) const { return (const char*)g.Bt + (size_t)u.pn * (size_t)(2 * BM) * g.K; }
};
template <class Epi, class Sched>
__device__ __forceinline__ void gemm_phase(PG8_LAS unsigned char* lds, const Gemm g, const Sched& S, const Epi& E) {
    constexpr bool STAMP = false; unsigned long long* stamps = nullptr;
    const int tid = rtid(), wid = __builtin_amdgcn_readfirstlane(tid >> 6), lane = tid & 63, wr = wid >> 2, wc = wid & 3, fr = lane & 15, fq = lane >> 4;
    const int K = g.K, nt = K / BK;
    int ts_lo = 0, ts_hi = 0, nts = 0; const unsigned long long rt_entry = STAMP ? 0ull : 0ull;
#define PG8_STAMP() do { if (STAMP && wid == 0 && nts < 64) { const unsigned long long _c = 0ull; \
        ts_lo = (lane == nts) ? (int)(unsigned)_c : ts_lo; ts_hi = (lane == nts) ? (int)(unsigned)(_c >> 32) : ts_hi; ++nts; } } while (0)
    PG8_STAMP();
    unsigned voffA[2], voffB[2];
#pragma unroll
    for (int i = 0; i < 2; ++i) { int R, C; stage_rc(tid * 16 + i * 8192, R, C); const int Rb = Epi::PERM ? ((R & ~31) + perm32(R & 31)) : R;
        voffA[i] = (unsigned)(R * K + C) * 2u; voffB[i] = (unsigned)(Rb * K + C) * 2u; }
    const size_t kstep = (size_t)(BK * 2);
    const size_t hstep = (size_t)HALF * K * 2;
    const size_t tstep = 2 * hstep;
    const unsigned ldsw = (unsigned)wid * 1024u;
    const int aoff = lds_byte(wr * 64 + fr, fq * 8), boff = lds_byte(wc * 32 + fr, fq * 8);
#define PG8_SA(b, h) (((b) * 2 + (h)) * HTB)
#define PG8_SB(b, h) ((4 + (b) * 2 + (h)) * HTB)
#define PG8_STAGE(bufoff, gbase, voff) do { _Pragma("unroll") for (int _i = 0; _i < 2; ++_i) \
        __builtin_amdgcn_global_load_lds((const unsigned*)((const char*)(gbase) + (voff)[_i]), (PG8_LAS unsigned*)(lds + (bufoff) + ldsw + _i * 8192), 16, 0, 0); } while (0)
#define PG8_LDA(dst, b, h) do { _Pragma("unroll") for (int m = 0; m < 4; ++m) _Pragma("unroll") for (int k = 0; k < 2; ++k) dst[m][k] = *(const PG8_LAS bf16x8*)(lds + PG8_SA(b, h) + aoff + m * 2048 + k * 1024); } while (0)
#define PG8_LDB(dst, b, h) do { _Pragma("unroll") for (int n = 0; n < 2; ++n) _Pragma("unroll") for (int k = 0; k < 2; ++k) dst[n][k] = *(const PG8_LAS bf16x8*)(lds + PG8_SB(b, h) + boff + n * 2048 + k * 1024); } while (0)
#define PG8_MMA(ai, bj, At, Bt) do { __builtin_amdgcn_s_setprio(1); _Pragma("unroll") for (int m = 0; m < 4; ++m) _Pragma("unroll") for (int n = 0; n < 2; ++n) _Pragma("unroll") for (int k = 0; k < 2; ++k) \
        acc[ai][bj][m][n] = __builtin_amdgcn_mfma_f32_16x16x32_bf16(Bt[n][k], At[m][k], acc[ai][bj][m][n], 0, 0, 0); __builtin_amdgcn_s_setprio(0); } while (0)
#define PG8_WAIT_V(n) asm volatile("s_waitcnt vmcnt(" #n ")" ::: "memory")
#define PG8_WAIT_L(n) asm volatile("s_waitcnt lgkmcnt(" #n ")" ::: "memory")
#define PG8_BAR __builtin_amdgcn_s_barrier()
#define PG8_SCHED __builtin_amdgcn_sched_barrier(0)
    Unit cur, nxt; int ui = 0;
    if (!S.next(0, cur)) return;
    f32x4 acc[2][2][4][2];
#pragma unroll
    for (int a = 0; a < 2; ++a)
#pragma unroll
        for (int b = 0; b < 2; ++b)
#pragma unroll
            for (int m = 0; m < 4; ++m)
#pragma unroll
                for (int n = 0; n < 2; ++n) acc[a][b][m][n] = (f32x4){0.f, 0.f, 0.f, 0.f};
    bf16x8 At[4][2], B0[2][2], B1[2][2];
    const char* cA = S.pa(cur, g); const char* cB = S.pb(cur, g);
    S.a_ready(cur);
    PG8_STAGE(PG8_SB(0, 0), cB, voffB); PG8_STAGE(PG8_SA(0, 0), cA, voffA); PG8_STAGE(PG8_SB(0, 1), cB + hstep, voffB); PG8_STAGE(PG8_SA(0, 1), cA + hstep, voffA);
    if (wr == 1) PG8_BAR;
    PG8_WAIT_V(4); PG8_BAR;
    PG8_STAGE(PG8_SB(1, 0), cB + kstep, voffB); PG8_STAGE(PG8_SA(1, 0), cA + kstep, voffA); PG8_STAGE(PG8_SB(1, 1), cB + hstep + kstep, voffB);
    PG8_WAIT_V(6); PG8_BAR;
    PG8_STAMP();
    for (;;) {
        const bool has_next = S.next(ui + 1, nxt);
        const char* nA = has_next ? S.pa(nxt, g) : cA; const char* nB = has_next ? S.pb(nxt, g) : cB;
        for (int t = 0; t < nt; t += 2) {
            const bool last = (t == nt - 2);
            const char* a1 = cA + (size_t)(t + 1) * kstep;
            const char* a2 = last ? nA : cA + (size_t)(t + 2) * kstep; const char* b2 = last ? nB : cB + (size_t)(t + 2) * kstep;
            const char* a3 = a2 + kstep; const char* b3 = b2 + kstep;
            if (last && has_next) S.a_ready(nxt);
            PG8_LDB(B0, 0, 0); PG8_SCHED; PG8_LDA(At, 0, 0); PG8_STAGE(PG8_SA(1, 1), a1 + hstep, voffA);
            PG8_WAIT_L(8); PG8_BAR; PG8_WAIT_L(0); PG8_MMA(0, 0, At, B0); PG8_BAR; PG8_SCHED;
            PG8_LDB(B1, 0, 1); PG8_STAGE(PG8_SB(0, 0), b2, voffB);
            PG8_BAR; PG8_WAIT_L(0); PG8_MMA(0, 1, At, B1); PG8_BAR;
            PG8_LDA(At, 0, 1); PG8_STAGE(PG8_SA(0, 0), a2, voffA);
            PG8_BAR; PG8_WAIT_L(0); PG8_MMA(1, 0, At, B0); PG8_BAR; PG8_SCHED;
            PG8_STAGE(PG8_SB(0, 1), b2 + hstep, voffB);
            PG8_WAIT_V(6); PG8_BAR; PG8_MMA(1, 1, At, B1); PG8_BAR;
            PG8_LDB(B0, 1, 0); PG8_SCHED; PG8_LDA(At, 1, 0); PG8_STAGE(PG8_SA(0, 1), a2 + hstep, voffA);
            PG8_WAIT_L(8); PG8_BAR; PG8_WAIT_L(0); PG8_MMA(0, 0, At, B0); PG8_BAR; PG8_SCHED;
            PG8_LDB(B1, 1, 1); PG8_STAGE(PG8_SB(1, 0), b3, voffB);
            PG8_BAR; PG8_WAIT_L(0); PG8_MMA(0, 1, At, B1); PG8_BAR;
            PG8_LDA(At, 1, 1); PG8_STAGE(PG8_SA(1, 0), a3, voffA);
            PG8_BAR; PG8_WAIT_L(0); PG8_MMA(1, 0, At, B0); PG8_BAR; PG8_SCHED;
            PG8_STAGE(PG8_SB(1, 1), b3 + hstep, voffB);
            PG8_WAIT_V(6); PG8_BAR; PG8_MMA(1, 1, At, B1); PG8_BAR;
        }
        PG8_STAMP();
        if constexpr (!Epi::AFTER_DRAIN) { E(acc, cur, wr, wc, fr, fq); S.done(cur); }
        PG8_STAMP();
        if (!has_next) break;
#pragma unroll
        for (int a = 0; a < 2; ++a)
#pragma unroll
            for (int b = 0; b < 2; ++b)
#pragma unroll
                for (int m = 0; m < 4; ++m)
#pragma unroll
                    for (int n = 0; n < 2; ++n) acc[a][b][m][n] = (f32x4){0.f, 0.f, 0.f, 0.f};
        cur = nxt; cA = nA; cB = nB; ++ui;
    }
    PG8_WAIT_V(0);
    if (wr == 0) PG8_BAR;
    PG8_BAR;
    if constexpr (Epi::AFTER_DRAIN) { E.fused(acc, cur, wr, wc, fr, fq, lds, wid, lane); S.done(cur); }
    PG8_STAMP();
    if (STAMP && wid == 0) { stamps[lane] = lane < nts ? (((unsigned long long)(unsigned)ts_hi << 32) | (unsigned)ts_lo) : 0ull;
        if (lane == 62) stamps[62] = rt_entry; if (lane == 63) stamps[63] = 0ull; }
#undef PG8_STAMP
#undef PG8_SA
#undef PG8_SB
#undef PG8_STAGE
#undef PG8_LDA
#undef PG8_LDB
#undef PG8_MMA
#undef PG8_WAIT_V
#undef PG8_WAIT_L
#undef PG8_BAR
#undef PG8_SCHED
}

}

struct EpiP {
  static constexpr bool PERM = true, AFTER_DRAIN = false;
  u16* P;
  DI void operator()(const f32x4 (&acc)[2][2][4][2], const pg8::Unit& u, int wr, int wc, int fr, int fq) const {
    const int row0 = u.pm * 256 + wr * 64 + fr, col0 = u.pn * 256 + wc * 32 + 8 * fq;
#pragma unroll
    for (int ai = 0; ai < 2; ++ai)
#pragma unroll
      for (int m = 0; m < 4; ++m) {
        u16* rowp = P + (size_t)(row0 + ai * 128 + m * 16) * PW + col0;
#pragma unroll
        for (int bj = 0; bj < 2; ++bj) {
          if (col0 + bj * 128 < PW) {
            const f32x4 v0 = acc[ai][bj][m][0], v1 = acc[ai][bj][m][1];
            u32x4 w; w.x = pk2(v0[0], v0[1]); w.y = pk2(v0[2], v0[3]); w.z = pk2(v1[0], v1[1]); w.w = pk2(v1[2], v1[3]);
            *(u32x4*)(rowp + bj * 128) = w;
          }
        }
      }
  }
};
struct EpiX {
  static constexpr bool PERM = false, AFTER_DRAIN = false;
  const float* xin; float* xout;
  DI void operator()(const f32x4 (&acc)[2][2][4][2], const pg8::Unit& u, int wr, int wc, int fr, int fq) const {
    int row0 = u.pm * 256 + wr * 64 + fr, col0 = u.pn * 256 + wc * 32 + 4 * fq;
    asm volatile("" : "+v"(row0), "+v"(col0));
#pragma unroll
    for (int ai = 0; ai < 2; ++ai) {
      const int mb = 0;
      f32x4 xv[4][2][2];
#pragma unroll
      for (int m = mb; m < mb + 4; ++m)
#pragma unroll
        for (int bj = 0; bj < 2; ++bj)
#pragma unroll
          for (int n = 0; n < 2; ++n)
            xv[m][bj][n] = *(const f32x4*)(xin + (size_t)(row0 + ai * 128 + m * 16) * D_ + col0 + bj * 128 + n * 16);
#pragma unroll
      for (int m = mb; m < mb + 4; ++m)
#pragma unroll
        for (int bj = 0; bj < 2; ++bj)
#pragma unroll
          for (int n = 0; n < 2; ++n)
            *(f32x4*)(xout + (size_t)(row0 + ai * 128 + m * 16) * D_ + col0 + bj * 128 + n * 16) = xv[m][bj][n] + acc[ai][bj][m][n];
      __builtin_amdgcn_sched_barrier(0);
    }
  }
};

DI size_t wtile(int n0, int K) { return (size_t)(n0 >> 7) * (size_t)(K >> 6) * 8192; }
DI size_t htile(int m0) { return (size_t)(m0 >> 8) * 16 * 16384 + (size_t)(m0 & 255) * 64; }

template <int MI, int NJ>
DI void zero_acc(f32x16 (&acc)[MI][NJ]) {
#pragma unroll
  for (int i = 0; i < MI; ++i)
#pragma unroll
    for (int j = 0; j < NJ; ++j)
#pragma unroll
      for (int e = 0; e < 16; ++e) acc[i][j][e] = 0.f;
}

#define TILE_WALK_BEGIN(MT, NT, SM, SN)                                                   \
  {                                                                                       \
    const int xg_ = bid & 7, loc_ = bid >> 3, nloc_ = nblk >> 3;                          \
    const int nsn_ = ((NT) + (SN) - 1) / (SN), nst_ = (((MT) + (SM) - 1) / (SM)) * nsn_;  \
    for (int st_ = xg_; st_ < nst_; st_ += 8)                                             \
      for (int j_ = loc_; j_ < (SM) * (SN); j_ += nloc_) {                                \
        const int mi = (st_ / nsn_) * (SM) + j_ / (SN), ni = (st_ % nsn_) * (SN) + j_ % (SN); \
        if (mi >= (MT) || ni >= (NT)) continue;
#define TILE_WALK_END }}

DI int t5_bucket(int rel) {
  int n = rel < 0 ? -rel : rel;
  float nf = (float)(n > 1 ? n : 1);
  int large = 8 + (int)(logf(nf / 8.f) / logf(16.f) * 8.f);
  large = large < 15 ? large : 15;
  return (rel > 0 ? 16 : 0) + (n < 8 ? n : large);
}

DI void prep_job(const float* __restrict__ src, int K, int Nsrc, u16* __restrict__ dst, int Ndst, int mode,
                 const float* __restrict__ scale, char* smem, int bid, int nblk, bool rowmajor = false) {
  u16* sT = (u16*)smem;
  const int tid = otid();
  const int ntn = Ndst >> 6, ntk = K >> 6;
  float v[16];
  auto gl = [&](int t) {
    const int n0 = (t / ntk) << 6, k0 = (t % ntk) << 6;
    const int n = n0 + (tid & 63);
    int sc = n;
    if (mode == 1) sc = (n < 1536) ? n : (n < 6912 ? n + 16 : (n < 6928 ? n - 6912 + 1536 : -1));
#pragma unroll
    for (int i = 0; i < 16; ++i) {
      const int k = i * 4 + (tid >> 6);
      float x = 0.f;
      if (sc >= 0) x = src[(size_t)(k0 + k) * Nsrc + sc];
      if (scale) x *= scale[k0 + k];
      v[i] = x;
    }
  };
  if (bid < ntn * ntk) gl(bid);
  for (int t = bid; t < ntn * ntk; t += nblk) {
    const int n0 = (t / ntk) << 6, k0 = (t % ntk) << 6;
    __syncthreads();
#pragma unroll
    for (int i = 0; i < 16; ++i) sT[(tid & 63) * 72 + i * 4 + (tid >> 6)] = f2bf(v[i]);
    if (t + nblk < ntn * ntk) gl(t + nblk);
    __syncthreads();
    const int nn = tid >> 2, ks = (tid & 3) * 16;
    u32x4 v0 = *(const u32x4*)(sT + nn * 72 + ks), v1 = *(const u32x4*)(sT + nn * 72 + ks + 8);
    u16* d = rowmajor ? dst + (size_t)(n0 + nn) * K + k0 + ks
                      : dst + ((size_t)((n0 + nn) >> 7) * (size_t)(K >> 6) + (size_t)(k0 >> 6)) * 8192 + (size_t)((n0 + nn) & 127) * 64 + ks;
    *(u32x4*)d = v0;
    *(u32x4*)(d + 8) = v1;
  }
}

DI void phase_prologue(const Params& p, char* smem, int bid, int nblk) {
  const int tid = otid(), lane = tid & 63, w = tid >> 6;
  for (int i = bid * 256 + tid; i < 12 * 4095; i += nblk * 256) {
    const int hd = i / 4095, idx = i % 4095;
    p.lut[hd * LUTS + idx] = p.in[2][t5_bucket(idx - 2047) * 12 + hd];
  }
  for (int row = bid * 4 + w; row < NBATCH * MEML; row += nblk * 4) {
    const float* src = p.in[1] + (size_t)row * D_;
    float ss = 0.f;
#pragma unroll
    for (int i = 0; i < 4; ++i) {
      f32x4 v = *(const f32x4*)(src + i * 256 + lane * 4);
      ss += v[0] * v[0] + v[1] * v[1] + v[2] * v[2] + v[3] * v[3];
      u32x2 o; o.x = pk2(v[0], v[1]); o.y = pk2(v[2], v[3]);
      *(u32x2*)(p.memb + (size_t)row * D_ + i * 256 + lane * 4) = o;
    }
    ss = wave_sum(ss);
    if (lane == 0) p.memrs[row] = rsqrtf(ss / (float)D_ + EPS_);
  }
  for (int l = 0; l < 2; ++l) {
    u16* W = p.W + (size_t)l * LAYER_W;
    prep_job(p.in[5] + (size_t)l * D_ * 6928, D_, 6928, W + WIN_OFF, PW, 1, nullptr, smem, bid, nblk, true);
    for (int i = 0; i < 5; ++i)
      prep_job(p.in[27] + ((size_t)l * 5 + i) * D_ * D_, D_, D_, W + WMG_OFF + (size_t)i * D_ * D_, D_, 0, nullptr, smem, bid, nblk, true);
    for (int i = 0; i < 5; ++i)
      prep_job(p.in[29] + ((size_t)l * 5 + i) * BWID * D_, BWID, D_, W + WBR_OFF + (size_t)i * D_ * BWID, D_, 0, nullptr, smem, bid, nblk, true);
    prep_job(p.in[30] + (size_t)l * D_ * D_, D_, D_, W + WOUT_OFF, D_, 0, nullptr, smem, bid, nblk, true);
    prep_job(p.in[23] + (size_t)l * BWID * BWID, BWID, BWID, W + WGLU_OFF, BWID, 0, nullptr, smem, bid, nblk, true);
    prep_job(p.in[26] + (size_t)l * D_ * D_, D_, D_, W + WKV_OFF, D_, 0, p.in[25] + (size_t)l * D_, smem, bid, nblk);
  }
}

DI void phase_norm(const float* __restrict__ x, const float* __restrict__ g, u16* __restrict__ hdst, int nrows, int bid, int nblk) {
  const int tid_ = otid(), lane = tid_ & 63, w = tid_ >> 6;
  const int stride = nblk * 4;
  for (int row0 = bid * 4 + w; row0 < nrows; row0 += 4 * stride) {
    f32x4 v[4][4];
    float ss[4] = {0.f, 0.f, 0.f, 0.f};
#pragma unroll
    for (int u = 0; u < 4; ++u) {
      const int row = row0 + u * stride;
      if (row < nrows) {
        const float* src = x + (size_t)row * D_;
#pragma unroll
        for (int i = 0; i < 4; ++i) v[u][i] = *(const f32x4*)(src + i * 256 + lane * 4);
      }
    }
#pragma unroll
    for (int u = 0; u < 4; ++u) {
      const int row = row0 + u * stride;
      if (row < nrows) {
#pragma unroll
        for (int i = 0; i < 4; ++i) ss[u] += v[u][i][0] * v[u][i][0] + v[u][i][1] * v[u][i][1] + v[u][i][2] * v[u][i][2] + v[u][i][3] * v[u][i][3];
        ss[u] = wave_sum(ss[u]);
        const float rs = rsqrtf(ss[u] / (float)D_ + EPS_);
#pragma unroll
        for (int i = 0; i < 4; ++i) {
          f32x4 gg = *(const f32x4*)(g + i * 256 + lane * 4);
          u32x2 o; o.x = pk2(v[u][i][0] * rs * gg[0], v[u][i][1] * rs * gg[1]); o.y = pk2(v[u][i][2] * rs * gg[2], v[u][i][3] * rs * gg[3]);
          const int c = i * 256 + lane * 4;
          *(u32x2*)(hdst + (size_t)row * D_ + c) = o;
        }
      }
    }
  }
}

DI void phase_final(float* __restrict__ x, const float* __restrict__ g, int nrows, int bid, int nblk) {
  const int tid_ = otid(), lane = tid_ & 63, w = tid_ >> 6;
  const int stride = nblk * 4;
  for (int row0 = bid * 4 + w; row0 < nrows; row0 += 4 * stride) {
    f32x4 v[4][4];
    float ss[4] = {0.f, 0.f, 0.f, 0.f};
#pragma unroll
    for (int u = 0; u < 4; ++u) {
      const int row = row0 + u * stride;
      if (row < nrows) {
        const float* src = x + (size_t)row * D_;
#pragma unroll
        for (int i = 0; i < 4; ++i) v[u][i] = *(const f32x4*)(src + i * 256 + lane * 4);
      }
    }
#pragma unroll
    for (int u = 0; u < 4; ++u) {
      const int row = row0 + u * stride;
      if (row < nrows) {
        float* src = x + (size_t)row * D_;
#pragma unroll
        for (int i = 0; i < 4; ++i) ss[u] += v[u][i][0] * v[u][i][0] + v[u][i][1] * v[u][i][1] + v[u][i][2] * v[u][i][2] + v[u][i][3] * v[u][i][3];
        ss[u] = wave_sum(ss[u]);
        const float rs = rsqrtf(ss[u] / (float)D_ + EPS_);
#pragma unroll
        for (int i = 0; i < 4; ++i) {
          f32x4 gg = *(const f32x4*)(g + i * 256 + lane * 4);
          f32x4 o; o[0] = v[u][i][0] * rs * gg[0]; o[1] = v[u][i][1] * rs * gg[1]; o[2] = v[u][i][2] * rs * gg[2]; o[3] = v[u][i][3] * rs * gg[3];
          *(f32x4*)(src + i * 256 + lane * 4) = o;
        }
      }
    }
  }
}

DI void phase_kv(const Params& p, char* smem, int bid, int nblk) {
  const int tid_ = otid(), lane = tid_ & 63, w = tid_ >> 6, wm = w >> 1, wn = w & 1, r = lane & 31, h = lane >> 5;
  for (int t = bid; t < 2 * 32 * 8; t += nblk) {
    const int l = t >> 8, tt = t & 255, m0 = (tt >> 3) * 128, n0 = (tt & 7) * 128;
    f32x16 acc[2][2];
    zero_acc<2, 2>(acc);
    gemm_acc<128, 128>(p.memb + (size_t)m0 * D_, D_, 64, p.W + (size_t)l * LAYER_W + WKV_OFF + wtile(n0, D_), 64, 8192, D_, acc, smem);
    u16* dst = p.KV + (size_t)l * NBATCH * MEML * D_;
#pragma unroll
    for (int i = 0; i < 2; ++i)
#pragma unroll
      for (int e = 0; e < 16; ++e) {
        const int row = m0 + wm * 64 + 32 * i + crow(e, h);
        const float rs = p.memrs[row];
#pragma unroll
        for (int j = 0; j < 2; ++j) dst[(size_t)row * D_ + n0 + wn * 64 + 32 * j + r] = f2bf(acc[i][j][e] * rs);
      }
  }
}

DI void phase_inproj(const Params& p, int l, int Tg, char* smem, int bid, int nblk) {
  const pg8::Gemm g{p.h, p.W + (size_t)l * LAYER_W + WIN_OFF, Tg, 7168, D_};
  pg8::StaticOrder S; S.init(Tg, 7168, nblk, bid);
  const EpiP E{p.P};
  pg8::gemm_phase<EpiP, pg8::StaticOrder>((PG8_LAS unsigned char*)smem, g, S, E);
}

struct EpiG {
  static constexpr bool PERM = true, AFTER_DRAIN = false;
  unsigned char* G; const float* bias;
  DI void operator()(const f32x4 (&acc)[2][2][4][2], const pg8::Unit& u, int wr, int wc, int fr, int fq) const {
    int row0 = u.pm * 256 + wr * 64 + fr, col0 = u.pn * 256 + wc * 32 + 8 * fq;
    asm volatile("" : "+v"(row0), "+v"(col0));
    f32x4 bv[2][2];
#pragma unroll
    for (int bj = 0; bj < 2; ++bj)
#pragma unroll
      for (int n = 0; n < 2; ++n) bv[bj][n] = *(const f32x4*)(bias + col0 + bj * 128 + 4 * n);
#pragma unroll
    for (int ai = 0; ai < 2; ++ai)
#pragma unroll
      for (int m = 0; m < 4; ++m) {
        unsigned char* rowp = G + (size_t)(row0 + ai * 128 + m * 16) * (5 * D_) + col0;
#pragma unroll
        for (int bj = 0; bj < 2; ++bj) {
          const f32x4 v0 = acc[ai][bj][m][0] + bv[bj][0], v1 = acc[ai][bj][m][1] + bv[bj][1];
          u32x2 w;
          w.x = (unsigned)(sigmoidf_(v0[0]) * 255.f + 0.5f) | ((unsigned)(sigmoidf_(v0[1]) * 255.f + 0.5f) << 8) |
                ((unsigned)(sigmoidf_(v0[2]) * 255.f + 0.5f) << 16) | ((unsigned)(sigmoidf_(v0[3]) * 255.f + 0.5f) << 24);
          w.y = (unsigned)(sigmoidf_(v1[0]) * 255.f + 0.5f) | ((unsigned)(sigmoidf_(v1[1]) * 255.f + 0.5f) << 8) |
                ((unsigned)(sigmoidf_(v1[2]) * 255.f + 0.5f) << 16) | ((unsigned)(sigmoidf_(v1[3]) * 255.f + 0.5f) << 24);
          *(u32x2*)(rowp + bj * 128) = w;
        }
      }
  }
};

DI void phase_gates(const Params& p, int l, int Tg, unsigned char* G, char* smem, int bid, int nblk) {
  const pg8::Gemm g{p.h, p.W + (size_t)l * LAYER_W + WMG_OFF, Tg, 5 * D_, D_};
  pg8::StaticOrder S; S.init(Tg, 5 * D_, nblk, bid);
  const EpiG E{G, p.in[28] + (size_t)l * 5 * D_};
  pg8::gemm_phase<EpiG, pg8::StaticOrder>((PG8_LAS unsigned char*)smem, g, S, E);
}

struct EpiGLU {
  static constexpr bool PERM = true, AFTER_DRAIN = false;
  const u16* g; const u16* zs; u16* o3; const float* gb;
  DI void operator()(const f32x4 (&acc)[2][2][4][2], const pg8::Unit& u, int wr, int wc, int fr, int fq) const {
    int row0 = u.pm * 256 + wr * 64 + fr, col0 = u.pn * 256 + wc * 32 + 8 * fq;
    asm volatile("" : "+v"(row0), "+v"(col0));
    f32x4 bv[2][2];
#pragma unroll
    for (int bj = 0; bj < 2; ++bj)
#pragma unroll
      for (int n = 0; n < 2; ++n) bv[bj][n] = *(const f32x4*)(gb + col0 + bj * 128 + 4 * n);
#pragma unroll
    for (int am = 0; am < 4; ++am) {
      const int ai = am >> 1, mb = (am & 1) * 2;
      u32x4 gvv[4][2], zvv[4][2];
#pragma unroll
      for (int m = mb; m < mb + 2; ++m)
#pragma unroll
        for (int bj = 0; bj < 2; ++bj) {
          const size_t row = (size_t)(row0 + ai * 128 + m * 16);
          const int col = col0 + bj * 128;
          gvv[m][bj] = *(const u32x4*)(g + row * BWID + col);
          zvv[m][bj] = *(const u32x4*)(zs + row * BWID + col);
        }
#pragma unroll
      for (int m = mb; m < mb + 2; ++m)
#pragma unroll
        for (int bj = 0; bj < 2; ++bj) {
          const size_t row = (size_t)(row0 + ai * 128 + m * 16);
          const int col = col0 + bj * 128;
          const u32x4 gv = gvv[m][bj], zv = zvv[m][bj];
          const f32x4 v0 = acc[ai][bj][m][0] + bv[bj][0], v1 = acc[ai][bj][m][1] + bv[bj][1];
          u32x4 w;
          w.x = pk2(bflo(gv.x) * sigmoidf_(v0[0]) * bflo(zv.x), bfhi(gv.x) * sigmoidf_(v0[1]) * bfhi(zv.x));
          w.y = pk2(bflo(gv.y) * sigmoidf_(v0[2]) * bflo(zv.y), bfhi(gv.y) * sigmoidf_(v0[3]) * bfhi(zv.y));
          w.z = pk2(bflo(gv.z) * sigmoidf_(v1[0]) * bflo(zv.z), bfhi(gv.z) * sigmoidf_(v1[1]) * bfhi(zv.z));
          w.w = pk2(bflo(gv.w) * sigmoidf_(v1[2]) * bflo(zv.w), bfhi(gv.w) * sigmoidf_(v1[3]) * bfhi(zv.w));
          *(u32x4*)(o3 + row * BWID + col) = w;
        }
      __builtin_amdgcn_sched_barrier(0);
    }
  }
};

DI void phase_glu(const Params& p, int l, int Tg, char* smem, int bid, int nblk) {
  const pg8::Gemm g{p.s5f, p.W + (size_t)l * LAYER_W + WGLU_OFF, Tg, BWID, BWID};
  pg8::StaticOrder S; S.init(Tg, BWID, nblk, bid);
  const EpiGLU E{p.s5f, p.syb, p.o3, p.in[24] + (size_t)l * BWID};
  pg8::gemm_phase<EpiGLU, pg8::StaticOrder>((PG8_LAS unsigned char*)smem, g, S, E);
}

struct BranchOrder {
  const u16* ob0; size_t ostride; const u16* wbr; int c, ntile, G;
  DI bool next(int i, pg8::Unit& u) const {
    const int t = c + (i / 5) * G;
    if (t >= ntile) return false;
    u.pm = t >> 2; u.pn = t & 3; u.br = i % 5; return true;
  }
  DI void a_ready(const pg8::Unit&) const {}
  DI void done(const pg8::Unit&) const {}
  DI const char* pa(const pg8::Unit& u, const pg8::Gemm& g) const { return (const char*)(ob0 + (size_t)u.br * ostride + (size_t)u.pm * 256 * BWID); }
  DI const char* pb(const pg8::Unit& u, const pg8::Gemm& g) const { return (const char*)(wbr + (size_t)u.br * D_ * BWID + (size_t)u.pn * 256 * BWID); }
};
struct EpiY {
  static constexpr bool PERM = true, AFTER_DRAIN = false;
  const unsigned char* G; u16* y;
  DI void operator()(const f32x4 (&acc)[2][2][4][2], const pg8::Unit& u, int wr, int wc, int fr, int fq) const {
    int row0 = u.pm * 256 + wr * 64 + fr, col0 = u.pn * 256 + wc * 32 + 8 * fq;
    asm volatile("" : "+v"(row0), "+v"(col0));
    const float ks_ = 1.f / 255.f;
#pragma unroll
    for (int ai = 0; ai < 2; ++ai) {
      u32x2 gq[4][2]; u32x4 yv[4][2];
#pragma unroll
      for (int m = 0; m < 4; ++m)
#pragma unroll
        for (int bj = 0; bj < 2; ++bj) {
          const size_t row = (size_t)(row0 + ai * 128 + m * 16);
          const int col = col0 + bj * 128;
          gq[m][bj] = *(const u32x2*)(G + row * (5 * D_) + u.br * D_ + col);
          yv[m][bj] = (u32x4){0u, 0u, 0u, 0u};
          if (u.br > 0) yv[m][bj] = *(const u32x4*)(y + row * D_ + col);
        }
#pragma unroll
      for (int m = 0; m < 4; ++m)
#pragma unroll
        for (int bj = 0; bj < 2; ++bj) {
          const size_t row = (size_t)(row0 + ai * 128 + m * 16);
          const int col = col0 + bj * 128;
          const u32x2 g = gq[m][bj]; const u32x4 yy = yv[m][bj];
          const float g0 = (float)(g.x & 255u) * ks_, g1 = (float)((g.x >> 8) & 255u) * ks_, g2 = (float)((g.x >> 16) & 255u) * ks_, g3 = (float)(g.x >> 24) * ks_;
          const float g4 = (float)(g.y & 255u) * ks_, g5 = (float)((g.y >> 8) & 255u) * ks_, g6 = (float)((g.y >> 16) & 255u) * ks_, g7 = (float)(g.y >> 24) * ks_;
          const f32x4 v0 = acc[ai][bj][m][0], v1 = acc[ai][bj][m][1];
          u32x4 w;
          w.x = pk2(bflo(yy.x) + g0 * v0[0], bfhi(yy.x) + g1 * v0[1]);
          w.y = pk2(bflo(yy.y) + g2 * v0[2], bfhi(yy.y) + g3 * v0[3]);
          w.z = pk2(bflo(yy.z) + g4 * v1[0], bfhi(yy.z) + g5 * v1[1]);
          w.w = pk2(bflo(yy.w) + g6 * v1[2], bfhi(yy.w) + g7 * v1[3]);
          *(u32x4*)(y + row * D_ + col) = w;
        }
      __builtin_amdgcn_sched_barrier(0);
    }
  }
};

DI void phase_merge(const Params& p, int l, int Tg, const unsigned char* G, u16* ydst, char* smem, int bid, int nblk) {
  const pg8::Gemm g{nullptr, nullptr, Tg, D_, BWID};
  BranchOrder S;
  S.ob0 = p.o0; S.ostride = (size_t)Tg * BWID;
  S.wbr = p.W + (size_t)l * LAYER_W + WBR_OFF; S.c = bid; S.G = nblk; S.ntile = (Tg / 256) * 4;
  const EpiY E{G, ydst};
  pg8::gemm_phase<EpiY, BranchOrder>((PG8_LAS unsigned char*)smem, g, S, E);
}

DI void phase_out(const Params& p, int l, int Tg, const u16* ysrc, const float* xin,
                  float* xout, char* smem, int bid, int nblk) {
  const pg8::Gemm g{ysrc, p.W + (size_t)l * LAYER_W + WOUT_OFF, Tg, D_, D_};
  pg8::StaticOrder S; S.init(Tg, D_, nblk, bid);
  const EpiX E{xin, xout};
  pg8::gemm_phase<EpiX, pg8::StaticOrder>((PG8_LAS unsigned char*)smem, g, S, E);
}

DI void phase_conv(const Params& p, int l, int Tg, int bid, int nblk) {
  const float* cw = p.in[6] + (size_t)l * 5 * 1024;
  const float* cb = p.in[7] + (size_t)l * 1024;
  const int total = Tg * 128, stride = nblk * 256;
  for (int idx0 = bid * 256 + otid(); idx0 < total; idx0 += 2 * stride) {
    const int c0 = (idx0 & 127) * 8;
    u32x4 xin[2][5];
    bool ok[2][5];
#pragma unroll
    for (int u = 0; u < 2; ++u) {
      const int idx = idx0 + u * stride;
      const int tok = idx >> 7, spos = tok & (S_ - 1);
#pragma unroll
      for (int k = 0; k < 5; ++k) {
        const int sp = spos + k - 2;
        ok[u][k] = (idx < total) && sp >= 0 && sp < S_;
        xin[u][k] = (u32x4){0u, 0u, 0u, 0u};
        if (ok[u][k]) xin[u][k] = *(const u32x4*)(p.P + (size_t)(tok + k - 2) * PW + c0);
      }
    }
    float acc[2][8];
#pragma unroll
    for (int j = 0; j < 8; ++j) { acc[0][j] = cb[c0 + j]; acc[1][j] = acc[0][j]; }
#pragma unroll
    for (int k = 0; k < 5; ++k) {
      float wv[8], f0[8], f1[8];
#pragma unroll
      for (int j = 0; j < 8; ++j) wv[j] = cw[k * 1024 + c0 + j];
      unpack8(xin[0][k], f0);
      unpack8(xin[1][k], f1);
#pragma unroll
      for (int j = 0; j < 8; ++j) { acc[0][j] += f0[j] * wv[j]; acc[1][j] += f1[j] * wv[j]; }
    }
#pragma unroll
    for (int u = 0; u < 2; ++u) {
      const int idx = idx0 + u * stride;
      if (idx < total) {
        u32x4 o;
        o.x = pk2(siluf_(acc[u][0]), siluf_(acc[u][1])); o.y = pk2(siluf_(acc[u][2]), siluf_(acc[u][3]));
        o.z = pk2(siluf_(acc[u][4]), siluf_(acc[u][5])); o.w = pk2(siluf_(acc[u][6]), siluf_(acc[u][7]));
        *(u32x4*)(p.xa + (size_t)(idx >> 7) * 1024 + c0) = o;
      }
    }
  }
}

template <int DQK, int DV>
DI void attn_pass(const bf16x8 (&qf)[DQK / 16], const u16* __restrict__ Kg, int ldk, const u16* __restrict__ Vg, int ldv,
                  int kt0, int kt1, int q_pos, int q_lo, const float* lut, int window, float m_init, float l_init,
                  f32x16 (&o)[DV / 32], float& l_out, u16* sK, u16* sV) {
  constexpr int LDK = DQK + 8, LDV = DV + 16, NKC = DQK / 32, NVC = DV / 32;
  const int tid = otid(), lane = tid & 63, r = lane & 31, h = lane >> 5;
  u32x4 rk[NKC], rv[NVC];
#pragma unroll
  for (int d = 0; d < DV / 32; ++d)
#pragma unroll
    for (int e = 0; e < 16; ++e) o[d][e] = 0.f;
  float m = m_init, lsum = (h == 0) ? l_init : 0.f;
  {
#pragma unroll
    for (int i = 0; i < NKC; ++i) { const int c = tid + 256 * i, row = c / (DQK / 8), col = (c % (DQK / 8)) * 8; rk[i] = *(const u32x4*)(Kg + (size_t)(kt0 * 64 + row) * ldk + col); }
#pragma unroll
    for (int i = 0; i < NVC; ++i) { const int c = tid + 256 * i, row = c / (DV / 8), col = (c % (DV / 8)) * 8; rv[i] = *(const u32x4*)(Vg + (size_t)(kt0 * 64 + row) * ldv + col); }
  }
#pragma unroll 1
  for (int kt = kt0; kt < kt1; ++kt) {
    __syncthreads();
#pragma unroll
    for (int i = 0; i < NKC; ++i) { const int c = tid + 256 * i, row = c / (DQK / 8), col = (c % (DQK / 8)) * 8; *(u32x4*)(sK + row * LDK + col) = rk[i]; }
#pragma unroll
    for (int i = 0; i < NVC; ++i) { const int c = tid + 256 * i, row = c / (DV / 8), col = (c % (DV / 8)) * 8; *(u32x4*)(sV + row * LDV + col) = rv[i]; }
    __syncthreads();
    if (kt + 1 < kt1) {
#pragma unroll
      for (int i = 0; i < NKC; ++i) { const int c = tid + 256 * i, row = c / (DQK / 8), col = (c % (DQK / 8)) * 8; rk[i] = *(const u32x4*)(Kg + (size_t)((kt + 1) * 64 + row) * ldk + col); }
#pragma unroll
      for (int i = 0; i < NVC; ++i) { const int c = tid + 256 * i, row = c / (DV / 8), col = (c % (DV / 8)) * 8; rv[i] = *(const u32x4*)(Vg + (size_t)((kt + 1) * 64 + row) * ldv + col); }
    }
    f32x16 s[2];
#pragma unroll
    for (int t = 0; t < 2; ++t) {
      bf16x8 ka[DQK / 16];
#pragma unroll
      for (int ks = 0; ks < DQK / 16; ++ks) ka[ks] = ldfrag(sK, LDK, 32 * t + r, 16 * ks + 8 * h);
#pragma unroll
      for (int e = 0; e < 16; ++e) s[t][e] = 0.f;
#pragma unroll
      for (int ks = 0; ks < DQK / 16; ++ks) s[t] = MFMA32(ka[ks], qf[ks], s[t]);
    }
    const int kbase = kt * 64;
    if (lut) {
      const bool far_ = (window == 0) && ((kbase - (q_lo + 31) >= 91) || (q_lo - (kbase + 63) >= 91));
      if (far_) {
        const float bconst = lut[(kbase > q_lo) ? 4000 : 100];
#pragma unroll
        for (int t = 0; t < 2; ++t)
#pragma unroll
          for (int e = 0; e < 16; ++e) s[t][e] += bconst;
      } else {
#pragma unroll
        for (int t = 0; t < 2; ++t)
#pragma unroll
          for (int e = 0; e < 16; ++e) {
            const int rel = kbase + 32 * t + crow(e, h) - q_pos;
            float v = s[t][e] + lut[rel + 2047];
            if (window > 0 && (rel > window || rel < -window)) v = -INFINITY;
            s[t][e] = v;
          }
      }
    }
    float mx = s[0][0];
#pragma unroll
    for (int t = 0; t < 2; ++t)
#pragma unroll
      for (int e = 0; e < 16; ++e) mx = fmaxf(mx, s[t][e]);
    mx = fmaxf(mx, __shfl_xor(mx, 32, 64));
    if (__builtin_amdgcn_ballot_w64(mx > m + 8.f) != 0ull) {
      const float mn = fmaxf(m, mx);
      const float alpha = __builtin_amdgcn_exp2f(m - mn);
      m = mn;
      lsum *= alpha;
#pragma unroll
      for (int d = 0; d < DV / 32; ++d)
#pragma unroll
        for (int e = 0; e < 16; ++e) o[d][e] *= alpha;
    }
    float ps = 0.f;
#pragma unroll
    for (int t = 0; t < 2; ++t)
#pragma unroll
      for (int e = 0; e < 16; ++e) { const float pv = __builtin_amdgcn_exp2f(s[t][e] - m); s[t][e] = pv; ps += pv; }
    lsum += ps;
    bf16x8 pf[2][2];
#pragma unroll
    for (int t = 0; t < 2; ++t)
#pragma unroll
      for (int s2 = 0; s2 < 2; ++s2) pf[t][s2] = pack8(s[t], s2);
#pragma unroll
    for (int d = 0; d < DV / 32; ++d) {
      bf16x8 va[2][2];
#pragma unroll
      for (int t = 0; t < 2; ++t)
#pragma unroll
        for (int s2 = 0; s2 < 2; ++s2) va[t][s2] = ldfrag_tr_perm(sV, LDV, 32 * t + 16 * s2, 32 * d, lane);
#pragma unroll
      for (int t = 0; t < 2; ++t)
#pragma unroll
        for (int s2 = 0; s2 < 2; ++s2) o[d] = MFMA32(va[t][s2], pf[t][s2], o[d]);
    }
  }
  lsum += __shfl_xor(lsum, 32, 64);
  l_out = lsum;
}

template <int DQK>
DI void load_qfrag(bf16x8 (&qf)[DQK / 16], const u16* qrow, float scale, int h) {
#pragma unroll
  for (int ks = 0; ks < DQK / 16; ++ks) {
    u32x4 v = *(const u32x4*)(qrow + 16 * ks + 8 * h);
    qf[ks] = __builtin_bit_cast(bf16x8, scale8(v, scale));
  }
}

DI void attn_lds(char* smem, u16*& sK, u16*& sV, float*& slut) {
  sK = (u16*)smem; sV = sK + 64 * 136; slut = (float*)(sV + 64 * 144);
}

DI void diff_item(const Params& p, int l, int item, char* smem) {
  const int tid = otid(), lane = tid & 63, w = tid >> 6, r = lane & 31, h = lane >> 5;
  const int bl = item >> 6, hd = (item >> 4) & 3, qb = item & 15;
  u16 *sK, *sV; float* slut;
  attn_lds(smem, sK, sV, slut);
  __syncthreads();
  {
    const float* gl = p.lut + hd * LUTS;
    const float v0 = gl[2047 - 256 + tid], v1 = gl[2047 + tid];
    const float vf = (tid < 2) ? gl[tid ? 4000 : 100] : 0.f;
    slut[2047 - 256 + tid] = v0 * 1.4426950408889634f; slut[2047 + tid] = v1 * 1.4426950408889634f;
    if (tid < 2) slut[tid ? 4000 : 100] = vf * 1.4426950408889634f;
  }
  const float lam_init = 0.8f - 0.6f * expf(-0.3f * (float)l);
  const float* lp = p.in[12] + (size_t)l * 4 * 64;
  const float d1 = wave_sum(lp[lane] * lp[64 + lane]), d2 = wave_sum(lp[128 + lane] * lp[192 + lane]);
  const float lam = expf(d1) - expf(d2) + lam_init;
  const int q_lo = qb * 128 + 32 * w, q_pos = q_lo + r;
  const size_t tokq = (size_t)bl * S_ + q_pos;
  const u16* Pb = p.P + (size_t)bl * S_ * PW;
  f32x16 o[4];
  float lt;
  u16* odst = p.o1 + tokq * BWID + hd * 128;
  {
    bf16x8 qf[4];
    load_qfrag<64>(qf, p.P + tokq * PW + P_DQ + (hd * 2 + 0) * 64, 0.125f * 1.4426950408889634f, h);
    attn_pass<64, 128>(qf, Pb + P_DK + (hd * 2 + 0) * 64, PW, Pb + P_DV + hd * 128, PW, 0, 32, q_pos, q_lo, slut, 0, -INFINITY, 0.f, o, lt, sK, sV);
    const float inv = 1.f / lt;
#pragma unroll
    for (int d = 0; d < 4; ++d)
#pragma unroll
      for (int g4 = 0; g4 < 4; ++g4) {
        u32x2 ov;
        ov.x = pk2(o[d][4 * g4 + 0] * inv, o[d][4 * g4 + 1] * inv);
        ov.y = pk2(o[d][4 * g4 + 2] * inv, o[d][4 * g4 + 3] * inv);
        *(u32x2*)(odst + 32 * d + 8 * g4 + 4 * h) = ov;
      }
  }
  {
    bf16x8 qf[4];
    load_qfrag<64>(qf, p.P + tokq * PW + P_DQ + (hd * 2 + 1) * 64, 0.125f * 1.4426950408889634f, h);
    attn_pass<64, 128>(qf, Pb + P_DK + (hd * 2 + 1) * 64, PW, Pb + P_DV + hd * 128, PW, 0, 32, q_pos, q_lo, slut, 0, -INFINITY, 0.f, o, lt, sK, sV);
    const float inv = lam / lt;
#pragma unroll
    for (int d = 0; d < 4; ++d)
#pragma unroll
      for (int g4 = 0; g4 < 4; ++g4) {
        const u32x2 pv = *(const u32x2*)(odst + 32 * d + 8 * g4 + 4 * h);
        o[d][4 * g4 + 0] = bflo(pv.x) - o[d][4 * g4 + 0] * inv;
        o[d][4 * g4 + 1] = bfhi(pv.x) - o[d][4 * g4 + 1] * inv;
        o[d][4 * g4 + 2] = bflo(pv.y) - o[d][4 * g4 + 2] * inv;
        o[d][4 * g4 + 3] = bfhi(pv.y) - o[d][4 * g4 + 3] * inv;
      }
  }
  float ss = 0.f;
#pragma unroll
  for (int d = 0; d < 4; ++d)
#pragma unroll
    for (int e = 0; e < 16; ++e) ss += o[d][e] * o[d][e];
  ss += __shfl_xor(ss, 32, 64);
  const float rs = rsqrtf(ss / 128.f + EPS_) * (1.f - lam_init);
  const float* sg = p.in[13] + (size_t)l * 128;
  u32x2 zall[4][4];
#pragma unroll
  for (int d = 0; d < 4; ++d)
#pragma unroll
    for (int g4 = 0; g4 < 4; ++g4) zall[d][g4] = *(const u32x2*)(p.P + tokq * PW + P_DZ + hd * 128 + 32 * d + 8 * g4 + 4 * h);
#pragma unroll
  for (int d = 0; d < 4; ++d)
#pragma unroll
    for (int g4 = 0; g4 < 4; ++g4) {
      const int dv = 32 * d + 8 * g4 + 4 * h;
      const u32x2 zz = zall[d][g4];
      const float z0 = bflo(zz.x), z1 = bfhi(zz.x), z2 = bflo(zz.y), z3 = bfhi(zz.y);
      u32x2 ov;
      ov.x = pk2(o[d][4 * g4 + 0] * rs * sg[dv + 0] * siluf_(z0), o[d][4 * g4 + 1] * rs * sg[dv + 1] * siluf_(z1));
      ov.y = pk2(o[d][4 * g4 + 2] * rs * sg[dv + 2] * siluf_(z2), o[d][4 * g4 + 3] * rs * sg[dv + 3] * siluf_(z3));
      *(u32x2*)(odst + dv) = ov;
    }
}

DI void win_item(const Params& p, int l, int item, char* smem) {
  const int tid = otid(), lane = tid & 63, w = tid >> 6, r = lane & 31, h = lane >> 5;
  const int bl = item >> 7, qh = (item >> 4) & 7, qb = item & 15;
  const int kvh = qh >> 2;
  u16 *sK, *sV; float* slut;
  attn_lds(smem, sK, sV, slut);
  __syncthreads();
  {
    const float* gl = p.lut + (4 + qh) * LUTS;
    const float v0 = gl[2047 - 256 + tid], v1 = gl[2047 + tid];
    slut[2047 - 256 + tid] = v0 * 1.4426950408889634f; slut[2047 + tid] = v1 * 1.4426950408889634f;
  }
  const float sink = p.in[14][l * 8 + qh];
  const int q_lo = qb * 128 + 32 * w, q_pos = q_lo + r;
  const size_t tokq = (size_t)bl * S_ + q_pos;
  const u16* Pb = p.P + (size_t)bl * S_ * PW;
  int kt0 = qb * 2 - 2; if (kt0 < 0) kt0 = 0;
  int kt1 = qb * 2 + 4; if (kt1 > 32) kt1 = 32;
  f32x16 o[2];
  float lt;
  bf16x8 qf[4];
  load_qfrag<64>(qf, p.P + tokq * PW + P_CQ + qh * 64, 0.125f * 1.4426950408889634f, h);
  attn_pass<64, 64>(qf, Pb + P_CK + kvh * 64, PW, Pb + P_CV + kvh * 64, PW, kt0, kt1, q_pos, q_lo, slut, 128, sink * 1.4426950408889634f, 1.f, o, lt, sK, sV);
  const float inv = 1.f / lt;
  u32x2 zall[2][4];
#pragma unroll
  for (int d = 0; d < 2; ++d)
#pragma unroll
    for (int g4 = 0; g4 < 4; ++g4) zall[d][g4] = *(const u32x2*)(p.P + tokq * PW + P_CZ + qh * 64 + 32 * d + 8 * g4 + 4 * h);
#pragma unroll
  for (int d = 0; d < 2; ++d)
#pragma unroll
    for (int g4 = 0; g4 < 4; ++g4) {
      const int dv = 32 * d + 8 * g4 + 4 * h;
      const u32x2 zz = zall[d][g4];
      const float z0 = bflo(zz.x), z1 = bfhi(zz.x), z2 = bflo(zz.y), z3 = bfhi(zz.y);
      u32x2 ov;
      ov.x = pk2(o[d][4 * g4 + 0] * inv * siluf_(z0), o[d][4 * g4 + 1] * inv * siluf_(z1));
      ov.y = pk2(o[d][4 * g4 + 2] * inv * siluf_(z2), o[d][4 * g4 + 3] * inv * siluf_(z3));
      *(u32x2*)(p.o2 + tokq * BWID + qh * 64 + dv) = ov;
    }
}

DI void mem_item(const Params& p, int l, int grp, int item, char* smem) {
  const int tid = otid(), lane = tid & 63, w = tid >> 6, r = lane & 31, h = lane >> 5;
  const int bl = item >> 6, hd = (item >> 4) & 3, qb = item & 15;
  u16 *sK, *sV; float* slut;
  attn_lds(smem, sK, sV, slut);
  const int q_lo = qb * 128 + 32 * w, q_pos = q_lo + r;
  const size_t tokq = (size_t)bl * S_ + q_pos;
  const int bg = grp * p.BG + bl;
  const u16* kv = p.KV + ((size_t)l * NBATCH + bg) * MEML * D_;
  f32x16 o[4];
  float lt;
  bf16x8 qf[8];
  load_qfrag<128>(qf, p.P + tokq * PW + P_MQ + hd * 128, 0.08838834764831845f * 1.4426950408889634f, h);
  attn_pass<128, 128>(qf, kv + hd * 128, D_, kv + 512 + hd * 128, D_, 0, 4, q_pos, q_lo, nullptr, 0, -INFINITY, 0.f, o, lt, sK, sV);
  const float inv = 1.f / lt;
  u32x2 zall[4][4];
#pragma unroll
  for (int d = 0; d < 4; ++d)
#pragma unroll
    for (int g4 = 0; g4 < 4; ++g4) zall[d][g4] = *(const u32x2*)(p.P + tokq * PW + P_MZ + hd * 128 + 32 * d + 8 * g4 + 4 * h);
#pragma unroll
  for (int d = 0; d < 4; ++d)
#pragma unroll
    for (int g4 = 0; g4 < 4; ++g4) {
      const int dv = 32 * d + 8 * g4 + 4 * h;
      const u32x2 zz = zall[d][g4];
      const float z0 = bflo(zz.x), z1 = bfhi(zz.x), z2 = bflo(zz.y), z3 = bfhi(zz.y);
      u32x2 ov;
      ov.x = pk2(o[d][4 * g4 + 0] * inv * siluf_(z0), o[d][4 * g4 + 1] * inv * siluf_(z1));
      ov.y = pk2(o[d][4 * g4 + 2] * inv * siluf_(z2), o[d][4 * g4 + 3] * inv * siluf_(z3));
      *(u32x2*)(p.o4 + tokq * BWID + hd * 128 + dv) = ov;
    }
}

DI void ssd_item(const Params& p, int l, int item, char* smem) {
  const int tid = otid(), lane = tid & 63, w = tid >> 6, r = lane & 31, h = lane >> 5;
  const int bl = item >> 4, hd = (item >> 1) & 7, dir = item & 1;
  const int gq = hd >> 2, lt = w & 1, ph = w >> 1;
  u16* sB = (u16*)smem;
  u16* sC = sB + 64 * 136;
  u16* sX1 = sC + 64 * 136;
  u16* sX2 = sX1 + 64 * 80;
  u16* sS = sX2 + 64 * 80;
  float* sW = (float*)(sS + 64 * 136);
  float* sDt = sW + 64;
  const float Aneg = -expf(p.in[9][(l * 2 + dir) * 8 + hd]);
  const float dtb = p.in[8][(l * 2 + dir) * 8 + hd];
  u16* ydst = dir ? p.syb : p.o0;
  const u16* Pb = p.P + (size_t)bl * S_ * PW;
  const u16* xab = p.xa + (size_t)bl * S_ * 1024;
  __syncthreads();
  for (int i = tid; i < 64 * 136 / 2; i += 256) ((unsigned*)sS)[i] = 0u;
  f32x16 accS[2];
#pragma unroll
  for (int i = 0; i < 2; ++i)
#pragma unroll
    for (int e = 0; e < 16; ++e) accS[i][e] = 0.f;
  u32x4 rB[4], rC[4], rX[2];
  float rdt = 0.f;
  auto prefetch = [&](int cc) {
    if (tid < 64) {
      const int pp = 64 * cc + tid, tok = dir ? (S_ - 1 - pp) : pp;
      rdt = bf2f(Pb[(size_t)tok * PW + P_DT + dir * 8 + hd]);
    }
#pragma unroll
    for (int i = 0; i < 4; ++i) {
      const int c = tid + 256 * i, row = c >> 4, col = (c & 15) * 8;
      const int pp = 64 * cc + row, tok = dir ? (S_ - 1 - pp) : pp;
      rB[i] = *(const u32x4*)(xab + (size_t)tok * 1024 + 512 + gq * 128 + col);
      rC[i] = *(const u32x4*)(xab + (size_t)tok * 1024 + 768 + gq * 128 + col);
    }
#pragma unroll
    for (int i = 0; i < 2; ++i) {
      const int c = tid + 256 * i, row = c >> 3, col = (c & 7) * 8;
      const int pp = 64 * cc + row, tok = dir ? (S_ - 1 - pp) : pp;
      rX[i] = *(const u32x4*)(xab + (size_t)tok * 1024 + hd * 64 + col);
    }
  };
  prefetch(0);
#pragma unroll 1
  for (int cc = 0; cc < 32; ++cc) {
    __syncthreads();
    if (tid < 64) {
      const float x = rdt + dtb;
      const float dt = x > 20.f ? x : log1pf(expf(x));
      float a = dt * Aneg;
#pragma unroll
      for (int o = 1; o < 64; o <<= 1) { const float t = __shfl_up(a, o, 64); if (lane >= o) a += t; }
      sW[tid] = a;
      sDt[tid] = dt;
    }
#pragma unroll
    for (int i = 0; i < 4; ++i) {
      const int c = tid + 256 * i, row = c >> 4, col = (c & 15) * 8;
      *(u32x4*)(sB + row * 136 + col) = rB[i];
      *(u32x4*)(sC + row * 136 + col) = rC[i];
    }
    __syncthreads();
    const float wlast = sW[63];
#pragma unroll
    for (int i = 0; i < 2; ++i) {
      const int c = tid + 256 * i, row = c >> 3, col = (c & 7) * 8;
      const float f1 = sDt[row], f2 = f1 * __expf(wlast - sW[row]);
      *(u32x4*)(sX1 + row * 80 + col) = scale8(rX[i], f1);
      *(u32x4*)(sX2 + row * 80 + col) = scale8(rX[i], f2);
    }
    __syncthreads();
    if (cc + 1 < 32) prefetch(cc + 1);
    f32x16 ay;
#pragma unroll
    for (int e = 0; e < 16; ++e) ay[e] = 0.f;
#pragma unroll
    for (int ks = 0; ks < 8; ++ks) {
      bf16x8 a = ldfrag(sS, 136, 32 * ph + r, 16 * ks + 8 * h);
      bf16x8 b = ldfrag(sC, 136, 32 * lt + r, 16 * ks + 8 * h);
      ay = MFMA32(a, b, ay);
    }
    const float wl = sW[32 * lt + r];
    {
      const float ewl = __expf(wl);
#pragma unroll
      for (int e = 0; e < 16; ++e) ay[e] *= ewl;
    }
    for (int st = 0; st <= lt; ++st) {
      f32x16 g;
#pragma unroll
      for (int e = 0; e < 16; ++e) g[e] = 0.f;
#pragma unroll
      for (int ks = 0; ks < 8; ++ks) {
        bf16x8 a = ldfrag(sB, 136, 32 * st + r, 16 * ks + 8 * h);
        bf16x8 b = ldfrag(sC, 136, 32 * lt + r, 16 * ks + 8 * h);
        g = MFMA32(a, b, g);
      }
#pragma unroll
      for (int e = 0; e < 16; ++e) {
        const int sidx = 32 * st + crow(e, h);
        const float f = (sidx <= 32 * lt + r) ? __expf(wl - sW[sidx]) : 0.f;
        g[e] *= f;
      }
#pragma unroll
      for (int s2 = 0; s2 < 2; ++s2) {
        bf16x8 pfr = pack8(g, s2);
        bf16x8 a = ldfrag_tr_perm(sX1, 80, 32 * st + 16 * s2, 32 * ph, lane);
        ay = MFMA32(a, pfr, ay);
      }
    }
    {
      const int pp = 64 * cc + 32 * lt + r, tok = dir ? (S_ - 1 - pp) : pp;
      u16* yd = ydst + ((size_t)bl * S_ + tok) * BWID + hd * 64 + 32 * ph + 4 * h;
#pragma unroll
      for (int g4 = 0; g4 < 4; ++g4) {
        u32x2 ov; ov.x = pk2(ay[4 * g4 + 0], ay[4 * g4 + 1]); ov.y = pk2(ay[4 * g4 + 2], ay[4 * g4 + 3]);
        *(u32x2*)(yd + 8 * g4) = ov;
      }
    }
    {
      const float ew = __expf(wlast);
#pragma unroll
      for (int pt = 0; pt < 2; ++pt)
#pragma unroll
        for (int e = 0; e < 16; ++e) accS[pt][e] *= ew;
#pragma unroll
      for (int ks = 0; ks < 4; ++ks) {
        bf16x8 b = ldfrag_tr_nat(sB, 136, 16 * ks, 32 * w, lane);
#pragma unroll
        for (int pt = 0; pt < 2; ++pt) {
          bf16x8 a = ldfrag_tr_nat(sX2, 80, 16 * ks, 32 * pt, lane);
          accS[pt] = MFMA32(a, b, accS[pt]);
        }
      }
    }
    __syncthreads();
#pragma unroll
    for (int pt = 0; pt < 2; ++pt)
#pragma unroll
      for (int e = 0; e < 16; ++e) sS[(32 * pt + crow(e, h)) * 136 + 32 * w + r] = f2bf(accS[pt][e]);
  }
}

DI void s5_item(const Params& p, int l, int item, char* smem) {
  const int tid = otid(), lane = tid & 63, w = tid >> 6;
  const int wi = item * 4 + w;
  const int bl = wi >> 6, g = (wi >> 1) & 31, dir = wi & 1;
  float* sBu = (float*)(smem + w * 12800);
  u16* sX = (u16*)(smem + w * 12800 + 8448);
  const int c16 = lane & 15, kg = lane >> 4;
  const float* lre = p.in[15] + ((size_t)(l * 2 + dir) * 32 + g) * 64;
  const float* lim = p.in[16] + ((size_t)(l * 2 + dir) * 32 + g) * 64;
  const float dt = expf(p.in[17][(l * 2 + dir) * 32 + g]);
  const float* bre = p.in[18] + ((size_t)l * 32 + g) * 64 * 16;
  const float* bim = p.in[19] + ((size_t)l * 32 + g) * 64 * 16;
  const float* cre = p.in[20] + (((size_t)(l * 2 + dir) * 32 + g) * 16) * 64;
  const float* cim = p.in[21] + (((size_t)(l * 2 + dir) * 32 + g) * 16) * 64;
  float ar, ai;
  {
    const float lr = lre[lane], li = lim[lane];
    const float mag = expf(lr * dt);
    ar = mag * cosf(li * dt); ai = mag * sinf(li * dt);
  }
  bf16x8 bfr[8];
#pragma unroll
  for (int ct = 0; ct < 4; ++ct) {
    const int st = 16 * ct + c16;
    const float lr = lre[st], li = lim[st];
    const float mag = expf(lr * dt);
    const float a_r = mag * cosf(li * dt), a_i = mag * sinf(li * dt);
    const float den = lr * lr + li * li;
    const float fr = ((a_r - 1.f) * lr + a_i * li) / den, fi = (a_i * lr - (a_r - 1.f) * li) / den;
    float vr[8], vi[8];
#pragma unroll
    for (int j = 0; j < 8; ++j) {
      float br_ = 0.f, bi_ = 0.f;
      if (kg < 2) { br_ = bre[st * 16 + 8 * kg + j]; bi_ = bim[st * 16 + 8 * kg + j]; }
      vr[j] = fr * br_ - fi * bi_;
      vi[j] = fr * bi_ + fi * br_;
    }
    u32x4 ur, ui;
    ur.x = pk2(vr[0], vr[1]); ur.y = pk2(vr[2], vr[3]); ur.z = pk2(vr[4], vr[5]); ur.w = pk2(vr[6], vr[7]);
    ui.x = pk2(vi[0], vi[1]); ui.y = pk2(vi[2], vi[3]); ui.z = pk2(vi[4], vi[5]); ui.w = pk2(vi[6], vi[7]);
    bfr[ct] = __builtin_bit_cast(bf16x8, ur);
    bfr[4 + ct] = __builtin_bit_cast(bf16x8, ui);
  }
  bf16x8 cfr[4];
#pragma unroll
  for (int ks = 0; ks < 4; ++ks) {
    const float* src = (ks < 2) ? (cre + c16 * 64 + 32 * ks + 8 * kg) : (cim + c16 * 64 + 32 * (ks - 2) + 8 * kg);
    const float sg = (ks < 2) ? 1.f : -1.f;
    u32x4 u;
    u.x = pk2(sg * src[0], sg * src[1]); u.y = pk2(sg * src[2], sg * src[3]);
    u.z = pk2(sg * src[4], sg * src[5]); u.w = pk2(sg * src[6], sg * src[7]);
    cfr[ks] = __builtin_bit_cast(bf16x8, u);
  }
  u16* ydst = dir ? p.o3 : p.s5f;
  const u16* Pb = p.P + (size_t)bl * S_ * PW + P_UIN + g * 16;
  float xr = 0.f, xi = 0.f;
  u32x4 ring[8];
#pragma unroll
  for (int j = 0; j < 8; ++j) {
    ring[j] = (u32x4){0u, 0u, 0u, 0u};
    const int pp = 16 * j + c16, tok = dir ? (S_ - 1 - pp) : pp;
    if (kg < 2) ring[j] = *(const u32x4*)(Pb + (size_t)tok * PW + 8 * kg);
  }
#pragma unroll 1
  for (int cc0 = 0; cc0 < S_ / 16; cc0 += 8)
#pragma unroll
  for (int j8 = 0; j8 < 8; ++j8) {
    const int cc = cc0 + j8;
    const bf16x8 ua = __builtin_bit_cast(bf16x8, ring[j8]);
    if (cc + 8 < S_ / 16) {
      const int pp = 16 * (cc + 8) + c16, tok = dir ? (S_ - 1 - pp) : pp;
      if (kg < 2) ring[j8] = *(const u32x4*)(Pb + (size_t)tok * PW + 8 * kg);
    }
    wave_lds_sync();
#pragma unroll
    for (int ct = 0; ct < 8; ++ct) {
      f32x4 d = {0.f, 0.f, 0.f, 0.f};
      d = MFMA16(ua, bfr[ct], d);
#pragma unroll
      for (int e = 0; e < 4; ++e) sBu[(4 * kg + e) * 132 + 16 * ct + c16] = d[e];
    }
    wave_lds_sync();
#pragma unroll
    for (int t = 0; t < 16; ++t) {
      const float bur = sBu[t * 132 + lane], bui = sBu[t * 132 + 64 + lane];
      const float nr = ar * xr - ai * xi + bur;
      const float ni = ar * xi + ai * xr + bui;
      xr = nr; xi = ni;
      sX[t * 136 + lane] = f2bf(xr);
      sX[t * 136 + 64 + lane] = f2bf(xi);
    }
    wave_lds_sync();
    f32x4 y = {0.f, 0.f, 0.f, 0.f};
#pragma unroll
    for (int ks = 0; ks < 4; ++ks) {
      bf16x8 a = ldfrag(sX, 136, c16, 32 * ks + 8 * kg);
      y = MFMA16(a, cfr[ks], y);
    }
#pragma unroll
    for (int e = 0; e < 4; ++e) {
      const int pp = 16 * cc + 4 * kg + e, tok = dir ? (S_ - 1 - pp) : pp;
      ydst[((size_t)bl * S_ + tok) * BWID + g * 16 + c16] = f2bf(y[e]);
    }
  }
}

DI void phase_finalize(const Params& p, int l, int Tg, int bid, int nblk) {
  const int tid_ = otid(), lane = tid_ & 63, w = tid_ >> 6;
  const float* dsk = p.in[10] + l * 8;
  const float* ng = p.in[11] + (size_t)l * BWID;
  const float* s5d = p.in[22] + (size_t)l * BWID;
  const int c0 = lane * 8, stride = nblk * 4;
  for (int tok0 = bid * 4 + w; tok0 < Tg; tok0 += 2 * stride) {
    u32x4 r_yf[2], r_yb[2], r_xs[2], r_z[2], r_sf[2], r_sb[2], r_u[2], r_uz[2];
#pragma unroll
    for (int u = 0; u < 2; ++u) {
      const int tok = tok0 + u * stride;
      if (tok < Tg) {
        r_yf[u] = *(const u32x4*)(p.o0 + (size_t)tok * BWID + c0);
        r_yb[u] = *(const u32x4*)(p.syb + (size_t)tok * BWID + c0);
        r_xs[u] = *(const u32x4*)(p.xa + (size_t)tok * 1024 + c0);
        r_z[u] = *(const u32x4*)(p.P + (size_t)tok * PW + P_SZ + c0);
        r_sf[u] = *(const u32x4*)(p.s5f + (size_t)tok * BWID + c0);
        r_sb[u] = *(const u32x4*)(p.o3 + (size_t)tok * BWID + c0);
        r_u[u] = *(const u32x4*)(p.P + (size_t)tok * PW + P_UIN + c0);
        r_uz[u] = *(const u32x4*)(p.P + (size_t)tok * PW + P_UZ + c0);
      }
    }
#pragma unroll
    for (int u = 0; u < 2; ++u) {
      const int tok = tok0 + u * stride;
      if (tok < Tg) {
        float yf[8], yb[8], xs[8], z[8];
        unpack8(r_yf[u], yf); unpack8(r_yb[u], yb); unpack8(r_xs[u], xs); unpack8(r_z[u], z);
        const float dk = dsk[c0 >> 6];
        float v[8], ss = 0.f;
#pragma unroll
        for (int j = 0; j < 8; ++j) { v[j] = (yf[j] + yb[j] + dk * xs[j]) * siluf_(z[j]); ss += v[j] * v[j]; }
        ss = wave_sum(ss);
        const float rs = rsqrtf(ss / (float)BWID + EPS_);
        u32x4 o;
        o.x = pk2(v[0] * rs * ng[c0 + 0], v[1] * rs * ng[c0 + 1]); o.y = pk2(v[2] * rs * ng[c0 + 2], v[3] * rs * ng[c0 + 3]);
        o.z = pk2(v[4] * rs * ng[c0 + 4], v[5] * rs * ng[c0 + 5]); o.w = pk2(v[6] * rs * ng[c0 + 6], v[7] * rs * ng[c0 + 7]);
        *(u32x4*)(p.o0 + (size_t)tok * BWID + c0) = o;
        float sf[8], sb[8], uu[8], gq[8], uz[8];
        unpack8(r_sf[u], sf); unpack8(r_sb[u], sb); unpack8(r_u[u], uu); unpack8(r_uz[u], uz);
#pragma unroll
        for (int j = 0; j < 8; ++j) {
          const float y = sf[j] + sb[j] + s5d[c0 + j] * uu[j];
          const float t = tanhf(0.7978845608028654f * (y + 0.044715f * y * y * y));
          gq[j] = 0.5f * y * (1.f + t);
        }
        u32x4 o2;
        o2.x = pk2(gq[0], gq[1]); o2.y = pk2(gq[2], gq[3]); o2.z = pk2(gq[4], gq[5]); o2.w = pk2(gq[6], gq[7]);
        *(u32x4*)(p.s5f + (size_t)tok * BWID + c0) = o2;
        u32x4 o3v;
        o3v.x = pk2(siluf_(uz[0]), siluf_(uz[1])); o3v.y = pk2(siluf_(uz[2]), siluf_(uz[3]));
        o3v.z = pk2(siluf_(uz[4]), siluf_(uz[5])); o3v.w = pk2(siluf_(uz[6]), siluf_(uz[7]));
        *(u32x4*)(p.syb + (size_t)tok * BWID + c0) = o3v;
      }
    }
  }
}

DI void phase_mixers(const Params& p, int l, int grp, int* ctr, char* smem, volatile int* s_itemp, int half) {
  const int BG = p.BG;
  const int n_ssd = BG * 8, n_s5 = BG * 8, n_diff = BG * 32, n_mem = BG * 32, n_win = BG * 64;
  const int total = n_ssd + n_s5 + n_diff + n_mem + n_win;
  for (;;) {
    __syncthreads();
    if (threadIdx.x == 0) *s_itemp = atomicAdd(ctr, 1);
    __syncthreads();
    int it = __builtin_amdgcn_readfirstlane(*s_itemp);
    if (it >= total) break;
    if (it < n_ssd) { if (MX & 1) ssd_item(p, l, it * 2 + half, smem); continue; }
    it -= n_ssd;
    if (it < n_s5) { if (MX & 2) s5_item(p, l, it * 2 + half, smem); continue; }
    it -= n_s5;
    if (it < n_diff) { if (MX & 4) diff_item(p, l, it * 2 + half, smem); continue; }
    it -= n_diff;
    if (it < n_mem) { if (MX & 8) mem_item(p, l, grp, it * 2 + half, smem); continue; }
    it -= n_mem;
    if (MX & 16) win_item(p, l, ((it >> 4) * 2 + half) * 16 + (it & 15), smem);
  }
}

__global__ void __launch_bounds__(512, 2) fwd_megakernel(Params p) {
  extern __shared__ __attribute__((aligned(16))) char smem[];
  __shared__ __attribute__((aligned(16))) unsigned s_misc[8];
  cg::grid_group grid = cg::this_grid();
  const int bid = blockIdx.x, nblk = gridDim.x;
  const int half = __builtin_amdgcn_readfirstlane((int)(threadIdx.x >> 8));
  const int vbid = bid * 2 + half, vnblk = nblk * 2;
  char* smem_h = smem + half * HALF_SMEM;
  const int BG = p.BG, Tg = BG * S_, ngrp = NBATCH / BG;
  if (threadIdx.x < 8) s_misc[threadIdx.x] = 0u;
  __syncthreads();
  XcdBarrier xb = xcd_barrier_post(p.bar, (volatile LAS unsigned*)s_misc);
  if (PH & 1) phase_prologue(p, smem_h, vbid, vnblk);
  if (p.BG < 0) grid.sync();
  xcd_barrier(xb);
  if (PH & 2) phase_kv(p, smem_h, vbid, vnblk);
  for (int grp = 0; grp < ngrp; ++grp) {
    const size_t rowoff = (size_t)grp * Tg * D_;
    for (int l = 0; l < 2; ++l) {
      const float* xin = (l == 0 ? p.in[0] : (const float*)p.out) + rowoff;
      if (PH & 4) phase_norm(xin, p.in[4] + (size_t)l * D_, p.h, Tg, vbid, vnblk);
      xcd_barrier(xb);
      if (PH & 8) phase_inproj(p, l, Tg, smem, bid, nblk);
      xcd_barrier(xb);
      if (PH & 16) phase_conv(p, l, Tg, vbid, vnblk);
      xcd_barrier(xb);
      if (PH & 32) phase_mixers(p, l, grp, p.ctr + grp * 2 + l, smem_h, (volatile int*)&s_misc[4], half);
      xcd_barrier(xb);
      if (PH & 64) phase_finalize(p, l, Tg, vbid, vnblk);
      xcd_barrier(xb);
      unsigned char* Gbuf = (unsigned char*)(p.P + (size_t)Tg * D_);
      phase_gates(p, l, Tg, Gbuf, smem, bid, nblk);
      if (PH & 128) phase_glu(p, l, Tg, smem, bid, nblk);
      xcd_barrier(xb);
      if (PH & 256) phase_merge(p, l, Tg, Gbuf, p.P, smem, bid, nblk);
      xcd_barrier(xb);
      if (PH & 512) phase_out(p, l, Tg, p.P, xin, p.out + rowoff, smem, bid, nblk);
      xcd_barrier(xb);
    }
  }
  if (PH & 1024) phase_final(p.out, p.in[3], NBATCH * S_, vbid, vnblk);
}

extern "C" void kernel_launch(void* const* d_in, const int* in_sizes, int n_in, void* d_out, int out_size, void* d_ws,
                              size_t ws_size, hipStream_t stream) {
  static int grid_blocks = 0;
  if (!grid_blocks) {
    int dev = 0, cus = 0, per_cu = 0;
    hipGetDevice(&dev);
    hipDeviceGetAttribute(&cus, hipDeviceAttributeMultiprocessorCount, dev);
    hipFuncSetAttribute((const void*)fwd_megakernel, hipFuncAttributeMaxDynamicSharedMemorySize, SMEM_BYTES);
    hipOccupancyMaxActiveBlocksPerMultiprocessor(&per_cu, fwd_megakernel, 512, SMEM_BYTES);
    if (per_cu > 1) per_cu = 1;
    if (per_cu < 1) per_cu = 1;
    grid_blocks = cus * per_cu;
  }
  Params p{};
  for (int i = 0; i < 31; ++i) p.in[i] = (const float*)d_in[i];
  p.out = (float*)d_out;
  char* ws = (char*)d_ws;
  size_t off = 0;
  auto take = [&](size_t bytes) { char* r = ws + off; off += (bytes + 255) & ~(size_t)255; return r; };
  p.W = (u16*)take(2 * LAYER_W * 2);
  p.KV = (u16*)take((size_t)2 * NBATCH * MEML * D_ * 2);
  p.memb = (u16*)take((size_t)NBATCH * MEML * D_ * 2);
  p.memrs = (float*)take(NBATCH * MEML * 4);
  p.lut = (float*)take(12 * LUTS * 4);
  p.ctr = (int*)take(4096);
  p.bar = (unsigned*)take(XCD_BAR_WORDS * 4);
  const size_t fixed = off;
  int BG = 8;
  auto need = [&](int bg) { size_t tg = (size_t)bg * S_; return fixed + tg * (D_ * 2 + (size_t)PW * 2 + 1024 * 2 + 7 * BWID * 2) + 16 * 256; };
  while (BG > 1 && need(BG) > ws_size) BG >>= 1;
  const size_t Tg = (size_t)BG * S_;
  p.h = (u16*)take(Tg * D_ * 2);
  p.P = (u16*)take(Tg * PW * 2);
  p.xa = (u16*)take(Tg * 1024 * 2);
  p.o0 = (u16*)take(Tg * BWID * 2);
  p.o1 = (u16*)take(Tg * BWID * 2);
  p.o2 = (u16*)take(Tg * BWID * 2);
  p.o3 = (u16*)take(Tg * BWID * 2);
  p.o4 = (u16*)take(Tg * BWID * 2);
  p.syb = (u16*)take(Tg * BWID * 2);
  p.s5f = (u16*)take(Tg * BWID * 2);
  p.BG = BG;
  p.pad = 0;
  hipMemsetAsync(p.ctr, 0, 4096 + ((XCD_BAR_WORDS * 4 + 255) & ~255), stream);
  void* args[] = {&p};
  hipError_t e = hipLaunchCooperativeKernel((const void*)fwd_megakernel, dim3(grid_blocks), dim3(512), args, SMEM_BYTES, stream);
  if (e != hipSuccess) fprintf(stderr, "cooperative launch failed: %s (grid %d)\n", hipGetErrorString(e), grid_blocks);
}
```
